# Optimizing an MI355X kernel written in HIP

```python
import jax, jax.numpy as jnp
from jax import lax
import numpy as np

D_MODEL = 1024
BATCH = 8
SEQ = 4096
DEPTH = 2
DEC_BATCH = 16
DEC_SEQ = 64
PAST_LEN = 1024

CHUNK = 64
POOL_WINDOWS = (2, 4, 8, 16)
POOL_GROUPS = 4
POOL_GROUP_DIM = 128
POOL_WIDTH = POOL_GROUPS * POOL_GROUP_DIM
POOL_OUT_GROUP = D_MODEL // POOL_GROUPS
POOL_HIST = max(POOL_WINDOWS) - 1
CONV_WIDTH = D_MODEL // 2
CONV_K = 3
N_BRANCH = 2
IN_WIDTH = POOL_WIDTH + 3 * CONV_WIDTH + N_BRANCH * D_MODEL
D_FF = 2816
EPS = 1e-6

kernel_name = "hybrid_pool_shortconv_convffn_stream_step"


def rmsnorm(x, g):
    xf = x.astype(jnp.float32)
    y = xf * lax.rsqrt(jnp.mean(xf * xf, axis=-1, keepdims=True) + EPS)
    return (y * g.astype(jnp.float32)).astype(x.dtype)


def causal_dwconv(u, buf, w):
    S = u.shape[1]
    ext = jnp.concatenate([buf.astype(u.dtype), u], axis=1)
    y = sum(ext[:, k:k + S] * w[k] for k in range(CONV_K))
    return y, ext[:, -(CONV_K - 1):]


def pool_mixer(u, buf, pos, w_map, scale):
    B, S, _ = u.shape
    ext = jnp.concatenate([buf.astype(u.dtype), u], axis=1)
    cs = jnp.cumsum(ext.astype(jnp.float32), axis=1)
    cs = jnp.pad(cs, ((0, 0), (1, 0), (0, 0)))
    outs = []
    for gi, win in enumerate(POOL_WINDOWS):
        sl = slice(gi * POOL_GROUP_DIM, (gi + 1) * POOL_GROUP_DIM)
        hi = cs[:, POOL_HIST + 1:POOL_HIST + 1 + S, sl]
        lo = cs[:, POOL_HIST + 1 - win:POOL_HIST + 1 - win + S, sl]
        cnt = jnp.minimum(win, pos + 1).astype(jnp.float32)[None, :, None]
        outs.append((hi - lo) / cnt)
    pooled = jnp.stack(outs, axis=2)
    mixed = (pooled - u.reshape(B, S, POOL_GROUPS, POOL_GROUP_DIM).astype(jnp.float32)).astype(u.dtype)
    y = jnp.einsum('bsgc,gcd->bsgd', mixed, w_map).reshape(B, S, D_MODEL)
    return y * scale, ext[:, -POOL_HIST:]


def layer(x, pool_buf, conv_buf, ffn_buf, pos, norm_mix_g, w_in, b_gate, w_pool_map,
          pool_scale, conv_w, w_conv_out, w_o, norm_ffn_g, w_up, ffn_conv_w, ffn_conv_b, w_down):
    h = rmsnorm(x, norm_mix_g)
    proj = jnp.einsum('bsd,de->bse', h, w_in)
    o = 0
    u_pool = proj[..., o:o + POOL_WIDTH]; o += POOL_WIDTH
    gb = proj[..., o:o + CONV_WIDTH]; o += CONV_WIDTH
    gc = proj[..., o:o + CONV_WIDTH]; o += CONV_WIDTH
    v = proj[..., o:o + CONV_WIDTH]; o += CONV_WIDTH
    gate_logits = proj[..., o:o + N_BRANCH * D_MODEL] + b_gate
    y_a, new_pool = pool_mixer(u_pool, pool_buf, pos, w_pool_map, pool_scale)
    cv, new_conv = causal_dwconv(gc * v, conv_buf, conv_w)
    y_b = jnp.einsum('bsc,cd->bsd', gb * cv, w_conv_out)
    gates = jax.nn.sigmoid(gate_logits.astype(jnp.float32)).astype(x.dtype)
    merged = gates[..., :D_MODEL] * y_a + gates[..., D_MODEL:] * y_b
    x = x + jnp.einsum('bsd,de->bse', merged, w_o)
    h = rmsnorm(x, norm_ffn_g)
    up = jnp.einsum('bsd,df->bsf', h, w_up)
    upc, new_ffn = causal_dwconv(up, ffn_buf, ffn_conv_w)
    upc = upc + ffn_conv_b
    act = jax.nn.silu(upc[..., D_FF:]) * upc[..., :D_FF]
    x = x + jnp.einsum('bsf,fd->bsd', act, w_down)
    return x, new_pool, new_conv, new_ffn


def setup_inputs(seed: int = 0) -> dict:
    key = jax.random.key(seed)
    ks = jax.random.split(key, 24)
    f32 = jnp.float32
    nrm = lambda k, shape, s: (jax.random.normal(k, shape, f32) * s)
    return {
        "x_prompt": nrm(ks[0], (BATCH, SEQ, D_MODEL), 1.0),
        "x_sample": nrm(ks[1], (DEC_BATCH, DEC_SEQ, D_MODEL), 1.0),
        "state_pool": nrm(ks[2], (DEPTH, DEC_BATCH, POOL_HIST, POOL_WIDTH), 1.0),
        "state_conv": nrm(ks[3], (DEPTH, DEC_BATCH, CONV_K - 1, CONV_WIDTH), 1.0),
        "state_ffn": nrm(ks[4], (DEPTH, DEC_BATCH, CONV_K - 1, 2 * D_FF), 1.0),
        "norm_mix_g": 1.0 + nrm(ks[5], (DEPTH, D_MODEL), 0.05),
        "w_in": nrm(ks[6], (DEPTH, D_MODEL, IN_WIDTH), D_MODEL ** -0.5),
        "b_gate": nrm(ks[7], (DEPTH, N_BRANCH * D_MODEL), 0.05),
        "w_pool_map": nrm(ks[8], (DEPTH, POOL_GROUPS, POOL_GROUP_DIM, POOL_OUT_GROUP), POOL_GROUP_DIM ** -0.5),
        "pool_scale": 1.0 + nrm(ks[9], (DEPTH, D_MODEL), 0.05),
        "conv_w": nrm(ks[10], (DEPTH, CONV_K, CONV_WIDTH), CONV_K ** -0.5),
        "w_conv_out": nrm(ks[11], (DEPTH, CONV_WIDTH, D_MODEL), CONV_WIDTH ** -0.5),
        "w_o": nrm(ks[12], (DEPTH, D_MODEL, D_MODEL), D_MODEL ** -0.5),
        "norm_ffn_g": 1.0 + nrm(ks[13], (DEPTH, D_MODEL), 0.05),
        "w_up": nrm(ks[14], (DEPTH, D_MODEL, 2 * D_FF), D_MODEL ** -0.5),
        "ffn_conv_w": nrm(ks[15], (DEPTH, CONV_K, 2 * D_FF), CONV_K ** -0.5),
        "ffn_conv_b": nrm(ks[16], (DEPTH, 2 * D_FF), 0.02),
        "w_down": nrm(ks[17], (DEPTH, D_FF, D_MODEL), D_FF ** -0.5),
        "final_norm_g": 1.0 + nrm(ks[18], (D_MODEL,), 0.05),
    }


def reference(x_prompt, x_sample, state_pool, state_conv, state_ffn, norm_mix_g, w_in, b_gate,
              w_pool_map, pool_scale, conv_w, w_conv_out, w_o, norm_ffn_g, w_up, ffn_conv_w,
              ffn_conv_b, w_down, final_norm_g):
    S_p = x_prompt.shape[1]
    S_s = x_sample.shape[1]
    pos_p = jnp.arange(S_p, dtype=jnp.int32)
    pos_s = PAST_LEN + jnp.arange(S_s, dtype=jnp.int32)
    zp_pool = jnp.zeros((x_prompt.shape[0], POOL_HIST, POOL_WIDTH), x_prompt.dtype)
    zp_conv = jnp.zeros((x_prompt.shape[0], CONV_K - 1, CONV_WIDTH), x_prompt.dtype)
    zp_ffn = jnp.zeros((x_prompt.shape[0], CONV_K - 1, 2 * D_FF), x_prompt.dtype)

    xp, xs = x_prompt, x_sample
    pp, cp, fp, ps, cs_, fs = [], [], [], [], [], []
    for l in range(DEPTH):
        params = (norm_mix_g[l], w_in[l], b_gate[l], w_pool_map[l], pool_scale[l], conv_w[l],
                  w_conv_out[l], w_o[l], norm_ffn_g[l], w_up[l], ffn_conv_w[l], ffn_conv_b[l], w_down[l])
        xp, a, b, c = layer(xp, zp_pool, zp_conv, zp_ffn, pos_p, *params)
        pp.append(a); cp.append(b); fp.append(c)
        xs, a, b, c = layer(xs, state_pool[l], state_conv[l], state_ffn[l], pos_s, *params)
        ps.append(a); cs_.append(b); fs.append(c)

    y_prompt = rmsnorm(xp, final_norm_g)
    y_sample = rmsnorm(xs, final_norm_g)
    return (y_prompt, y_sample, jnp.stack(pp), jnp.stack(cp), jnp.stack(fp),
            jnp.stack(ps), jnp.stack(cs_), jnp.stack(fs))
```

```cpp
#include <hip/hip_runtime.h>
#include <hip/hip_cooperative_groups.h>
#include <cstdio>
#include <cstdint>
namespace cg = cooperative_groups;

namespace pg8 {
#define PG8_LAS __attribute__((address_space(3)))
typedef unsigned short bf16_t;
typedef short bf16x8 __attribute__((ext_vector_type(8)));
typedef float f32x4 __attribute__((ext_vector_type(4)));
typedef unsigned u32x4 __attribute__((ext_vector_type(4)));
constexpr int BM = 256, BK = 64, HALF = 128, HTB = HALF * BK * 2, STAGE_BYTES = 8 * HTB, NXCD = 8, WGM = 8;

__host__ __device__ __forceinline__ int lds_byte(int r, int c) { const int st = (r >> 4) * 2 + (c >> 5), rr = r & 15, cc = c & 31, ob = rr * 64 + cc * 2; return st * 1024 + (ob ^ (((ob >> 9) & 1) << 5)); }
__host__ __device__ __forceinline__ void stage_rc(int b, int& R, int& C) { const int st = b / 1024, sb = b % 1024, swz = sb ^ (((sb >> 9) & 1) << 5); R = (st >> 1) * 16 + swz / 64; C = (st & 1) * 32 + (swz % 64) / 2; }
__host__ __device__ __forceinline__ int perm32(int rho) { const int n = rho >> 4, i = rho & 15; return 8 * (i >> 2) + 4 * n + (i & 3); }

struct Unit { int pm, pn; };
struct Gemm { const bf16_t* A; const bf16_t* Bt; int M, N, K, lda, apn_shift, apn_bytes; };

struct StaticOrder {
    int nM, nN, nwg, G, c;
    __host__ __device__ void init(int M, int N, int G_, int c_) { nM = M / BM; nN = N / BM; nwg = nM * nN; G = G_; c = c_; }
    __host__ __device__ bool next(int i, Unit& u) const {
        const long L = (long)i * G + c; if (L >= nwg) return false;
        int wgid = (int)L; { const int q = nwg / NXCD, r = nwg % NXCD, xcd = wgid % NXCD, off = wgid / NXCD; wgid = (xcd < r ? xcd * (q + 1) : r * (q + 1) + (xcd - r) * q) + off; }
        const int nig = WGM * nN, gid = wgid / nig, fm = gid * WGM, gsz = (nM - fm) < WGM ? (nM - fm) : WGM;
        u.pm = fm + ((wgid % nig) % gsz); u.pn = (wgid % nig) / gsz; return true;
    }
    __device__ __forceinline__ void a_ready(const Unit&) const {}
    __device__ __forceinline__ void done(const Unit&) const {}
};

__device__ __forceinline__ unsigned cvt_pk_bf16(float lo, float hi) { unsigned r; asm volatile("v_cvt_pk_bf16_f32 %0, %1, %2" : "=v"(r) : "v"(lo), "v"(hi)); return r; }

template <class Epi, class Sched, bool ALIGN_EPI = false, bool SP2 = false>
__device__ __forceinline__ void gemm_phase(PG8_LAS unsigned char* lds, const Gemm g, const Sched& S, const Epi& E) {
    int tid_ = threadIdx.x; asm volatile("" : "+v"(tid_));
    const int tid = tid_, wid = __builtin_amdgcn_readfirstlane(tid >> 6), lane = tid & 63, wr = wid >> 2, wc = wid & 3, fr = lane & 15, fq = lane >> 4;
    const int K = g.K, nt = K / BK, lda = g.lda;
    unsigned voffA[2], voffB[2];
#pragma unroll
    for (int i = 0; i < 2; ++i) { int R, C; stage_rc(tid * 16 + i * 8192, R, C); const int Rb = Epi::PERM ? ((R & ~31) + perm32(R & 31)) : R;
        voffA[i] = (unsigned)(R * lda + C) * 2u; voffB[i] = (unsigned)(Rb * K + C) * 2u; }
    const size_t kstep = (size_t)(BK * 2);
    const size_t hstepA = (size_t)HALF * lda * 2, hstepB = (size_t)HALF * K * 2;
    const size_t tstepA = 2 * hstepA, tstepB = 2 * hstepB;
    const unsigned ldsw = (unsigned)wid * 1024u;
    const int aoff = lds_byte(wr * 64 + fr, fq * 8), boff = lds_byte(wc * 32 + fr, fq * 8);
#define PG8_SA(b, h) (((b) * 2 + (h)) * HTB)
#define PG8_SB(b, h) ((4 + (b) * 2 + (h)) * HTB)
#define PG8_STAGE(bufoff, gbase, voff) do { _Pragma("unroll") for (int _i = 0; _i < 2; ++_i) \
        __builtin_amdgcn_global_load_lds((const unsigned*)((const char*)(gbase) + (voff)[_i]), (PG8_LAS unsigned*)(lds + (bufoff) + ldsw + _i * 8192), 16, 0, 0); } while (0)
#define PG8_LDA(dst, b, h) do { _Pragma("unroll") for (int m = 0; m < 4; ++m) _Pragma("unroll") for (int k = 0; k < 2; ++k) dst[m][k] = *(const PG8_LAS bf16x8*)(lds + PG8_SA(b, h) + aoff + m * 2048 + k * 1024); } while (0)
#define PG8_LDB(dst, b, h) do { _Pragma("unroll") for (int n = 0; n < 2; ++n) _Pragma("unroll") for (int k = 0; k < 2; ++k) dst[n][k] = *(const PG8_LAS bf16x8*)(lds + PG8_SB(b, h) + boff + n * 2048 + k * 1024); } while (0)
#define PG8_MMA(ai, bj, At, Bt) do { __builtin_amdgcn_s_setprio(1); _Pragma("unroll") for (int m = 0; m < 4; ++m) _Pragma("unroll") for (int n = 0; n < 2; ++n) _Pragma("unroll") for (int k = 0; k < 2; ++k) \
        acc[ai][bj][m][n] = __builtin_amdgcn_mfma_f32_16x16x32_bf16(Bt[n][k], At[m][k], acc[ai][bj][m][n], 0, 0, 0); __builtin_amdgcn_s_setprio(0); } while (0)
#define PG8_WAIT_V(n) asm volatile("s_waitcnt vmcnt(" #n ")" ::: "memory")
#define PG8_WAIT_L(n) asm volatile("s_waitcnt lgkmcnt(" #n ")" ::: "memory")
#define PG8_BAR __builtin_amdgcn_s_barrier()
#define PG8_SCHED __builtin_amdgcn_sched_barrier(0)
    Unit cur, nxt; int ui = 0;
    if (!S.next(0, cur)) return;
    f32x4 acc[2][2][4][2];
#pragma unroll
    for (int a = 0; a < 2; ++a)
#pragma unroll
        for (int b = 0; b < 2; ++b)
#pragma unroll
            for (int m = 0; m < 4; ++m)
#pragma unroll
                for (int n = 0; n < 2; ++n) acc[a][b][m][n] = (f32x4){0.f, 0.f, 0.f, 0.f};
    bf16x8 At[4][2], B0[2][2], B1[2][2];
    const char* cA = (const char*)g.A + (size_t)cur.pm * tstepA + (size_t)(cur.pn >> g.apn_shift) * g.apn_bytes; const char* cB = (const char*)g.Bt + (size_t)cur.pn * tstepB;
    S.a_ready(cur);
    if constexpr (SP2) {
        PG8_STAGE(PG8_SB(0, 0), cB, voffB); PG8_STAGE(PG8_SB(0, 1), cB + hstepB, voffB); PG8_STAGE(PG8_SA(0, 0), cA, voffA); PG8_STAGE(PG8_SA(0, 1), cA + hstepA, voffA);
        if (wr == 1) PG8_BAR;
        PG8_WAIT_V(2); PG8_BAR;
        PG8_STAGE(PG8_SB(1, 0), cB + kstep, voffB); PG8_STAGE(PG8_SA(1, 0), cA + kstep, voffA); PG8_STAGE(PG8_SB(1, 1), cB + hstepB + kstep, voffB);
        PG8_WAIT_V(6); PG8_BAR;
    } else {
        PG8_STAGE(PG8_SB(0, 0), cB, voffB); PG8_STAGE(PG8_SA(0, 0), cA, voffA); PG8_STAGE(PG8_SB(0, 1), cB + hstepB, voffB); PG8_STAGE(PG8_SA(0, 1), cA + hstepA, voffA);
        if (wr == 1) PG8_BAR;
        PG8_WAIT_V(4); PG8_BAR;
        PG8_STAGE(PG8_SB(1, 0), cB + kstep, voffB); PG8_STAGE(PG8_SA(1, 0), cA + kstep, voffA); PG8_STAGE(PG8_SB(1, 1), cB + hstepB + kstep, voffB);
        PG8_WAIT_V(6); PG8_BAR;
    }
    for (;;) {
        const bool has_next = S.next(ui + 1, nxt);
        const char* nA = has_next ? (const char*)g.A + (size_t)nxt.pm * tstepA + (size_t)(nxt.pn >> g.apn_shift) * g.apn_bytes : cA; const char* nB = has_next ? (const char*)g.Bt + (size_t)nxt.pn * tstepB : cB;
#pragma unroll 1
        for (int t = 0; t < nt; t += 2) {
            const bool last = (t == nt - 2);
            const char* a1 = cA + (size_t)(t + 1) * kstep;
            const char* a2 = last ? nA : cA + (size_t)(t + 2) * kstep; const char* b2 = last ? nB : cB + (size_t)(t + 2) * kstep;
            const char* a3 = a2 + kstep; const char* b3 = b2 + kstep;
            if (last && has_next) S.a_ready(nxt);
            if constexpr (SP2) {
            PG8_LDB(B0, 0, 0); PG8_LDB(B1, 0, 1); PG8_SCHED; PG8_LDA(At, 0, 0); PG8_STAGE(PG8_SA(1, 1), a1 + hstepA, voffA);
            PG8_WAIT_V(8); PG8_WAIT_L(0); PG8_BAR; PG8_MMA(0, 0, At, B0); PG8_MMA(0, 1, At, B1); PG8_BAR; PG8_SCHED;
            PG8_LDA(At, 0, 1); PG8_STAGE(PG8_SB(0, 0), b2, voffB); PG8_STAGE(PG8_SB(0, 1), b2 + hstepB, voffB); PG8_STAGE(PG8_SA(0, 0), a2, voffA);
            PG8_WAIT_V(8); PG8_WAIT_L(0); PG8_BAR; PG8_MMA(1, 0, At, B0); PG8_MMA(1, 1, At, B1); PG8_BAR; PG8_SCHED;
            PG8_LDB(B0, 1, 0); PG8_LDB(B1, 1, 1); PG8_SCHED; PG8_LDA(At, 1, 0); PG8_STAGE(PG8_SA(0, 1), a2 + hstepA, voffA);
            PG8_WAIT_V(8); PG8_WAIT_L(0); PG8_BAR; PG8_MMA(0, 0, At, B0); PG8_MMA(0, 1, At, B1); PG8_BAR; PG8_SCHED;
            PG8_LDA(At, 1, 1); PG8_STAGE(PG8_SB(1, 0), b3, voffB); PG8_STAGE(PG8_SB(1, 1), b3 + hstepB, voffB); PG8_STAGE(PG8_SA(1, 0), a3, voffA);
            PG8_WAIT_V(8); PG8_WAIT_L(0); PG8_BAR; PG8_MMA(1, 0, At, B0); PG8_MMA(1, 1, At, B1); PG8_BAR; PG8_SCHED;
            } else {
            PG8_LDB(B0, 0, 0); PG8_SCHED; PG8_LDA(At, 0, 0); PG8_STAGE(PG8_SA(1, 1), a1 + hstepA, voffA);
            PG8_WAIT_L(8); PG8_BAR; PG8_WAIT_L(0); PG8_MMA(0, 0, At, B0); PG8_BAR; PG8_SCHED;
            PG8_LDB(B1, 0, 1); PG8_STAGE(PG8_SB(0, 0), b2, voffB);
            PG8_BAR; PG8_WAIT_L(0); PG8_MMA(0, 1, At, B1); PG8_BAR;
            PG8_LDA(At, 0, 1); PG8_STAGE(PG8_SA(0, 0), a2, voffA);
            PG8_BAR; PG8_WAIT_L(0); PG8_MMA(1, 0, At, B0); PG8_BAR; PG8_SCHED;
            PG8_STAGE(PG8_SB(0, 1), b2 + hstepB, voffB);
            PG8_WAIT_V(6); PG8_BAR; PG8_MMA(1, 1, At, B1); PG8_BAR;
            PG8_LDB(B0, 1, 0); PG8_SCHED; PG8_LDA(At, 1, 0); PG8_STAGE(PG8_SA(0, 1), a2 + hstepA, voffA);
            PG8_WAIT_L(8); PG8_BAR; PG8_WAIT_L(0); PG8_MMA(0, 0, At, B0); PG8_BAR; PG8_SCHED;
            PG8_LDB(B1, 1, 1); PG8_STAGE(PG8_SB(1, 0), b3, voffB);
            PG8_BAR; PG8_WAIT_L(0); PG8_MMA(0, 1, At, B1); PG8_BAR;
            PG8_LDA(At, 1, 1); PG8_STAGE(PG8_SA(1, 0), a3, voffA);
            PG8_BAR; PG8_WAIT_L(0); PG8_MMA(1, 0, At, B0); PG8_BAR; PG8_SCHED;
            PG8_STAGE(PG8_SB(1, 1), b3 + hstepB, voffB);
            PG8_WAIT_V(6); PG8_BAR; PG8_MMA(1, 1, At, B1); PG8_BAR;
            }
        }
        if constexpr (ALIGN_EPI) { if (wr == 0) PG8_BAR; }
        E(acc, cur, wr, wc, fr, fq); S.done(cur);
        if (!has_next) break;
#pragma unroll
        for (int a = 0; a < 2; ++a)
#pragma unroll
            for (int b = 0; b < 2; ++b)
#pragma unroll
                for (int m = 0; m < 4; ++m)
#pragma unroll
                    for (int n = 0; n < 2; ++n) acc[a][b][m][n] = (f32x4){0.f, 0.f, 0.f, 0.f};
        cur = nxt; cA = nA; cB = nB; ++ui;
        if constexpr (ALIGN_EPI) { if (wr == 1) PG8_BAR; }
    }
    PG8_WAIT_V(0);
    if constexpr (!ALIGN_EPI) { if (wr == 0) PG8_BAR; }
    PG8_BAR;
#undef PG8_SA
#undef PG8_SB
#undef PG8_STAGE
#undef PG8_LDA
#undef PG8_LDB
#undef PG8_MMA
#undef PG8_WAIT_V
#undef PG8_WAIT_L
#undef PG8_BAR
#undef PG8_SCHED
}
}

typedef unsigned short bf16;
typedef float f32x4 __attribute__((ext_vector_type(4)));
typedef unsigned u32x4 __attribute__((ext_vector_type(4)));
typedef unsigned u32x2 __attribute__((ext_vector_type(2)));
#define LAS __attribute__((address_space(3)))

constexpr int D = 1024, MP = 32768, MS = 1024, M = MP + MS, NTILE = M / 256, NTP = MP / 256;
constexpr int INW = 4096, PW = 512, CW = 512, FF = 2816, FF2 = 5632;
constexpr float EPS = 1e-6f;
constexpr int NWAVES = 8, NTHR = 512;
constexpr int LDS_BYTES = 147456;
#ifndef PHMASK
#define PHMASK 0xFFFF
#endif

constexpr size_t O_POOLP = (size_t)M * D;
constexpr size_t O_CONVP = O_POOLP + 2 * 8 * 15 * 512;
constexpr size_t O_FFNP = O_CONVP + 2 * 8 * 2 * 512;
constexpr size_t O_POOLS = O_FFNP + 2 * 8 * 2 * 5632;
constexpr size_t O_CONVS = O_POOLS + 2 * 16 * 15 * 512;
constexpr size_t O_FFNS = O_CONVS + 2 * 16 * 2 * 512;
constexpr size_t O_END = O_FFNS + 2 * 16 * 2 * 5632;

constexpr size_t MiB = 1u << 20;
constexpr size_t WS_SSQ = 1 * MiB;
constexpr size_t WS_W = 4 * MiB, W_LAYER = 28 * MiB;
constexpr size_t WO_IN = 0, WO_UP = 8 * MiB, WO_DN = 19 * MiB, WO_O = 24 * MiB + MiB / 2, WO_CO = 26 * MiB + MiB / 2, WO_MAP = 27 * MiB + MiB / 2;
constexpr size_t WS_XB = 60 * MiB;
constexpr size_t WS_ACTV = 126 * MiB;
constexpr size_t WS_UPOOL = WS_ACTV, WS_CVIN = WS_ACTV + 33 * MiB, WS_GB = WS_ACTV + 66 * MiB, WS_SA = WS_ACTV + 99 * MiB, WS_SB = WS_ACTV + 165 * MiB,
                 WS_MIXED = WS_ACTV + 231 * MiB, WS_GBCV = WS_ACTV + 264 * MiB, WS_MA = WS_ACTV;
constexpr size_t WS_ACT = WS_ACTV;
constexpr size_t WS_UPC = WS_ACTV + 182 * MiB;
constexpr size_t WS_END = WS_UPC + 187 * MiB;
constexpr int CH0_TILES = 64, CH1_TILES = NTILE - CH0_TILES;

__device__ __forceinline__ float bf_lo(unsigned w) { return __builtin_bit_cast(float, w << 16); }
__device__ __forceinline__ float bf_hi(unsigned w) { return __builtin_bit_cast(float, w & 0xffff0000u); }
__device__ __forceinline__ unsigned pk2(float lo, float hi) { return pg8::cvt_pk_bf16(lo, hi); }
__device__ __forceinline__ float sigmoidf_(float x) { return __builtin_amdgcn_rcpf(1.f + __builtin_amdgcn_exp2f(-1.44269504f * x)); }
#define UNPACK8(V_, F_) do { F_[0] = bf_lo((V_)[0]); F_[1] = bf_hi((V_)[0]); F_[2] = bf_lo((V_)[1]); F_[3] = bf_hi((V_)[1]); F_[4] = bf_lo((V_)[2]); F_[5] = bf_hi((V_)[2]); F_[6] = bf_lo((V_)[3]); F_[7] = bf_hi((V_)[3]); } while (0)

__device__ __forceinline__ void unit_rstd(const float* ssq, int pm, int wr, int fr, int fq, float (&r)[2][4]) {
    const int lane = fq * 16 + fr;
#pragma unroll
    for (int ai = 0; ai < 2; ++ai) {
        const f32x4* p = (const f32x4*)(ssq + (size_t)(pm * 256 + ai * 128 + wr * 64 + lane) * 16);
        const f32x4 a = p[0], b = p[1], c = p[2], d = p[3];
        const float s = ((a.x + a.y) + (a.z + a.w)) + ((b.x + b.y) + (b.z + b.w)) + ((c.x + c.y) + (c.z + c.w)) + ((d.x + d.y) + (d.z + d.w));
        const float rs = 1.0f / sqrtf(s * (1.0f / D) + EPS);
#pragma unroll
        for (int m = 0; m < 4; ++m) r[ai][m] = __shfl(rs, m * 16 + fr);
    }
}

template <class T> __device__ __forceinline__ T* launder_s(T* p) { asm volatile("" : "+s"(p)); return p; }
struct EpiProj {
    static constexpr bool PERM = true, AFTER_DRAIN = false;
    unsigned char* ws; float* out; const float* b_gate; const float* pool_scale; int l;
    __device__ __forceinline__ void operator()(const f32x4 (&acc)[2][2][4][2], const pg8::Unit& u, int wr, int wc, int fr, int fq) const {
        unsigned char* w_ = launder_s(ws); float* o_ = launder_s(out);
        float r[2][4]; unit_rstd((const float*)(w_ + WS_SSQ), u.pm, wr, fr, fq, r);
        const int pm = u.pm, pn = u.pn;
        const int lc0 = wc * 32 + 8 * fq;
        const bool samp = pm >= NTP;
        if (pn < 4) {
            bf16* O = (bf16*)(w_ + ((pn < 2) ? WS_UPOOL : WS_GB)); const int cb = (pn & 1) * 256 + lc0;
#pragma unroll
            for (int ai = 0; ai < 2; ++ai)
#pragma unroll
                for (int m = 0; m < 4; ++m) { const size_t row = (size_t)pm * 256 + ai * 128 + wr * 64 + m * 16 + fr; const float rr = r[ai][m];
#pragma unroll
                    for (int bj = 0; bj < 2; ++bj) { const f32x4 v0 = acc[ai][bj][m][0] * rr, v1 = acc[ai][bj][m][1] * rr; u32x4 w;
                        w.x = pk2(v0[0], v0[1]); w.y = pk2(v0[2], v0[3]); w.z = pk2(v1[0], v1[1]); w.w = pk2(v1[2], v1[3]);
                        *(u32x4*)(O + row * 512 + cb + bj * 128) = w; } }
            if (pn < 2 && (samp || ((pm & 15) == 15 && wr == 1)) && fr >= 1) {
                float* pool_p = o_ + O_POOLP + (size_t)l * 8 * 15 * 512; float* pool_s = o_ + O_POOLS + (size_t)l * 16 * 15 * 512;
#pragma unroll
                for (int ai = 0; ai < 2; ++ai) { if (!samp && ai == 0) continue;
                    float* sp = samp ? pool_s + ((size_t)((pm - NTP) * 4 + ai * 2 + wr) * 15 + (fr - 1)) * 512 : pool_p + ((size_t)(pm >> 4) * 15 + (fr - 1)) * 512;
                    const float rr = r[ai][3];
#pragma unroll
                    for (int bj = 0; bj < 2; ++bj) { *(f32x4*)(sp + cb + bj * 128) = acc[ai][bj][3][0] * rr; *(f32x4*)(sp + cb + bj * 128 + 4) = acc[ai][bj][3][1] * rr; } }
            }
        } else if (pn < 8) {
            const int cb = (pn - 4) * 128 + lc0; bf16* CVIN = (bf16*)(w_ + WS_CVIN);
            float* conv_p = o_ + O_CONVP + (size_t)l * 8 * 2 * 512; float* conv_s = o_ + O_CONVS + (size_t)l * 16 * 2 * 512;
#pragma unroll
            for (int ai = 0; ai < 2; ++ai)
#pragma unroll
                for (int m = 0; m < 4; ++m) { const size_t row = (size_t)pm * 256 + ai * 128 + wr * 64 + m * 16 + fr; const float rr = r[ai][m] * r[ai][m];
                    const f32x4 v0 = acc[ai][0][m][0] * acc[ai][1][m][0] * rr, v1 = acc[ai][0][m][1] * acc[ai][1][m][1] * rr; u32x4 w;
                    w.x = pk2(v0[0], v0[1]); w.y = pk2(v0[2], v0[3]); w.z = pk2(v1[0], v1[1]); w.w = pk2(v1[2], v1[3]);
                    *(u32x4*)(CVIN + row * 512 + cb) = w;
                    if (m == 3 && fr >= 14 && (samp || ((pm & 15) == 15 && wr == 1 && ai == 1))) {
                        float* sp = samp ? conv_s + ((size_t)((pm - NTP) * 4 + ai * 2 + wr) * 2 + (fr - 14)) * 512 : conv_p + ((size_t)(pm >> 4) * 2 + (fr - 14)) * 512;
                        *(f32x4*)(sp + cb) = v0; *(f32x4*)(sp + cb + 4) = v1; } }
        } else {
            const bool ga = pn < 12; bf16* O = (bf16*)(w_ + (ga ? WS_SA : WS_SB)); const int cb = ((pn - 8) & 3) * 256 + lc0; const float* bg = b_gate + (ga ? 0 : D);
#pragma unroll
            for (int bj = 0; bj < 2; ++bj) { const int c = cb + bj * 128;
                const f32x4 b0 = *(const f32x4*)(bg + c), b1 = *(const f32x4*)(bg + c + 4);
                f32x4 s0 = (f32x4){1.f, 1.f, 1.f, 1.f}, s1 = s0; if (ga) { s0 = *(const f32x4*)(pool_scale + c); s1 = *(const f32x4*)(pool_scale + c + 4); }
#pragma unroll
                for (int ai = 0; ai < 2; ++ai)
#pragma unroll
                    for (int m = 0; m < 4; ++m) { const size_t row = (size_t)pm * 256 + ai * 128 + wr * 64 + m * 16 + fr; const float rr = r[ai][m];
                        const f32x4 x0 = acc[ai][bj][m][0] * rr + b0, x1 = acc[ai][bj][m][1] * rr + b1; f32x4 v0, v1;
#pragma unroll
                        for (int e = 0; e < 4; ++e) { v0[e] = sigmoidf_(x0[e]) * s0[e]; v1[e] = sigmoidf_(x1[e]) * s1[e]; }
                        u32x4 w; w.x = pk2(v0[0], v0[1]); w.y = pk2(v0[2], v0[3]); w.z = pk2(v1[0], v1[1]); w.w = pk2(v1[2], v1[3]);
                        *(u32x4*)(O + row * 1024 + c) = w; } }
        }
    }
};

struct EpiMA {
    static constexpr bool PERM = true, AFTER_DRAIN = false;
    const bf16* SA; bf16* MA;
    __device__ __forceinline__ void operator()(const f32x4 (&acc)[2][2][4][2], const pg8::Unit& u, int wr, int wc, int fr, int fq) const {
        const int cb = u.pn * 256 + wc * 32 + 8 * fq;
#pragma unroll
        for (int ai = 0; ai < 2; ++ai)
#pragma unroll
            for (int m = 0; m < 4; ++m) { const size_t row = (size_t)u.pm * 256 + ai * 128 + wr * 64 + m * 16 + fr;
#pragma unroll
                for (int bj = 0; bj < 2; ++bj) { const size_t o = row * 1024 + cb + bj * 128; const u32x4 s = *(const u32x4*)(SA + o); float f[8]; UNPACK8(s, f);
                    const f32x4 a0 = acc[ai][bj][m][0], a1 = acc[ai][bj][m][1]; u32x4 w;
                    w.x = pk2(a0[0] * f[0], a0[1] * f[1]); w.y = pk2(a0[2] * f[2], a0[3] * f[3]); w.z = pk2(a1[0] * f[4], a1[1] * f[5]); w.w = pk2(a1[2] * f[6], a1[3] * f[7]);
                    *(u32x4*)(MA + o) = w; }
                asm volatile("" ::: "memory"); }
    }
};
struct EpiMerge {
    static constexpr bool PERM = true, AFTER_DRAIN = false;
    const bf16* SB; bf16* MA;
    __device__ __forceinline__ void operator()(const f32x4 (&acc)[2][2][4][2], const pg8::Unit& u, int wr, int wc, int fr, int fq) const {
        const int cb = u.pn * 256 + wc * 32 + 8 * fq;
#pragma unroll
        for (int ai = 0; ai < 2; ++ai)
#pragma unroll
            for (int m = 0; m < 4; ++m) { const size_t row = (size_t)u.pm * 256 + ai * 128 + wr * 64 + m * 16 + fr;
#pragma unroll
                for (int bj = 0; bj < 2; ++bj) { const size_t o = row * 1024 + cb + bj * 128; const u32x4 s = *(const u32x4*)(SB + o); const u32x4 p = *(const u32x4*)(MA + o);
                    float f[8], q[8]; UNPACK8(s, f); UNPACK8(p, q);
                    const f32x4 a0 = acc[ai][bj][m][0], a1 = acc[ai][bj][m][1]; u32x4 w;
                    w.x = pk2(a0[0] * f[0] + q[0], a0[1] * f[1] + q[1]); w.y = pk2(a0[2] * f[2] + q[2], a0[3] * f[3] + q[3]);
                    w.z = pk2(a1[0] * f[4] + q[4], a1[1] * f[5] + q[5]); w.w = pk2(a1[2] * f[6] + q[6], a1[3] * f[7] + q[7]);
                    *(u32x4*)(MA + o) = w; }
                asm volatile("" ::: "memory"); }
    }
};
struct EpiRes {
    static constexpr bool PERM = true, AFTER_DRAIN = false;
    const float* base_p; const float* base_s; float* out; bf16* xb; float* ssq;
    __device__ __forceinline__ void operator()(const f32x4 (&acc)[2][2][4][2], const pg8::Unit& u, int wr, int wc, int fr, int fq) const {
        const int pm = u.pm, cb = u.pn * 256 + wc * 32 + 8 * fq;
        const float* base = pm < NTP ? base_p + (size_t)pm * 256 * D : base_s + (size_t)(pm - NTP) * 256 * D;
#pragma unroll
        for (int ai = 0; ai < 2; ++ai)
#pragma unroll
            for (int m = 0; m < 4; ++m) { const int lr = ai * 128 + wr * 64 + m * 16 + fr; const size_t row = (size_t)pm * 256 + lr; float s = 0.f;
#pragma unroll
                for (int bj = 0; bj < 2; ++bj) { const int c = cb + bj * 128;
                    const f32x4 v0 = acc[ai][bj][m][0] + *(const f32x4*)(base + (size_t)lr * D + c), v1 = acc[ai][bj][m][1] + *(const f32x4*)(base + (size_t)lr * D + c + 4);
                    *(f32x4*)(out + row * D + c) = v0; *(f32x4*)(out + row * D + c + 4) = v1;
                    u32x4 w; w.x = pk2(v0[0], v0[1]); w.y = pk2(v0[2], v0[3]); w.z = pk2(v1[0], v1[1]); w.w = pk2(v1[2], v1[3]);
                    *(u32x4*)(xb + row * D + c) = w;
                    s += (v0[0] * v0[0] + v0[1] * v0[1]) + (v0[2] * v0[2] + v0[3] * v0[3]) + (v1[0] * v1[0] + v1[1] * v1[1]) + (v1[2] * v1[2] + v1[3] * v1[3]); }
                s += __shfl_xor(s, 16); s += __shfl_xor(s, 32);
                if (fq == 0) ssq[row * 16 + u.pn * 4 + wc] = s;
                asm volatile("" ::: "memory"); }
    }
};
struct EpiUpRaw {
    static constexpr bool PERM = true, AFTER_DRAIN = false;
    unsigned char* ws; float* out; int l; int pm_off;
    __device__ __forceinline__ void operator()(const f32x4 (&acc)[2][2][4][2], const pg8::Unit& u, int wr, int wc, int fr, int fq) const {
        unsigned char* w_ = launder_s(ws); float* o_ = launder_s(out);
        const int pm = u.pm + pm_off, pn = u.pn;
        float r[2][4]; unit_rstd((const float*)(w_ + WS_SSQ), pm, wr, fr, fq, r);
        bf16* UPC = (bf16*)(w_ + WS_UPC); float* ffn_p = o_ + O_FFNP + (size_t)l * 8 * 2 * FF2; float* ffn_s = o_ + O_FFNS + (size_t)l * 16 * 2 * FF2;
        const bool samp = pm >= NTP;
        const int lc0 = wc * 32 + 8 * fq;
#pragma unroll
        for (int ai = 0; ai < 2; ++ai)
#pragma unroll
            for (int m = 0; m < 4; ++m) { const size_t lrow = (size_t)u.pm * 256 + ai * 128 + wr * 64 + m * 16 + fr; const float rr = r[ai][m];
                const bool st = (m == 3 && fr >= 14 && (samp || ((pm & 15) == 15 && wr == 1 && ai == 1)));
                float* sp = samp ? ffn_s + ((size_t)((pm - NTP) * 4 + ai * 2 + wr) * 2 + (fr - 14)) * FF2 : ffn_p + ((size_t)(pm >> 4) * 2 + (fr - 14)) * FF2;
#pragma unroll
                for (int bj = 0; bj < 2; ++bj) { const f32x4 v0 = acc[ai][bj][m][0] * rr, v1 = acc[ai][bj][m][1] * rr; u32x4 w;
                    w.x = pk2(v0[0], v0[1]); w.y = pk2(v0[2], v0[3]); w.z = pk2(v1[0], v1[1]); w.w = pk2(v1[2], v1[3]);
                    *(u32x4*)(UPC + lrow * FF2 + pn * 256 + bj * 128 + lc0) = w;
                    if (st) { const int oc = bj * FF + pn * 128 + lc0; *(f32x4*)(sp + oc) = v0; *(f32x4*)(sp + oc + 4) = v1; } } }
    }
};

struct Args { const float* in[19]; float* out; unsigned char* ws; };

struct Frame {
    LAS unsigned char* lds;
    int tid, lane, wave, G, bid;
};

__device__ __forceinline__ float wave_sum(float v) {
#pragma unroll
    for (int o = 1; o < 64; o <<= 1) v += __shfl_xor(v, o);
    return v;
}

__device__ __forceinline__ void tr_item(const float* W, int ldw, int srccol, int ks0, const float* gs, bf16* WT, int Kd, int dst_row, int kd0, bool zero, LAS float* scr, int lane) {
    if (!zero) {
#pragma unroll 8
        for (int i = 0; i < 32; ++i) { const int kk = 2 * i + (lane >> 5); float v = W[(size_t)(ks0 + kk) * ldw + srccol + (lane & 31)]; if (gs) v *= gs[ks0 + kk]; scr[kk * 33 + (lane & 31)] = v; }
    }
    asm volatile("s_waitcnt lgkmcnt(0)" ::: "memory");
    const int c = lane & 7;
#pragma unroll
    for (int j = 0; j < 4; ++j) { const int n = (lane >> 3) + 8 * j; const LAS float* s = scr + (8 * c) * 33 + n;
        u32x4 o;
        if (zero) { o = (u32x4){0u, 0u, 0u, 0u}; }
        else { o.x = pk2(s[0 * 33], s[1 * 33]); o.y = pk2(s[2 * 33], s[3 * 33]); o.z = pk2(s[4 * 33], s[5 * 33]); o.w = pk2(s[6 * 33], s[7 * 33]); }
        *(u32x4*)(WT + (size_t)(dst_row + n) * Kd + kd0 + 8 * c) = o; }
    asm volatile("s_waitcnt lgkmcnt(0)" ::: "memory");
}

constexpr int I_IN = 16 * 128, I_UP = 16 * 176, I_DN = 44 * 32, I_O = 16 * 32, I_CO = 8 * 32, I_MAP = 128;
constexpr int ITEMS_L = I_IN + I_UP + I_DN + I_O + I_CO + I_MAP;

__device__ __forceinline__ void p0_prologue(const Frame& F, const Args& a) {
    int tid_ = threadIdx.x; asm volatile("" : "+v"(tid_)); const int TID = tid_, LANE = tid_ & 63, WAVE = __builtin_amdgcn_readfirstlane(tid_ >> 6);
    LAS float* scr = (LAS float*)(F.lds + WAVE * 16384);
    const int gw = F.bid * NWAVES + WAVE, NGW = F.G * NWAVES;
    unsigned char* ws = a.ws;
    for (int it = gw; it < 2 * ITEMS_L; it += NGW) {
        const int l = it / ITEMS_L; int r = it % ITEMS_L;
        unsigned char* wl = ws + WS_W + (size_t)l * W_LAYER;
        if (r < I_IN) { const int kb = r / 128, n0 = (r % 128) * 32;
            const int src = (n0 < 1024 || n0 >= 2048) ? n0 : 1024 + 512 * (((n0 - 1024) % 256) / 128) + 128 * ((n0 - 1024) / 256) + (n0 % 128);
            tr_item(a.in[6] + (size_t)l * D * INW, INW, src, kb * 64, a.in[5] + l * D, (bf16*)(wl + WO_IN), D, n0, kb * 64, false, scr, LANE); continue; } r -= I_IN;
        if (r < I_UP) { const int kb = r / 176, n0 = (r % 176) * 32;
            const int src = ((n0 % 256) / 128) * FF + 128 * (n0 / 256) + (n0 % 128);
            tr_item(a.in[14] + (size_t)l * D * FF2, FF2, src, kb * 64, a.in[13] + l * D, (bf16*)(wl + WO_UP), D, n0, kb * 64, false, scr, LANE); continue; } r -= I_UP;
        if (r < I_DN) { const int kb = r / 32, n0 = (r % 32) * 32;
            tr_item(a.in[17] + (size_t)l * FF * D, D, n0, kb * 64, nullptr, (bf16*)(wl + WO_DN), FF, n0, kb * 64, false, scr, LANE); continue; } r -= I_DN;
        if (r < I_O) { const int kb = r / 32, n0 = (r % 32) * 32;
            tr_item(a.in[12] + (size_t)l * D * D, D, n0, kb * 64, nullptr, (bf16*)(wl + WO_O), D, n0, kb * 64, false, scr, LANE); continue; } r -= I_O;
        if (r < I_CO) { const int kb = r / 32, n0 = (r % 32) * 32;
            tr_item(a.in[11] + (size_t)l * CW * D, D, n0, kb * 64, nullptr, (bf16*)(wl + WO_CO), CW, n0, kb * 64, false, scr, LANE); continue; } r -= I_CO;
        { const int g = r / 32, kb = (r % 32) / 8, nb = r % 8; const bool zero = (kb >> 1) != (g & 1);
            tr_item(a.in[8] + (size_t)l * 4 * 128 * 256 + (size_t)g * 128 * 256, 256, nb * 32, (kb & 1) * 64, nullptr, (bf16*)(wl + WO_MAP), 256, g * 256 + nb * 32, kb * 64, zero, scr, LANE); }
    }
    bf16* XB = (bf16*)(ws + WS_XB); float* SSQ = (float*)(ws + WS_SSQ);
    for (int m = gw; m < M; m += NGW) {
        const float* xrow = m < MP ? a.in[0] + (size_t)m * D : a.in[1] + (size_t)(m - MP) * D;
        const f32x4* xr = (const f32x4*)xrow + LANE; f32x4 v[4]; float s = 0.f;
#pragma unroll
        for (int j = 0; j < 4; ++j) { v[j] = xr[64 * j]; s += (v[j].x * v[j].x + v[j].y * v[j].y) + (v[j].z * v[j].z + v[j].w * v[j].w); }
        s = wave_sum(s);
        u32x2* o8 = (u32x2*)(XB + (size_t)m * D) + LANE;
#pragma unroll
        for (int j = 0; j < 4; ++j) { u32x2 w; w.x = pk2(v[j].x, v[j].y); w.y = pk2(v[j].z, v[j].w); o8[64 * j] = w; }
        if (LANE < 16) SSQ[(size_t)m * 16 + LANE] = LANE == 0 ? s : 0.f;
    }
}

__device__ __forceinline__ void mix_elt(const Frame& F, const Args& a, int l) {
    int tid_ = threadIdx.x; asm volatile("" : "+v"(tid_)); const int TID = tid_, LANE = tid_ & 63, WAVE = __builtin_amdgcn_readfirstlane(tid_ >> 6);
    unsigned char* ws = a.ws;
    const bf16* UPOOL = (const bf16*)(ws + WS_UPOOL); const bf16* CVIN = (const bf16*)(ws + WS_CVIN); const bf16* GB = (const bf16*)(ws + WS_GB);
    bf16* MIXED = (bf16*)(ws + WS_MIXED); bf16* GBCV = (bf16*)(ws + WS_GBCV);
    const float* spool = a.in[2] + (size_t)l * 16 * 15 * 512; const float* sconv = a.in[3] + (size_t)l * 16 * 2 * 512; const float* cw = a.in[10] + (size_t)l * 3 * 512;
    const size_t total = (size_t)M * 128, stride = (size_t)F.G * NTHR;
    for (size_t idx = (size_t)F.bid * NTHR + TID; idx < total; idx += stride) {
        const int row = (int)(idx >> 7), c8 = (int)(idx & 127);
        const bool samp = row >= MP; int t, s = 0;
        if (!samp) t = row & 4095; else { const int sr = row - MP; s = sr >> 6; t = sr & 63; }
        if (c8 < 64) {
            const int ch0 = c8 * 8, win = 2 << (c8 >> 4);
            float sum[8];
#pragma unroll
            for (int e = 0; e < 8; ++e) sum[e] = 0.f;
            float f[8];
            const u32x4 uw = *(const u32x4*)(UPOOL + (size_t)row * 512 + ch0);
            for (int j = 1; j < win; ++j) {
                const int tt = t - j;
                if (tt >= 0) { const u32x4 w = *(const u32x4*)(UPOOL + (size_t)(row - j) * 512 + ch0); UNPACK8(w, f);
#pragma unroll
                    for (int e = 0; e < 8; ++e) sum[e] += f[e]; }
                else if (samp) { const float* p = spool + ((size_t)s * 15 + 15 + tt) * 512 + ch0; const f32x4 p0 = *(const f32x4*)p, p1 = *(const f32x4*)(p + 4);
#pragma unroll
                    for (int e = 0; e < 4; ++e) { sum[e] += p0[e]; sum[4 + e] += p1[e]; } }
            }
            UNPACK8(uw, f);
            const float cnt = samp ? (float)win : (float)(win < t + 1 ? win : t + 1), inv = 1.0f / cnt;
            float o[8];
#pragma unroll
            for (int e = 0; e < 8; ++e) o[e] = (sum[e] + f[e]) * inv - f[e];
            u32x4 w; w.x = pk2(o[0], o[1]); w.y = pk2(o[2], o[3]); w.z = pk2(o[4], o[5]); w.w = pk2(o[6], o[7]);
            *(u32x4*)(MIXED + (size_t)row * 512 + ch0) = w;
        } else {
            const int ch0 = (c8 - 64) * 8;
            float x0[8], x1[8], x2[8], gb[8];
            { const u32x4 w = *(const u32x4*)(CVIN + (size_t)row * 512 + ch0); UNPACK8(w, x0); }
            { const u32x4 w = *(const u32x4*)(GB + (size_t)row * 512 + ch0); UNPACK8(w, gb); }
            if (t >= 1) { const u32x4 w = *(const u32x4*)(CVIN + (size_t)(row - 1) * 512 + ch0); UNPACK8(w, x1); }
            else if (samp) { const float* p = sconv + ((size_t)s * 2 + 1) * 512 + ch0; const f32x4 p0 = *(const f32x4*)p, p1 = *(const f32x4*)(p + 4);
#pragma unroll
                for (int e = 0; e < 4; ++e) { x1[e] = p0[e]; x1[4 + e] = p1[e]; } }
            else {
#pragma unroll
                for (int e = 0; e < 8; ++e) x1[e] = 0.f; }
            if (t >= 2) { const u32x4 w = *(const u32x4*)(CVIN + (size_t)(row - 2) * 512 + ch0); UNPACK8(w, x2); }
            else if (samp) { const float* p = sconv + ((size_t)s * 2 + t) * 512 + ch0; const f32x4 p0 = *(const f32x4*)p, p1 = *(const f32x4*)(p + 4);
#pragma unroll
                for (int e = 0; e < 4; ++e) { x2[e] = p0[e]; x2[4 + e] = p1[e]; } }
            else {
#pragma unroll
                for (int e = 0; e < 8; ++e) x2[e] = 0.f; }
            float o[8];
#pragma unroll
            for (int h = 0; h < 2; ++h) { const f32x4 w0 = *(const f32x4*)(cw + ch0 + 4 * h), w1 = *(const f32x4*)(cw + 512 + ch0 + 4 * h), w2 = *(const f32x4*)(cw + 1024 + ch0 + 4 * h);
#pragma unroll
                for (int e = 0; e < 4; ++e) o[4 * h + e] = gb[4 * h + e] * (w0[e] * x2[4 * h + e] + w1[e] * x1[4 * h + e] + w2[e] * x0[4 * h + e]); }
            u32x4 w; w.x = pk2(o[0], o[1]); w.y = pk2(o[2], o[3]); w.z = pk2(o[4], o[5]); w.w = pk2(o[6], o[7]);
            *(u32x4*)(GBCV + (size_t)row * 512 + ch0) = w;
        }
    }
}

__device__ __forceinline__ void act_elt(const Frame& F, const Args& a, int l, int row0, int nrows) {
    int tid_ = threadIdx.x; asm volatile("" : "+v"(tid_)); const int TID = tid_, LANE = tid_ & 63, WAVE = __builtin_amdgcn_readfirstlane(tid_ >> 6);
    unsigned char* ws = a.ws;
    const bf16* UPC = (const bf16*)(ws + WS_UPC); bf16* ACT = (bf16*)(ws + WS_ACT);
    const float* sffn = a.in[4] + (size_t)l * 16 * 2 * FF2; const float* fw = a.in[15] + (size_t)l * 3 * FF2; const float* fb = a.in[16] + (size_t)l * FF2;
    const size_t total = (size_t)nrows * 352, stride = (size_t)F.G * NTHR;
    for (size_t idx = (size_t)F.bid * NTHR + TID; idx < total; idx += stride) {
        const int lrow = (int)(idx / 352), c8 = (int)(idx % 352); const int row = row0 + lrow;
        const int f0 = c8 * 8, pn = f0 >> 7, j0 = f0 & 127;
        const bool samp = row >= MP; int t, s = 0;
        if (!samp) t = row & 4095; else { const int sr = row - MP; s = sr >> 6; t = sr & 63; }
        float o[8];
#pragma unroll
        for (int e = 0; e < 8; ++e) o[e] = 0.f;
        float res[2][8];
#pragma unroll
        for (int h = 0; h < 2; ++h) {
            const int pc = pn * 256 + h * 128 + j0, oc = h * FF + f0;
            float x0[8], x1[8], x2[8];
            { const u32x4 w = *(const u32x4*)(UPC + (size_t)lrow * FF2 + pc); UNPACK8(w, x0); }
            if (t >= 1) { const u32x4 w = *(const u32x4*)(UPC + (size_t)(lrow - 1) * FF2 + pc); UNPACK8(w, x1); }
            else if (samp) { const float* p = sffn + ((size_t)s * 2 + 1) * FF2 + oc; const f32x4 p0 = *(const f32x4*)p, p1 = *(const f32x4*)(p + 4);
#pragma unroll
                for (int e = 0; e < 4; ++e) { x1[e] = p0[e]; x1[4 + e] = p1[e]; } }
            else {
#pragma unroll
                for (int e = 0; e < 8; ++e) x1[e] = 0.f; }
            if (t >= 2) { const u32x4 w = *(const u32x4*)(UPC + (size_t)(lrow - 2) * FF2 + pc); UNPACK8(w, x2); }
            else if (samp) { const float* p = sffn + ((size_t)s * 2 + t) * FF2 + oc; const f32x4 p0 = *(const f32x4*)p, p1 = *(const f32x4*)(p + 4);
#pragma unroll
                for (int e = 0; e < 4; ++e) { x2[e] = p0[e]; x2[4 + e] = p1[e]; } }
            else {
#pragma unroll
                for (int e = 0; e < 8; ++e) x2[e] = 0.f; }
#pragma unroll
            for (int q = 0; q < 2; ++q) { const f32x4 w0 = *(const f32x4*)(fw + oc + 4 * q), w1 = *(const f32x4*)(fw + FF2 + oc + 4 * q), w2 = *(const f32x4*)(fw + 2 * FF2 + oc + 4 * q), b = *(const f32x4*)(fb + oc + 4 * q);
#pragma unroll
                for (int e = 0; e < 4; ++e) res[h][4 * q + e] = w0[e] * x2[4 * q + e] + w1[e] * x1[4 * q + e] + w2[e] * x0[4 * q + e] + b[e]; }
        }
#pragma unroll
        for (int e = 0; e < 8; ++e) o[e] = res[1][e] * sigmoidf_(res[1][e]) * res[0][e];
        u32x4 w; w.x = pk2(o[0], o[1]); w.y = pk2(o[2], o[3]); w.z = pk2(o[4], o[5]); w.w = pk2(o[6], o[7]);
        *(u32x4*)(ACT + (size_t)row * FF + f0) = w;
    }
}

__device__ __forceinline__ void final_norm(const Frame& F, const Args& a) {
    int tid_ = threadIdx.x; asm volatile("" : "+v"(tid_)); const int TID = tid_, LANE = tid_ & 63, WAVE = __builtin_amdgcn_readfirstlane(tid_ >> 6);
    const float* SSQ = (const float*)(a.ws + WS_SSQ); const float* g = a.in[18];
    const int gw = F.bid * NWAVES + WAVE, NGW = F.G * NWAVES;
    f32x4 gv[4];
#pragma unroll
    for (int j = 0; j < 4; ++j) gv[j] = ((const f32x4*)g)[LANE + 64 * j];
    for (int m = gw; m < M; m += NGW) {
        float s = LANE < 16 ? SSQ[(size_t)m * 16 + LANE] : 0.f;
        s = wave_sum(s);
        const float rs = 1.0f / sqrtf(s * (1.0f / D) + EPS);
        f32x4* xr = (f32x4*)(a.out + (size_t)m * D) + LANE;
#pragma unroll
        for (int j = 0; j < 4; ++j) { f32x4 v = xr[64 * j]; v = v * rs * gv[j]; xr[64 * j] = v; }
    }
}

typedef const __attribute__((address_space(4))) Args* KArgs;
__device__ __forceinline__ Args load_args(KArgs kp) {
    asm volatile("" : "+s"(kp)); Args a;
#pragma unroll
    for (int i = 0; i < 19; ++i) a.in[i] = kp->in[i];
    a.out = kp->out; a.ws = kp->ws; return a;
}

__global__ void __launch_bounds__(NTHR, 2) fwd_mega(Args a_unused) {
    extern __shared__ __attribute__((aligned(16))) unsigned char lds_raw[];
    cg::grid_group grid = cg::this_grid();
    KArgs kp = (KArgs)__builtin_amdgcn_kernarg_segment_ptr();
    Frame F;
    F.lds = (LAS unsigned char*)lds_raw;
    F.tid = threadIdx.x; F.lane = F.tid & 63; F.wave = __builtin_amdgcn_readfirstlane(F.tid >> 6);
    F.G = gridDim.x; F.bid = blockIdx.x;

    if constexpr (PHMASK & 1) { const Args a = load_args(kp); p0_prologue(F, a); }
    grid.sync();

#pragma unroll 1
    for (int l = 0; l < 2; ++l) {
        if constexpr (PHMASK & 2) {
            const Args a = load_args(kp); unsigned char* ws = a.ws; unsigned char* wl = ws + WS_W + (size_t)l * W_LAYER;
            pg8::Gemm g{(const bf16*)(ws + WS_XB), (const bf16*)(wl + WO_IN), M, INW, D, D, 0, 0}; pg8::StaticOrder S; S.init(M, INW, F.G, F.bid);
            EpiProj E{ws, a.out, a.in[7] + (size_t)l * 2 * D, a.in[9] + (size_t)l * D, l};
            pg8::gemm_phase<EpiProj, pg8::StaticOrder, true, true>(F.lds, g, S, E);
        }
        grid.sync();
        if constexpr (PHMASK & 4) { const Args a = load_args(kp); mix_elt(F, a, l); }
        grid.sync();
        if constexpr (PHMASK & 8) {
            const Args a = load_args(kp); unsigned char* ws = a.ws; unsigned char* wl = ws + WS_W + (size_t)l * W_LAYER;
            pg8::Gemm g{(const bf16*)(ws + WS_MIXED), (const bf16*)(wl + WO_MAP), M, D, 256, PW, 1, 512}; pg8::StaticOrder S; S.init(M, D, F.G, F.bid);
            EpiMA E{(const bf16*)(ws + WS_SA), (bf16*)(ws + WS_MA)};
            pg8::gemm_phase<EpiMA, pg8::StaticOrder, true, true>(F.lds, g, S, E);
        }
        grid.sync();
        if constexpr (PHMASK & 16) {
            const Args a = load_args(kp); unsigned char* ws = a.ws; unsigned char* wl = ws + WS_W + (size_t)l * W_LAYER;
            pg8::Gemm g{(const bf16*)(ws + WS_GBCV), (const bf16*)(wl + WO_CO), M, D, CW, CW, 0, 0}; pg8::StaticOrder S; S.init(M, D, F.G, F.bid);
            EpiMerge E{(const bf16*)(ws + WS_SB), (bf16*)(ws + WS_MA)};
            pg8::gemm_phase<EpiMerge, pg8::StaticOrder, true, true>(F.lds, g, S, E);
        }
        grid.sync();
        if constexpr (PHMASK & 32) {
            const Args a = load_args(kp); unsigned char* ws = a.ws; unsigned char* wl = ws + WS_W + (size_t)l * W_LAYER;
            pg8::Gemm g{(const bf16*)(ws + WS_MA), (const bf16*)(wl + WO_O), M, D, D, D, 0, 0}; pg8::StaticOrder S; S.init(M, D, F.G, F.bid);
            EpiRes E{l == 0 ? a.in[0] : a.out, l == 0 ? a.in[1] : a.out + (size_t)MP * D, a.out, (bf16*)(ws + WS_XB), (float*)(ws + WS_SSQ)};
            pg8::gemm_phase<EpiRes, pg8::StaticOrder, true, true>(F.lds, g, S, E);
        }
        grid.sync();
#pragma unroll 1
        for (int ch = 0; ch < 2; ++ch) {
            const int t0 = ch == 0 ? 0 : CH0_TILES, ntl = ch == 0 ? CH0_TILES : CH1_TILES;
            if constexpr (PHMASK & 64) {
                const Args a = load_args(kp); unsigned char* ws = a.ws; unsigned char* wl = ws + WS_W + (size_t)l * W_LAYER;
                pg8::Gemm g{(const bf16*)(ws + WS_XB) + (size_t)t0 * 256 * D, (const bf16*)(wl + WO_UP), ntl * 256, FF2, D, D, 0, 0}; pg8::StaticOrder S; S.init(ntl * 256, FF2, F.G, F.bid);
                EpiUpRaw E{ws, a.out, l, t0};
                pg8::gemm_phase<EpiUpRaw, pg8::StaticOrder, true, true>(F.lds, g, S, E);
            }
            grid.sync();
            if constexpr (PHMASK & 128) { const Args a = load_args(kp); act_elt(F, a, l, t0 * 256, ntl * 256); }
            grid.sync();
        }
        if constexpr (PHMASK & 256) {
            const Args a = load_args(kp); unsigned char* ws = a.ws; unsigned char* wl = ws + WS_W + (size_t)l * W_LAYER;
            pg8::Gemm g{(const bf16*)(ws + WS_ACT), (const bf16*)(wl + WO_DN), M, D, FF, FF, 0, 0}; pg8::StaticOrder S; S.init(M, D, F.G, F.bid);
            EpiRes E{a.out, a.out + (size_t)MP * D, a.out, (bf16*)(ws + WS_XB), (float*)(ws + WS_SSQ)};
            pg8::gemm_phase<EpiRes, pg8::StaticOrder, true, true>(F.lds, g, S, E);
        }
        grid.sync();
    }
    if constexpr (PHMASK & 512) { const Args a = load_args(kp); final_norm(F, a); }
}

extern "C" void kernel_launch(void* const* d_in, const int* in_sizes, int n_in, void* d_out, int out_size, void* d_ws, size_t ws_size, hipStream_t stream) {
    static int grid = 0;
    if (grid == 0) {
        if (n_in != 19 || in_sizes[0] != MP * D || (size_t)out_size != O_END || ws_size < WS_END) {
            fprintf(stderr, "kernel_launch: unexpected shapes: n_in %d in0 %d out %d ws %zu (need %zu)\n", n_in, n_in > 0 ? in_sizes[0] : -1, out_size, ws_size, (size_t)WS_END); grid = -1; return; }
        int dev = 0, cus = 0, per_cu = 0;
        hipGetDevice(&dev); hipDeviceGetAttribute(&cus, hipDeviceAttributeMultiprocessorCount, dev);
        if (hipFuncSetAttribute((const void*)fwd_mega, hipFuncAttributeMaxDynamicSharedMemorySize, LDS_BYTES) != hipSuccess) { fprintf(stderr, "kernel_launch: hipFuncSetAttribute failed\n"); grid = -1; return; }
        if (hipOccupancyMaxActiveBlocksPerMultiprocessor(&per_cu, (const void*)fwd_mega, NTHR, LDS_BYTES) != hipSuccess || per_cu < 1) { fprintf(stderr, "kernel_launch: occupancy query says %d\n", per_cu); per_cu = 1; }
        (void)hipGetLastError();
        grid = cus;
    }
    if (grid < 0) return;
    Args a{};
    for (int i = 0; i < 19; ++i) a.in[i] = (const float*)d_in[i];
    a.out = (float*)d_out; a.ws = (unsigned char*)d_ws;
    void* args[] = {&a};
    hipError_t e = hipLaunchCooperativeKernel((const void*)fwd_mega, dim3(grid), dim3(NTHR), args, LDS_BYTES, stream);
    if (e != hipSuccess) fprintf(stderr, "cooperative launch failed: %s (grid %d)\n", hipGetErrorString(e), grid);
}
```

```cpp
#include <hip/hip_runtime.h>
#include <hip/hip_cooperative_groups.h>
#include <cstdio>
#include <cstdint>
namespace cg = cooperative_groups;

namespace pg8 {
#define PG8_LAS __attribute__((address_space(3)))
typedef unsigned short bf16_t;
typedef short bf16x8 __attribute__((ext_vector_type(8)));
typedef float f32x4 __attribute__((ext_vector_type(4)));
typedef unsigned u32x4 __attribute__((ext_vector_type(4)));
constexpr int BM = 256, BK = 64, HALF = 128, HTB = HALF * BK * 2, STAGE_BYTES = 8 * HTB, NXCD = 8, WGM = 8;

__host__ __device__ __forceinline__ int lds_byte(int r, int c) { const int st = (r >> 4) * 2 + (c >> 5), rr = r & 15, cc = c & 31, ob = rr * 64 + cc * 2; return st * 1024 + (ob ^ (((ob >> 9) & 1) << 5)); }
__host__ __device__ __forceinline__ void stage_rc(int b, int& R, int& C) { const int st = b / 1024, sb = b % 1024, swz = sb ^ (((sb >> 9) & 1) << 5); R = (st >> 1) * 16 + swz / 64; C = (st & 1) * 32 + (swz % 64) / 2; }
__host__ __device__ __forceinline__ int perm32(int rho) { const int n = rho >> 4, i = rho & 15; return 8 * (i >> 2) + 4 * n + (i & 3); }

struct Unit { int pm, pn; };
struct Gemm { const bf16_t* A; const bf16_t* Bt; int M, N, K, lda, apn_shift, apn_bytes; };

struct StaticOrder {
    int nM, nN, nwg, G, c;
    __host__ __device__ void init(int M, int N, int G_, int c_) { nM = M / BM; nN = N / BM; nwg = nM * nN; G = G_; c = c_; }
    __host__ __device__ bool next(int i, Unit& u) const {
        const long L = (long)i * G + c; if (L >= nwg) return false;
        int wgid = (int)L; { const int q = nwg / NXCD, r = nwg % NXCD, xcd = wgid % NXCD, off = wgid / NXCD; wgid = (xcd < r ? xcd * (q + 1) : r * (q + 1) + (xcd - r) * q) + off; }
        const int nig = WGM * nN, gid = wgid / nig, fm = gid * WGM, gsz = (nM - fm) < WGM ? (nM - fm) : WGM;
        u.pm = fm + ((wgid % nig) % gsz); u.pn = (wgid % nig) / gsz; return true;
    }
    __device__ __forceinline__ void a_ready(const Unit&) const {}
    __device__ __forceinline__ void done(const Unit&) const {}
};

__device__ __forceinline__ unsigned cvt_pk_bf16(float lo, float hi) { unsigned r; asm volatile("v_cvt_pk_bf16_f32 %0, %1, %2" : "=v"(r) : "v"(lo), "v"(hi)); return r; }

template <class Epi, class Sched, bool ALIGN_EPI = false, bool SP2 = false>
__device__ __forceinline__ void gemm_phase(PG8_LAS unsigned char* lds, const Gemm g, const Sched& S, const Epi& E) {
    int tid_ = threadIdx.x; asm volatile("" : "+v"(tid_));
    const int tid = tid_, wid = __builtin_amdgcn_readfirstlane(tid >> 6), lane = tid & 63, wr = wid >> 2, wc = wid & 3, fr = lane & 15, fq = lane >> 4;
    const int K = g.K, nt = K / BK, lda = g.lda;
    unsigned voffA[2], voffB[2];
#pragma unroll
    for (int i = 0; i < 2; ++i) { int R, C; stage_rc(tid * 16 + i * 8192, R, C); const int Rb = Epi::PERM ? ((R & ~31) + perm32(R & 31)) : R;
        voffA[i] = (unsigned)(R * lda + C) * 2u; voffB[i] = (unsigned)(Rb * K + C) * 2u; }
    const size_t kstep = (size_t)(BK * 2);
    const size_t hstepA = (size_t)HALF * lda * 2, hstepB = (size_t)HALF * K * 2;
    const size_t tstepA = 2 * hstepA, tstepB = 2 * hstepB;
    const unsigned ldsw = (unsigned)wid * 1024u;
    const int aoff = lds_byte(wr * 64 + fr, fq * 8), boff = lds_byte(wc * 32 + fr, fq * 8);
#define PG8_SA(b, h) (((b) * 2 + (h)) * HTB)
#define PG8_SB(b, h) ((4 + (b) * 2 + (h)) * HTB)
#define PG8_STAGE(bufoff, gbase, voff) do { _Pragma("unroll") for (int _i = 0; _i < 2; ++_i) \
        __builtin_amdgcn_global_load_lds((const unsigned*)((const char*)(gbase) + (voff)[_i]), (PG8_LAS unsigned*)(lds + (bufoff) + ldsw + _i * 8192), 16, 0, 0); } while (0)
#define PG8_LDA(dst, b, h) do { _Pragma("unroll") for (int m = 0; m < 4; ++m) _Pragma("unroll") for (int k = 0; k < 2; ++k) dst[m][k] = *(const PG8_LAS bf16x8*)(lds + PG8_SA(b, h) + aoff + m * 2048 + k * 1024); } while (0)
#define PG8_LDB(dst, b, h) do { _Pragma("unroll") for (int n = 0; n < 2; ++n) _Pragma("unroll") for (int k = 0; k < 2; ++k) dst[n][k] = *(const PG8_LAS bf16x8*)(lds + PG8_SB(b, h) + boff + n * 2048 + k * 1024); } while (0)
#define PG8_MMA(ai, bj, At, Bt) do { __builtin_amdgcn_s_setprio(1); _Pragma("unroll") for (int m = 0; m < 4; ++m) _Pragma("unroll") for (int n = 0; n < 2; ++n) _Pragma("unroll") for (int k = 0; k < 2; ++k) \
        acc[ai][bj][m][n] = __builtin_amdgcn_mfma_f32_16x16x32_bf16(Bt[n][k], At[m][k], acc[ai][bj][m][n], 0, 0, 0); __builtin_amdgcn_s_setprio(0); } while (0)
#define PG8_WAIT_V(n) asm volatile("s_waitcnt vmcnt(" #n ")" ::: "memory")
#define PG8_WAIT_L(n) asm volatile("s_waitcnt lgkmcnt(" #n ")" ::: "memory")
#define PG8_BAR __builtin_amdgcn_s_barrier()
#define PG8_SCHED __builtin_amdgcn_sched_barrier(0)
    Unit cur, nxt; int ui = 0;
    if (!S.next(0, cur)) return;
    f32x4 acc[2][2][4][2];
#pragma unroll
    for (int a = 0; a < 2; ++a)
#pragma unroll
        for (int b = 0; b < 2; ++b)
#pragma unroll
            for (int m = 0; m < 4; ++m)
#pragma unroll
                for (int n = 0; n < 2; ++n) acc[a][b][m][n] = (f32x4){0.f, 0.f, 0.f, 0.f};
    bf16x8 At[4][2], B0[2][2], B1[2][2];
    const char* cA = (const char*)g.A + (size_t)cur.pm * tstepA + (size_t)(cur.pn >> g.apn_shift) * g.apn_bytes; const char* cB = (const char*)g.Bt + (size_t)cur.pn * tstepB;
    S.a_ready(cur);
    if constexpr (SP2) {
        PG8_STAGE(PG8_SB(0, 0), cB, voffB); PG8_STAGE(PG8_SB(0, 1), cB + hstepB, voffB); PG8_STAGE(PG8_SA(0, 0), cA, voffA); PG8_STAGE(PG8_SA(0, 1), cA + hstepA, voffA);
        if (wr == 1) PG8_BAR;
        PG8_WAIT_V(2); PG8_BAR;
        PG8_STAGE(PG8_SB(1, 0), cB + kstep, voffB); PG8_STAGE(PG8_SA(1, 0), cA + kstep, voffA); PG8_STAGE(PG8_SB(1, 1), cB + hstepB + kstep, voffB);
        PG8_WAIT_V(6); PG8_BAR;
    } else {
        PG8_STAGE(PG8_SB(0, 0), cB, voffB); PG8_STAGE(PG8_SA(0, 0), cA, voffA); PG8_STAGE(PG8_SB(0, 1), cB + hstepB, voffB); PG8_STAGE(PG8_SA(0, 1), cA + hstepA, voffA);
        if (wr == 1) PG8_BAR;
        PG8_WAIT_V(4); PG8_BAR;
        PG8_STAGE(PG8_SB(1, 0), cB + kstep, voffB); PG8_STAGE(PG8_SA(1, 0), cA + kstep, voffA); PG8_STAGE(PG8_SB(1, 1), cB + hstepB + kstep, voffB);
        PG8_WAIT_V(6); PG8_BAR;
    }
    for (;;) {
        const bool has_next = S.next(ui + 1, nxt);
        const char* nA = has_next ? (const char*)g.A + (size_t)nxt.pm * tstepA + (size_t)(nxt.pn >> g.apn_shift) * g.apn_bytes : cA; const char* nB = has_next ? (const char*)g.Bt + (size_t)nxt.pn * tstepB : cB;
#pragma unroll 1
        for (int t = 0; t < nt; t += 2) {
            const bool last = (t == nt - 2);
            const char* a1 = cA + (size_t)(t + 1) * kstep;
            const char* a2 = last ? nA : cA + (size_t)(t + 2) * kstep; const char* b2 = last ? nB : cB + (size_t)(t + 2) * kstep;
            const char* a3 = a2 + kstep; const char* b3 = b2 + kstep;
            if (last && has_next) S.a_ready(nxt);
            if constexpr (SP2) {
            PG8_LDB(B0, 0, 0); PG8_LDB(B1, 0, 1); PG8_SCHED; PG8_LDA(At, 0, 0); PG8_STAGE(PG8_SA(1, 1), a1 + hstepA, voffA);
            PG8_WAIT_V(8); PG8_WAIT_L(0); PG8_BAR; PG8_MMA(0, 0, At, B0); PG8_MMA(0, 1, At, B1); PG8_BAR; PG8_SCHED;
            PG8_LDA(At, 0, 1); PG8_STAGE(PG8_SB(0, 0), b2, voffB); PG8_STAGE(PG8_SB(0, 1), b2 + hstepB, voffB); PG8_STAGE(PG8_SA(0, 0), a2, voffA);
            PG8_WAIT_V(8); PG8_WAIT_L(0); PG8_BAR; PG8_MMA(1, 0, At, B0); PG8_MMA(1, 1, At, B1); PG8_BAR; PG8_SCHED;
            PG8_LDB(B0, 1, 0); PG8_LDB(B1, 1, 1); PG8_SCHED; PG8_LDA(At, 1, 0); PG8_STAGE(PG8_SA(0, 1), a2 + hstepA, voffA);
            PG8_WAIT_V(8); PG8_WAIT_L(0); PG8_BAR; PG8_MMA(0, 0, At, B0); PG8_MMA(0, 1, At, B1); PG8_BAR; PG8_SCHED;
            PG8_LDA(At, 1, 1); PG8_STAGE(PG8_SB(1, 0), b3, voffB); PG8_STAGE(PG8_SB(1, 1), b3 + hstepB, voffB); PG8_STAGE(PG8_SA(1, 0), a3, voffA);
            PG8_WAIT_V(8); PG8_WAIT_L(0); PG8_BAR; PG8_MMA(1, 0, At, B0); PG8_MMA(1, 1, At, B1); PG8_BAR; PG8_SCHED;
            } else {
            PG8_LDB(B0, 0, 0); PG8_SCHED; PG8_LDA(At, 0, 0); PG8_STAGE(PG8_SA(1, 1), a1 + hstepA, voffA);
            PG8_WAIT_L(8); PG8_BAR; PG8_WAIT_L(0); PG8_MMA(0, 0, At, B0); PG8_BAR; PG8_SCHED;
            PG8_LDB(B1, 0, 1); PG8_STAGE(PG8_SB(0, 0), b2, voffB);
            PG8_BAR; PG8_WAIT_L(0); PG8_MMA(0, 1, At, B1); PG8_BAR;
            PG8_LDA(At, 0, 1); PG8_STAGE(PG8_SA(0, 0), a2, voffA);
            PG8_BAR; PG8_WAIT_L(0); PG8_MMA(1, 0, At, B0); PG8_BAR; PG8_SCHED;
            PG8_STAGE(PG8_SB(0, 1), b2 + hstepB, voffB);
            PG8_WAIT_V(6); PG8_BAR; PG8_MMA(1, 1, At, B1); PG8_BAR;
            PG8_LDB(B0, 1, 0); PG8_SCHED; PG8_LDA(At, 1, 0); PG8_STAGE(PG8_SA(0, 1), a2 + hstepA, voffA);
            PG8_WAIT_L(8); PG8_BAR; PG8_WAIT_L(0); PG8_MMA(0, 0, At, B0); PG8_BAR; PG8_SCHED;
            PG8_LDB(B1, 1, 1); PG8_STAGE(PG8_SB(1, 0), b3, voffB);
            PG8_BAR; PG8_WAIT_L(0); PG8_MMA(0, 1, At, B1); PG8_BAR;
            PG8_LDA(At, 1, 1); PG8_STAGE(PG8_SA(1, 0), a3, voffA);
            PG8_BAR; PG8_WAIT_L(0); PG8_MMA(1, 0, At, B0); PG8_BAR; PG8_SCHED;
            PG8_STAGE(PG8_SB(1, 1), b3 + hstepB, voffB);
            PG8_WAIT_V(6); PG8_BAR; PG8_MMA(1, 1, At, B1); PG8_BAR;
            }
        }
        if constexpr (ALIGN_EPI) { if (wr == 0) PG8_BAR; }
        E(acc, cur, wr, wc, fr, fq); S.done(cur);
        if (!has_next) break;
#pragma unroll
        for (int a = 0; a < 2; ++a)
#pragma unroll
            for (int b = 0; b < 2; ++b)
#pragma unroll
                for (int m = 0; m < 4; ++m)
#pragma unroll
                    for (int n = 0; n < 2; ++n) acc[a][b][m][n] = (f32x4){0.f, 0.f, 0.f, 0.f};
        cur = nxt; cA = nA; cB = nB; ++ui;
        if constexpr (ALIGN_EPI) { if (wr == 1) PG8_BAR; }
    }
    PG8_WAIT_V(0);
    if constexpr (!ALIGN_EPI) { if (wr == 0) PG8_BAR; }
    PG8_BAR;
#undef PG8_SA
#undef PG8_SB
#undef PG8_STAGE
#undef PG8_LDA
#undef PG8_LDB
#undef PG8_MMA
#undef PG8_WAIT_V
#undef PG8_WAIT_L
#undef PG8_BAR
#undef PG8_SCHED
}
}

typedef unsigned short bf16;
typedef float f32x4 __attribute__((ext_vector_type(4)));
typedef unsigned u32x4 __attribute__((ext_vector_type(4)));
typedef unsigned u32x2 __attribute__((ext_vector_type(2)));
#define LAS __attribute__((address_space(3)))

constexpr int D = 1024, MP = 32768, MS = 1024, M = MP + MS, NTILE = M / 256, NTP = MP / 256;
constexpr int INW = 4096, PW = 512, CW = 512, FF = 2816, FF2 = 5632;
constexpr float EPS = 1e-6f;
constexpr int NWAVES = 8, NTHR = 512;
constexpr int LDS_BYTES = 147456;
#ifndef PHMASK
#define PHMASK 0xFFFF
#endif

constexpr size_t O_POOLP = (size_t)M * D;
constexpr size_t O_CONVP = O_POOLP + 2 * 8 * 15 * 512;
constexpr size_t O_FFNP = O_CONVP + 2 * 8 * 2 * 512;
constexpr size_t O_POOLS = O_FFNP + 2 * 8 * 2 * 5632;
constexpr size_t O_CONVS = O_POOLS + 2 * 16 * 15 * 512;
constexpr size_t O_FFNS = O_CONVS + 2 * 16 * 2 * 512;
constexpr size_t O_END = O_FFNS + 2 * 16 * 2 * 5632;

constexpr size_t MiB = 1u << 20;
constexpr size_t WS_SSQ = 1 * MiB;
constexpr size_t WS_W = 4 * MiB, W_LAYER = 28 * MiB;
constexpr size_t WO_IN = 0, WO_UP = 8 * MiB, WO_DN = 19 * MiB, WO_O = 24 * MiB + MiB / 2, WO_CO = 26 * MiB + MiB / 2, WO_MAP = 27 * MiB + MiB / 2;
constexpr size_t WS_XB = 60 * MiB;
constexpr size_t WS_ACTV = 126 * MiB;
constexpr size_t WS_UPOOL = WS_ACTV, WS_CVIN = WS_ACTV + 33 * MiB, WS_GB = WS_ACTV + 66 * MiB, WS_SA = WS_ACTV + 99 * MiB, WS_SB = WS_ACTV + 165 * MiB,
                 WS_MIXED = WS_ACTV + 231 * MiB, WS_GBCV = WS_ACTV + 264 * MiB, WS_MA = WS_ACTV;
constexpr size_t WS_ACT = WS_ACTV;
constexpr size_t WS_HALO = WS_ACTV + 182 * MiB;
constexpr size_t WS_END = WS_ACTV + 297 * MiB;
constexpr int EX_OFF = 131072;

__device__ __forceinline__ float bf_lo(unsigned w) { return __builtin_bit_cast(float, w << 16); }
__device__ __forceinline__ float bf_hi(unsigned w) { return __builtin_bit_cast(float, w & 0xffff0000u); }
__device__ __forceinline__ unsigned pk2(float lo, float hi) { return pg8::cvt_pk_bf16(lo, hi); }
__device__ __forceinline__ float sigmoidf_(float x) { return __builtin_amdgcn_rcpf(1.f + __builtin_amdgcn_exp2f(-1.44269504f * x)); }
#define UNPACK8(V_, F_) do { F_[0] = bf_lo((V_)[0]); F_[1] = bf_hi((V_)[0]); F_[2] = bf_lo((V_)[1]); F_[3] = bf_hi((V_)[1]); F_[4] = bf_lo((V_)[2]); F_[5] = bf_hi((V_)[2]); F_[6] = bf_lo((V_)[3]); F_[7] = bf_hi((V_)[3]); } while (0)

__device__ __forceinline__ void unit_rstd(const float* ssq, int pm, int wr, int fr, int fq, float (&r)[2][4]) {
    const int lane = fq * 16 + fr;
#pragma unroll
    for (int ai = 0; ai < 2; ++ai) {
        const f32x4* p = (const f32x4*)(ssq + (size_t)(pm * 256 + ai * 128 + wr * 64 + lane) * 16);
        const f32x4 a = p[0], b = p[1], c = p[2], d = p[3];
        const float s = ((a.x + a.y) + (a.z + a.w)) + ((b.x + b.y) + (b.z + b.w)) + ((c.x + c.y) + (c.z + c.w)) + ((d.x + d.y) + (d.z + d.w));
        const float rs = 1.0f / sqrtf(s * (1.0f / D) + EPS);
#pragma unroll
        for (int m = 0; m < 4; ++m) r[ai][m] = __shfl(rs, m * 16 + fr);
    }
}

template <class T> __device__ __forceinline__ T* launder_s(T* p) { asm volatile("" : "+s"(p)); return p; }
struct EpiProj {
    static constexpr bool PERM = true, AFTER_DRAIN = false;
    unsigned char* ws; float* out; const float* b_gate; const float* pool_scale; int l;
    __device__ __forceinline__ void operator()(const f32x4 (&acc)[2][2][4][2], const pg8::Unit& u, int wr, int wc, int fr, int fq) const {
        unsigned char* w_ = launder_s(ws); float* o_ = launder_s(out);
        float r[2][4]; unit_rstd((const float*)(w_ + WS_SSQ), u.pm, wr, fr, fq, r);
        const int pm = u.pm, pn = u.pn;
        const int lc0 = wc * 32 + 8 * fq;
        const bool samp = pm >= NTP;
        if (pn < 4) {
            bf16* O = (bf16*)(w_ + ((pn < 2) ? WS_UPOOL : WS_GB)); const int cb = (pn & 1) * 256 + lc0;
#pragma unroll
            for (int ai = 0; ai < 2; ++ai)
#pragma unroll
                for (int m = 0; m < 4; ++m) { const size_t row = (size_t)pm * 256 + ai * 128 + wr * 64 + m * 16 + fr; const float rr = r[ai][m];
#pragma unroll
                    for (int bj = 0; bj < 2; ++bj) { const f32x4 v0 = acc[ai][bj][m][0] * rr, v1 = acc[ai][bj][m][1] * rr; u32x4 w;
                        w.x = pk2(v0[0], v0[1]); w.y = pk2(v0[2], v0[3]); w.z = pk2(v1[0], v1[1]); w.w = pk2(v1[2], v1[3]);
                        *(u32x4*)(O + row * 512 + cb + bj * 128) = w; } }
            if (pn < 2 && (samp || ((pm & 15) == 15 && wr == 1)) && fr >= 1) {
                float* pool_p = o_ + O_POOLP + (size_t)l * 8 * 15 * 512; float* pool_s = o_ + O_POOLS + (size_t)l * 16 * 15 * 512;
#pragma unroll
                for (int ai = 0; ai < 2; ++ai) { if (!samp && ai == 0) continue;
                    float* sp = samp ? pool_s + ((size_t)((pm - NTP) * 4 + ai * 2 + wr) * 15 + (fr - 1)) * 512 : pool_p + ((size_t)(pm >> 4) * 15 + (fr - 1)) * 512;
                    const float rr = r[ai][3];
#pragma unroll
                    for (int bj = 0; bj < 2; ++bj) { *(f32x4*)(sp + cb + bj * 128) = acc[ai][bj][3][0] * rr; *(f32x4*)(sp + cb + bj * 128 + 4) = acc[ai][bj][3][1] * rr; } }
            }
        } else if (pn < 8) {
            const int cb = (pn - 4) * 128 + lc0; bf16* CVIN = (bf16*)(w_ + WS_CVIN);
            float* conv_p = o_ + O_CONVP + (size_t)l * 8 * 2 * 512; float* conv_s = o_ + O_CONVS + (size_t)l * 16 * 2 * 512;
#pragma unroll
            for (int ai = 0; ai < 2; ++ai)
#pragma unroll
                for (int m = 0; m < 4; ++m) { const size_t row = (size_t)pm * 256 + ai * 128 + wr * 64 + m * 16 + fr; const float rr = r[ai][m] * r[ai][m];
                    const f32x4 v0 = acc[ai][0][m][0] * acc[ai][1][m][0] * rr, v1 = acc[ai][0][m][1] * acc[ai][1][m][1] * rr; u32x4 w;
                    w.x = pk2(v0[0], v0[1]); w.y = pk2(v0[2], v0[3]); w.z = pk2(v1[0], v1[1]); w.w = pk2(v1[2], v1[3]);
                    *(u32x4*)(CVIN + row * 512 + cb) = w;
                    if (m == 3 && fr >= 14 && (samp || ((pm & 15) == 15 && wr == 1 && ai == 1))) {
                        float* sp = samp ? conv_s + ((size_t)((pm - NTP) * 4 + ai * 2 + wr) * 2 + (fr - 14)) * 512 : conv_p + ((size_t)(pm >> 4) * 2 + (fr - 14)) * 512;
                        *(f32x4*)(sp + cb) = v0; *(f32x4*)(sp + cb + 4) = v1; } }
        } else {
            const bool ga = pn < 12; bf16* O = (bf16*)(w_ + (ga ? WS_SA : WS_SB)); const int cb = ((pn - 8) & 3) * 256 + lc0; const float* bg = b_gate + (ga ? 0 : D);
#pragma unroll
            for (int bj = 0; bj < 2; ++bj) { const int c = cb + bj * 128;
                const f32x4 b0 = *(const f32x4*)(bg + c), b1 = *(const f32x4*)(bg + c + 4);
                f32x4 s0 = (f32x4){1.f, 1.f, 1.f, 1.f}, s1 = s0; if (ga) { s0 = *(const f32x4*)(pool_scale + c); s1 = *(const f32x4*)(pool_scale + c + 4); }
#pragma unroll
                for (int ai = 0; ai < 2; ++ai)
#pragma unroll
                    for (int m = 0; m < 4; ++m) { const size_t row = (size_t)pm * 256 + ai * 128 + wr * 64 + m * 16 + fr; const float rr = r[ai][m];
                        const f32x4 x0 = acc[ai][bj][m][0] * rr + b0, x1 = acc[ai][bj][m][1] * rr + b1; f32x4 v0, v1;
#pragma unroll
                        for (int e = 0; e < 4; ++e) { v0[e] = sigmoidf_(x0[e]) * s0[e]; v1[e] = sigmoidf_(x1[e]) * s1[e]; }
                        u32x4 w; w.x = pk2(v0[0], v0[1]); w.y = pk2(v0[2], v0[3]); w.z = pk2(v1[0], v1[1]); w.w = pk2(v1[2], v1[3]);
                        *(u32x4*)(O + row * 1024 + c) = w; } }
        }
    }
};

struct EpiMA {
    static constexpr bool PERM = true, AFTER_DRAIN = false;
    const bf16* SA; bf16* MA;
    __device__ __forceinline__ void operator()(const f32x4 (&acc)[2][2][4][2], const pg8::Unit& u, int wr, int wc, int fr, int fq) const {
        const int cb = u.pn * 256 + wc * 32 + 8 * fq;
#pragma unroll
        for (int ai = 0; ai < 2; ++ai)
#pragma unroll
            for (int m = 0; m < 4; ++m) { const size_t row = (size_t)u.pm * 256 + ai * 128 + wr * 64 + m * 16 + fr;
#pragma unroll
                for (int bj = 0; bj < 2; ++bj) { const size_t o = row * 1024 + cb + bj * 128; const u32x4 s = *(const u32x4*)(SA + o); float f[8]; UNPACK8(s, f);
                    const f32x4 a0 = acc[ai][bj][m][0], a1 = acc[ai][bj][m][1]; u32x4 w;
                    w.x = pk2(a0[0] * f[0], a0[1] * f[1]); w.y = pk2(a0[2] * f[2], a0[3] * f[3]); w.z = pk2(a1[0] * f[4], a1[1] * f[5]); w.w = pk2(a1[2] * f[6], a1[3] * f[7]);
                    *(u32x4*)(MA + o) = w; }
                asm volatile("" ::: "memory"); }
    }
};
struct EpiMerge {
    static constexpr bool PERM = true, AFTER_DRAIN = false;
    const bf16* SB; bf16* MA;
    __device__ __forceinline__ void operator()(const f32x4 (&acc)[2][2][4][2], const pg8::Unit& u, int wr, int wc, int fr, int fq) const {
        const int cb = u.pn * 256 + wc * 32 + 8 * fq;
#pragma unroll
        for (int ai = 0; ai < 2; ++ai)
#pragma unroll
            for (int m = 0; m < 4; ++m) { const size_t row = (size_t)u.pm * 256 + ai * 128 + wr * 64 + m * 16 + fr;
#pragma unroll
                for (int bj = 0; bj < 2; ++bj) { const size_t o = row * 1024 + cb + bj * 128; const u32x4 s = *(const u32x4*)(SB + o); const u32x4 p = *(const u32x4*)(MA + o);
                    float f[8], q[8]; UNPACK8(s, f); UNPACK8(p, q);
                    const f32x4 a0 = acc[ai][bj][m][0], a1 = acc[ai][bj][m][1]; u32x4 w;
                    w.x = pk2(a0[0] * f[0] + q[0], a0[1] * f[1] + q[1]); w.y = pk2(a0[2] * f[2] + q[2], a0[3] * f[3] + q[3]);
                    w.z = pk2(a1[0] * f[4] + q[4], a1[1] * f[5] + q[5]); w.w = pk2(a1[2] * f[6] + q[6], a1[3] * f[7] + q[7]);
                    *(u32x4*)(MA + o) = w; }
                asm volatile("" ::: "memory"); }
    }
};
struct EpiRes {
    static constexpr bool PERM = true, AFTER_DRAIN = false;
    const float* base_p; const float* base_s; float* out; bf16* xb; float* ssq;
    __device__ __forceinline__ void operator()(const f32x4 (&acc)[2][2][4][2], const pg8::Unit& u, int wr, int wc, int fr, int fq) const {
        const int pm = u.pm, cb = u.pn * 256 + wc * 32 + 8 * fq;
        const float* base = pm < NTP ? base_p + (size_t)pm * 256 * D : base_s + (size_t)(pm - NTP) * 256 * D;
#pragma unroll
        for (int ai = 0; ai < 2; ++ai)
#pragma unroll
            for (int m = 0; m < 4; ++m) { const int lr = ai * 128 + wr * 64 + m * 16 + fr; const size_t row = (size_t)pm * 256 + lr; float s = 0.f;
#pragma unroll
                for (int bj = 0; bj < 2; ++bj) { const int c = cb + bj * 128;
                    const f32x4 v0 = acc[ai][bj][m][0] + *(const f32x4*)(base + (size_t)lr * D + c), v1 = acc[ai][bj][m][1] + *(const f32x4*)(base + (size_t)lr * D + c + 4);
                    *(f32x4*)(out + row * D + c) = v0; *(f32x4*)(out + row * D + c + 4) = v1;
                    u32x4 w; w.x = pk2(v0[0], v0[1]); w.y = pk2(v0[2], v0[3]); w.z = pk2(v1[0], v1[1]); w.w = pk2(v1[2], v1[3]);
                    *(u32x4*)(xb + row * D + c) = w;
                    s += (v0[0] * v0[0] + v0[1] * v0[1]) + (v0[2] * v0[2] + v0[3] * v0[3]) + (v1[0] * v1[0] + v1[1] * v1[1]) + (v1[2] * v1[2] + v1[3] * v1[3]); }
                s += __shfl_xor(s, 16); s += __shfl_xor(s, 32);
                if (fq == 0) ssq[row * 16 + u.pn * 4 + wc] = s;
                asm volatile("" ::: "memory"); }
    }
};
template <int CTRL> __device__ __forceinline__ float dppf(float v) { return __builtin_bit_cast(float, __builtin_amdgcn_update_dpp(0, __builtin_bit_cast(int, v), CTRL, 0xf, 0xf, true)); }
#define DPP_SHR1 0x111
#define DPP_SHR2 0x112
#define DPP_SHL15 0x10F
#define DPP_SHL14 0x10E
struct EpiUpAct {
    static constexpr bool PERM = true, AFTER_DRAIN = false;
    unsigned char* ws; float* out; const float* fw; const float* fb; const float* sffn; LAS unsigned char* ex; int l;
    __device__ __forceinline__ void operator()(const f32x4 (&acc)[2][2][4][2], const pg8::Unit& u, int wr, int wc, int fr, int fq) const {
        unsigned char* w_ = launder_s(ws); float* o_ = launder_s(out);
        const int pm = u.pm, pn = u.pn; const bool samp = pm >= NTP;
        float r[2][4]; unit_rstd((const float*)(w_ + WS_SSQ), pm, wr, fr, fq, r);
        const int lc0 = wc * 32 + 8 * fq;
        f32x4 x[2][2][4][2];
#pragma unroll
        for (int ai = 0; ai < 2; ++ai)
#pragma unroll
            for (int bj = 0; bj < 2; ++bj)
#pragma unroll
                for (int m = 0; m < 4; ++m)
#pragma unroll
                    for (int n = 0; n < 2; ++n) x[ai][bj][m][n] = acc[ai][bj][m][n] * r[ai][m];
        {
            float* ffn_p = o_ + O_FFNP + (size_t)l * 8 * 2 * FF2; float* ffn_s = o_ + O_FFNS + (size_t)l * 16 * 2 * FF2; float* HALO = (float*)(w_ + WS_HALO) + (size_t)pm * 4 * FF2;
            if (fr >= 14) {
#pragma unroll
                for (int ai = 0; ai < 2; ++ai) {
                    if (samp || ((pm & 15) == 15 && wr == 1 && ai == 1)) {
                        float* sp = samp ? ffn_s + ((size_t)((pm - NTP) * 4 + ai * 2 + wr) * 2 + (fr - 14)) * FF2 : ffn_p + ((size_t)(pm >> 4) * 2 + (fr - 14)) * FF2;
#pragma unroll
                        for (int bj = 0; bj < 2; ++bj) { const int oc = bj * FF + pn * 128 + lc0; *(f32x4*)(sp + oc) = x[ai][bj][3][0]; *(f32x4*)(sp + oc + 4) = x[ai][bj][3][1]; } }
                }
                if (wr == 1) {
#pragma unroll
                    for (int bj = 0; bj < 2; ++bj) { float* hp = HALO + (size_t)(2 + fr - 14) * FF2 + pn * 256 + bj * 128 + lc0; *(f32x4*)hp = x[1][bj][3][0]; *(f32x4*)(hp + 4) = x[1][bj][3][1]; } }
            }
            if (fr < 2 && wr == 0) {
#pragma unroll
                for (int bj = 0; bj < 2; ++bj) { float* hp = HALO + (size_t)fr * FF2 + pn * 256 + bj * 128 + lc0; *(f32x4*)hp = x[0][bj][0][0]; *(f32x4*)(hp + 4) = x[0][bj][0][1]; } }
        }
        if (!samp) {
            if (fr >= 14) {
#pragma unroll
                for (int ai = 0; ai < 2; ++ai)
#pragma unroll
                    for (int bj = 0; bj < 2; ++bj)
#pragma unroll
                        for (int n = 0; n < 2; ++n) *(LAS f32x4*)(ex + ((((2 * ai + wr) * 2 + (fr - 14)) * 256) + bj * 128 + lc0 + 4 * n) * 4) = x[ai][bj][3][n];
            }
            asm volatile("s_waitcnt lgkmcnt(0)" ::: "memory"); __builtin_amdgcn_s_barrier(); asm volatile("" ::: "memory");
        }
        bf16* ACT = (bf16*)(w_ + WS_ACT);
        unsigned pk[2][4][2];
#pragma unroll
        for (int n = 0; n < 2; ++n) {
            const int f = pn * 128 + lc0 + 4 * n;
            const f32x4 wv0 = *(const f32x4*)(fw + f), wv1 = *(const f32x4*)(fw + FF2 + f), wv2 = *(const f32x4*)(fw + 2 * FF2 + f), bv = *(const f32x4*)(fb + f);
            const f32x4 wg0 = *(const f32x4*)(fw + FF + f), wg1 = *(const f32x4*)(fw + FF2 + FF + f), wg2 = *(const f32x4*)(fw + 2 * FF2 + FF + f), bg = *(const f32x4*)(fb + FF + f);
#pragma unroll
            for (int ai = 0; ai < 2; ++ai) {
                const int B = 2 * ai + wr;
                f32x4 e1v = (f32x4){0.f, 0.f, 0.f, 0.f}, e2v = e1v, e1g = e1v, e2g = e1v;
                if (fr < 2) {
                    if (samp) {
                        const float* b0 = sffn + (size_t)((pm - NTP) * 4 + B) * 2 * FF2; const float* b1 = b0 + FF2;
                        const f32x4 v1 = *(const f32x4*)(b1 + f), g1 = *(const f32x4*)(b1 + FF + f);
                        if (fr == 0) { e1v = v1; e1g = g1; e2v = *(const f32x4*)(b0 + f); e2g = *(const f32x4*)(b0 + FF + f); } else { e2v = v1; e2g = g1; }
                    } else if (B > 0) {
                        const LAS unsigned char* eb = ex + ((B - 1) * 2 * 256 + lc0 + 4 * n) * 4;
                        const f32x4 v63 = *(const LAS f32x4*)(eb + 256 * 4), g63 = *(const LAS f32x4*)(eb + 256 * 4 + 128 * 4);
                        if (fr == 0) { e1v = v63; e1g = g63; e2v = *(const LAS f32x4*)eb; e2g = *(const LAS f32x4*)(eb + 128 * 4); } else { e2v = v63; e2g = g63; }
                    }
                }
#pragma unroll
                for (int m = 0; m < 4; ++m) {
                    float av[4];
#pragma unroll
                    for (int e = 0; e < 4; ++e) {
                        const float xv = x[ai][0][m][n][e], xg = x[ai][1][m][n][e];
                        float yv = bv[e] + wv2[e] * xv + wv1[e] * dppf<DPP_SHR1>(xv) + wv0[e] * dppf<DPP_SHR2>(xv);
                        float yg = bg[e] + wg2[e] * xg + wg1[e] * dppf<DPP_SHR1>(xg) + wg0[e] * dppf<DPP_SHR2>(xg);
                        if (m > 0) { const float pv = x[ai][0][m > 0 ? m - 1 : 0][n][e], pg = x[ai][1][m > 0 ? m - 1 : 0][n][e];
                            yv += wv1[e] * dppf<DPP_SHL15>(pv) + wv0[e] * dppf<DPP_SHL14>(pv); yg += wg1[e] * dppf<DPP_SHL15>(pg) + wg0[e] * dppf<DPP_SHL14>(pg); }
                        else { yv += wv1[e] * e1v[e] + wv0[e] * e2v[e]; yg += wg1[e] * e1g[e] + wg0[e] * e2g[e]; }
                        av[e] = yg * sigmoidf_(yg) * yv;
                    }
                    const unsigned lo = pk2(av[0], av[1]), hi = pk2(av[2], av[3]);
                    if (n == 0) { pk[ai][m][0] = lo; pk[ai][m][1] = hi; }
                    else { u32x4 w; w.x = pk[ai][m][0]; w.y = pk[ai][m][1]; w.z = lo; w.w = hi;
                        *(u32x4*)(ACT + ((size_t)pm * 256 + ai * 128 + wr * 64 + m * 16 + fr) * FF + pn * 128 + lc0) = w; }
                }
            }
        }
    }
};

struct Args { const float* in[19]; float* out; unsigned char* ws; };

struct Frame {
    LAS unsigned char* lds;
    int tid, lane, wave, G, bid;
};

__device__ __forceinline__ float wave_sum(float v) {
#pragma unroll
    for (int o = 1; o < 64; o <<= 1) v += __shfl_xor(v, o);
    return v;
}

__device__ __forceinline__ void tr_item(const float* W, int ldw, int srccol, int ks0, const float* gs, bf16* WT, int Kd, int dst_row, int kd0, bool zero, LAS float* scr, int lane) {
    if (!zero) {
#pragma unroll 8
        for (int i = 0; i < 32; ++i) { const int kk = 2 * i + (lane >> 5); float v = W[(size_t)(ks0 + kk) * ldw + srccol + (lane & 31)]; if (gs) v *= gs[ks0 + kk]; scr[kk * 33 + (lane & 31)] = v; }
    }
    asm volatile("s_waitcnt lgkmcnt(0)" ::: "memory");
    const int c = lane & 7;
#pragma unroll
    for (int j = 0; j < 4; ++j) { const int n = (lane >> 3) + 8 * j; const LAS float* s = scr + (8 * c) * 33 + n;
        u32x4 o;
        if (zero) { o = (u32x4){0u, 0u, 0u, 0u}; }
        else { o.x = pk2(s[0 * 33], s[1 * 33]); o.y = pk2(s[2 * 33], s[3 * 33]); o.z = pk2(s[4 * 33], s[5 * 33]); o.w = pk2(s[6 * 33], s[7 * 33]); }
        *(u32x4*)(WT + (size_t)(dst_row + n) * Kd + kd0 + 8 * c) = o; }
    asm volatile("s_waitcnt lgkmcnt(0)" ::: "memory");
}

constexpr int I_IN = 16 * 128, I_UP = 16 * 176, I_DN = 44 * 32, I_O = 16 * 32, I_CO = 8 * 32, I_MAP = 128;
constexpr int ITEMS_L = I_IN + I_UP + I_DN + I_O + I_CO + I_MAP;

__device__ __forceinline__ void p0_prologue(const Frame& F, const Args& a) {
    int tid_ = threadIdx.x; asm volatile("" : "+v"(tid_)); const int TID = tid_, LANE = tid_ & 63, WAVE = __builtin_amdgcn_readfirstlane(tid_ >> 6);
    LAS float* scr = (LAS float*)(F.lds + WAVE * 16384);
    const int gw = F.bid * NWAVES + WAVE, NGW = F.G * NWAVES;
    unsigned char* ws = a.ws;
    for (int it = gw; it < 2 * ITEMS_L; it += NGW) {
        const int l = it / ITEMS_L; int r = it % ITEMS_L;
        unsigned char* wl = ws + WS_W + (size_t)l * W_LAYER;
        if (r < I_IN) { const int kb = r / 128, n0 = (r % 128) * 32;
            const int src = (n0 < 1024 || n0 >= 2048) ? n0 : 1024 + 512 * (((n0 - 1024) % 256) / 128) + 128 * ((n0 - 1024) / 256) + (n0 % 128);
            tr_item(a.in[6] + (size_t)l * D * INW, INW, src, kb * 64, a.in[5] + l * D, (bf16*)(wl + WO_IN), D, n0, kb * 64, false, scr, LANE); continue; } r -= I_IN;
        if (r < I_UP) { const int kb = r / 176, n0 = (r % 176) * 32;
            const int src = ((n0 % 256) / 128) * FF + 128 * (n0 / 256) + (n0 % 128);
            tr_item(a.in[14] + (size_t)l * D * FF2, FF2, src, kb * 64, a.in[13] + l * D, (bf16*)(wl + WO_UP), D, n0, kb * 64, false, scr, LANE); continue; } r -= I_UP;
        if (r < I_DN) { const int kb = r / 32, n0 = (r % 32) * 32;
            tr_item(a.in[17] + (size_t)l * FF * D, D, n0, kb * 64, nullptr, (bf16*)(wl + WO_DN), FF, n0, kb * 64, false, scr, LANE); continue; } r -= I_DN;
        if (r < I_O) { const int kb = r / 32, n0 = (r % 32) * 32;
            tr_item(a.in[12] + (size_t)l * D * D, D, n0, kb * 64, nullptr, (bf16*)(wl + WO_O), D, n0, kb * 64, false, scr, LANE); continue; } r -= I_O;
        if (r < I_CO) { const int kb = r / 32, n0 = (r % 32) * 32;
            tr_item(a.in[11] + (size_t)l * CW * D, D, n0, kb * 64, nullptr, (bf16*)(wl + WO_CO), CW, n0, kb * 64, false, scr, LANE); continue; } r -= I_CO;
        { const int g = r / 32, kb = (r % 32) / 8, nb = r % 8; const bool zero = (kb >> 1) != (g & 1);
            tr_item(a.in[8] + (size_t)l * 4 * 128 * 256 + (size_t)g * 128 * 256, 256, nb * 32, (kb & 1) * 64, nullptr, (bf16*)(wl + WO_MAP), 256, g * 256 + nb * 32, kb * 64, zero, scr, LANE); }
    }
    bf16* XB = (bf16*)(ws + WS_XB); float* SSQ = (float*)(ws + WS_SSQ);
    for (int m = gw; m < M; m += NGW) {
        const float* xrow = m < MP ? a.in[0] + (size_t)m * D : a.in[1] + (size_t)(m - MP) * D;
        const f32x4* xr = (const f32x4*)xrow + LANE; f32x4 v[4]; float s = 0.f;
#pragma unroll
        for (int j = 0; j < 4; ++j) { v[j] = xr[64 * j]; s += (v[j].x * v[j].x + v[j].y * v[j].y) + (v[j].z * v[j].z + v[j].w * v[j].w); }
        s = wave_sum(s);
        u32x2* o8 = (u32x2*)(XB + (size_t)m * D) + LANE;
#pragma unroll
        for (int j = 0; j < 4; ++j) { u32x2 w; w.x = pk2(v[j].x, v[j].y); w.y = pk2(v[j].z, v[j].w); o8[64 * j] = w; }
        if (LANE < 16) SSQ[(size_t)m * 16 + LANE] = LANE == 0 ? s : 0.f;
    }
}

__device__ __forceinline__ void mix_elt(const Frame& F, const Args& a, int l) {
    int tid_ = threadIdx.x; asm volatile("" : "+v"(tid_)); const int TID = tid_, LANE = tid_ & 63, WAVE = __builtin_amdgcn_readfirstlane(tid_ >> 6);
    unsigned char* ws = a.ws;
    const bf16* UPOOL = (const bf16*)(ws + WS_UPOOL); const bf16* CVIN = (const bf16*)(ws + WS_CVIN); const bf16* GB = (const bf16*)(ws + WS_GB);
    bf16* MIXED = (bf16*)(ws + WS_MIXED); bf16* GBCV = (bf16*)(ws + WS_GBCV);
    const float* spool = a.in[2] + (size_t)l * 16 * 15 * 512; const float* sconv = a.in[3] + (size_t)l * 16 * 2 * 512; const float* cw = a.in[10] + (size_t)l * 3 * 512;
    const size_t total = (size_t)M * 128, stride = (size_t)F.G * NTHR;
    for (size_t idx = (size_t)F.bid * NTHR + TID; idx < total; idx += stride) {
        const int row = (int)(idx >> 7), c8 = (int)(idx & 127);
        const bool samp = row >= MP; int t, s = 0;
        if (!samp) t = row & 4095; else { const int sr = row - MP; s = sr >> 6; t = sr & 63; }
        if (c8 < 64) {
            const int ch0 = c8 * 8, win = 2 << (c8 >> 4);
            float sum[8];
#pragma unroll
            for (int e = 0; e < 8; ++e) sum[e] = 0.f;
            float f[8];
            const u32x4 uw = *(const u32x4*)(UPOOL + (size_t)row * 512 + ch0);
            for (int j = 1; j < win; ++j) {
                const int tt = t - j;
                if (tt >= 0) { const u32x4 w = *(const u32x4*)(UPOOL + (size_t)(row - j) * 512 + ch0); UNPACK8(w, f);
#pragma unroll
                    for (int e = 0; e < 8; ++e) sum[e] += f[e]; }
                else if (samp) { const float* p = spool + ((size_t)s * 15 + 15 + tt) * 512 + ch0; const f32x4 p0 = *(const f32x4*)p, p1 = *(const f32x4*)(p + 4);
#pragma unroll
                    for (int e = 0; e < 4; ++e) { sum[e] += p0[e]; sum[4 + e] += p1[e]; } }
            }
            UNPACK8(uw, f);
            const float cnt = samp ? (float)win : (float)(win < t + 1 ? win : t + 1), inv = 1.0f / cnt;
            float o[8];
#pragma unroll
            for (int e = 0; e < 8; ++e) o[e] = (sum[e] + f[e]) * inv - f[e];
            u32x4 w; w.x = pk2(o[0], o[1]); w.y = pk2(o[2], o[3]); w.z = pk2(o[4], o[5]); w.w = pk2(o[6], o[7]);
            *(u32x4*)(MIXED + (size_t)row * 512 + ch0) = w;
        } else {
            const int ch0 = (c8 - 64) * 8;
            float x0[8], x1[8], x2[8], gb[8];
            { const u32x4 w = *(const u32x4*)(CVIN + (size_t)row * 512 + ch0); UNPACK8(w, x0); }
            { const u32x4 w = *(const u32x4*)(GB + (size_t)row * 512 + ch0); UNPACK8(w, gb); }
            if (t >= 1) { const u32x4 w = *(const u32x4*)(CVIN + (size_t)(row - 1) * 512 + ch0); UNPACK8(w, x1); }
            else if (samp) { const float* p = sconv + ((size_t)s * 2 + 1) * 512 + ch0; const f32x4 p0 = *(const f32x4*)p, p1 = *(const f32x4*)(p + 4);
#pragma unroll
                for (int e = 0; e < 4; ++e) { x1[e] = p0[e]; x1[4 + e] = p1[e]; } }
            else {
#pragma unroll
                for (int e = 0; e < 8; ++e) x1[e] = 0.f; }
            if (t >= 2) { const u32x4 w = *(const u32x4*)(CVIN + (size_t)(row - 2) * 512 + ch0); UNPACK8(w, x2); }
            else if (samp) { const float* p = sconv + ((size_t)s * 2 + t) * 512 + ch0; const f32x4 p0 = *(const f32x4*)p, p1 = *(const f32x4*)(p + 4);
#pragma unroll
                for (int e = 0; e < 4; ++e) { x2[e] = p0[e]; x2[4 + e] = p1[e]; } }
            else {
#pragma unroll
                for (int e = 0; e < 8; ++e) x2[e] = 0.f; }
            float o[8];
#pragma unroll
            for (int h = 0; h < 2; ++h) { const f32x4 w0 = *(const f32x4*)(cw + ch0 + 4 * h), w1 = *(const f32x4*)(cw + 512 + ch0 + 4 * h), w2 = *(const f32x4*)(cw + 1024 + ch0 + 4 * h);
#pragma unroll
                for (int e = 0; e < 4; ++e) o[4 * h + e] = gb[4 * h + e] * (w0[e] * x2[4 * h + e] + w1[e] * x1[4 * h + e] + w2[e] * x0[4 * h + e]); }
            u32x4 w; w.x = pk2(o[0], o[1]); w.y = pk2(o[2], o[3]); w.z = pk2(o[4], o[5]); w.w = pk2(o[6], o[7]);
            *(u32x4*)(GBCV + (size_t)row * 512 + ch0) = w;
        }
    }
}

__device__ __forceinline__ void ffn_fixup(const Frame& F, const Args& a, int l) {
    int tid_ = threadIdx.x; asm volatile("" : "+v"(tid_)); const int TID = tid_;
    unsigned char* ws = a.ws;
    const float* HALO = (const float*)(ws + WS_HALO); bf16* ACT = (bf16*)(ws + WS_ACT);
    const float* fw = a.in[15] + (size_t)l * 3 * FF2; const float* fb = a.in[16] + (size_t)l * FF2;
    const int total = NTP * 2 * 352, stride = F.G * NTHR;
    for (int idx = F.bid * NTHR + TID; idx < total; idx += stride) {
        const int pm = idx / 704, rem = idx % 704, rr = rem / 352, c8 = rem % 352;
        if ((pm & 15) == 0) continue;
        const int f0 = c8 * 8, pn = f0 >> 7, j0 = f0 & 127;
        float res[2][8];
#pragma unroll
        for (int h = 0; h < 2; ++h) {
            const int pc = pn * 256 + h * 128 + j0, oc = h * FF + f0;
            const float* p0 = HALO + ((size_t)pm * 4 + rr) * FF2 + pc;
            const float* p1 = rr == 1 ? HALO + ((size_t)pm * 4 + 0) * FF2 + pc : HALO + ((size_t)(pm - 1) * 4 + 3) * FF2 + pc;
            const float* p2 = rr == 1 ? HALO + ((size_t)(pm - 1) * 4 + 3) * FF2 + pc : HALO + ((size_t)(pm - 1) * 4 + 2) * FF2 + pc;
#pragma unroll
            for (int q = 0; q < 2; ++q) { const f32x4 x0 = *(const f32x4*)(p0 + 4 * q), x1 = *(const f32x4*)(p1 + 4 * q), x2 = *(const f32x4*)(p2 + 4 * q);
                const f32x4 w0 = *(const f32x4*)(fw + oc + 4 * q), w1 = *(const f32x4*)(fw + FF2 + oc + 4 * q), w2 = *(const f32x4*)(fw + 2 * FF2 + oc + 4 * q), b = *(const f32x4*)(fb + oc + 4 * q);
#pragma unroll
                for (int e = 0; e < 4; ++e) res[h][4 * q + e] = w0[e] * x2[e] + w1[e] * x1[e] + w2[e] * x0[e] + b[e]; }
        }
        float o[8];
#pragma unroll
        for (int e = 0; e < 8; ++e) o[e] = res[1][e] * sigmoidf_(res[1][e]) * res[0][e];
        u32x4 w; w.x = pk2(o[0], o[1]); w.y = pk2(o[2], o[3]); w.z = pk2(o[4], o[5]); w.w = pk2(o[6], o[7]);
        *(u32x4*)(ACT + ((size_t)pm * 256 + rr) * FF + f0) = w;
    }
}

__device__ __forceinline__ void final_norm(const Frame& F, const Args& a) {
    int tid_ = threadIdx.x; asm volatile("" : "+v"(tid_)); const int TID = tid_, LANE = tid_ & 63, WAVE = __builtin_amdgcn_readfirstlane(tid_ >> 6);
    const float* SSQ = (const float*)(a.ws + WS_SSQ); const float* g = a.in[18];
    const int gw = F.bid * NWAVES + WAVE, NGW = F.G * NWAVES;
    f32x4 gv[4];
#pragma unroll
    for (int j = 0; j < 4; ++j) gv[j] = ((const f32x4*)g)[LANE + 64 * j];
    for (int m = gw; m < M; m += NGW) {
        float s = LANE < 16 ? SSQ[(size_t)m * 16 + LANE] : 0.f;
        s = wave_sum(s);
        const float rs = 1.0f / sqrtf(s * (1.0f / D) + EPS);
        f32x4* xr = (f32x4*)(a.out + (size_t)m * D) + LANE;
#pragma unroll
        for (int j = 0; j < 4; ++j) { f32x4 v = xr[64 * j]; v = v * rs * gv[j]; xr[64 * j] = v; }
    }
}

typedef const __attribute__((address_space(4))) Args* KArgs;
__device__ __forceinline__ Args load_args(KArgs kp) {
    asm volatile("" : "+s"(kp)); Args a;
#pragma unroll
    for (int i = 0; i < 19; ++i) a.in[i] = kp->in[i];
    a.out = kp->out; a.ws = kp->ws; return a;
}

__global__ void __launch_bounds__(NTHR, 2) fwd_mega(Args a_unused) {
    extern __shared__ __attribute__((aligned(16))) unsigned char lds_raw[];
    cg::grid_group grid = cg::this_grid();
    KArgs kp = (KArgs)__builtin_amdgcn_kernarg_segment_ptr();
    Frame F;
    F.lds = (LAS unsigned char*)lds_raw;
    F.tid = threadIdx.x; F.lane = F.tid & 63; F.wave = __builtin_amdgcn_readfirstlane(F.tid >> 6);
    F.G = gridDim.x; F.bid = blockIdx.x;

    if constexpr (PHMASK & 1) { const Args a = load_args(kp); p0_prologue(F, a); }
    grid.sync();

#pragma unroll 1
    for (int l = 0; l < 2; ++l) {
        if constexpr (PHMASK & 2) {
            const Args a = load_args(kp); unsigned char* ws = a.ws; unsigned char* wl = ws + WS_W + (size_t)l * W_LAYER;
            pg8::Gemm g{(const bf16*)(ws + WS_XB), (const bf16*)(wl + WO_IN), M, INW, D, D, 0, 0}; pg8::StaticOrder S; S.init(M, INW, F.G, F.bid);
            EpiProj E{ws, a.out, a.in[7] + (size_t)l * 2 * D, a.in[9] + (size_t)l * D, l};
            pg8::gemm_phase<EpiProj, pg8::StaticOrder, true, true>(F.lds, g, S, E);
        }
        grid.sync();
        if constexpr (PHMASK & 4) { const Args a = load_args(kp); mix_elt(F, a, l); }
        grid.sync();
        if constexpr (PHMASK & 8) {
            const Args a = load_args(kp); unsigned char* ws = a.ws; unsigned char* wl = ws + WS_W + (size_t)l * W_LAYER;
            pg8::Gemm g{(const bf16*)(ws + WS_MIXED), (const bf16*)(wl + WO_MAP), M, D, 256, PW, 1, 512}; pg8::StaticOrder S; S.init(M, D, F.G, F.bid);
            EpiMA E{(const bf16*)(ws + WS_SA), (bf16*)(ws + WS_MA)};
            pg8::gemm_phase<EpiMA, pg8::StaticOrder, true, true>(F.lds, g, S, E);
        }
        grid.sync();
        if constexpr (PHMASK & 16) {
            const Args a = load_args(kp); unsigned char* ws = a.ws; unsigned char* wl = ws + WS_W + (size_t)l * W_LAYER;
            pg8::Gemm g{(const bf16*)(ws + WS_GBCV), (const bf16*)(wl + WO_CO), M, D, CW, CW, 0, 0}; pg8::StaticOrder S; S.init(M, D, F.G, F.bid);
            EpiMerge E{(const bf16*)(ws + WS_SB), (bf16*)(ws + WS_MA)};
            pg8::gemm_phase<EpiMerge, pg8::StaticOrder, true, true>(F.lds, g, S, E);
        }
        grid.sync();
        if constexpr (PHMASK & 32) {
            const Args a = load_args(kp); unsigned char* ws = a.ws; unsigned char* wl = ws + WS_W + (size_t)l * W_LAYER;
            pg8::Gemm g{(const bf16*)(ws + WS_MA), (const bf16*)(wl + WO_O), M, D, D, D, 0, 0}; pg8::StaticOrder S; S.init(M, D, F.G, F.bid);
            EpiRes E{l == 0 ? a.in[0] : a.out, l == 0 ? a.in[1] : a.out + (size_t)MP * D, a.out, (bf16*)(ws + WS_XB), (float*)(ws + WS_SSQ)};
            pg8::gemm_phase<EpiRes, pg8::StaticOrder, true, true>(F.lds, g, S, E);
        }
        grid.sync();
        if constexpr (PHMASK & 64) {
            const Args a = load_args(kp); unsigned char* ws = a.ws; unsigned char* wl = ws + WS_W + (size_t)l * W_LAYER;
            pg8::Gemm g{(const bf16*)(ws + WS_XB), (const bf16*)(wl + WO_UP), M, FF2, D, D, 0, 0}; pg8::StaticOrder S; S.init(M, FF2, F.G, F.bid);
            EpiUpAct E{ws, a.out, a.in[15] + (size_t)l * 3 * FF2, a.in[16] + (size_t)l * FF2, a.in[4] + (size_t)l * 16 * 2 * FF2, F.lds + EX_OFF, l};
            pg8::gemm_phase<EpiUpAct, pg8::StaticOrder, true, true>(F.lds, g, S, E);
        }
        grid.sync();
        if constexpr (PHMASK & 128) { const Args a = load_args(kp); ffn_fixup(F, a, l); }
        grid.sync();
        if constexpr (PHMASK & 256) {
            const Args a = load_args(kp); unsigned char* ws = a.ws; unsigned char* wl = ws + WS_W + (size_t)l * W_LAYER;
            pg8::Gemm g{(const bf16*)(ws + WS_ACT), (const bf16*)(wl + WO_DN), M, D, FF, FF, 0, 0}; pg8::StaticOrder S; S.init(M, D, F.G, F.bid);
            EpiRes E{a.out, a.out + (size_t)MP * D, a.out, (bf16*)(ws + WS_XB), (float*)(ws + WS_SSQ)};
            pg8::gemm_phase<EpiRes, pg8::StaticOrder, true, true>(F.lds, g, S, E);
        }
        grid.sync();
    }
    if constexpr (PHMASK & 512) { const Args a = load_args(kp); final_norm(F, a); }
}

extern "C" void kernel_launch(void* const* d_in, const int* in_sizes, int n_in, void* d_out, int out_size, void* d_ws, size_t ws_size, hipStream_t stream) {
    static int grid = 0;
    if (grid == 0) {
        if (n_in != 19 || in_sizes[0] != MP * D || (size_t)out_size != O_END || ws_size < WS_END) {
            fprintf(stderr, "kernel_launch: unexpected shapes: n_in %d in0 %d out %d ws %zu (need %zu)\n", n_in, n_in > 0 ? in_sizes[0] : -1, out_size, ws_size, (size_t)WS_END); grid = -1; return; }
        int dev = 0, cus = 0, per_cu = 0;
        hipGetDevice(&dev); hipDeviceGetAttribute(&cus, hipDeviceAttributeMultiprocessorCount, dev);
        if (hipFuncSetAttribute((const void*)fwd_mega, hipFuncAttributeMaxDynamicSharedMemorySize, LDS_BYTES) != hipSuccess) { fprintf(stderr, "kernel_launch: hipFuncSetAttribute failed\n"); grid = -1; return; }
        if (hipOccupancyMaxActiveBlocksPerMultiprocessor(&per_cu, (const void*)fwd_mega, NTHR, LDS_BYTES) != hipSuccess || per_cu < 1) { fprintf(stderr, "kernel_launch: occupancy query says %d\n", per_cu); per_cu = 1; }
        (void)hipGetLastError();
        grid = cus;
    }
    if (grid < 0) return;
    Args a{};
    for (int i = 0; i < 19; ++i) a.in[i] = (const float*)d_in[i];
    a.out = (float*)d_out; a.ws = (unsigned char*)d_ws;
    void* args[] = {&a};
    hipError_t e = hipLaunchCooperativeKernel((const void*)fwd_mega, dim3(grid), dim3(NTHR), args, LDS_BYTES, stream);
    if (e != hipSuccess) fprintf(stderr, "cooperative launch failed: %s (grid %d)\n", hipGetErrorString(e), grid);
}
```

```cpp
#include <hip/hip_runtime.h>
#include <hip/hip_cooperative_groups.h>
#include <cstdio>
#include <cstdint>
namespace cg = cooperative_groups;

namespace pg8 {
#define PG8_LAS __attribute__((address_space(3)))
typedef unsigned short bf16_t;
typedef short bf16x8 __attribute__((ext_vector_type(8)));
typedef float f32x4 __attribute__((ext_vector_type(4)));
typedef unsigned u32x4 __attribute__((ext_vector_type(4)));
constexpr int BM = 256, BK = 64, HALF = 128, HTB = HALF * BK * 2, STAGE_BYTES = 8 * HTB, NXCD = 8, WGM = 8;

__host__ __device__ __forceinline__ int lds_byte(int r, int c) { const int st = (r >> 4) * 2 + (c >> 5), rr = r & 15, cc = c & 31, ob = rr * 64 + cc * 2; return st * 1024 + (ob ^ (((ob >> 9) & 1) << 5)); }
__host__ __device__ __forceinline__ void stage_rc(int b, int& R, int& C) { const int st = b / 1024, sb = b % 1024, swz = sb ^ (((sb >> 9) & 1) << 5); R = (st >> 1) * 16 + swz / 64; C = (st & 1) * 32 + (swz % 64) / 2; }
__host__ __device__ __forceinline__ int perm32(int rho) { const int n = rho >> 4, i = rho & 15; return 8 * (i >> 2) + 4 * n + (i & 3); }

struct Unit { int pm, pn; };
struct Gemm { const bf16_t* A; const bf16_t* Bt; int M, N, K, lda, apn_shift, apn_bytes; };

struct StaticOrder {
    int nM, nN, nwg, G, c;
    __host__ __device__ void init(int M, int N, int G_, int c_) { nM = M / BM; nN = N / BM; nwg = nM * nN; G = G_; c = c_; }
    __host__ __device__ bool next(int i, Unit& u) const {
        const long L = (long)i * G + c; if (L >= nwg) return false;
        int wgid = (int)L; { const int q = nwg / NXCD, r = nwg % NXCD, xcd = wgid % NXCD, off = wgid / NXCD; wgid = (xcd < r ? xcd * (q + 1) : r * (q + 1) + (xcd - r) * q) + off; }
        const int nig = WGM * nN, gid = wgid / nig, fm = gid * WGM, gsz = (nM - fm) < WGM ? (nM - fm) : WGM;
        u.pm = fm + ((wgid % nig) % gsz); u.pn = (wgid % nig) / gsz; return true;
    }
    __device__ __forceinline__ void a_ready(const Unit&) const {}
    __device__ __forceinline__ void done(const Unit&) const {}
};

__device__ __forceinline__ unsigned cvt_pk_bf16(float lo, float hi) { unsigned r; asm volatile("v_cvt_pk_bf16_f32 %0, %1, %2" : "=v"(r) : "v"(lo), "v"(hi)); return r; }

template <class Epi, class Sched, bool ALIGN_EPI = false, bool SP2 = false>
__device__ __forceinline__ void gemm_phase(PG8_LAS unsigned char* lds, const Gemm g, const Sched& S, const Epi& E) {
    int tid_ = threadIdx.x; asm volatile("" : "+v"(tid_));
    const int tid = tid_, wid = __builtin_amdgcn_readfirstlane(tid >> 6), lane = tid & 63, wr = wid >> 2, wc = wid & 3, fr = lane & 15, fq = lane >> 4;
    const int K = g.K, nt = K / BK, lda = g.lda;
    unsigned voffA[2], voffB[2];
#pragma unroll
    for (int i = 0; i < 2; ++i) { int R, C; stage_rc(tid * 16 + i * 8192, R, C); const int Rb = Epi::PERM ? ((R & ~31) + perm32(R & 31)) : R;
        voffA[i] = (unsigned)(R * lda + C) * 2u; voffB[i] = (unsigned)(Rb * K + C) * 2u; }
    const size_t kstep = (size_t)(BK * 2);
    const size_t hstepA = (size_t)HALF * lda * 2, hstepB = (size_t)HALF * K * 2;
    const size_t tstepA = 2 * hstepA, tstepB = 2 * hstepB;
    const unsigned ldsw = (unsigned)wid * 1024u;
    const int aoff = lds_byte(wr * 64 + fr, fq * 8), boff = lds_byte(wc * 32 + fr, fq * 8);
#define PG8_SA(b, h) (((b) * 2 + (h)) * HTB)
#define PG8_SB(b, h) ((4 + (b) * 2 + (h)) * HTB)
#define PG8_STAGE(bufoff, gbase, voff) do { _Pragma("unroll") for (int _i = 0; _i < 2; ++_i) \
        __builtin_amdgcn_global_load_lds((const unsigned*)((const char*)(gbase) + (voff)[_i]), (PG8_LAS unsigned*)(lds + (bufoff) + ldsw + _i * 8192), 16, 0, 0); } while (0)
#define PG8_LDA(dst, b, h) do { _Pragma("unroll") for (int m = 0; m < 4; ++m) _Pragma("unroll") for (int k = 0; k < 2; ++k) dst[m][k] = *(const PG8_LAS bf16x8*)(lds + PG8_SA(b, h) + aoff + m * 2048 + k * 1024); } while (0)
#define PG8_LDB(dst, b, h) do { _Pragma("unroll") for (int n = 0; n < 2; ++n) _Pragma("unroll") for (int k = 0; k < 2; ++k) dst[n][k] = *(const PG8_LAS bf16x8*)(lds + PG8_SB(b, h) + boff + n * 2048 + k * 1024); } while (0)
#define PG8_MMA(ai, bj, At, Bt) do { __builtin_amdgcn_s_setprio(1); _Pragma("unroll") for (int m = 0; m < 4; ++m) _Pragma("unroll") for (int n = 0; n < 2; ++n) _Pragma("unroll") for (int k = 0; k < 2; ++k) \
        acc[ai][bj][m][n] = __builtin_amdgcn_mfma_f32_16x16x32_bf16(Bt[n][k], At[m][k], acc[ai][bj][m][n], 0, 0, 0); __builtin_amdgcn_s_setprio(0); } while (0)
#define PG8_WAIT_V(n) asm volatile("s_waitcnt vmcnt(" #n ")" ::: "memory")
#define PG8_WAIT_L(n) asm volatile("s_waitcnt lgkmcnt(" #n ")" ::: "memory")
#define PG8_BAR __builtin_amdgcn_s_barrier()
#define PG8_SCHED __builtin_amdgcn_sched_barrier(0)
    Unit cur, nxt; int ui = 0;
    if (!S.next(0, cur)) return;
    f32x4 acc[2][2][4][2];
#pragma unroll
    for (int a = 0; a < 2; ++a)
#pragma unroll
        for (int b = 0; b < 2; ++b)
#pragma unroll
            for (int m = 0; m < 4; ++m)
#pragma unroll
                for (int n = 0; n < 2; ++n) acc[a][b][m][n] = (f32x4){0.f, 0.f, 0.f, 0.f};
    bf16x8 At[4][2], B0[2][2], B1[2][2];
    const char* cA = (const char*)g.A + (size_t)cur.pm * tstepA + (size_t)(cur.pn >> g.apn_shift) * g.apn_bytes; const char* cB = (const char*)g.Bt + (size_t)cur.pn * tstepB;
    S.a_ready(cur);
    if constexpr (SP2) {
        PG8_STAGE(PG8_SB(0, 0), cB, voffB); PG8_STAGE(PG8_SB(0, 1), cB + hstepB, voffB); PG8_STAGE(PG8_SA(0, 0), cA, voffA); PG8_STAGE(PG8_SA(0, 1), cA + hstepA, voffA);
        if (wr == 1) PG8_BAR;
        PG8_WAIT_V(2); PG8_BAR;
        PG8_STAGE(PG8_SB(1, 0), cB + kstep, voffB); PG8_STAGE(PG8_SA(1, 0), cA + kstep, voffA); PG8_STAGE(PG8_SB(1, 1), cB + hstepB + kstep, voffB);
        PG8_WAIT_V(6); PG8_BAR;
    } else {
        PG8_STAGE(PG8_SB(0, 0), cB, voffB); PG8_STAGE(PG8_SA(0, 0), cA, voffA); PG8_STAGE(PG8_SB(0, 1), cB + hstepB, voffB); PG8_STAGE(PG8_SA(0, 1), cA + hstepA, voffA);
        if (wr == 1) PG8_BAR;
        PG8_WAIT_V(4); PG8_BAR;
        PG8_STAGE(PG8_SB(1, 0), cB + kstep, voffB); PG8_STAGE(PG8_SA(1, 0), cA + kstep, voffA); PG8_STAGE(PG8_SB(1, 1), cB + hstepB + kstep, voffB);
        PG8_WAIT_V(6); PG8_BAR;
    }
    for (;;) {
        const bool has_next = S.next(ui + 1, nxt);
        const char* nA = has_next ? (const char*)g.A + (size_t)nxt.pm * tstepA + (size_t)(nxt.pn >> g.apn_shift) * g.apn_bytes : cA; const char* nB = has_next ? (const char*)g.Bt + (size_t)nxt.pn * tstepB : cB;
#pragma unroll 1
        for (int t = 0; t < nt; t += 2) {
            const bool last = (t == nt - 2);
            const char* a1 = cA + (size_t)(t + 1) * kstep;
            const char* a2 = last ? nA : cA + (size_t)(t + 2) * kstep; const char* b2 = last ? nB : cB + (size_t)(t + 2) * kstep;
            const char* a3 = a2 + kstep; const char* b3 = b2 + kstep;
            if (last && has_next) S.a_ready(nxt);
            if constexpr (SP2) {
            PG8_LDB(B0, 0, 0); PG8_LDB(B1, 0, 1); PG8_SCHED; PG8_LDA(At, 0, 0); PG8_STAGE(PG8_SA(1, 1), a1 + hstepA, voffA);
            PG8_WAIT_V(8); PG8_WAIT_L(0); PG8_BAR; PG8_MMA(0, 0, At, B0); PG8_MMA(0, 1, At, B1); PG8_BAR; PG8_SCHED;
            PG8_LDA(At, 0, 1); PG8_STAGE(PG8_SB(0, 0), b2, voffB); PG8_STAGE(PG8_SB(0, 1), b2 + hstepB, voffB); PG8_STAGE(PG8_SA(0, 0), a2, voffA);
            PG8_WAIT_V(8); PG8_WAIT_L(0); PG8_BAR; PG8_MMA(1, 0, At, B0); PG8_MMA(1, 1, At, B1); PG8_BAR; PG8_SCHED;
            PG8_LDB(B0, 1, 0); PG8_LDB(B1, 1, 1); PG8_SCHED; PG8_LDA(At, 1, 0); PG8_STAGE(PG8_SA(0, 1), a2 + hstepA, voffA);
            PG8_WAIT_V(8); PG8_WAIT_L(0); PG8_BAR; PG8_MMA(0, 0, At, B0); PG8_MMA(0, 1, At, B1); PG8_BAR; PG8_SCHED;
            PG8_LDA(At, 1, 1); PG8_STAGE(PG8_SB(1, 0), b3, voffB); PG8_STAGE(PG8_SB(1, 1), b3 + hstepB, voffB); PG8_STAGE(PG8_SA(1, 0), a3, voffA);
            PG8_WAIT_V(8); PG8_WAIT_L(0); PG8_BAR; PG8_MMA(1, 0, At, B0); PG8_MMA(1, 1, At, B1); PG8_BAR; PG8_SCHED;
            } else {
            PG8_LDB(B0, 0, 0); PG8_SCHED; PG8_LDA(At, 0, 0); PG8_STAGE(PG8_SA(1, 1), a1 + hstepA, voffA);
            PG8_WAIT_L(8); PG8_BAR; PG8_WAIT_L(0); PG8_MMA(0, 0, At, B0); PG8_BAR; PG8_SCHED;
            PG8_LDB(B1, 0, 1); PG8_STAGE(PG8_SB(0, 0), b2, voffB);
            PG8_BAR; PG8_WAIT_L(0); PG8_MMA(0, 1, At, B1); PG8_BAR;
            PG8_LDA(At, 0, 1); PG8_STAGE(PG8_SA(0, 0), a2, voffA);
            PG8_BAR; PG8_WAIT_L(0); PG8_MMA(1, 0, At, B0); PG8_BAR; PG8_SCHED;
            PG8_STAGE(PG8_SB(0, 1), b2 + hstepB, voffB);
            PG8_WAIT_V(6); PG8_BAR; PG8_MMA(1, 1, At, B1); PG8_BAR;
            PG8_LDB(B0, 1, 0); PG8_SCHED; PG8_LDA(At, 1, 0); PG8_STAGE(PG8_SA(0, 1), a2 + hstepA, voffA);
            PG8_WAIT_L(8); PG8_BAR; PG8_WAIT_L(0); PG8_MMA(0, 0, At, B0); PG8_BAR; PG8_SCHED;
            PG8_LDB(B1, 1, 1); PG8_STAGE(PG8_SB(1, 0), b3, voffB);
            PG8_BAR; PG8_WAIT_L(0); PG8_MMA(0, 1, At, B1); PG8_BAR;
            PG8_LDA(At, 1, 1); PG8_STAGE(PG8_SA(1, 0), a3, voffA);
            PG8_BAR; PG8_WAIT_L(0); PG8_MMA(1, 0, At, B0); PG8_BAR; PG8_SCHED;
            PG8_STAGE(PG8_SB(1, 1), b3 + hstepB, voffB);
            PG8_WAIT_V(6); PG8_BAR; PG8_MMA(1, 1, At, B1); PG8_BAR;
            }
        }
        if constexpr (ALIGN_EPI) { if (wr == 0) PG8_BAR; }
        E(acc, cur, wr, wc, fr, fq); S.done(cur);
        if (!has_next) break;
#pragma unroll
        for (int a = 0; a < 2; ++a)
#pragma unroll
            for (int b = 0; b < 2; ++b)
#pragma unroll
                for (int m = 0; m < 4; ++m)
#pragma unroll
                    for (int n = 0; n < 2; ++n) acc[a][b][m][n] = (f32x4){0.f, 0.f, 0.f, 0.f};
        cur = nxt; cA = nA; cB = nB; ++ui;
        if constexpr (ALIGN_EPI) { if (wr == 1) PG8_BAR; }
    }
    PG8_WAIT_V(0);
    if constexpr (!ALIGN_EPI) { if (wr == 0) PG8_BAR; }
    PG8_BAR;
#undef PG8_SA
#undef PG8_SB
#undef PG8_STAGE
#undef PG8_LDA
#undef PG8_LDB
#undef PG8_MMA
#undef PG8_WAIT_V
#undef PG8_WAIT_L
#undef PG8_BAR
#undef PG8_SCHED
}
}

typedef unsigned short bf16;
typedef float f32x4 __attribute__((ext_vector_type(4)));
typedef unsigned u32x4 __attribute__((ext_vector_type(4)));
typedef unsigned u32x2 __attribute__((ext_vector_type(2)));
#define LAS __attribute__((address_space(3)))

constexpr int D = 1024, MP = 32768, MS = 1024, M = MP + MS, NTILE = M / 256, NTP = MP / 256;
constexpr int INW = 4096, PW = 512, CW = 512, FF = 2816, FF2 = 5632;
constexpr float EPS = 1e-6f;
constexpr int NWAVES = 8, NTHR = 512;
constexpr int LDS_BYTES = 147456;
#ifndef PHMASK
#define PHMASK 0xFFFF
#endif
#ifndef PROBE
#define PROBE 0
#endif

constexpr size_t O_POOLP = (size_t)M * D;
constexpr size_t O_CONVP = O_POOLP + 2 * 8 * 15 * 512;
constexpr size_t O_FFNP = O_CONVP + 2 * 8 * 2 * 512;
constexpr size_t O_POOLS = O_FFNP + 2 * 8 * 2 * 5632;
constexpr size_t O_CONVS = O_POOLS + 2 * 16 * 15 * 512;
constexpr size_t O_FFNS = O_CONVS + 2 * 16 * 2 * 512;
constexpr size_t O_END = O_FFNS + 2 * 16 * 2 * 5632;

constexpr size_t MiB = 1u << 20;
constexpr size_t WS_SSQ = 1 * MiB;
constexpr size_t WS_W = 4 * MiB, W_LAYER = 28 * MiB;
constexpr size_t WO_IN = 0, WO_UP = 8 * MiB, WO_DN = 19 * MiB, WO_O = 24 * MiB + MiB / 2, WO_CO = 26 * MiB + MiB / 2, WO_MAP = 27 * MiB + MiB / 2;
constexpr size_t WS_XB = 60 * MiB;
constexpr size_t WS_ACTV = 126 * MiB;
constexpr size_t WS_UPOOL = WS_ACTV, WS_CVIN = WS_ACTV + 33 * MiB, WS_GB = WS_ACTV + 66 * MiB, WS_SA = WS_ACTV + 99 * MiB, WS_SB = WS_ACTV + 165 * MiB,
                 WS_MIXED = WS_ACTV + 231 * MiB, WS_GBCV = WS_ACTV + 264 * MiB, WS_MA = WS_ACTV;
constexpr size_t WS_ACT = WS_ACTV;
constexpr size_t WS_HALO = WS_ACTV + 182 * MiB;
constexpr size_t WS_END = WS_ACTV + 297 * MiB;
constexpr int BST_OFF = 131072 + 8192;
constexpr int EX_OFF = 131072;

__device__ __forceinline__ float bf_lo(unsigned w) { return __builtin_bit_cast(float, w << 16); }
__device__ __forceinline__ float bf_hi(unsigned w) { return __builtin_bit_cast(float, w & 0xffff0000u); }
__device__ __forceinline__ unsigned pk2(float lo, float hi) { return pg8::cvt_pk_bf16(lo, hi); }
__device__ __forceinline__ float sigmoidf_(float x) { return __builtin_amdgcn_rcpf(1.f + __builtin_amdgcn_exp2f(-1.44269504f * x)); }
#define UNPACK8(V_, F_) do { F_[0] = bf_lo((V_)[0]); F_[1] = bf_hi((V_)[0]); F_[2] = bf_lo((V_)[1]); F_[3] = bf_hi((V_)[1]); F_[4] = bf_lo((V_)[2]); F_[5] = bf_hi((V_)[2]); F_[6] = bf_lo((V_)[3]); F_[7] = bf_hi((V_)[3]); } while (0)

__device__ __forceinline__ void unit_rstd(const float* ssq, int pm, int wr, int fr, int fq, float (&r)[2][4]) {
    const int lane = fq * 16 + fr;
#pragma unroll
    for (int ai = 0; ai < 2; ++ai) {
        const f32x4* p = (const f32x4*)(ssq + (size_t)(pm * 256 + ai * 128 + wr * 64 + lane) * 16);
        const f32x4 a = p[0], b = p[1], c = p[2], d = p[3];
        const float s = ((a.x + a.y) + (a.z + a.w)) + ((b.x + b.y) + (b.z + b.w)) + ((c.x + c.y) + (c.z + c.w)) + ((d.x + d.y) + (d.z + d.w));
        const float rs = 1.0f / sqrtf(s * (1.0f / D) + EPS);
#pragma unroll
        for (int m = 0; m < 4; ++m) r[ai][m] = __shfl(rs, m * 16 + fr);
    }
}

template <class T> __device__ __forceinline__ T* launder_s(T* p) { asm volatile("" : "+s"(p)); return p; }
struct EpiProj {
    static constexpr bool PERM = true, AFTER_DRAIN = false;
    unsigned char* ws; float* out; const float* b_gate; const float* pool_scale; int l;
    __device__ __forceinline__ void operator()(const f32x4 (&acc)[2][2][4][2], const pg8::Unit& u, int wr, int wc, int fr, int fq) const {
        unsigned char* w_ = launder_s(ws); float* o_ = launder_s(out);
        float r[2][4]; unit_rstd((const float*)(w_ + WS_SSQ), u.pm, wr, fr, fq, r);
        const int pm = u.pm, pn = u.pn;
        const int lc0 = wc * 32 + 8 * fq;
        const bool samp = pm >= NTP;
        if (pn < 4) {
            bf16* O = (bf16*)(w_ + ((pn < 2) ? WS_UPOOL : WS_GB)); const int cb = (pn & 1) * 256 + lc0;
#pragma unroll
            for (int ai = 0; ai < 2; ++ai)
#pragma unroll
                for (int m = 0; m < 4; ++m) { const size_t row = (size_t)pm * 256 + ai * 128 + wr * 64 + m * 16 + fr; const float rr = r[ai][m];
#pragma unroll
                    for (int bj = 0; bj < 2; ++bj) { const f32x4 v0 = acc[ai][bj][m][0] * rr, v1 = acc[ai][bj][m][1] * rr; u32x4 w;
                        w.x = pk2(v0[0], v0[1]); w.y = pk2(v0[2], v0[3]); w.z = pk2(v1[0], v1[1]); w.w = pk2(v1[2], v1[3]);
                        *(u32x4*)(O + row * 512 + cb + bj * 128) = w; } }
            if (pn < 2 && (samp || ((pm & 15) == 15 && wr == 1)) && fr >= 1) {
                float* pool_p = o_ + O_POOLP + (size_t)l * 8 * 15 * 512; float* pool_s = o_ + O_POOLS + (size_t)l * 16 * 15 * 512;
#pragma unroll
                for (int ai = 0; ai < 2; ++ai) { if (!samp && ai == 0) continue;
                    float* sp = samp ? pool_s + ((size_t)((pm - NTP) * 4 + ai * 2 + wr) * 15 + (fr - 1)) * 512 : pool_p + ((size_t)(pm >> 4) * 15 + (fr - 1)) * 512;
                    const float rr = r[ai][3];
#pragma unroll
                    for (int bj = 0; bj < 2; ++bj) { *(f32x4*)(sp + cb + bj * 128) = acc[ai][bj][3][0] * rr; *(f32x4*)(sp + cb + bj * 128 + 4) = acc[ai][bj][3][1] * rr; } }
            }
        } else if (pn < 8) {
            const int cb = (pn - 4) * 128 + lc0; bf16* CVIN = (bf16*)(w_ + WS_CVIN);
            float* conv_p = o_ + O_CONVP + (size_t)l * 8 * 2 * 512; float* conv_s = o_ + O_CONVS + (size_t)l * 16 * 2 * 512;
#pragma unroll
            for (int ai = 0; ai < 2; ++ai)
#pragma unroll
                for (int m = 0; m < 4; ++m) { const size_t row = (size_t)pm * 256 + ai * 128 + wr * 64 + m * 16 + fr; const float rr = r[ai][m] * r[ai][m];
                    const f32x4 v0 = acc[ai][0][m][0] * acc[ai][1][m][0] * rr, v1 = acc[ai][0][m][1] * acc[ai][1][m][1] * rr; u32x4 w;
                    w.x = pk2(v0[0], v0[1]); w.y = pk2(v0[2], v0[3]); w.z = pk2(v1[0], v1[1]); w.w = pk2(v1[2], v1[3]);
                    *(u32x4*)(CVIN + row * 512 + cb) = w;
                    if (m == 3 && fr >= 14 && (samp || ((pm & 15) == 15 && wr == 1 && ai == 1))) {
                        float* sp = samp ? conv_s + ((size_t)((pm - NTP) * 4 + ai * 2 + wr) * 2 + (fr - 14)) * 512 : conv_p + ((size_t)(pm >> 4) * 2 + (fr - 14)) * 512;
                        *(f32x4*)(sp + cb) = v0; *(f32x4*)(sp + cb + 4) = v1; } }
        } else {
            const bool ga = pn < 12; bf16* O = (bf16*)(w_ + (ga ? WS_SA : WS_SB)); const int cb = ((pn - 8) & 3) * 256 + lc0; const float* bg = b_gate + (ga ? 0 : D);
#pragma unroll
            for (int bj = 0; bj < 2; ++bj) { const int c = cb + bj * 128;
                const f32x4 b0 = *(const f32x4*)(bg + c), b1 = *(const f32x4*)(bg + c + 4);
                f32x4 s0 = (f32x4){1.f, 1.f, 1.f, 1.f}, s1 = s0; if (ga) { s0 = *(const f32x4*)(pool_scale + c); s1 = *(const f32x4*)(pool_scale + c + 4); }
#pragma unroll
                for (int ai = 0; ai < 2; ++ai)
#pragma unroll
                    for (int m = 0; m < 4; ++m) { const size_t row = (size_t)pm * 256 + ai * 128 + wr * 64 + m * 16 + fr; const float rr = r[ai][m];
                        const f32x4 x0 = acc[ai][bj][m][0] * rr + b0, x1 = acc[ai][bj][m][1] * rr + b1; f32x4 v0, v1;
#pragma unroll
                        for (int e = 0; e < 4; ++e) { v0[e] = sigmoidf_(x0[e]) * s0[e]; v1[e] = sigmoidf_(x1[e]) * s1[e]; }
                        u32x4 w; w.x = pk2(v0[0], v0[1]); w.y = pk2(v0[2], v0[3]); w.z = pk2(v1[0], v1[1]); w.w = pk2(v1[2], v1[3]);
                        *(u32x4*)(O + row * 1024 + c) = w; } }
        }
    }
};

struct EpiMA {
    static constexpr bool PERM = true, AFTER_DRAIN = false;
    const bf16* SA; bf16* MA;
    __device__ __forceinline__ void operator()(const f32x4 (&acc)[2][2][4][2], const pg8::Unit& u, int wr, int wc, int fr, int fq) const {
        const int cb = u.pn * 256 + wc * 32 + 8 * fq;
#pragma unroll
        for (int ai = 0; ai < 2; ++ai)
#pragma unroll
            for (int m = 0; m < 4; ++m) { const size_t row = (size_t)u.pm * 256 + ai * 128 + wr * 64 + m * 16 + fr;
#pragma unroll
                for (int bj = 0; bj < 2; ++bj) { const size_t o = row * 1024 + cb + bj * 128; const u32x4 s = *(const u32x4*)(SA + o); float f[8]; UNPACK8(s, f);
                    const f32x4 a0 = acc[ai][bj][m][0], a1 = acc[ai][bj][m][1]; u32x4 w;
                    w.x = pk2(a0[0] * f[0], a0[1] * f[1]); w.y = pk2(a0[2] * f[2], a0[3] * f[3]); w.z = pk2(a1[0] * f[4], a1[1] * f[5]); w.w = pk2(a1[2] * f[6], a1[3] * f[7]);
                    *(u32x4*)(MA + o) = w; }
                asm volatile("" ::: "memory"); }
    }
};
struct EpiMerge {
    static constexpr bool PERM = true, AFTER_DRAIN = false;
    const bf16* SB; bf16* MA;
    __device__ __forceinline__ void operator()(const f32x4 (&acc)[2][2][4][2], const pg8::Unit& u, int wr, int wc, int fr, int fq) const {
        const int cb = u.pn * 256 + wc * 32 + 8 * fq;
#pragma unroll
        for (int ai = 0; ai < 2; ++ai)
#pragma unroll
            for (int m = 0; m < 4; ++m) { const size_t row = (size_t)u.pm * 256 + ai * 128 + wr * 64 + m * 16 + fr;
#pragma unroll
                for (int bj = 0; bj < 2; ++bj) { const size_t o = row * 1024 + cb + bj * 128; const u32x4 s = *(const u32x4*)(SB + o); const u32x4 p = *(const u32x4*)(MA + o);
                    float f[8], q[8]; UNPACK8(s, f); UNPACK8(p, q);
                    const f32x4 a0 = acc[ai][bj][m][0], a1 = acc[ai][bj][m][1]; u32x4 w;
                    w.x = pk2(a0[0] * f[0] + q[0], a0[1] * f[1] + q[1]); w.y = pk2(a0[2] * f[2] + q[2], a0[3] * f[3] + q[3]);
                    w.z = pk2(a1[0] * f[4] + q[4], a1[1] * f[5] + q[5]); w.w = pk2(a1[2] * f[6] + q[6], a1[3] * f[7] + q[7]);
                    *(u32x4*)(MA + o) = w; }
                asm volatile("" ::: "memory"); }
    }
};
struct EpiRes {
    static constexpr bool PERM = true, AFTER_DRAIN = false;
    const float* base_p; const float* base_s; float* out; bf16* xb; float* ssq;
    __device__ __forceinline__ void operator()(const f32x4 (&acc)[2][2][4][2], const pg8::Unit& u, int wr, int wc, int fr, int fq) const {
        const int pm = u.pm, cb = u.pn * 256 + wc * 32 + 8 * fq;
        const float* base = pm < NTP ? base_p + (size_t)pm * 256 * D : base_s + (size_t)(pm - NTP) * 256 * D;
#pragma unroll
        for (int ai = 0; ai < 2; ++ai)
#pragma unroll
            for (int m = 0; m < 4; ++m) { const int lr = ai * 128 + wr * 64 + m * 16 + fr; const size_t row = (size_t)pm * 256 + lr; float s = 0.f;
#pragma unroll
                for (int bj = 0; bj < 2; ++bj) { const int c = cb + bj * 128;
                    const f32x4 v0 = acc[ai][bj][m][0] + *(const f32x4*)(base + (size_t)lr * D + c), v1 = acc[ai][bj][m][1] + *(const f32x4*)(base + (size_t)lr * D + c + 4);
                    *(f32x4*)(out + row * D + c) = v0; *(f32x4*)(out + row * D + c + 4) = v1;
                    u32x4 w; w.x = pk2(v0[0], v0[1]); w.y = pk2(v0[2], v0[3]); w.z = pk2(v1[0], v1[1]); w.w = pk2(v1[2], v1[3]);
                    *(u32x4*)(xb + row * D + c) = w;
                    s += (v0[0] * v0[0] + v0[1] * v0[1]) + (v0[2] * v0[2] + v0[3] * v0[3]) + (v1[0] * v1[0] + v1[1] * v1[1]) + (v1[2] * v1[2] + v1[3] * v1[3]); }
                s += __shfl_xor(s, 16); s += __shfl_xor(s, 32);
                if (fq == 0) ssq[row * 16 + u.pn * 4 + wc] = s;
                asm volatile("" ::: "memory"); }
    }
};
template <int CTRL> __device__ __forceinline__ float dppf(float v) { return __builtin_bit_cast(float, __builtin_amdgcn_update_dpp(0, __builtin_bit_cast(int, v), CTRL, 0xf, 0xf, true)); }
#define DPP_SHR1 0x111
#define DPP_SHR2 0x112
#define DPP_SHL15 0x10F
#define DPP_SHL14 0x10E
struct EpiUpAct {
    static constexpr bool PERM = true, AFTER_DRAIN = false;
    unsigned char* ws; float* out; const float* fw; const float* fb; const float* sffn; LAS unsigned char* ex; int l;
    __device__ __forceinline__ void operator()(const f32x4 (&acc)[2][2][4][2], const pg8::Unit& u, int wr, int wc, int fr, int fq) const {
        unsigned char* w_ = launder_s(ws); float* o_ = launder_s(out);
        const int pm = u.pm, pn = u.pn; const bool samp = pm >= NTP;
        float r[2][4]; unit_rstd((const float*)(w_ + WS_SSQ), pm, wr, fr, fq, r);
        const int lc0 = wc * 32 + 8 * fq;
        f32x4 x[2][2][4][2];
#pragma unroll
        for (int ai = 0; ai < 2; ++ai)
#pragma unroll
            for (int bj = 0; bj < 2; ++bj)
#pragma unroll
                for (int m = 0; m < 4; ++m)
#pragma unroll
                    for (int n = 0; n < 2; ++n) x[ai][bj][m][n] = acc[ai][bj][m][n] * r[ai][m];
        {
            float* ffn_p = o_ + O_FFNP + (size_t)l * 8 * 2 * FF2; float* ffn_s = o_ + O_FFNS + (size_t)l * 16 * 2 * FF2; float* HALO = (float*)(w_ + WS_HALO) + (size_t)pm * 4 * FF2;
            if (fr >= 14) {
#pragma unroll
                for (int ai = 0; ai < 2; ++ai) {
                    if (samp || ((pm & 15) == 15 && wr == 1 && ai == 1)) {
                        float* sp = samp ? ffn_s + ((size_t)((pm - NTP) * 4 + ai * 2 + wr) * 2 + (fr - 14)) * FF2 : ffn_p + ((size_t)(pm >> 4) * 2 + (fr - 14)) * FF2;
#pragma unroll
                        for (int bj = 0; bj < 2; ++bj) { const int oc = bj * FF + pn * 128 + lc0; *(f32x4*)(sp + oc) = x[ai][bj][3][0]; *(f32x4*)(sp + oc + 4) = x[ai][bj][3][1]; } }
                }
                if (wr == 1) {
#pragma unroll
                    for (int bj = 0; bj < 2; ++bj) { float* hp = HALO + (size_t)(2 + fr - 14) * FF2 + pn * 256 + bj * 128 + lc0; *(f32x4*)hp = x[1][bj][3][0]; *(f32x4*)(hp + 4) = x[1][bj][3][1]; } }
            }
            if (fr < 2 && wr == 0) {
#pragma unroll
                for (int bj = 0; bj < 2; ++bj) { float* hp = HALO + (size_t)fr * FF2 + pn * 256 + bj * 128 + lc0; *(f32x4*)hp = x[0][bj][0][0]; *(f32x4*)(hp + 4) = x[0][bj][0][1]; } }
        }
        if (!samp) {
            if (fr >= 14) {
#pragma unroll
                for (int ai = 0; ai < 2; ++ai)
#pragma unroll
                    for (int bj = 0; bj < 2; ++bj)
#pragma unroll
                        for (int n = 0; n < 2; ++n) *(LAS f32x4*)(ex + ((((2 * ai + wr) * 2 + (fr - 14)) * 256) + bj * 128 + lc0 + 4 * n) * 4) = x[ai][bj][3][n];
            }
            asm volatile("s_waitcnt lgkmcnt(0)" ::: "memory"); __builtin_amdgcn_s_barrier(); asm volatile("" ::: "memory");
        }
        bf16* ACT = (bf16*)(w_ + WS_ACT);
        unsigned pk[2][4][2];
#pragma unroll
        for (int n = 0; n < 2; ++n) {
            const int f = pn * 128 + lc0 + 4 * n;
            const f32x4 wv0 = *(const f32x4*)(fw + f), wv1 = *(const f32x4*)(fw + FF2 + f), wv2 = *(const f32x4*)(fw + 2 * FF2 + f), bv = *(const f32x4*)(fb + f);
            const f32x4 wg0 = *(const f32x4*)(fw + FF + f), wg1 = *(const f32x4*)(fw + FF2 + FF + f), wg2 = *(const f32x4*)(fw + 2 * FF2 + FF + f), bg = *(const f32x4*)(fb + FF + f);
#pragma unroll
            for (int ai = 0; ai < 2; ++ai) {
                const int B = 2 * ai + wr;
                f32x4 e1v = (f32x4){0.f, 0.f, 0.f, 0.f}, e2v = e1v, e1g = e1v, e2g = e1v;
                if (fr < 2) {
                    if (samp) {
                        const float* b0 = sffn + (size_t)((pm - NTP) * 4 + B) * 2 * FF2; const float* b1 = b0 + FF2;
                        const f32x4 v1 = *(const f32x4*)(b1 + f), g1 = *(const f32x4*)(b1 + FF + f);
                        if (fr == 0) { e1v = v1; e1g = g1; e2v = *(const f32x4*)(b0 + f); e2g = *(const f32x4*)(b0 + FF + f); } else { e2v = v1; e2g = g1; }
                    } else if (B > 0) {
                        const LAS unsigned char* eb = ex + ((B - 1) * 2 * 256 + lc0 + 4 * n) * 4;
                        const f32x4 v63 = *(const LAS f32x4*)(eb + 256 * 4), g63 = *(const LAS f32x4*)(eb + 256 * 4 + 128 * 4);
                        if (fr == 0) { e1v = v63; e1g = g63; e2v = *(const LAS f32x4*)eb; e2g = *(const LAS f32x4*)(eb + 128 * 4); } else { e2v = v63; e2g = g63; }
                    }
                }
#pragma unroll
                for (int m = 0; m < 4; ++m) {
                    float av[4];
#pragma unroll
                    for (int e = 0; e < 4; ++e) {
                        const float xv = x[ai][0][m][n][e], xg = x[ai][1][m][n][e];
                        float yv = bv[e] + wv2[e] * xv + wv1[e] * dppf<DPP_SHR1>(xv) + wv0[e] * dppf<DPP_SHR2>(xv);
                        float yg = bg[e] + wg2[e] * xg + wg1[e] * dppf<DPP_SHR1>(xg) + wg0[e] * dppf<DPP_SHR2>(xg);
                        if (m > 0) { const float pv = x[ai][0][m > 0 ? m - 1 : 0][n][e], pg = x[ai][1][m > 0 ? m - 1 : 0][n][e];
                            yv += wv1[e] * dppf<DPP_SHL15>(pv) + wv0[e] * dppf<DPP_SHL14>(pv); yg += wg1[e] * dppf<DPP_SHL15>(pg) + wg0[e] * dppf<DPP_SHL14>(pg); }
                        else { yv += wv1[e] * e1v[e] + wv0[e] * e2v[e]; yg += wg1[e] * e1g[e] + wg0[e] * e2g[e]; }
                        av[e] = yg * sigmoidf_(yg) * yv;
                    }
                    const unsigned lo = pk2(av[0], av[1]), hi = pk2(av[2], av[3]);
                    if (n == 0) { pk[ai][m][0] = lo; pk[ai][m][1] = hi; }
                    else { u32x4 w; w.x = pk[ai][m][0]; w.y = pk[ai][m][1]; w.z = lo; w.w = hi;
                        *(u32x4*)(ACT + ((size_t)pm * 256 + ai * 128 + wr * 64 + m * 16 + fr) * FF + pn * 128 + lc0) = w; }
                }
            }
        }
    }
};

#define XB_TMO      128
#define XB_XCNT(j)  (256  + 64 * (j))
#define XB_XSUB(j)  (1280 + 64 * (j))
#define XB_XGEN(j)  (2304 + 64 * (j))
#define XB_TOP      3328
#define XB_TOPGEN   3392
#define XCD_BAR_WORDS 3456
#define XB_SPIN_CAP (1u << 18)
__device__ __forceinline__ unsigned xb_ld(unsigned* p)              { return __hip_atomic_load(p, __ATOMIC_RELAXED, __HIP_MEMORY_SCOPE_AGENT); }
__device__ __forceinline__ unsigned xb_add(unsigned* p, unsigned v) { return __hip_atomic_fetch_add(p, v, __ATOMIC_RELAXED, __HIP_MEMORY_SCOPE_AGENT); }
__device__ __forceinline__ unsigned xb_xcc_id() { return (unsigned)__builtin_amdgcn_s_getreg((3 << 11) | 20) & 0xFu; }
#define XB_SPIN(cond, bar) do { unsigned _sp = 0; while (cond) { __builtin_amdgcn_s_sleep(1); \
    if ((++_sp & 255u) == 0u) { if (xb_ld(&(bar)[XB_TMO])) break; if (_sp > XB_SPIN_CAP) { atomicAdd(&(bar)[XB_TMO], 1u); break; } } } } while (0)
struct XcdBarrier { unsigned* bar; unsigned x; volatile LAS unsigned* st; };
__device__ __forceinline__ XcdBarrier xcd_barrier_post(unsigned* bar, volatile LAS unsigned* st) {
    XcdBarrier b; b.bar = bar; b.x = xb_xcc_id(); b.st = st;
    if (threadIdx.x == 0) (void)xb_add(&bar[XB_XCNT(b.x)], 1u);
    return b;
}
__device__ __forceinline__ void xcd_barrier_complete(unsigned* bar, unsigned x, unsigned& nloc, unsigned& nx) {
    const unsigned G = gridDim.x * gridDim.y * gridDim.z;
    unsigned sum, cnt, mine, sp = 0u;
    for (;;) {
        sum = 0u; cnt = 0u; mine = 0u;
#pragma unroll
        for (unsigned j = 0; j < 16; ++j) { const unsigned c = xb_ld(&bar[XB_XCNT(j)]); sum += c; cnt += (c > 0u) ? 1u : 0u; mine = (j == x) ? c : mine; }
        if (sum == G) break;
        __builtin_amdgcn_s_sleep(1);
        if ((++sp & 255u) == 0u) { if (xb_ld(&bar[XB_TMO])) break; if (sp > XB_SPIN_CAP) { atomicAdd(&bar[XB_TMO], 1u); break; } }
    }
    nloc = mine > 0u ? mine : 1u; nx = cnt > 0u ? cnt : 1u;
}
__device__ __forceinline__ void xcd_barrier(const XcdBarrier& b) {
    asm volatile("s_waitcnt vmcnt(0)" ::: "memory");
    __syncthreads();
    if (threadIdx.x == 0) {
        unsigned* bar = b.bar;
        __builtin_amdgcn_s_waitcnt(0);
        unsigned nloc = b.st[0], nx = b.st[1];
        if (nloc == 0u) { xcd_barrier_complete(bar, b.x, nloc, nx); b.st[0] = nloc; b.st[1] = nx; }
        const unsigned old = xb_add(&bar[XB_XSUB(b.x)], 1u);
        const unsigned gen = old / nloc;
        if (old + 1u == (gen + 1u) * nloc) {
            __builtin_amdgcn_fence(__ATOMIC_RELEASE, "agent");
            asm volatile("s_waitcnt vmcnt(0)" ::: "memory");
            const unsigned og = xb_add(&bar[XB_TOP], 1u);
            const unsigned tg = og / nx;
            if (og + 1u == (tg + 1u) * nx) xb_add(&bar[XB_TOPGEN], 1u);
            else XB_SPIN(xb_ld(&bar[XB_TOPGEN]) == tg, bar);
            __builtin_amdgcn_fence(__ATOMIC_ACQUIRE, "agent");
            xb_add(&bar[XB_XGEN(b.x)], 1u);
            asm volatile("s_waitcnt vmcnt(0)" ::: "memory");
        } else {
            XB_SPIN(xb_ld(&bar[XB_XGEN(b.x)]) == gen, bar);
            __builtin_amdgcn_fence(__ATOMIC_ACQUIRE, "agent");
            asm volatile("s_waitcnt vmcnt(0)" ::: "memory");
        }
    }
    __syncthreads();
}

struct Args { const float* in[19]; float* out; unsigned char* ws; };

struct Frame {
    LAS unsigned char* lds;
    int tid, lane, wave, G, bid;
};

__device__ __forceinline__ float wave_sum(float v) {
#pragma unroll
    for (int o = 1; o < 64; o <<= 1) v += __shfl_xor(v, o);
    return v;
}

__device__ __forceinline__ void tr_item(const float* W, int ldw, int srccol, int ks0, const float* gs, bf16* WT, int Kd, int dst_row, int kd0, bool zero, LAS float* scr, int lane) {
    if (!zero) {
#pragma unroll 8
        for (int i = 0; i < 32; ++i) { const int kk = 2 * i + (lane >> 5); float v = W[(size_t)(ks0 + kk) * ldw + srccol + (lane & 31)]; if (gs) v *= gs[ks0 + kk]; scr[kk * 33 + (lane & 31)] = v; }
    }
    asm volatile("s_waitcnt lgkmcnt(0)" ::: "memory");
    const int c = lane & 7;
#pragma unroll
    for (int j = 0; j < 4; ++j) { const int n = (lane >> 3) + 8 * j; const LAS float* s = scr + (8 * c) * 33 + n;
        u32x4 o;
        if (zero) { o = (u32x4){0u, 0u, 0u, 0u}; }
        else { o.x = pk2(s[0 * 33], s[1 * 33]); o.y = pk2(s[2 * 33], s[3 * 33]); o.z = pk2(s[4 * 33], s[5 * 33]); o.w = pk2(s[6 * 33], s[7 * 33]); }
        *(u32x4*)(WT + (size_t)(dst_row + n) * Kd + kd0 + 8 * c) = o; }
    asm volatile("s_waitcnt lgkmcnt(0)" ::: "memory");
}

constexpr int I_IN = 16 * 128, I_UP = 16 * 176, I_DN = 44 * 32, I_O = 16 * 32, I_CO = 8 * 32, I_MAP = 128;
constexpr int ITEMS_L = I_IN + I_UP + I_DN + I_O + I_CO + I_MAP;

__device__ __forceinline__ void p0_prologue(const Frame& F, const Args& a) {
    int tid_ = threadIdx.x; asm volatile("" : "+v"(tid_)); const int TID = tid_, LANE = tid_ & 63, WAVE = __builtin_amdgcn_readfirstlane(tid_ >> 6);
    LAS float* scr = (LAS float*)(F.lds + WAVE * 16384);
    const int gw = F.bid * NWAVES + WAVE, NGW = F.G * NWAVES;
    unsigned char* ws = a.ws;
    for (int it = gw; it < 2 * ITEMS_L; it += NGW) {
        const int l = it / ITEMS_L; int r = it % ITEMS_L;
        unsigned char* wl = ws + WS_W + (size_t)l * W_LAYER;
        if (r < I_IN) { const int kb = r / 128, n0 = (r % 128) * 32;
            const int src = (n0 < 1024 || n0 >= 2048) ? n0 : 1024 + 512 * (((n0 - 1024) % 256) / 128) + 128 * ((n0 - 1024) / 256) + (n0 % 128);
            tr_item(a.in[6] + (size_t)l * D * INW, INW, src, kb * 64, a.in[5] + l * D, (bf16*)(wl + WO_IN), D, n0, kb * 64, false, scr, LANE); continue; } r -= I_IN;
        if (r < I_UP) { const int kb = r / 176, n0 = (r % 176) * 32;
            const int src = ((n0 % 256) / 128) * FF + 128 * (n0 / 256) + (n0 % 128);
            tr_item(a.in[14] + (size_t)l * D * FF2, FF2, src, kb * 64, a.in[13] + l * D, (bf16*)(wl + WO_UP), D, n0, kb * 64, false, scr, LANE); continue; } r -= I_UP;
        if (r < I_DN) { const int kb = r / 32, n0 = (r % 32) * 32;
            tr_item(a.in[17] + (size_t)l * FF * D, D, n0, kb * 64, nullptr, (bf16*)(wl + WO_DN), FF, n0, kb * 64, false, scr, LANE); continue; } r -= I_DN;
        if (r < I_O) { const int kb = r / 32, n0 = (r % 32) * 32;
            tr_item(a.in[12] + (size_t)l * D * D, D, n0, kb * 64, nullptr, (bf16*)(wl + WO_O), D, n0, kb * 64, false, scr, LANE); continue; } r -= I_O;
        if (r < I_CO) { const int kb = r / 32, n0 = (r % 32) * 32;
            tr_item(a.in[11] + (size_t)l * CW * D, D, n0, kb * 64, nullptr, (bf16*)(wl + WO_CO), CW, n0, kb * 64, false, scr, LANE); continue; } r -= I_CO;
        { const int g = r / 32, kb = (r % 32) / 8, nb = r % 8; const bool zero = (kb >> 1) != (g & 1);
            tr_item(a.in[8] + (size_t)l * 4 * 128 * 256 + (size_t)g * 128 * 256, 256, nb * 32, (kb & 1) * 64, nullptr, (bf16*)(wl + WO_MAP), 256, g * 256 + nb * 32, kb * 64, zero, scr, LANE); }
    }
    bf16* XB = (bf16*)(ws + WS_XB); float* SSQ = (float*)(ws + WS_SSQ);
    for (int m = gw; m < M; m += NGW) {
        const float* xrow = m < MP ? a.in[0] + (size_t)m * D : a.in[1] + (size_t)(m - MP) * D;
        const f32x4* xr = (const f32x4*)xrow + LANE; f32x4 v[4]; float s = 0.f;
#pragma unroll
        for (int j = 0; j < 4; ++j) { v[j] = xr[64 * j]; s += (v[j].x * v[j].x + v[j].y * v[j].y) + (v[j].z * v[j].z + v[j].w * v[j].w); }
        s = wave_sum(s);
        u32x2* o8 = (u32x2*)(XB + (size_t)m * D) + LANE;
#pragma unroll
        for (int j = 0; j < 4; ++j) { u32x2 w; w.x = pk2(v[j].x, v[j].y); w.y = pk2(v[j].z, v[j].w); o8[64 * j] = w; }
        if (LANE < 16) SSQ[(size_t)m * 16 + LANE] = LANE == 0 ? s : 0.f;
    }
}

constexpr int MIX_RB = 33;
__device__ __forceinline__ void mix_elt(const Frame& F, const Args& a, int l) {
    int tid_ = threadIdx.x; asm volatile("" : "+v"(tid_)); const int TID = tid_;
    unsigned char* ws = a.ws;
    const bf16* UPOOL = (const bf16*)(ws + WS_UPOOL); const bf16* CVIN = (const bf16*)(ws + WS_CVIN); const bf16* GB = (const bf16*)(ws + WS_GB);
    bf16* MIXED = (bf16*)(ws + WS_MIXED); bf16* GBCV = (bf16*)(ws + WS_GBCV);
    const float* spool = a.in[2] + (size_t)l * 16 * 15 * 512; const float* sconv = a.in[3] + (size_t)l * 16 * 2 * 512; const float* cw = a.in[10] + (size_t)l * 3 * 512;
    const int nrb = (M + MIX_RB - 1) / MIX_RB, total = nrb * 128, stride = F.G * NTHR;
    for (int idx = F.bid * NTHR + TID; idx < total; idx += stride) {
        const int rb = idx >> 7, c8 = idx & 127;
        const int r0 = rb * MIX_RB, r1 = (r0 + MIX_RB) < M ? (r0 + MIX_RB) : M;
        if (c8 < 64) {
            const int ch0 = c8 * 8, win = 2 << (c8 >> 4);
            float sum[8], f[8];
            for (int row = r0; row < r1; ++row) {
                const bool samp = row >= MP; int t, sq = 0;
                if (!samp) t = row & 4095; else { const int sr = row - MP; sq = sr >> 6; t = sr & 63; }
                const u32x4 uw = *(const u32x4*)(UPOOL + (size_t)row * 512 + ch0);
                if (row == r0 || t == 0) {
#pragma unroll
                    for (int e = 0; e < 8; ++e) sum[e] = 0.f;
                    for (int j = 1; j < win; ++j) {
                        const int tt = t - j;
                        if (tt >= 0) { const u32x4 w = *(const u32x4*)(UPOOL + (size_t)(row - j) * 512 + ch0); UNPACK8(w, f);
#pragma unroll
                            for (int e = 0; e < 8; ++e) sum[e] += f[e]; }
                        else if (samp) { const float* p = spool + ((size_t)sq * 15 + 15 + tt) * 512 + ch0; const f32x4 p0 = *(const f32x4*)p, p1 = *(const f32x4*)(p + 4);
#pragma unroll
                            for (int e = 0; e < 4; ++e) { sum[e] += p0[e]; sum[4 + e] += p1[e]; } }
                    }
                } else {
                    const int tt = t - win;
                    if (tt >= 0) { const u32x4 w = *(const u32x4*)(UPOOL + (size_t)(row - win) * 512 + ch0); UNPACK8(w, f);
#pragma unroll
                        for (int e = 0; e < 8; ++e) sum[e] -= f[e]; }
                    else if (samp) { const float* p = spool + ((size_t)sq * 15 + 15 + tt) * 512 + ch0; const f32x4 p0 = *(const f32x4*)p, p1 = *(const f32x4*)(p + 4);
#pragma unroll
                        for (int e = 0; e < 4; ++e) { sum[e] -= p0[e]; sum[4 + e] -= p1[e]; } }
                }
                UNPACK8(uw, f);
                const float cnt = samp ? (float)win : (float)(win < t + 1 ? win : t + 1), inv = 1.0f / cnt;
                float o[8];
#pragma unroll
                for (int e = 0; e < 8; ++e) { sum[e] += f[e]; o[e] = sum[e] * inv - f[e]; }
                u32x4 w; w.x = pk2(o[0], o[1]); w.y = pk2(o[2], o[3]); w.z = pk2(o[4], o[5]); w.w = pk2(o[6], o[7]);
                *(u32x4*)(MIXED + (size_t)row * 512 + ch0) = w;
            }
        } else {
            const int ch0 = (c8 - 64) * 8;
            float w0[8], w1[8], w2[8];
#pragma unroll
            for (int h = 0; h < 2; ++h) { const f32x4 a0 = *(const f32x4*)(cw + ch0 + 4 * h), a1 = *(const f32x4*)(cw + 512 + ch0 + 4 * h), a2 = *(const f32x4*)(cw + 1024 + ch0 + 4 * h);
#pragma unroll
                for (int e = 0; e < 4; ++e) { w0[4 * h + e] = a0[e]; w1[4 * h + e] = a1[e]; w2[4 * h + e] = a2[e]; } }
            float x0[8], x1[8], x2[8], gb[8];
#pragma unroll
            for (int e = 0; e < 8; ++e) { x1[e] = 0.f; x2[e] = 0.f; }
            for (int row = r0; row < r1; ++row) {
                const bool samp = row >= MP; int t, sq = 0;
                if (!samp) t = row & 4095; else { const int sr = row - MP; sq = sr >> 6; t = sr & 63; }
                { const u32x4 w = *(const u32x4*)(CVIN + (size_t)row * 512 + ch0); UNPACK8(w, x0); }
                { const u32x4 w = *(const u32x4*)(GB + (size_t)row * 512 + ch0); UNPACK8(w, gb); }
                if (row == r0 || t == 0) {
                    if (t >= 1) { const u32x4 w = *(const u32x4*)(CVIN + (size_t)(row - 1) * 512 + ch0); UNPACK8(w, x1); }
                    else if (samp) { const float* p = sconv + ((size_t)sq * 2 + 1) * 512 + ch0; const f32x4 p0 = *(const f32x4*)p, p1 = *(const f32x4*)(p + 4);
#pragma unroll
                        for (int e = 0; e < 4; ++e) { x1[e] = p0[e]; x1[4 + e] = p1[e]; } }
                    else {
#pragma unroll
                        for (int e = 0; e < 8; ++e) x1[e] = 0.f; }
                    if (t >= 2) { const u32x4 w = *(const u32x4*)(CVIN + (size_t)(row - 2) * 512 + ch0); UNPACK8(w, x2); }
                    else if (samp) { const float* p = sconv + ((size_t)sq * 2 + t) * 512 + ch0; const f32x4 p0 = *(const f32x4*)p, p1 = *(const f32x4*)(p + 4);
#pragma unroll
                        for (int e = 0; e < 4; ++e) { x2[e] = p0[e]; x2[4 + e] = p1[e]; } }
                    else {
#pragma unroll
                        for (int e = 0; e < 8; ++e) x2[e] = 0.f; }
                }
                float o[8];
#pragma unroll
                for (int e = 0; e < 8; ++e) { o[e] = gb[e] * (w0[e] * x2[e] + w1[e] * x1[e] + w2[e] * x0[e]); x2[e] = x1[e]; x1[e] = x0[e]; }
                u32x4 w; w.x = pk2(o[0], o[1]); w.y = pk2(o[2], o[3]); w.z = pk2(o[4], o[5]); w.w = pk2(o[6], o[7]);
                *(u32x4*)(GBCV + (size_t)row * 512 + ch0) = w;
            }
        }
    }
}

__device__ __forceinline__ void ffn_fixup(const Frame& F, const Args& a, int l) {
    int tid_ = threadIdx.x; asm volatile("" : "+v"(tid_)); const int TID = tid_;
    unsigned char* ws = a.ws;
    const float* HALO = (const float*)(ws + WS_HALO); bf16* ACT = (bf16*)(ws + WS_ACT);
    const float* fw = a.in[15] + (size_t)l * 3 * FF2; const float* fb = a.in[16] + (size_t)l * FF2;
    const int total = NTP * 2 * 352, stride = F.G * NTHR;
    for (int idx = F.bid * NTHR + TID; idx < total; idx += stride) {
        const int pm = idx / 704, rem = idx % 704, rr = rem / 352, c8 = rem % 352;
        if ((pm & 15) == 0) continue;
        const int f0 = c8 * 8, pn = f0 >> 7, j0 = f0 & 127;
        float res[2][8];
#pragma unroll
        for (int h = 0; h < 2; ++h) {
            const int pc = pn * 256 + h * 128 + j0, oc = h * FF + f0;
            const float* p0 = HALO + ((size_t)pm * 4 + rr) * FF2 + pc;
            const float* p1 = rr == 1 ? HALO + ((size_t)pm * 4 + 0) * FF2 + pc : HALO + ((size_t)(pm - 1) * 4 + 3) * FF2 + pc;
            const float* p2 = rr == 1 ? HALO + ((size_t)(pm - 1) * 4 + 3) * FF2 + pc : HALO + ((size_t)(pm - 1) * 4 + 2) * FF2 + pc;
#pragma unroll
            for (int q = 0; q < 2; ++q) { const f32x4 x0 = *(const f32x4*)(p0 + 4 * q), x1 = *(const f32x4*)(p1 + 4 * q), x2 = *(const f32x4*)(p2 + 4 * q);
                const f32x4 w0 = *(const f32x4*)(fw + oc + 4 * q), w1 = *(const f32x4*)(fw + FF2 + oc + 4 * q), w2 = *(const f32x4*)(fw + 2 * FF2 + oc + 4 * q), b = *(const f32x4*)(fb + oc + 4 * q);
#pragma unroll
                for (int e = 0; e < 4; ++e) res[h][4 * q + e] = w0[e] * x2[e] + w1[e] * x1[e] + w2[e] * x0[e] + b[e]; }
        }
        float o[8];
#pragma unroll
        for (int e = 0; e < 8; ++e) o[e] = res[1][e] * sigmoidf_(res[1][e]) * res[0][e];
        u32x4 w; w.x = pk2(o[0], o[1]); w.y = pk2(o[2], o[3]); w.z = pk2(o[4], o[5]); w.w = pk2(o[6], o[7]);
        *(u32x4*)(ACT + ((size_t)pm * 256 + rr) * FF + f0) = w;
    }
}

__device__ __forceinline__ void final_norm(const Frame& F, const Args& a) {
    int tid_ = threadIdx.x; asm volatile("" : "+v"(tid_)); const int TID = tid_, LANE = tid_ & 63, WAVE = __builtin_amdgcn_readfirstlane(tid_ >> 6);
    const float* SSQ = (const float*)(a.ws + WS_SSQ); const float* g = a.in[18];
    const int gw = F.bid * NWAVES + WAVE, NGW = F.G * NWAVES;
    f32x4 gv[4];
#pragma unroll
    for (int j = 0; j < 4; ++j) gv[j] = ((const f32x4*)g)[LANE + 64 * j];
    for (int m = gw; m < M; m += NGW) {
        float s = LANE < 16 ? SSQ[(size_t)m * 16 + LANE] : 0.f;
        s = wave_sum(s);
        const float rs = 1.0f / sqrtf(s * (1.0f / D) + EPS);
        f32x4* xr = (f32x4*)(a.out + (size_t)m * D) + LANE;
#pragma unroll
        for (int j = 0; j < 4; ++j) { f32x4 v = xr[64 * j]; v = v * rs * gv[j]; xr[64 * j] = v; }
    }
}

typedef const __attribute__((address_space(4))) Args* KArgs;
__device__ __forceinline__ Args load_args(KArgs kp) {
    asm volatile("" : "+s"(kp)); Args a;
#pragma unroll
    for (int i = 0; i < 19; ++i) a.in[i] = kp->in[i];
    a.out = kp->out; a.ws = kp->ws; return a;
}

__global__ void __launch_bounds__(NTHR, 2) fwd_mega(Args a_unused) {
    extern __shared__ __attribute__((aligned(16))) unsigned char lds_raw[];
    cg::grid_group grid = cg::this_grid();
    KArgs kp = (KArgs)__builtin_amdgcn_kernarg_segment_ptr();
    Frame F;
    F.lds = (LAS unsigned char*)lds_raw;
    F.tid = threadIdx.x; F.lane = F.tid & 63; F.wave = __builtin_amdgcn_readfirstlane(F.tid >> 6);
    F.G = gridDim.x; F.bid = blockIdx.x;
    unsigned* barw;
    { const Args a = load_args(kp); barw = (unsigned*)a.ws; }
    if (blockIdx.x == 0) for (int i = threadIdx.x; i < XCD_BAR_WORDS; i += NTHR) __hip_atomic_store(barw + i, 0u, __ATOMIC_RELAXED, __HIP_MEMORY_SCOPE_AGENT);
    volatile LAS unsigned* bst = (volatile LAS unsigned*)(F.lds + BST_OFF);
    if (threadIdx.x < 4) bst[threadIdx.x] = 0u;
    __syncthreads();

    if constexpr (PHMASK & 1) { const Args a = load_args(kp); p0_prologue(F, a); }
    if constexpr (PROBE == 2) { __syncthreads(); const Args a = load_args(kp); p0_prologue(F, a); }
    grid.sync();
    const XcdBarrier xb = xcd_barrier_post(barw, bst);

#pragma unroll 1
    for (int l = 0; l < 2; ++l) {
        if constexpr (PHMASK & 2) {
            const Args a = load_args(kp); unsigned char* ws = a.ws; unsigned char* wl = ws + WS_W + (size_t)l * W_LAYER;
            pg8::Gemm g{(const bf16*)(ws + WS_XB), (const bf16*)(wl + WO_IN), M, INW, D, D, 0, 0}; pg8::StaticOrder S; S.init(M, INW, F.G, F.bid);
            EpiProj E{ws, a.out, a.in[7] + (size_t)l * 2 * D, a.in[9] + (size_t)l * D, l};
            pg8::gemm_phase<EpiProj, pg8::StaticOrder, true, true>(F.lds, g, S, E);
            if constexpr (PROBE == 4) { __syncthreads(); pg8::gemm_phase<EpiProj, pg8::StaticOrder, true, true>(F.lds, g, S, E); }
        }
        xcd_barrier(xb);
_Pragma("unroll 1")
        for (int rep = 0; rep < (PROBE == 3 ? 2 : 1); ++rep) { const Args a = load_args(kp); mix_elt(F, a, l); }
        xcd_barrier(xb);
        if constexpr (PHMASK & 8) {
            const Args a = load_args(kp); unsigned char* ws = a.ws; unsigned char* wl = ws + WS_W + (size_t)l * W_LAYER;
            pg8::Gemm g{(const bf16*)(ws + WS_MIXED), (const bf16*)(wl + WO_MAP), M, D, 256, PW, 1, 512}; pg8::StaticOrder S; S.init(M, D, F.G, F.bid);
            EpiMA E{(const bf16*)(ws + WS_SA), (bf16*)(ws + WS_MA)};
            pg8::gemm_phase<EpiMA, pg8::StaticOrder, true, true>(F.lds, g, S, E);
        }
        xcd_barrier(xb);
        if constexpr (PHMASK & 16) {
            const Args a = load_args(kp); unsigned char* ws = a.ws; unsigned char* wl = ws + WS_W + (size_t)l * W_LAYER;
            pg8::Gemm g{(const bf16*)(ws + WS_GBCV), (const bf16*)(wl + WO_CO), M, D, CW, CW, 0, 0}; pg8::StaticOrder S; S.init(M, D, F.G, F.bid);
            EpiMerge E{(const bf16*)(ws + WS_SB), (bf16*)(ws + WS_MA)};
            pg8::gemm_phase<EpiMerge, pg8::StaticOrder, true, true>(F.lds, g, S, E);
        }
        xcd_barrier(xb);
        if constexpr (PHMASK & 32) {
            const Args a = load_args(kp); unsigned char* ws = a.ws; unsigned char* wl = ws + WS_W + (size_t)l * W_LAYER;
            pg8::Gemm g{(const bf16*)(ws + WS_MA), (const bf16*)(wl + WO_O), M, D, D, D, 0, 0}; pg8::StaticOrder S; S.init(M, D, F.G, F.bid);
            EpiRes E{l == 0 ? a.in[0] : a.out, l == 0 ? a.in[1] : a.out + (size_t)MP * D, a.out, (bf16*)(ws + WS_XB), (float*)(ws + WS_SSQ)};
            pg8::gemm_phase<EpiRes, pg8::StaticOrder, true, true>(F.lds, g, S, E);
        }
        xcd_barrier(xb);
        if constexpr (PHMASK & 64) {
            const Args a = load_args(kp); unsigned char* ws = a.ws; unsigned char* wl = ws + WS_W + (size_t)l * W_LAYER;
            pg8::Gemm g{(const bf16*)(ws + WS_XB), (const bf16*)(wl + WO_UP), M, FF2, D, D, 0, 0}; pg8::StaticOrder S; S.init(M, FF2, F.G, F.bid);
            EpiUpAct E{ws, a.out, a.in[15] + (size_t)l * 3 * FF2, a.in[16] + (size_t)l * FF2, a.in[4] + (size_t)l * 16 * 2 * FF2, F.lds + EX_OFF, l};
            pg8::gemm_phase<EpiUpAct, pg8::StaticOrder, true, true>(F.lds, g, S, E);
        }
        xcd_barrier(xb);
        if constexpr (PHMASK & 128) { const Args a = load_args(kp); ffn_fixup(F, a, l); }
        xcd_barrier(xb);
        if constexpr (PHMASK & 256) {
            const Args a = load_args(kp); unsigned char* ws = a.ws; unsigned char* wl = ws + WS_W + (size_t)l * W_LAYER;
            pg8::Gemm g{(const bf16*)(ws + WS_ACT), (const bf16*)(wl + WO_DN), M, D, FF, FF, 0, 0}; pg8::StaticOrder S; S.init(M, D, F.G, F.bid);
            EpiRes E{a.out, a.out + (size_t)MP * D, a.out, (bf16*)(ws + WS_XB), (float*)(ws + WS_SSQ)};
            pg8::gemm_phase<EpiRes, pg8::StaticOrder, true, true>(F.lds, g, S, E);
        }
        xcd_barrier(xb);
    }
    if constexpr (PHMASK & 512) { const Args a = load_args(kp); final_norm(F, a); }
    if constexpr (PROBE == 1) { for (int i = 0; i < 16; ++i) xcd_barrier(xb); }
}

extern "C" void kernel_launch(void* const* d_in, const int* in_sizes, int n_in, void* d_out, int out_size, void* d_ws, size_t ws_size, hipStream_t stream) {
    static int grid = 0;
    if (grid == 0) {
        if (n_in != 19 || in_sizes[0] != MP * D || (size_t)out_size != O_END || ws_size < WS_END) {
            fprintf(stderr, "kernel_launch: unexpected shapes: n_in %d in0 %d out %d ws %zu (need %zu)\n", n_in, n_in > 0 ? in_sizes[0] : -1, out_size, ws_size, (size_t)WS_END); grid = -1; return; }
        int dev = 0, cus = 0, per_cu = 0;
        hipGetDevice(&dev); hipDeviceGetAttribute(&cus, hipDeviceAttributeMultiprocessorCount, dev);
        if (hipFuncSetAttribute((const void*)fwd_mega, hipFuncAttributeMaxDynamicSharedMemorySize, LDS_BYTES) != hipSuccess) { fprintf(stderr, "kernel_launch: hipFuncSetAttribute failed\n"); grid = -1; return; }
        if (hipOccupancyMaxActiveBlocksPerMultiprocessor(&per_cu, (const void*)fwd_mega, NTHR, LDS_BYTES) != hipSuccess || per_cu < 1) { fprintf(stderr, "kernel_launch: occupancy query says %d\n", per_cu); per_cu = 1; }
        (void)hipGetLastError();
        grid = cus;
    }
    if (grid < 0) return;
    Args a{};
    for (int i = 0; i < 19; ++i) a.in[i] = (const float*)d_in[i];
    a.out = (float*)d_out; a.ws = (unsigned char*)d_ws;
    void* args[] = {&a};
    hipError_t e = hipLaunchCooperativeKernel((const void*)fwd_mega, dim3(grid), dim3(NTHR), args, LDS_BYTES, stream);
    if (e != hipSuccess) fprintf(stderr, "cooperative launch failed: %s (grid %d)\n", hipGetErrorString(e), grid);
}
```

```cpp
#include <hip/hip_runtime.h>
#include <hip/hip_cooperative_groups.h>
#include <cstdio>
#include <cstdint>
namespace cg = cooperative_groups;

namespace pg8 {
#define PG8_LAS __attribute__((address_space(3)))
typedef unsigned short bf16_t;
typedef short bf16x8 __attribute__((ext_vector_type(8)));
typedef float f32x4 __attribute__((ext_vector_type(4)));
typedef unsigned u32x4 __attribute__((ext_vector_type(4)));
constexpr int BM = 256, BK = 64, HALF = 128, HTB = HALF * BK * 2, STAGE_BYTES = 8 * HTB, NXCD = 8, WGM = 8;

__host__ __device__ __forceinline__ int lds_byte(int r, int c) { const int st = (r >> 4) * 2 + (c >> 5), rr = r & 15, cc = c & 31, ob = rr * 64 + cc * 2; return st * 1024 + (ob ^ (((ob >> 9) & 1) << 5)); }
__host__ __device__ __forceinline__ void stage_rc(int b, int& R, int& C) { const int st = b / 1024, sb = b % 1024, swz = sb ^ (((sb >> 9) & 1) << 5); R = (st >> 1) * 16 + swz / 64; C = (st & 1) * 32 + (swz % 64) / 2; }
__host__ __device__ __forceinline__ int perm32(int rho) { const int n = rho >> 4, i = rho & 15; return 8 * (i >> 2) + 4 * n + (i & 3); }

struct Unit { int pm, pn; };
struct Gemm { const bf16_t* A; const bf16_t* Bt; int M, N, K, lda, apn_shift, apn_bytes; };

struct StaticOrder {
    int nM, nN, nwg, G, c;
    __host__ __device__ void init(int M, int N, int G_, int c_) { nM = M / BM; nN = N / BM; nwg = nM * nN; G = G_; c = c_; }
    __host__ __device__ bool next(int i, Unit& u) const {
        const long L = (long)i * G + c; if (L >= nwg) return false;
        int wgid = (int)L; { const int q = nwg / NXCD, r = nwg % NXCD, xcd = wgid % NXCD, off = wgid / NXCD; wgid = (xcd < r ? xcd * (q + 1) : r * (q + 1) + (xcd - r) * q) + off; }
        const int nig = WGM * nN, gid = wgid / nig, fm = gid * WGM, gsz = (nM - fm) < WGM ? (nM - fm) : WGM;
        u.pm = fm + ((wgid % nig) % gsz); u.pn = (wgid % nig) / gsz; return true;
    }
    __device__ __forceinline__ void a_ready(const Unit&) const {}
    __device__ __forceinline__ void done(const Unit&) const {}
};

__device__ __forceinline__ unsigned cvt_pk_bf16(float lo, float hi) { unsigned r; asm volatile("v_cvt_pk_bf16_f32 %0, %1, %2" : "=v"(r) : "v"(lo), "v"(hi)); return r; }

template <class Epi, class Sched, bool ALIGN_EPI = false, bool SP2 = false>
__device__ __forceinline__ void gemm_phase(PG8_LAS unsigned char* lds, const Gemm g, const Sched& S, const Epi& E) {
    int tid_ = threadIdx.x; asm volatile("" : "+v"(tid_));
    const int tid = tid_, wid = __builtin_amdgcn_readfirstlane(tid >> 6), lane = tid & 63, wr = wid >> 2, wc = wid & 3, fr = lane & 15, fq = lane >> 4;
    const int K = g.K, nt = K / BK, lda = g.lda;
    unsigned voffA[2], voffB[2];
#pragma unroll
    for (int i = 0; i < 2; ++i) { int R, C; stage_rc(tid * 16 + i * 8192, R, C); const int Rb = Epi::PERM ? ((R & ~31) + perm32(R & 31)) : R;
        voffA[i] = (unsigned)(R * lda + C) * 2u; voffB[i] = (unsigned)(Rb * K + C) * 2u; }
    const size_t kstep = (size_t)(BK * 2);
    const size_t hstepA = (size_t)HALF * lda * 2, hstepB = (size_t)HALF * K * 2;
    const size_t tstepA = 2 * hstepA, tstepB = 2 * hstepB;
    const unsigned ldsw = (unsigned)wid * 1024u;
    const int aoff = lds_byte(wr * 64 + fr, fq * 8), boff = lds_byte(wc * 32 + fr, fq * 8);
#define PG8_SA(b, h) (((b) * 2 + (h)) * HTB)
#define PG8_SB(b, h) ((4 + (b) * 2 + (h)) * HTB)
#define PG8_STAGE(bufoff, gbase, voff) do { _Pragma("unroll") for (int _i = 0; _i < 2; ++_i) \
        __builtin_amdgcn_global_load_lds((const unsigned*)((const char*)(gbase) + (voff)[_i]), (PG8_LAS unsigned*)(lds + (bufoff) + ldsw + _i * 8192), 16, 0, 0); } while (0)
#define PG8_LDA(dst, b, h) do { _Pragma("unroll") for (int m = 0; m < 4; ++m) _Pragma("unroll") for (int k = 0; k < 2; ++k) dst[m][k] = *(const PG8_LAS bf16x8*)(lds + PG8_SA(b, h) + aoff + m * 2048 + k * 1024); } while (0)
#define PG8_LDB(dst, b, h) do { _Pragma("unroll") for (int n = 0; n < 2; ++n) _Pragma("unroll") for (int k = 0; k < 2; ++k) dst[n][k] = *(const PG8_LAS bf16x8*)(lds + PG8_SB(b, h) + boff + n * 2048 + k * 1024); } while (0)
#define PG8_MMA(ai, bj, At, Bt) do { __builtin_amdgcn_s_setprio(1); _Pragma("unroll") for (int m = 0; m < 4; ++m) _Pragma("unroll") for (int n = 0; n < 2; ++n) _Pragma("unroll") for (int k = 0; k < 2; ++k) \
        acc[ai][bj][m][n] = __builtin_amdgcn_mfma_f32_16x16x32_bf16(Bt[n][k], At[m][k], acc[ai][bj][m][n], 0, 0, 0); __builtin_amdgcn_s_setprio(0); } while (0)
#define PG8_WAIT_V(n) asm volatile("s_waitcnt vmcnt(" #n ")" ::: "memory")
#define PG8_WAIT_L(n) asm volatile("s_waitcnt lgkmcnt(" #n ")" ::: "memory")
#define PG8_BAR __builtin_amdgcn_s_barrier()
#define PG8_SCHED __builtin_amdgcn_sched_barrier(0)
    Unit cur, nxt; int ui = 0;
    if (!S.next(0, cur)) return;
    f32x4 acc[2][2][4][2];
#pragma unroll
    for (int a = 0; a < 2; ++a)
#pragma unroll
        for (int b = 0; b < 2; ++b)
#pragma unroll
            for (int m = 0; m < 4; ++m)
#pragma unroll
                for (int n = 0; n < 2; ++n) acc[a][b][m][n] = (f32x4){0.f, 0.f, 0.f, 0.f};
    bf16x8 At[4][2], B0[2][2], B1[2][2];
    const char* cA = (const char*)g.A + (size_t)cur.pm * tstepA + (size_t)(cur.pn >> g.apn_shift) * g.apn_bytes; const char* cB = (const char*)g.Bt + (size_t)cur.pn * tstepB;
    S.a_ready(cur);
    if constexpr (SP2) {
        PG8_STAGE(PG8_SB(0, 0), cB, voffB); PG8_STAGE(PG8_SB(0, 1), cB + hstepB, voffB); PG8_STAGE(PG8_SA(0, 0), cA, voffA); PG8_STAGE(PG8_SA(0, 1), cA + hstepA, voffA);
        if (wr == 1) PG8_BAR;
        PG8_WAIT_V(2); PG8_BAR;
        PG8_STAGE(PG8_SB(1, 0), cB + kstep, voffB); PG8_STAGE(PG8_SA(1, 0), cA + kstep, voffA); PG8_STAGE(PG8_SB(1, 1), cB + hstepB + kstep, voffB);
        PG8_WAIT_V(6); PG8_BAR;
    } else {
        PG8_STAGE(PG8_SB(0, 0), cB, voffB); PG8_STAGE(PG8_SA(0, 0), cA, voffA); PG8_STAGE(PG8_SB(0, 1), cB + hstepB, voffB); PG8_STAGE(PG8_SA(0, 1), cA + hstepA, voffA);
        if (wr == 1) PG8_BAR;
        PG8_WAIT_V(4); PG8_BAR;
        PG8_STAGE(PG8_SB(1, 0), cB + kstep, voffB); PG8_STAGE(PG8_SA(1, 0), cA + kstep, voffA); PG8_STAGE(PG8_SB(1, 1), cB + hstepB + kstep, voffB);
        PG8_WAIT_V(6); PG8_BAR;
    }
    for (;;) {
        const bool has_next = S.next(ui + 1, nxt);
        const char* nA = has_next ? (const char*)g.A + (size_t)nxt.pm * tstepA + (size_t)(nxt.pn >> g.apn_shift) * g.apn_bytes : cA; const char* nB = has_next ? (const char*)g.Bt + (size_t)nxt.pn * tstepB : cB;
#pragma unroll 1
        for (int t = 0; t < nt; t += 2) {
            const bool last = (t == nt - 2);
            const char* a1 = cA + (size_t)(t + 1) * kstep;
            const char* a2 = last ? nA : cA + (size_t)(t + 2) * kstep; const char* b2 = last ? nB : cB + (size_t)(t + 2) * kstep;
            const char* a3 = a2 + kstep; const char* b3 = b2 + kstep;
            if (last && has_next) S.a_ready(nxt);
            if constexpr (SP2) {
            PG8_LDB(B0, 0, 0); PG8_LDB(B1, 0, 1); PG8_SCHED; PG8_LDA(At, 0, 0); PG8_STAGE(PG8_SA(1, 1), a1 + hstepA, voffA);
            PG8_WAIT_V(8); PG8_WAIT_L(0); PG8_BAR; PG8_MMA(0, 0, At, B0); PG8_MMA(0, 1, At, B1); PG8_BAR; PG8_SCHED;
            PG8_LDA(At, 0, 1); PG8_STAGE(PG8_SB(0, 0), b2, voffB); PG8_STAGE(PG8_SB(0, 1), b2 + hstepB, voffB); PG8_STAGE(PG8_SA(0, 0), a2, voffA);
            PG8_WAIT_V(8); PG8_WAIT_L(0); PG8_BAR; PG8_MMA(1, 0, At, B0); PG8_MMA(1, 1, At, B1); PG8_BAR; PG8_SCHED;
            PG8_LDB(B0, 1, 0); PG8_LDB(B1, 1, 1); PG8_SCHED; PG8_LDA(At, 1, 0); PG8_STAGE(PG8_SA(0, 1), a2 + hstepA, voffA);
            PG8_WAIT_V(8); PG8_WAIT_L(0); PG8_BAR; PG8_MMA(0, 0, At, B0); PG8_MMA(0, 1, At, B1); PG8_BAR; PG8_SCHED;
            PG8_LDA(At, 1, 1); PG8_STAGE(PG8_SB(1, 0), b3, voffB); PG8_STAGE(PG8_SB(1, 1), b3 + hstepB, voffB); PG8_STAGE(PG8_SA(1, 0), a3, voffA);
            PG8_WAIT_V(8); PG8_WAIT_L(0); PG8_BAR; PG8_MMA(1, 0, At, B0); PG8_MMA(1, 1, At, B1); PG8_BAR; PG8_SCHED;
            } else {
            PG8_LDB(B0, 0, 0); PG8_SCHED; PG8_LDA(At, 0, 0); PG8_STAGE(PG8_SA(1, 1), a1 + hstepA, voffA);
            PG8_WAIT_L(8); PG8_BAR; PG8_WAIT_L(0); PG8_MMA(0, 0, At, B0); PG8_BAR; PG8_SCHED;
            PG8_LDB(B1, 0, 1); PG8_STAGE(PG8_SB(0, 0), b2, voffB);
            PG8_BAR; PG8_WAIT_L(0); PG8_MMA(0, 1, At, B1); PG8_BAR;
            PG8_LDA(At, 0, 1); PG8_STAGE(PG8_SA(0, 0), a2, voffA);
            PG8_BAR; PG8_WAIT_L(0); PG8_MMA(1, 0, At, B0); PG8_BAR; PG8_SCHED;
            PG8_STAGE(PG8_SB(0, 1), b2 + hstepB, voffB);
            PG8_WAIT_V(6); PG8_BAR; PG8_MMA(1, 1, At, B1); PG8_BAR;
            PG8_LDB(B0, 1, 0); PG8_SCHED; PG8_LDA(At, 1, 0); PG8_STAGE(PG8_SA(0, 1), a2 + hstepA, voffA);
            PG8_WAIT_L(8); PG8_BAR; PG8_WAIT_L(0); PG8_MMA(0, 0, At, B0); PG8_BAR; PG8_SCHED;
            PG8_LDB(B1, 1, 1); PG8_STAGE(PG8_SB(1, 0), b3, voffB);
            PG8_BAR; PG8_WAIT_L(0); PG8_MMA(0, 1, At, B1); PG8_BAR;
            PG8_LDA(At, 1, 1); PG8_STAGE(PG8_SA(1, 0), a3, voffA);
            PG8_BAR; PG8_WAIT_L(0); PG8_MMA(1, 0, At, B0); PG8_BAR; PG8_SCHED;
            PG8_STAGE(PG8_SB(1, 1), b3 + hstepB, voffB);
            PG8_WAIT_V(6); PG8_BAR; PG8_MMA(1, 1, At, B1); PG8_BAR;
            }
        }
        if constexpr (ALIGN_EPI) { if (wr == 0) PG8_BAR; }
        E(acc, cur, wr, wc, fr, fq); S.done(cur);
        if (!has_next) break;
#pragma unroll
        for (int a = 0; a < 2; ++a)
#pragma unroll
            for (int b = 0; b < 2; ++b)
#pragma unroll
                for (int m = 0; m < 4; ++m)
#pragma unroll
                    for (int n = 0; n < 2; ++n) acc[a][b][m][n] = (f32x4){0.f, 0.f, 0.f, 0.f};
        cur = nxt; cA = nA; cB = nB; ++ui;
        if constexpr (ALIGN_EPI) { if (wr == 1) PG8_BAR; }
    }
    PG8_WAIT_V(0);
    if constexpr (!ALIGN_EPI) { if (wr == 0) PG8_BAR; }
    PG8_BAR;
#undef PG8_SA
#undef PG8_SB
#undef PG8_STAGE
#undef PG8_LDA
#undef PG8_LDB
#undef PG8_MMA
#undef PG8_WAIT_V
#undef PG8_WAIT_L
#undef PG8_BAR
#undef PG8_SCHED
}
}

typedef unsigned short bf16;
typedef float f32x4 __attribute__((ext_vector_type(4)));
typedef unsigned u32x4 __attribute__((ext_vector_type(4)));
typedef unsigned u32x2 __attribute__((ext_vector_type(2)));
#define LAS __attribute__((address_space(3)))

constexpr int D = 1024, MP = 32768, MS = 1024, M = MP + MS, NTILE = M / 256, NTP = MP / 256;
constexpr int INW = 4096, PW = 512, CW = 512, FF = 2816, FF2 = 5632;
constexpr float EPS = 1e-6f;
constexpr int NWAVES = 8, NTHR = 512;
constexpr int LDS_BYTES = 147456;
#ifndef PHMASK
#define PHMASK 0xFFFF
#endif
#ifndef PROBE
#define PROBE 0
#endif

constexpr size_t O_POOLP = (size_t)M * D;
constexpr size_t O_CONVP = O_POOLP + 2 * 8 * 15 * 512;
constexpr size_t O_FFNP = O_CONVP + 2 * 8 * 2 * 512;
constexpr size_t O_POOLS = O_FFNP + 2 * 8 * 2 * 5632;
constexpr size_t O_CONVS = O_POOLS + 2 * 16 * 15 * 512;
constexpr size_t O_FFNS = O_CONVS + 2 * 16 * 2 * 512;
constexpr size_t O_END = O_FFNS + 2 * 16 * 2 * 5632;

constexpr size_t MiB = 1u << 20;
constexpr size_t WS_SSQ = 1 * MiB;
constexpr size_t WS_W = 4 * MiB, W_LAYER = 28 * MiB;
constexpr size_t WO_IN = 0, WO_UP = 8 * MiB, WO_DN = 19 * MiB, WO_O = 24 * MiB + MiB / 2, WO_CO = 26 * MiB + MiB / 2, WO_MAP = 27 * MiB + MiB / 2;
constexpr size_t WS_XB = 60 * MiB;
constexpr size_t WS_ACTV = 126 * MiB;
constexpr size_t WS_UPOOL = WS_ACTV, WS_CVIN = WS_ACTV + 33 * MiB, WS_GB = WS_ACTV + 66 * MiB, WS_SA = WS_ACTV + 99 * MiB, WS_SB = WS_ACTV + 165 * MiB,
                 WS_MIXED = WS_ACTV + 231 * MiB, WS_GBCV = WS_ACTV + 264 * MiB, WS_MA = WS_ACTV;
constexpr size_t WS_ACT = WS_ACTV;
constexpr size_t WS_HALO = WS_ACTV + 182 * MiB;
constexpr size_t WS_END = WS_ACTV + 297 * MiB;
constexpr int BST_OFF = 131072 + 8192;
constexpr int EX_OFF = 131072;

__device__ __forceinline__ float bf_lo(unsigned w) { return __builtin_bit_cast(float, w << 16); }
__device__ __forceinline__ float bf_hi(unsigned w) { return __builtin_bit_cast(float, w & 0xffff0000u); }
__device__ __forceinline__ unsigned pk2(float lo, float hi) { return pg8::cvt_pk_bf16(lo, hi); }
__device__ __forceinline__ float sigmoidf_(float x) { return __builtin_amdgcn_rcpf(1.f + __builtin_amdgcn_exp2f(-1.44269504f * x)); }
#define UNPACK8(V_, F_) do { F_[0] = bf_lo((V_)[0]); F_[1] = bf_hi((V_)[0]); F_[2] = bf_lo((V_)[1]); F_[3] = bf_hi((V_)[1]); F_[4] = bf_lo((V_)[2]); F_[5] = bf_hi((V_)[2]); F_[6] = bf_lo((V_)[3]); F_[7] = bf_hi((V_)[3]); } while (0)

__device__ __forceinline__ void unit_rstd(const float* ssq, int pm, int wr, int fr, int fq, float (&r)[2][4]) {
    const int lane = fq * 16 + fr;
#pragma unroll
    for (int ai = 0; ai < 2; ++ai) {
        const f32x4* p = (const f32x4*)(ssq + (size_t)(pm * 256 + ai * 128 + wr * 64 + lane) * 16);
        const f32x4 a = p[0], b = p[1], c = p[2], d = p[3];
        const float s = ((a.x + a.y) + (a.z + a.w)) + ((b.x + b.y) + (b.z + b.w)) + ((c.x + c.y) + (c.z + c.w)) + ((d.x + d.y) + (d.z + d.w));
        const float rs = 1.0f / sqrtf(s * (1.0f / D) + EPS);
#pragma unroll
        for (int m = 0; m < 4; ++m) r[ai][m] = __shfl(rs, m * 16 + fr);
    }
}

template <class T> __device__ __forceinline__ T* launder_s(T* p) { asm volatile("" : "+s"(p)); return p; }
struct EpiProj {
    static constexpr bool PERM = true, AFTER_DRAIN = false;
    unsigned char* ws; float* out; const float* b_gate; const float* pool_scale; int l;
    __device__ __forceinline__ void operator()(const f32x4 (&acc)[2][2][4][2], const pg8::Unit& u, int wr, int wc, int fr, int fq) const {
        unsigned char* w_ = launder_s(ws); float* o_ = launder_s(out);
        float r[2][4]; unit_rstd((const float*)(w_ + WS_SSQ), u.pm, wr, fr, fq, r);
        const int pm = u.pm, pn = u.pn;
        const int lc0 = wc * 32 + 8 * fq;
        const bool samp = pm >= NTP;
        if (pn < 4) {
            bf16* O = (bf16*)(w_ + ((pn < 2) ? WS_UPOOL : WS_GB)); const int cb = (pn & 1) * 256 + lc0;
#pragma unroll
            for (int ai = 0; ai < 2; ++ai)
#pragma unroll
                for (int m = 0; m < 4; ++m) { const size_t row = (size_t)pm * 256 + ai * 128 + wr * 64 + m * 16 + fr; const float rr = r[ai][m];
#pragma unroll
                    for (int bj = 0; bj < 2; ++bj) { const f32x4 v0 = acc[ai][bj][m][0] * rr, v1 = acc[ai][bj][m][1] * rr; u32x4 w;
                        w.x = pk2(v0[0], v0[1]); w.y = pk2(v0[2], v0[3]); w.z = pk2(v1[0], v1[1]); w.w = pk2(v1[2], v1[3]);
                        *(u32x4*)(O + row * 512 + cb + bj * 128) = w; } }
            if (pn < 2 && (samp || ((pm & 15) == 15 && wr == 1)) && fr >= 1) {
                float* pool_p = o_ + O_POOLP + (size_t)l * 8 * 15 * 512; float* pool_s = o_ + O_POOLS + (size_t)l * 16 * 15 * 512;
#pragma unroll
                for (int ai = 0; ai < 2; ++ai) { if (!samp && ai == 0) continue;
                    float* sp = samp ? pool_s + ((size_t)((pm - NTP) * 4 + ai * 2 + wr) * 15 + (fr - 1)) * 512 : pool_p + ((size_t)(pm >> 4) * 15 + (fr - 1)) * 512;
                    const float rr = r[ai][3];
#pragma unroll
                    for (int bj = 0; bj < 2; ++bj) { *(f32x4*)(sp + cb + bj * 128) = acc[ai][bj][3][0] * rr; *(f32x4*)(sp + cb + bj * 128 + 4) = acc[ai][bj][3][1] * rr; } }
            }
        } else if (pn < 8) {
            const int cb = (pn - 4) * 128 + lc0; bf16* CVIN = (bf16*)(w_ + WS_CVIN);
            float* conv_p = o_ + O_CONVP + (size_t)l * 8 * 2 * 512; float* conv_s = o_ + O_CONVS + (size_t)l * 16 * 2 * 512;
#pragma unroll
            for (int ai = 0; ai < 2; ++ai)
#pragma unroll
                for (int m = 0; m < 4; ++m) { const size_t row = (size_t)pm * 256 + ai * 128 + wr * 64 + m * 16 + fr; const float rr = r[ai][m] * r[ai][m];
                    const f32x4 v0 = acc[ai][0][m][0] * acc[ai][1][m][0] * rr, v1 = acc[ai][0][m][1] * acc[ai][1][m][1] * rr; u32x4 w;
                    w.x = pk2(v0[0], v0[1]); w.y = pk2(v0[2], v0[3]); w.z = pk2(v1[0], v1[1]); w.w = pk2(v1[2], v1[3]);
                    *(u32x4*)(CVIN + row * 512 + cb) = w;
                    if (m == 3 && fr >= 14 && (samp || ((pm & 15) == 15 && wr == 1 && ai == 1))) {
                        float* sp = samp ? conv_s + ((size_t)((pm - NTP) * 4 + ai * 2 + wr) * 2 + (fr - 14)) * 512 : conv_p + ((size_t)(pm >> 4) * 2 + (fr - 14)) * 512;
                        *(f32x4*)(sp + cb) = v0; *(f32x4*)(sp + cb + 4) = v1; } }
        } else {
            const bool ga = pn < 12; bf16* O = (bf16*)(w_ + (ga ? WS_SA : WS_SB)); const int cb = ((pn - 8) & 3) * 256 + lc0; const float* bg = b_gate + (ga ? 0 : D);
#pragma unroll
            for (int bj = 0; bj < 2; ++bj) { const int c = cb + bj * 128;
                const f32x4 b0 = *(const f32x4*)(bg + c), b1 = *(const f32x4*)(bg + c + 4);
                f32x4 s0 = (f32x4){1.f, 1.f, 1.f, 1.f}, s1 = s0; if (ga) { s0 = *(const f32x4*)(pool_scale + c); s1 = *(const f32x4*)(pool_scale + c + 4); }
#pragma unroll
                for (int ai = 0; ai < 2; ++ai)
#pragma unroll
                    for (int m = 0; m < 4; ++m) { const size_t row = (size_t)pm * 256 + ai * 128 + wr * 64 + m * 16 + fr; const float rr = r[ai][m];
                        const f32x4 x0 = acc[ai][bj][m][0] * rr + b0, x1 = acc[ai][bj][m][1] * rr + b1; f32x4 v0, v1;
#pragma unroll
                        for (int e = 0; e < 4; ++e) { v0[e] = sigmoidf_(x0[e]) * s0[e]; v1[e] = sigmoidf_(x1[e]) * s1[e]; }
                        u32x4 w; w.x = pk2(v0[0], v0[1]); w.y = pk2(v0[2], v0[3]); w.z = pk2(v1[0], v1[1]); w.w = pk2(v1[2], v1[3]);
                        *(u32x4*)(O + row * 1024 + c) = w; } }
        }
    }
};

struct EpiMA {
    static constexpr bool PERM = true, AFTER_DRAIN = false;
    const bf16* SA; bf16* MA;
    __device__ __forceinline__ void operator()(const f32x4 (&acc)[2][2][4][2], const pg8::Unit& u, int wr, int wc, int fr, int fq) const {
        const int cb = u.pn * 256 + wc * 32 + 8 * fq;
#pragma unroll
        for (int ai = 0; ai < 2; ++ai)
#pragma unroll
            for (int m = 0; m < 4; ++m) { const size_t row = (size_t)u.pm * 256 + ai * 128 + wr * 64 + m * 16 + fr;
#pragma unroll
                for (int bj = 0; bj < 2; ++bj) { const size_t o = row * 1024 + cb + bj * 128; const u32x4 s = *(const u32x4*)(SA + o); float f[8]; UNPACK8(s, f);
                    const f32x4 a0 = acc[ai][bj][m][0], a1 = acc[ai][bj][m][1]; u32x4 w;
                    w.x = pk2(a0[0] * f[0], a0[1] * f[1]); w.y = pk2(a0[2] * f[2], a0[3] * f[3]); w.z = pk2(a1[0] * f[4], a1[1] * f[5]); w.w = pk2(a1[2] * f[6], a1[3] * f[7]);
                    *(u32x4*)(MA + o) = w; }
                asm volatile("" ::: "memory"); }
    }
};
struct EpiMerge {
    static constexpr bool PERM = true, AFTER_DRAIN = false;
    const bf16* SB; bf16* MA;
    __device__ __forceinline__ void operator()(const f32x4 (&acc)[2][2][4][2], const pg8::Unit& u, int wr, int wc, int fr, int fq) const {
        const int cb = u.pn * 256 + wc * 32 + 8 * fq;
#pragma unroll
        for (int ai = 0; ai < 2; ++ai)
#pragma unroll
            for (int m = 0; m < 4; ++m) { const size_t row = (size_t)u.pm * 256 + ai * 128 + wr * 64 + m * 16 + fr;
#pragma unroll
                for (int bj = 0; bj < 2; ++bj) { const size_t o = row * 1024 + cb + bj * 128; const u32x4 s = *(const u32x4*)(SB + o); const u32x4 p = *(const u32x4*)(MA + o);
                    float f[8], q[8]; UNPACK8(s, f); UNPACK8(p, q);
                    const f32x4 a0 = acc[ai][bj][m][0], a1 = acc[ai][bj][m][1]; u32x4 w;
                    w.x = pk2(a0[0] * f[0] + q[0], a0[1] * f[1] + q[1]); w.y = pk2(a0[2] * f[2] + q[2], a0[3] * f[3] + q[3]);
                    w.z = pk2(a1[0] * f[4] + q[4], a1[1] * f[5] + q[5]); w.w = pk2(a1[2] * f[6] + q[6], a1[3] * f[7] + q[7]);
                    *(u32x4*)(MA + o) = w; }
                asm volatile("" ::: "memory"); }
    }
};
struct EpiRes {
    static constexpr bool PERM = true, AFTER_DRAIN = false;
    const float* base_p; const float* base_s; float* out; bf16* xb; float* ssq;
    __device__ __forceinline__ void operator()(const f32x4 (&acc)[2][2][4][2], const pg8::Unit& u, int wr, int wc, int fr, int fq) const {
        const int pm = u.pm, cb = u.pn * 256 + wc * 32 + 8 * fq;
        const float* base = pm < NTP ? base_p + (size_t)pm * 256 * D : base_s + (size_t)(pm - NTP) * 256 * D;
#pragma unroll
        for (int ai = 0; ai < 2; ++ai)
#pragma unroll
            for (int m = 0; m < 4; ++m) { const int lr = ai * 128 + wr * 64 + m * 16 + fr; const size_t row = (size_t)pm * 256 + lr; float s = 0.f;
#pragma unroll
                for (int bj = 0; bj < 2; ++bj) { const int c = cb + bj * 128;
                    const f32x4 v0 = acc[ai][bj][m][0] + *(const f32x4*)(base + (size_t)lr * D + c), v1 = acc[ai][bj][m][1] + *(const f32x4*)(base + (size_t)lr * D + c + 4);
                    *(f32x4*)(out + row * D + c) = v0; *(f32x4*)(out + row * D + c + 4) = v1;
                    u32x4 w; w.x = pk2(v0[0], v0[1]); w.y = pk2(v0[2], v0[3]); w.z = pk2(v1[0], v1[1]); w.w = pk2(v1[2], v1[3]);
                    *(u32x4*)(xb + row * D + c) = w;
                    s += (v0[0] * v0[0] + v0[1] * v0[1]) + (v0[2] * v0[2] + v0[3] * v0[3]) + (v1[0] * v1[0] + v1[1] * v1[1]) + (v1[2] * v1[2] + v1[3] * v1[3]); }
                s += __shfl_xor(s, 16); s += __shfl_xor(s, 32);
                if (fq == 0) ssq[row * 16 + u.pn * 4 + wc] = s;
                asm volatile("" ::: "memory"); }
    }
};
template <int CTRL> __device__ __forceinline__ float dppf(float v) { return __builtin_bit_cast(float, __builtin_amdgcn_update_dpp(0, __builtin_bit_cast(int, v), CTRL, 0xf, 0xf, true)); }
#define DPP_SHR1 0x111
#define DPP_SHR2 0x112
#define DPP_SHL15 0x10F
#define DPP_SHL14 0x10E
struct EpiUpAct {
    static constexpr bool PERM = true, AFTER_DRAIN = false;
    unsigned char* ws; float* out; const float* fw; const float* fb; const float* sffn; LAS unsigned char* ex; int l;
    __device__ __forceinline__ void operator()(const f32x4 (&acc)[2][2][4][2], const pg8::Unit& u, int wr, int wc, int fr, int fq) const {
        unsigned char* w_ = launder_s(ws); float* o_ = launder_s(out);
        const int pm = u.pm, pn = u.pn; const bool samp = pm >= NTP;
        float r[2][4]; unit_rstd((const float*)(w_ + WS_SSQ), pm, wr, fr, fq, r);
        const int lc0 = wc * 32 + 8 * fq;
        f32x4 x[2][2][4][2];
#pragma unroll
        for (int ai = 0; ai < 2; ++ai)
#pragma unroll
            for (int bj = 0; bj < 2; ++bj)
#pragma unroll
                for (int m = 0; m < 4; ++m)
#pragma unroll
                    for (int n = 0; n < 2; ++n) x[ai][bj][m][n] = acc[ai][bj][m][n] * r[ai][m];
        {
            float* ffn_p = o_ + O_FFNP + (size_t)l * 8 * 2 * FF2; float* ffn_s = o_ + O_FFNS + (size_t)l * 16 * 2 * FF2; float* HALO = (float*)(w_ + WS_HALO) + (size_t)pm * 4 * FF2;
            if (fr >= 14) {
#pragma unroll
                for (int ai = 0; ai < 2; ++ai) {
                    if (samp || ((pm & 15) == 15 && wr == 1 && ai == 1)) {
                        float* sp = samp ? ffn_s + ((size_t)((pm - NTP) * 4 + ai * 2 + wr) * 2 + (fr - 14)) * FF2 : ffn_p + ((size_t)(pm >> 4) * 2 + (fr - 14)) * FF2;
#pragma unroll
                        for (int bj = 0; bj < 2; ++bj) { const int oc = bj * FF + pn * 128 + lc0; *(f32x4*)(sp + oc) = x[ai][bj][3][0]; *(f32x4*)(sp + oc + 4) = x[ai][bj][3][1]; } }
                }
                if (wr == 1) {
#pragma unroll
                    for (int bj = 0; bj < 2; ++bj) { float* hp = HALO + (size_t)(2 + fr - 14) * FF2 + pn * 256 + bj * 128 + lc0; *(f32x4*)hp = x[1][bj][3][0]; *(f32x4*)(hp + 4) = x[1][bj][3][1]; } }
            }
            if (fr < 2 && wr == 0) {
#pragma unroll
                for (int bj = 0; bj < 2; ++bj) { float* hp = HALO + (size_t)fr * FF2 + pn * 256 + bj * 128 + lc0; *(f32x4*)hp = x[0][bj][0][0]; *(f32x4*)(hp + 4) = x[0][bj][0][1]; } }
        }
        if (!samp) {
            if (fr >= 14) {
#pragma unroll
                for (int ai = 0; ai < 2; ++ai)
#pragma unroll
                    for (int bj = 0; bj < 2; ++bj)
#pragma unroll
                        for (int n = 0; n < 2; ++n) *(LAS f32x4*)(ex + ((((2 * ai + wr) * 2 + (fr - 14)) * 256) + bj * 128 + lc0 + 4 * n) * 4) = x[ai][bj][3][n];
            }
            asm volatile("s_waitcnt lgkmcnt(0)" ::: "memory"); __builtin_amdgcn_s_barrier(); asm volatile("" ::: "memory");
        }
        bf16* ACT = (bf16*)(w_ + WS_ACT);
        unsigned pk[2][4][2];
#pragma unroll
        for (int n = 0; n < 2; ++n) {
            const int f = pn * 128 + lc0 + 4 * n;
            const f32x4 wv0 = *(const f32x4*)(fw + f), wv1 = *(const f32x4*)(fw + FF2 + f), wv2 = *(const f32x4*)(fw + 2 * FF2 + f), bv = *(const f32x4*)(fb + f);
            const f32x4 wg0 = *(const f32x4*)(fw + FF + f), wg1 = *(const f32x4*)(fw + FF2 + FF + f), wg2 = *(const f32x4*)(fw + 2 * FF2 + FF + f), bg = *(const f32x4*)(fb + FF + f);
#pragma unroll
            for (int ai = 0; ai < 2; ++ai) {
                const int B = 2 * ai + wr;
                f32x4 e1v = (f32x4){0.f, 0.f, 0.f, 0.f}, e2v = e1v, e1g = e1v, e2g = e1v;
                if (fr < 2) {
                    if (samp) {
                        const float* b0 = sffn + (size_t)((pm - NTP) * 4 + B) * 2 * FF2; const float* b1 = b0 + FF2;
                        const f32x4 v1 = *(const f32x4*)(b1 + f), g1 = *(const f32x4*)(b1 + FF + f);
                        if (fr == 0) { e1v = v1; e1g = g1; e2v = *(const f32x4*)(b0 + f); e2g = *(const f32x4*)(b0 + FF + f); } else { e2v = v1; e2g = g1; }
                    } else if (B > 0) {
                        const LAS unsigned char* eb = ex + ((B - 1) * 2 * 256 + lc0 + 4 * n) * 4;
                        const f32x4 v63 = *(const LAS f32x4*)(eb + 256 * 4), g63 = *(const LAS f32x4*)(eb + 256 * 4 + 128 * 4);
                        if (fr == 0) { e1v = v63; e1g = g63; e2v = *(const LAS f32x4*)eb; e2g = *(const LAS f32x4*)(eb + 128 * 4); } else { e2v = v63; e2g = g63; }
                    }
                }
#pragma unroll
                for (int m = 0; m < 4; ++m) {
                    float av[4];
#pragma unroll
                    for (int e = 0; e < 4; ++e) {
                        const float xv = x[ai][0][m][n][e], xg = x[ai][1][m][n][e];
                        float yv = bv[e] + wv2[e] * xv, yg = bg[e] + wg2[e] * xg;
                        if (m > 0) {
                            const float pv = x[ai][0][m > 0 ? m - 1 : 0][n][e], pg = x[ai][1][m > 0 ? m - 1 : 0][n][e];
                            asm volatile("s_nop 1\n\t"
                                "v_fmac_f32_dpp %0, %2, %4 row_shr:1 row_mask:0xf bank_mask:0xf bound_ctrl:1\n\t"
                                "v_fmac_f32_dpp %1, %3, %6 row_shr:1 row_mask:0xf bank_mask:0xf bound_ctrl:1\n\t"
                                "v_fmac_f32_dpp %0, %2, %5 row_shr:2 row_mask:0xf bank_mask:0xf bound_ctrl:1\n\t"
                                "v_fmac_f32_dpp %1, %3, %7 row_shr:2 row_mask:0xf bank_mask:0xf bound_ctrl:1\n\t"
                                "v_fmac_f32_dpp %0, %8, %4 row_shl:15 row_mask:0xf bank_mask:0xf bound_ctrl:1\n\t"
                                "v_fmac_f32_dpp %1, %9, %6 row_shl:15 row_mask:0xf bank_mask:0xf bound_ctrl:1\n\t"
                                "v_fmac_f32_dpp %0, %8, %5 row_shl:14 row_mask:0xf bank_mask:0xf bound_ctrl:1\n\t"
                                "v_fmac_f32_dpp %1, %9, %7 row_shl:14 row_mask:0xf bank_mask:0xf bound_ctrl:1"
                                : "+v"(yv), "+v"(yg) : "v"(xv), "v"(xg), "v"(wv1[e]), "v"(wv0[e]), "v"(wg1[e]), "v"(wg0[e]), "v"(pv), "v"(pg));
                        } else {
                            yv += wv1[e] * e1v[e] + wv0[e] * e2v[e]; yg += wg1[e] * e1g[e] + wg0[e] * e2g[e];
                            asm volatile("s_nop 1\n\t"
                                "v_fmac_f32_dpp %0, %2, %4 row_shr:1 row_mask:0xf bank_mask:0xf bound_ctrl:1\n\t"
                                "v_fmac_f32_dpp %1, %3, %6 row_shr:1 row_mask:0xf bank_mask:0xf bound_ctrl:1\n\t"
                                "v_fmac_f32_dpp %0, %2, %5 row_shr:2 row_mask:0xf bank_mask:0xf bound_ctrl:1\n\t"
                                "v_fmac_f32_dpp %1, %3, %7 row_shr:2 row_mask:0xf bank_mask:0xf bound_ctrl:1"
                                : "+v"(yv), "+v"(yg) : "v"(xv), "v"(xg), "v"(wv1[e]), "v"(wv0[e]), "v"(wg1[e]), "v"(wg0[e]));
                        }
                        av[e] = yg * sigmoidf_(yg) * yv;
                    }
                    const unsigned lo = pk2(av[0], av[1]), hi = pk2(av[2], av[3]);
                    if (n == 0) { pk[ai][m][0] = lo; pk[ai][m][1] = hi; }
                    else { u32x4 w; w.x = pk[ai][m][0]; w.y = pk[ai][m][1]; w.z = lo; w.w = hi;
                        *(u32x4*)(ACT + ((size_t)pm * 256 + ai * 128 + wr * 64 + m * 16 + fr) * FF + pn * 128 + lc0) = w; }
                }
            }
        }
    }
};

#define XB_TMO      128
#define XB_XCNT(j)  (256  + 64 * (j))
#define XB_XSUB(j)  (1280 + 64 * (j))
#define XB_XGEN(j)  (2304 + 64 * (j))
#define XB_TOP      3328
#define XB_TOPGEN   3392
#define XCD_BAR_WORDS 3456
#define XB_SPIN_CAP (1u << 18)
__device__ __forceinline__ unsigned xb_ld(unsigned* p)              { return __hip_atomic_load(p, __ATOMIC_RELAXED, __HIP_MEMORY_SCOPE_AGENT); }
__device__ __forceinline__ unsigned xb_add(unsigned* p, unsigned v) { return __hip_atomic_fetch_add(p, v, __ATOMIC_RELAXED, __HIP_MEMORY_SCOPE_AGENT); }
__device__ __forceinline__ unsigned xb_xcc_id() { return (unsigned)__builtin_amdgcn_s_getreg((3 << 11) | 20) & 0xFu; }
#define XB_SPIN(cond, bar) do { unsigned _sp = 0; while (cond) { __builtin_amdgcn_s_sleep(1); \
    if ((++_sp & 255u) == 0u) { if (xb_ld(&(bar)[XB_TMO])) break; if (_sp > XB_SPIN_CAP) { atomicAdd(&(bar)[XB_TMO], 1u); break; } } } } while (0)
struct XcdBarrier { unsigned* bar; unsigned x; volatile LAS unsigned* st; };
__device__ __forceinline__ XcdBarrier xcd_barrier_post(unsigned* bar, volatile LAS unsigned* st) {
    XcdBarrier b; b.bar = bar; b.x = xb_xcc_id(); b.st = st;
    if (threadIdx.x == 0) (void)xb_add(&bar[XB_XCNT(b.x)], 1u);
    return b;
}
__device__ __forceinline__ void xcd_barrier_complete(unsigned* bar, unsigned x, unsigned& nloc, unsigned& nx) {
    const unsigned G = gridDim.x * gridDim.y * gridDim.z;
    unsigned sum, cnt, mine, sp = 0u;
    for (;;) {
        sum = 0u; cnt = 0u; mine = 0u;
#pragma unroll
        for (unsigned j = 0; j < 16; ++j) { const unsigned c = xb_ld(&bar[XB_XCNT(j)]); sum += c; cnt += (c > 0u) ? 1u : 0u; mine = (j == x) ? c : mine; }
        if (sum == G) break;
        __builtin_amdgcn_s_sleep(1);
        if ((++sp & 255u) == 0u) { if (xb_ld(&bar[XB_TMO])) break; if (sp > XB_SPIN_CAP) { atomicAdd(&bar[XB_TMO], 1u); break; } }
    }
    nloc = mine > 0u ? mine : 1u; nx = cnt > 0u ? cnt : 1u;
}
__device__ __forceinline__ void xcd_barrier(const XcdBarrier& b) {
    asm volatile("s_waitcnt vmcnt(0)" ::: "memory");
    __syncthreads();
    if (threadIdx.x == 0) {
        unsigned* bar = b.bar;
        __builtin_amdgcn_s_waitcnt(0);
        unsigned nloc = b.st[0], nx = b.st[1];
        if (nloc == 0u) { xcd_barrier_complete(bar, b.x, nloc, nx); b.st[0] = nloc; b.st[1] = nx; }
        const unsigned old = xb_add(&bar[XB_XSUB(b.x)], 1u);
        const unsigned gen = old / nloc;
        if (old + 1u == (gen + 1u) * nloc) {
            __builtin_amdgcn_fence(__ATOMIC_RELEASE, "agent");
            asm volatile("s_waitcnt vmcnt(0)" ::: "memory");
            const unsigned og = xb_add(&bar[XB_TOP], 1u);
            const unsigned tg = og / nx;
            if (og + 1u == (tg + 1u) * nx) xb_add(&bar[XB_TOPGEN], 1u);
            else XB_SPIN(xb_ld(&bar[XB_TOPGEN]) == tg, bar);
            __builtin_amdgcn_fence(__ATOMIC_ACQUIRE, "agent");
            xb_add(&bar[XB_XGEN(b.x)], 1u);
            asm volatile("s_waitcnt vmcnt(0)" ::: "memory");
        } else {
            XB_SPIN(xb_ld(&bar[XB_XGEN(b.x)]) == gen, bar);
            __builtin_amdgcn_fence(__ATOMIC_ACQUIRE, "agent");
            asm volatile("s_waitcnt vmcnt(0)" ::: "memory");
        }
    }
    __syncthreads();
}

struct Args { const float* in[19]; float* out; unsigned char* ws; };

struct Frame {
    LAS unsigned char* lds;
    int tid, lane, wave, G, bid;
};

__device__ __forceinline__ float wave_sum(float v) {
#pragma unroll
    for (int o = 1; o < 64; o <<= 1) v += __shfl_xor(v, o);
    return v;
}

__device__ __forceinline__ void tr_item(const float* W, int ldw, int srccol, int ks0, const float* gs, bf16* WT, int Kd, int dst_row, int kd0, bool zero, LAS float* scr, int lane) {
    if (!zero) {
#pragma unroll 8
        for (int i = 0; i < 32; ++i) { const int kk = 2 * i + (lane >> 5); float v = W[(size_t)(ks0 + kk) * ldw + srccol + (lane & 31)]; if (gs) v *= gs[ks0 + kk]; scr[kk * 33 + (lane & 31)] = v; }
    }
    asm volatile("s_waitcnt lgkmcnt(0)" ::: "memory");
    const int c = lane & 7;
#pragma unroll
    for (int j = 0; j < 4; ++j) { const int n = (lane >> 3) + 8 * j; const LAS float* s = scr + (8 * c) * 33 + n;
        u32x4 o;
        if (zero) { o = (u32x4){0u, 0u, 0u, 0u}; }
        else { o.x = pk2(s[0 * 33], s[1 * 33]); o.y = pk2(s[2 * 33], s[3 * 33]); o.z = pk2(s[4 * 33], s[5 * 33]); o.w = pk2(s[6 * 33], s[7 * 33]); }
        *(u32x4*)(WT + (size_t)(dst_row + n) * Kd + kd0 + 8 * c) = o; }
    asm volatile("s_waitcnt lgkmcnt(0)" ::: "memory");
}

constexpr int I_IN = 16 * 128, I_UP = 16 * 176, I_DN = 44 * 32, I_O = 16 * 32, I_CO = 8 * 32, I_MAP = 128;
constexpr int ITEMS_L = I_IN + I_UP + I_DN + I_O + I_CO + I_MAP;

__device__ __forceinline__ void p0_prologue(const Frame& F, const Args& a) {
    int tid_ = threadIdx.x; asm volatile("" : "+v"(tid_)); const int TID = tid_, LANE = tid_ & 63, WAVE = __builtin_amdgcn_readfirstlane(tid_ >> 6);
    LAS float* scr = (LAS float*)(F.lds + WAVE * 16384);
    const int gw = F.bid * NWAVES + WAVE, NGW = F.G * NWAVES;
    unsigned char* ws = a.ws;
    for (int it = gw; it < 2 * ITEMS_L; it += NGW) {
        const int l = it / ITEMS_L; int r = it % ITEMS_L;
        unsigned char* wl = ws + WS_W + (size_t)l * W_LAYER;
        if (r < I_IN) { const int kb = r / 128, n0 = (r % 128) * 32;
            const int src = (n0 < 1024 || n0 >= 2048) ? n0 : 1024 + 512 * (((n0 - 1024) % 256) / 128) + 128 * ((n0 - 1024) / 256) + (n0 % 128);
            tr_item(a.in[6] + (size_t)l * D * INW, INW, src, kb * 64, a.in[5] + l * D, (bf16*)(wl + WO_IN), D, n0, kb * 64, false, scr, LANE); continue; } r -= I_IN;
        if (r < I_UP) { const int kb = r / 176, n0 = (r % 176) * 32;
            const int src = ((n0 % 256) / 128) * FF + 128 * (n0 / 256) + (n0 % 128);
            tr_item(a.in[14] + (size_t)l * D * FF2, FF2, src, kb * 64, a.in[13] + l * D, (bf16*)(wl + WO_UP), D, n0, kb * 64, false, scr, LANE); continue; } r -= I_UP;
        if (r < I_DN) { const int kb = r / 32, n0 = (r % 32) * 32;
            tr_item(a.in[17] + (size_t)l * FF * D, D, n0, kb * 64, nullptr, (bf16*)(wl + WO_DN), FF, n0, kb * 64, false, scr, LANE); continue; } r -= I_DN;
        if (r < I_O) { const int kb = r / 32, n0 = (r % 32) * 32;
            tr_item(a.in[12] + (size_t)l * D * D, D, n0, kb * 64, nullptr, (bf16*)(wl + WO_O), D, n0, kb * 64, false, scr, LANE); continue; } r -= I_O;
        if (r < I_CO) { const int kb = r / 32, n0 = (r % 32) * 32;
            tr_item(a.in[11] + (size_t)l * CW * D, D, n0, kb * 64, nullptr, (bf16*)(wl + WO_CO), CW, n0, kb * 64, false, scr, LANE); continue; } r -= I_CO;
        { const int g = r / 32, kb = (r % 32) / 8, nb = r % 8; const bool zero = (kb >> 1) != (g & 1);
            tr_item(a.in[8] + (size_t)l * 4 * 128 * 256 + (size_t)g * 128 * 256, 256, nb * 32, (kb & 1) * 64, nullptr, (bf16*)(wl + WO_MAP), 256, g * 256 + nb * 32, kb * 64, zero, scr, LANE); }
    }
    bf16* XB = (bf16*)(ws + WS_XB); float* SSQ = (float*)(ws + WS_SSQ);
    for (int m = gw; m < M; m += NGW) {
        const float* xrow = m < MP ? a.in[0] + (size_t)m * D : a.in[1] + (size_t)(m - MP) * D;
        const f32x4* xr = (const f32x4*)xrow + LANE; f32x4 v[4]; float s = 0.f;
#pragma unroll
        for (int j = 0; j < 4; ++j) { v[j] = xr[64 * j]; s += (v[j].x * v[j].x + v[j].y * v[j].y) + (v[j].z * v[j].z + v[j].w * v[j].w); }
        s = wave_sum(s);
        u32x2* o8 = (u32x2*)(XB + (size_t)m * D) + LANE;
#pragma unroll
        for (int j = 0; j < 4; ++j) { u32x2 w; w.x = pk2(v[j].x, v[j].y); w.y = pk2(v[j].z, v[j].w); o8[64 * j] = w; }
        if (LANE < 16) SSQ[(size_t)m * 16 + LANE] = LANE == 0 ? s : 0.f;
    }
}

constexpr int MIX_RB = 33;
__device__ __forceinline__ void mix_elt(const Frame& F, const Args& a, int l) {
    int tid_ = threadIdx.x; asm volatile("" : "+v"(tid_)); const int TID = tid_;
    unsigned char* ws = a.ws;
    const bf16* UPOOL = (const bf16*)(ws + WS_UPOOL); const bf16* CVIN = (const bf16*)(ws + WS_CVIN); const bf16* GB = (const bf16*)(ws + WS_GB);
    bf16* MIXED = (bf16*)(ws + WS_MIXED); bf16* GBCV = (bf16*)(ws + WS_GBCV);
    const float* spool = a.in[2] + (size_t)l * 16 * 15 * 512; const float* sconv = a.in[3] + (size_t)l * 16 * 2 * 512; const float* cw = a.in[10] + (size_t)l * 3 * 512;
    const int nrb = (M + MIX_RB - 1) / MIX_RB, total = nrb * 128, stride = F.G * NTHR;
    for (int idx = F.bid * NTHR + TID; idx < total; idx += stride) {
        const int rb = idx >> 7, c8 = idx & 127;
        const int r0 = rb * MIX_RB, r1 = (r0 + MIX_RB) < M ? (r0 + MIX_RB) : M;
        if (c8 < 64) {
            const int ch0 = c8 * 8, win = 2 << (c8 >> 4);
            float sum[8], f[8];
            for (int row = r0; row < r1; ++row) {
                const bool samp = row >= MP; int t, sq = 0;
                if (!samp) t = row & 4095; else { const int sr = row - MP; sq = sr >> 6; t = sr & 63; }
                const u32x4 uw = *(const u32x4*)(UPOOL + (size_t)row * 512 + ch0);
                if (row == r0 || t == 0) {
#pragma unroll
                    for (int e = 0; e < 8; ++e) sum[e] = 0.f;
                    for (int j = 1; j < win; ++j) {
                        const int tt = t - j;
                        if (tt >= 0) { const u32x4 w = *(const u32x4*)(UPOOL + (size_t)(row - j) * 512 + ch0); UNPACK8(w, f);
#pragma unroll
                            for (int e = 0; e < 8; ++e) sum[e] += f[e]; }
                        else if (samp) { const float* p = spool + ((size_t)sq * 15 + 15 + tt) * 512 + ch0; const f32x4 p0 = *(const f32x4*)p, p1 = *(const f32x4*)(p + 4);
#pragma unroll
                            for (int e = 0; e < 4; ++e) { sum[e] += p0[e]; sum[4 + e] += p1[e]; } }
                    }
                } else {
                    const int tt = t - win;
                    if (tt >= 0) { const u32x4 w = *(const u32x4*)(UPOOL + (size_t)(row - win) * 512 + ch0); UNPACK8(w, f);
#pragma unroll
                        for (int e = 0; e < 8; ++e) sum[e] -= f[e]; }
                    else if (samp) { const float* p = spool + ((size_t)sq * 15 + 15 + tt) * 512 + ch0; const f32x4 p0 = *(const f32x4*)p, p1 = *(const f32x4*)(p + 4);
#pragma unroll
                        for (int e = 0; e < 4; ++e) { sum[e] -= p0[e]; sum[4 + e] -= p1[e]; } }
                }
                UNPACK8(uw, f);
                const float cnt = samp ? (float)win : (float)(win < t + 1 ? win : t + 1), inv = 1.0f / cnt;
                float o[8];
#pragma unroll
                for (int e = 0; e < 8; ++e) { sum[e] += f[e]; o[e] = sum[e] * inv - f[e]; }
                u32x4 w; w.x = pk2(o[0], o[1]); w.y = pk2(o[2], o[3]); w.z = pk2(o[4], o[5]); w.w = pk2(o[6], o[7]);
                *(u32x4*)(MIXED + (size_t)row * 512 + ch0) = w;
            }
        } else {
            const int ch0 = (c8 - 64) * 8;
            float w0[8], w1[8], w2[8];
#pragma unroll
            for (int h = 0; h < 2; ++h) { const f32x4 a0 = *(const f32x4*)(cw + ch0 + 4 * h), a1 = *(const f32x4*)(cw + 512 + ch0 + 4 * h), a2 = *(const f32x4*)(cw + 1024 + ch0 + 4 * h);
#pragma unroll
                for (int e = 0; e < 4; ++e) { w0[4 * h + e] = a0[e]; w1[4 * h + e] = a1[e]; w2[4 * h + e] = a2[e]; } }
            float x0[8], x1[8], x2[8], gb[8];
#pragma unroll
            for (int e = 0; e < 8; ++e) { x1[e] = 0.f; x2[e] = 0.f; }
            for (int row = r0; row < r1; ++row) {
                const bool samp = row >= MP; int t, sq = 0;
                if (!samp) t = row & 4095; else { const int sr = row - MP; sq = sr >> 6; t = sr & 63; }
                { const u32x4 w = *(const u32x4*)(CVIN + (size_t)row * 512 + ch0); UNPACK8(w, x0); }
                { const u32x4 w = *(const u32x4*)(GB + (size_t)row * 512 + ch0); UNPACK8(w, gb); }
                if (row == r0 || t == 0) {
                    if (t >= 1) { const u32x4 w = *(const u32x4*)(CVIN + (size_t)(row - 1) * 512 + ch0); UNPACK8(w, x1); }
                    else if (samp) { const float* p = sconv + ((size_t)sq * 2 + 1) * 512 + ch0; const f32x4 p0 = *(const f32x4*)p, p1 = *(const f32x4*)(p + 4);
#pragma unroll
                        for (int e = 0; e < 4; ++e) { x1[e] = p0[e]; x1[4 + e] = p1[e]; } }
                    else {
#pragma unroll
                        for (int e = 0; e < 8; ++e) x1[e] = 0.f; }
                    if (t >= 2) { const u32x4 w = *(const u32x4*)(CVIN + (size_t)(row - 2) * 512 + ch0); UNPACK8(w, x2); }
                    else if (samp) { const float* p = sconv + ((size_t)sq * 2 + t) * 512 + ch0; const f32x4 p0 = *(const f32x4*)p, p1 = *(const f32x4*)(p + 4);
#pragma unroll
                        for (int e = 0; e < 4; ++e) { x2[e] = p0[e]; x2[4 + e] = p1[e]; } }
                    else {
#pragma unroll
                        for (int e = 0; e < 8; ++e) x2[e] = 0.f; }
                }
                float o[8];
#pragma unroll
                for (int e = 0; e < 8; ++e) { o[e] = gb[e] * (w0[e] * x2[e] + w1[e] * x1[e] + w2[e] * x0[e]); x2[e] = x1[e]; x1[e] = x0[e]; }
                u32x4 w; w.x = pk2(o[0], o[1]); w.y = pk2(o[2], o[3]); w.z = pk2(o[4], o[5]); w.w = pk2(o[6], o[7]);
                *(u32x4*)(GBCV + (size_t)row * 512 + ch0) = w;
            }
        }
    }
}

__device__ __forceinline__ void ffn_fixup(const Frame& F, const Args& a, int l) {
    int tid_ = threadIdx.x; asm volatile("" : "+v"(tid_)); const int TID = tid_;
    unsigned char* ws = a.ws;
    const float* HALO = (const float*)(ws + WS_HALO); bf16* ACT = (bf16*)(ws + WS_ACT);
    const float* fw = a.in[15] + (size_t)l * 3 * FF2; const float* fb = a.in[16] + (size_t)l * FF2;
    const int total = NTP * 2 * 352, stride = F.G * NTHR;
    for (int idx = F.bid * NTHR + TID; idx < total; idx += stride) {
        const int pm = idx / 704, rem = idx % 704, rr = rem / 352, c8 = rem % 352;
        if ((pm & 15) == 0) continue;
        const int f0 = c8 * 8, pn = f0 >> 7, j0 = f0 & 127;
        float res[2][8];
#pragma unroll
        for (int h = 0; h < 2; ++h) {
            const int pc = pn * 256 + h * 128 + j0, oc = h * FF + f0;
            const float* p0 = HALO + ((size_t)pm * 4 + rr) * FF2 + pc;
            const float* p1 = rr == 1 ? HALO + ((size_t)pm * 4 + 0) * FF2 + pc : HALO + ((size_t)(pm - 1) * 4 + 3) * FF2 + pc;
            const float* p2 = rr == 1 ? HALO + ((size_t)(pm - 1) * 4 + 3) * FF2 + pc : HALO + ((size_t)(pm - 1) * 4 + 2) * FF2 + pc;
#pragma unroll
            for (int q = 0; q < 2; ++q) { const f32x4 x0 = *(const f32x4*)(p0 + 4 * q), x1 = *(const f32x4*)(p1 + 4 * q), x2 = *(const f32x4*)(p2 + 4 * q);
                const f32x4 w0 = *(const f32x4*)(fw + oc + 4 * q), w1 = *(const f32x4*)(fw + FF2 + oc + 4 * q), w2 = *(const f32x4*)(fw + 2 * FF2 + oc + 4 * q), b = *(const f32x4*)(fb + oc + 4 * q);
#pragma unroll
                for (int e = 0; e < 4; ++e) res[h][4 * q + e] = w0[e] * x2[e] + w1[e] * x1[e] + w2[e] * x0[e] + b[e]; }
        }
        float o[8];
#pragma unroll
        for (int e = 0; e < 8; ++e) o[e] = res[1][e] * sigmoidf_(res[1][e]) * res[0][e];
        u32x4 w; w.x = pk2(o[0], o[1]); w.y = pk2(o[2], o[3]); w.z = pk2(o[4], o[5]); w.w = pk2(o[6], o[7]);
        *(u32x4*)(ACT + ((size_t)pm * 256 + rr) * FF + f0) = w;
    }
}

__device__ __forceinline__ void final_norm(const Frame& F, const Args& a) {
    int tid_ = threadIdx.x; asm volatile("" : "+v"(tid_)); const int TID = tid_, LANE = tid_ & 63, WAVE = __builtin_amdgcn_readfirstlane(tid_ >> 6);
    const float* SSQ = (const float*)(a.ws + WS_SSQ); const float* g = a.in[18];
    const int gw = F.bid * NWAVES + WAVE, NGW = F.G * NWAVES;
    f32x4 gv[4];
#pragma unroll
    for (int j = 0; j < 4; ++j) gv[j] = ((const f32x4*)g)[LANE + 64 * j];
    for (int m = gw; m < M; m += NGW) {
        float s = LANE < 16 ? SSQ[(size_t)m * 16 + LANE] : 0.f;
        s = wave_sum(s);
        const float rs = 1.0f / sqrtf(s * (1.0f / D) + EPS);
        f32x4* xr = (f32x4*)(a.out + (size_t)m * D) + LANE;
#pragma unroll
        for (int j = 0; j < 4; ++j) { f32x4 v = xr[64 * j]; v = v * rs * gv[j]; xr[64 * j] = v; }
    }
}

typedef const __attribute__((address_space(4))) Args* KArgs;
__device__ __forceinline__ Args load_args(KArgs kp) {
    asm volatile("" : "+s"(kp)); Args a;
#pragma unroll
    for (int i = 0; i < 19; ++i) a.in[i] = kp->in[i];
    a.out = kp->out; a.ws = kp->ws; return a;
}

__global__ void __launch_bounds__(NTHR, 2) fwd_mega(Args a_unused) {
    extern __shared__ __attribute__((aligned(16))) unsigned char lds_raw[];
    cg::grid_group grid = cg::this_grid();
    KArgs kp = (KArgs)__builtin_amdgcn_kernarg_segment_ptr();
    Frame F;
    F.lds = (LAS unsigned char*)lds_raw;
    F.tid = threadIdx.x; F.lane = F.tid & 63; F.wave = __builtin_amdgcn_readfirstlane(F.tid >> 6);
    F.G = gridDim.x; F.bid = blockIdx.x;
    unsigned* barw;
    { const Args a = load_args(kp); barw = (unsigned*)a.ws; }
    if (blockIdx.x == 0) for (int i = threadIdx.x; i < XCD_BAR_WORDS; i += NTHR) __hip_atomic_store(barw + i, 0u, __ATOMIC_RELAXED, __HIP_MEMORY_SCOPE_AGENT);
    volatile LAS unsigned* bst = (volatile LAS unsigned*)(F.lds + BST_OFF);
    if (threadIdx.x < 4) bst[threadIdx.x] = 0u;
    __syncthreads();

    if constexpr (PHMASK & 1) { const Args a = load_args(kp); p0_prologue(F, a); }
    if constexpr (PROBE == 2) { __syncthreads(); const Args a = load_args(kp); p0_prologue(F, a); }
    grid.sync();
    const XcdBarrier xb = xcd_barrier_post(barw, bst);

#pragma unroll 1
    for (int l = 0; l < 2; ++l) {
        if constexpr (PHMASK & 2) {
            const Args a = load_args(kp); unsigned char* ws = a.ws; unsigned char* wl = ws + WS_W + (size_t)l * W_LAYER;
            pg8::Gemm g{(const bf16*)(ws + WS_XB), (const bf16*)(wl + WO_IN), M, INW, D, D, 0, 0}; pg8::StaticOrder S; S.init(M, INW, F.G, F.bid);
            EpiProj E{ws, a.out, a.in[7] + (size_t)l * 2 * D, a.in[9] + (size_t)l * D, l};
            pg8::gemm_phase<EpiProj, pg8::StaticOrder, true, true>(F.lds, g, S, E);
            if constexpr (PROBE == 4) { __syncthreads(); pg8::gemm_phase<EpiProj, pg8::StaticOrder, true, true>(F.lds, g, S, E); }
        }
        xcd_barrier(xb);
_Pragma("unroll 1")
        for (int rep = 0; rep < (PROBE == 3 ? 2 : 1); ++rep) { const Args a = load_args(kp); mix_elt(F, a, l); }
        xcd_barrier(xb);
        if constexpr (PHMASK & 8) {
            const Args a = load_args(kp); unsigned char* ws = a.ws; unsigned char* wl = ws + WS_W + (size_t)l * W_LAYER;
            pg8::Gemm g{(const bf16*)(ws + WS_MIXED), (const bf16*)(wl + WO_MAP), M, D, 256, PW, 1, 512}; pg8::StaticOrder S; S.init(M, D, F.G, F.bid);
            EpiMA E{(const bf16*)(ws + WS_SA), (bf16*)(ws + WS_MA)};
            pg8::gemm_phase<EpiMA, pg8::StaticOrder, true, true>(F.lds, g, S, E);
        }
        if constexpr (PHMASK & 16) {
            const Args a = load_args(kp); unsigned char* ws = a.ws; unsigned char* wl = ws + WS_W + (size_t)l * W_LAYER;
            pg8::Gemm g{(const bf16*)(ws + WS_GBCV), (const bf16*)(wl + WO_CO), M, D, CW, CW, 0, 0}; pg8::StaticOrder S; S.init(M, D, F.G, F.bid);
            EpiMerge E{(const bf16*)(ws + WS_SB), (bf16*)(ws + WS_MA)};
            pg8::gemm_phase<EpiMerge, pg8::StaticOrder, true, true>(F.lds, g, S, E);
        }
        xcd_barrier(xb);
        if constexpr (PHMASK & 32) {
            const Args a = load_args(kp); unsigned char* ws = a.ws; unsigned char* wl = ws + WS_W + (size_t)l * W_LAYER;
            pg8::Gemm g{(const bf16*)(ws + WS_MA), (const bf16*)(wl + WO_O), M, D, D, D, 0, 0}; pg8::StaticOrder S; S.init(M, D, F.G, F.bid);
            EpiRes E{l == 0 ? a.in[0] : a.out, l == 0 ? a.in[1] : a.out + (size_t)MP * D, a.out, (bf16*)(ws + WS_XB), (float*)(ws + WS_SSQ)};
            pg8::gemm_phase<EpiRes, pg8::StaticOrder, true, true>(F.lds, g, S, E);
        }
        xcd_barrier(xb);
        if constexpr (PHMASK & 64) {
            const Args a = load_args(kp); unsigned char* ws = a.ws; unsigned char* wl = ws + WS_W + (size_t)l * W_LAYER;
            pg8::Gemm g{(const bf16*)(ws + WS_XB), (const bf16*)(wl + WO_UP), M, FF2, D, D, 0, 0}; pg8::StaticOrder S; S.init(M, FF2, F.G, F.bid);
            EpiUpAct E{ws, a.out, a.in[15] + (size_t)l * 3 * FF2, a.in[16] + (size_t)l * FF2, a.in[4] + (size_t)l * 16 * 2 * FF2, F.lds + EX_OFF, l};
            pg8::gemm_phase<EpiUpAct, pg8::StaticOrder, true, true>(F.lds, g, S, E);
            if constexpr (PROBE == 5) { __syncthreads(); pg8::gemm_phase<EpiUpAct, pg8::StaticOrder, true, true>(F.lds, g, S, E); }
        }
        xcd_barrier(xb);
        if constexpr (PHMASK & 128) { const Args a = load_args(kp); ffn_fixup(F, a, l); }
        xcd_barrier(xb);
        if constexpr (PHMASK & 256) {
            const Args a = load_args(kp); unsigned char* ws = a.ws; unsigned char* wl = ws + WS_W + (size_t)l * W_LAYER;
            pg8::Gemm g{(const bf16*)(ws + WS_ACT), (const bf16*)(wl + WO_DN), M, D, FF, FF, 0, 0}; pg8::StaticOrder S; S.init(M, D, F.G, F.bid);
            EpiRes E{a.out, a.out + (size_t)MP * D, a.out, (bf16*)(ws + WS_XB), (float*)(ws + WS_SSQ)};
            pg8::gemm_phase<EpiRes, pg8::StaticOrder, true, true>(F.lds, g, S, E);
        }
        xcd_barrier(xb);
    }
    if constexpr (PHMASK & 512) { const Args a = load_args(kp); final_norm(F, a); }
    if constexpr (PROBE == 1) { for (int i = 0; i < 16; ++i) xcd_barrier(xb); }
}

extern "C" void kernel_launch(void* const* d_in, const int* in_sizes, int n_in, void* d_out, int out_size, void* d_ws, size_t ws_size, hipStream_t stream) {
    static int grid = 0;
    if (grid == 0) {
        if (n_in != 19 || in_sizes[0] != MP * D || (size_t)out_size != O_END || ws_size < WS_END) {
            fprintf(stderr, "kernel_launch: unexpected shapes: n_in %d in0 %d out %d ws %zu (need %zu)\n", n_in, n_in > 0 ? in_sizes[0] : -1, out_size, ws_size, (size_t)WS_END); grid = -1; return; }
        int dev = 0, cus = 0, per_cu = 0;
        hipGetDevice(&dev); hipDeviceGetAttribute(&cus, hipDeviceAttributeMultiprocessorCount, dev);
        if (hipFuncSetAttribute((const void*)fwd_mega, hipFuncAttributeMaxDynamicSharedMemorySize, LDS_BYTES) != hipSuccess) { fprintf(stderr, "kernel_launch: hipFuncSetAttribute failed\n"); grid = -1; return; }
        if (hipOccupancyMaxActiveBlocksPerMultiprocessor(&per_cu, (const void*)fwd_mega, NTHR, LDS_BYTES) != hipSuccess || per_cu < 1) { fprintf(stderr, "kernel_launch: occupancy query says %d\n", per_cu); per_cu = 1; }
        (void)hipGetLastError();
        grid = cus;
    }
    if (grid < 0) return;
    Args a{};
    for (int i = 0; i < 19; ++i) a.in[i] = (const float*)d_in[i];
    a.out = (float*)d_out; a.ws = (unsigned char*)d_ws;
    void* args[] = {&a};
    hipError_t e = hipLaunchCooperativeKernel((const void*)fwd_mega, dim3(grid), dim3(NTHR), args, LDS_BYTES, stream);
    if (e != hipSuccess) fprintf(stderr, "cooperative launch failed: %s (grid %d)\n", hipGetErrorString(e), grid);
}
```

```cpp
#include <hip/hip_runtime.h>
#include <hip/hip_cooperative_groups.h>
#include <cstdio>
#include <cstdint>
namespace cg = cooperative_groups;

namespace pg8 {
#define PG8_LAS __attribute__((address_space(3)))
typedef unsigned short bf16_t;
typedef short bf16x8 __attribute__((ext_vector_type(8)));
typedef float f32x4 __attribute__((ext_vector_type(4)));
typedef unsigned u32x4 __attribute__((ext_vector_type(4)));
constexpr int BM = 256, BK = 64, HALF = 128, HTB = HALF * BK * 2, STAGE_BYTES = 8 * HTB, NXCD = 8, WGM = 8;

__host__ __device__ __forceinline__ int lds_byte(int r, int c) { const int st = (r >> 4) * 2 + (c >> 5), rr = r & 15, cc = c & 31, ob = rr * 64 + cc * 2; return st * 1024 + (ob ^ (((ob >> 9) & 1) << 5)); }
__host__ __device__ __forceinline__ void stage_rc(int b, int& R, int& C) { const int st = b / 1024, sb = b % 1024, swz = sb ^ (((sb >> 9) & 1) << 5); R = (st >> 1) * 16 + swz / 64; C = (st & 1) * 32 + (swz % 64) / 2; }
__host__ __device__ __forceinline__ int perm32(int rho) { const int n = rho >> 4, i = rho & 15; return 8 * (i >> 2) + 4 * n + (i & 3); }

struct Unit { int pm, pn; };
struct Gemm { const bf16_t* A; const bf16_t* Bt; int M, N, K, lda, apn_shift, apn_bytes; };

struct StaticOrder {
    int nM, nN, nwg, G, c;
    __host__ __device__ void init(int M, int N, int G_, int c_) { nM = M / BM; nN = N / BM; nwg = nM * nN; G = G_; c = c_; }
    __host__ __device__ bool next(int i, Unit& u) const {
        const long L = (long)i * G + c; if (L >= nwg) return false;
        int wgid = (int)L; { const int q = nwg / NXCD, r = nwg % NXCD, xcd = wgid % NXCD, off = wgid / NXCD; wgid = (xcd < r ? xcd * (q + 1) : r * (q + 1) + (xcd - r) * q) + off; }
        const int nig = WGM * nN, gid = wgid / nig, fm = gid * WGM, gsz = (nM - fm) < WGM ? (nM - fm) : WGM;
        u.pm = fm + ((wgid % nig) % gsz); u.pn = (wgid % nig) / gsz; return true;
    }
    __device__ __forceinline__ void a_ready(const Unit&) const {}
    __device__ __forceinline__ void done(const Unit&) const {}
};

__device__ __forceinline__ unsigned cvt_pk_bf16(float lo, float hi) { unsigned r; asm volatile("v_cvt_pk_bf16_f32 %0, %1, %2" : "=v"(r) : "v"(lo), "v"(hi)); return r; }

template <class Epi, class Sched, bool ALIGN_EPI = false, bool SP2 = false>
__device__ __forceinline__ void gemm_phase(PG8_LAS unsigned char* lds, const Gemm g, const Sched& S, const Epi& E) {
    int tid_ = threadIdx.x; asm volatile("" : "+v"(tid_));
    const int tid = tid_, wid = __builtin_amdgcn_readfirstlane(tid >> 6), lane = tid & 63, wr = wid >> 2, wc = wid & 3, fr = lane & 15, fq = lane >> 4;
    const int K = g.K, nt = K / BK, lda = g.lda;
    unsigned voffA[2], voffB[2];
#pragma unroll
    for (int i = 0; i < 2; ++i) { int R, C; stage_rc(tid * 16 + i * 8192, R, C); const int Rb = Epi::PERM ? ((R & ~31) + perm32(R & 31)) : R;
        voffA[i] = (unsigned)(R * lda + C) * 2u; voffB[i] = (unsigned)(Rb * K + C) * 2u; }
    const size_t kstep = (size_t)(BK * 2);
    const size_t hstepA = (size_t)HALF * lda * 2, hstepB = (size_t)HALF * K * 2;
    const size_t tstepA = 2 * hstepA, tstepB = 2 * hstepB;
    const unsigned ldsw = (unsigned)wid * 1024u;
    const int aoff = lds_byte(wr * 64 + fr, fq * 8), boff = lds_byte(wc * 32 + fr, fq * 8);
#define PG8_SA(b, h) (((b) * 2 + (h)) * HTB)
#define PG8_SB(b, h) ((4 + (b) * 2 + (h)) * HTB)
#define PG8_STAGE(bufoff, gbase, voff) do { _Pragma("unroll") for (int _i = 0; _i < 2; ++_i) \
        __builtin_amdgcn_global_load_lds((const unsigned*)((const char*)(gbase) + (voff)[_i]), (PG8_LAS unsigned*)(lds + (bufoff) + ldsw + _i * 8192), 16, 0, 0); } while (0)
#define PG8_LDA(dst, b, h) do { _Pragma("unroll") for (int m = 0; m < 4; ++m) _Pragma("unroll") for (int k = 0; k < 2; ++k) dst[m][k] = *(const PG8_LAS bf16x8*)(lds + PG8_SA(b, h) + aoff + m * 2048 + k * 1024); } while (0)
#define PG8_LDB(dst, b, h) do { _Pragma("unroll") for (int n = 0; n < 2; ++n) _Pragma("unroll") for (int k = 0; k < 2; ++k) dst[n][k] = *(const PG8_LAS bf16x8*)(lds + PG8_SB(b, h) + boff + n * 2048 + k * 1024); } while (0)
#define PG8_MMA(ai, bj, At, Bt) do { __builtin_amdgcn_s_setprio(1); _Pragma("unroll") for (int m = 0; m < 4; ++m) _Pragma("unroll") for (int n = 0; n < 2; ++n) _Pragma("unroll") for (int k = 0; k < 2; ++k) \
        acc[ai][bj][m][n] = __builtin_amdgcn_mfma_f32_16x16x32_bf16(Bt[n][k], At[m][k], acc[ai][bj][m][n], 0, 0, 0); __builtin_amdgcn_s_setprio(0); } while (0)
#define PG8_WAIT_V(n) asm volatile("s_waitcnt vmcnt(" #n ")" ::: "memory")
#define PG8_WAIT_L(n) asm volatile("s_waitcnt lgkmcnt(" #n ")" ::: "memory")
#define PG8_BAR __builtin_amdgcn_s_barrier()
#define PG8_SCHED __builtin_amdgcn_sched_barrier(0)
    Unit cur, nxt; int ui = 0;
    if (!S.next(0, cur)) return;
    f32x4 acc[2][2][4][2];
#pragma unroll
    for (int a = 0; a < 2; ++a)
#pragma unroll
        for (int b = 0; b < 2; ++b)
#pragma unroll
            for (int m = 0; m < 4; ++m)
#pragma unroll
                for (int n = 0; n < 2; ++n) acc[a][b][m][n] = (f32x4){0.f, 0.f, 0.f, 0.f};
    bf16x8 At[4][2], B0[2][2], B1[2][2];
    const char* cA = (const char*)g.A + (size_t)cur.pm * tstepA + (size_t)(cur.pn >> g.apn_shift) * g.apn_bytes; const char* cB = (const char*)g.Bt + (size_t)cur.pn * tstepB;
    S.a_ready(cur);
    if constexpr (SP2) {
        PG8_STAGE(PG8_SB(0, 0), cB, voffB); PG8_STAGE(PG8_SB(0, 1), cB + hstepB, voffB); PG8_STAGE(PG8_SA(0, 0), cA, voffA); PG8_STAGE(PG8_SA(0, 1), cA + hstepA, voffA);
        if (wr == 1) PG8_BAR;
        PG8_WAIT_V(2); PG8_BAR;
        PG8_STAGE(PG8_SB(1, 0), cB + kstep, voffB); PG8_STAGE(PG8_SA(1, 0), cA + kstep, voffA); PG8_STAGE(PG8_SB(1, 1), cB + hstepB + kstep, voffB);
        PG8_WAIT_V(6); PG8_BAR;
    } else {
        PG8_STAGE(PG8_SB(0, 0), cB, voffB); PG8_STAGE(PG8_SA(0, 0), cA, voffA); PG8_STAGE(PG8_SB(0, 1), cB + hstepB, voffB); PG8_STAGE(PG8_SA(0, 1), cA + hstepA, voffA);
        if (wr == 1) PG8_BAR;
        PG8_WAIT_V(4); PG8_BAR;
        PG8_STAGE(PG8_SB(1, 0), cB + kstep, voffB); PG8_STAGE(PG8_SA(1, 0), cA + kstep, voffA); PG8_STAGE(PG8_SB(1, 1), cB + hstepB + kstep, voffB);
        PG8_WAIT_V(6); PG8_BAR;
    }
    for (;;) {
        const bool has_next = S.next(ui + 1, nxt);
        const char* nA = has_next ? (const char*)g.A + (size_t)nxt.pm * tstepA + (size_t)(nxt.pn >> g.apn_shift) * g.apn_bytes : cA; const char* nB = has_next ? (const char*)g.Bt + (size_t)nxt.pn * tstepB : cB;
#pragma unroll 1
        for (int t = 0; t < nt; t += 2) {
            const bool last = (t == nt - 2);
            const char* a1 = cA + (size_t)(t + 1) * kstep;
            const char* a2 = last ? nA : cA + (size_t)(t + 2) * kstep; const char* b2 = last ? nB : cB + (size_t)(t + 2) * kstep;
            const char* a3 = a2 + kstep; const char* b3 = b2 + kstep;
            if (last && has_next) S.a_ready(nxt);
            if constexpr (SP2) {
            PG8_LDB(B0, 0, 0); PG8_LDB(B1, 0, 1); PG8_SCHED; PG8_LDA(At, 0, 0); PG8_STAGE(PG8_SA(1, 1), a1 + hstepA, voffA);
            PG8_WAIT_V(8); PG8_WAIT_L(0); PG8_BAR; PG8_MMA(0, 0, At, B0); PG8_MMA(0, 1, At, B1); PG8_BAR; PG8_SCHED;
            PG8_LDA(At, 0, 1); PG8_STAGE(PG8_SB(0, 0), b2, voffB); PG8_STAGE(PG8_SB(0, 1), b2 + hstepB, voffB); PG8_STAGE(PG8_SA(0, 0), a2, voffA);
            PG8_WAIT_V(8); PG8_WAIT_L(0); PG8_BAR; PG8_MMA(1, 0, At, B0); PG8_MMA(1, 1, At, B1); PG8_BAR; PG8_SCHED;
            PG8_LDB(B0, 1, 0); PG8_LDB(B1, 1, 1); PG8_SCHED; PG8_LDA(At, 1, 0); PG8_STAGE(PG8_SA(0, 1), a2 + hstepA, voffA);
            PG8_WAIT_V(8); PG8_WAIT_L(0); PG8_BAR; PG8_MMA(0, 0, At, B0); PG8_MMA(0, 1, At, B1); PG8_BAR; PG8_SCHED;
            PG8_LDA(At, 1, 1); PG8_STAGE(PG8_SB(1, 0), b3, voffB); PG8_STAGE(PG8_SB(1, 1), b3 + hstepB, voffB); PG8_STAGE(PG8_SA(1, 0), a3, voffA);
            PG8_WAIT_V(8); PG8_WAIT_L(0); PG8_BAR; PG8_MMA(1, 0, At, B0); PG8_MMA(1, 1, At, B1); PG8_BAR; PG8_SCHED;
            } else {
            PG8_LDB(B0, 0, 0); PG8_SCHED; PG8_LDA(At, 0, 0); PG8_STAGE(PG8_SA(1, 1), a1 + hstepA, voffA);
            PG8_WAIT_L(8); PG8_BAR; PG8_WAIT_L(0); PG8_MMA(0, 0, At, B0); PG8_BAR; PG8_SCHED;
            PG8_LDB(B1, 0, 1); PG8_STAGE(PG8_SB(0, 0), b2, voffB);
            PG8_BAR; PG8_WAIT_L(0); PG8_MMA(0, 1, At, B1); PG8_BAR;
            PG8_LDA(At, 0, 1); PG8_STAGE(PG8_SA(0, 0), a2, voffA);
            PG8_BAR; PG8_WAIT_L(0); PG8_MMA(1, 0, At, B0); PG8_BAR; PG8_SCHED;
            PG8_STAGE(PG8_SB(0, 1), b2 + hstepB, voffB);
            PG8_WAIT_V(6); PG8_BAR; PG8_MMA(1, 1, At, B1); PG8_BAR;
            PG8_LDB(B0, 1, 0); PG8_SCHED; PG8_LDA(At, 1, 0); PG8_STAGE(PG8_SA(0, 1), a2 + hstepA, voffA);
            PG8_WAIT_L(8); PG8_BAR; PG8_WAIT_L(0); PG8_MMA(0, 0, At, B0); PG8_BAR; PG8_SCHED;
            PG8_LDB(B1, 1, 1); PG8_STAGE(PG8_SB(1, 0), b3, voffB);
            PG8_BAR; PG8_WAIT_L(0); PG8_MMA(0, 1, At, B1); PG8_BAR;
            PG8_LDA(At, 1, 1); PG8_STAGE(PG8_SA(1, 0), a3, voffA);
            PG8_BAR; PG8_WAIT_L(0); PG8_MMA(1, 0, At, B0); PG8_BAR; PG8_SCHED;
            PG8_STAGE(PG8_SB(1, 1), b3 + hstepB, voffB);
            PG8_WAIT_V(6); PG8_BAR; PG8_MMA(1, 1, At, B1); PG8_BAR;
            }
        }
        if constexpr (ALIGN_EPI) { if (wr == 0) PG8_BAR; }
        E(acc, cur, wr, wc, fr, fq); S.done(cur);
        if (!has_next) break;
#pragma unroll
        for (int a = 0; a < 2; ++a)
#pragma unroll
            for (int b = 0; b < 2; ++b)
#pragma unroll
                for (int m = 0; m < 4; ++m)
#pragma unroll
                    for (int n = 0; n < 2; ++n) acc[a][b][m][n] = (f32x4){0.f, 0.f, 0.f, 0.f};
        cur = nxt; cA = nA; cB = nB; ++ui;
        if constexpr (ALIGN_EPI) { if (wr == 1) PG8_BAR; }
    }
    PG8_WAIT_V(0);
    if constexpr (!ALIGN_EPI) { if (wr == 0) PG8_BAR; }
    PG8_BAR;
#undef PG8_SA
#undef PG8_SB
#undef PG8_STAGE
#undef PG8_LDA
#undef PG8_LDB
#undef PG8_MMA
#undef PG8_WAIT_V
#undef PG8_WAIT_L
#undef PG8_BAR
#undef PG8_SCHED
}
}

typedef unsigned short bf16;
typedef float f32x4 __attribute__((ext_vector_type(4)));
typedef unsigned u32x4 __attribute__((ext_vector_type(4)));
typedef unsigned u32x2 __attribute__((ext_vector_type(2)));
#define LAS __attribute__((address_space(3)))

constexpr int D = 1024, MP = 32768, MS = 1024, M = MP + MS, NTILE = M / 256, NTP = MP / 256;
constexpr int INW = 4096, PW = 512, CW = 512, FF = 2816, FF2 = 5632;
constexpr float EPS = 1e-6f;
constexpr int NWAVES = 8, NTHR = 512;
constexpr int LDS_BYTES = 147456;
#ifndef PHMASK
#define PHMASK 0xFFFF
#endif
#ifndef PROBE
#define PROBE 0
#endif

constexpr size_t O_POOLP = (size_t)M * D;
constexpr size_t O_CONVP = O_POOLP + 2 * 8 * 15 * 512;
constexpr size_t O_FFNP = O_CONVP + 2 * 8 * 2 * 512;
constexpr size_t O_POOLS = O_FFNP + 2 * 8 * 2 * 5632;
constexpr size_t O_CONVS = O_POOLS + 2 * 16 * 15 * 512;
constexpr size_t O_FFNS = O_CONVS + 2 * 16 * 2 * 512;
constexpr size_t O_END = O_FFNS + 2 * 16 * 2 * 5632;

constexpr size_t MiB = 1u << 20;
constexpr size_t WS_SSQ = 1 * MiB;
constexpr size_t WS_W = 4 * MiB, W_LAYER = 28 * MiB;
constexpr size_t WO_IN = 0, WO_UP = 8 * MiB, WO_DN = 19 * MiB, WO_O = 24 * MiB + MiB / 2, WO_CO = 26 * MiB + MiB / 2, WO_MAP = 27 * MiB + MiB / 2;
constexpr size_t WS_XB = 60 * MiB;
constexpr size_t WS_ACTV = 126 * MiB;
constexpr size_t WS_UPOOL = WS_ACTV, WS_CVIN = WS_ACTV + 33 * MiB, WS_GB = WS_ACTV + 66 * MiB, WS_SA = WS_ACTV + 99 * MiB, WS_SB = WS_ACTV + 165 * MiB,
                 WS_MIXED = WS_ACTV + 231 * MiB, WS_GBCV = WS_ACTV + 264 * MiB, WS_MA = WS_ACTV;
constexpr size_t WS_ACT = WS_ACTV;
constexpr size_t WS_HALO = WS_ACTV + 182 * MiB;
constexpr size_t WS_END = WS_ACTV + 297 * MiB;
constexpr int BST_OFF = 131072 + 8192;
constexpr int EX_OFF = 131072;

__device__ __forceinline__ float bf_lo(unsigned w) { return __builtin_bit_cast(float, w << 16); }
__device__ __forceinline__ float bf_hi(unsigned w) { return __builtin_bit_cast(float, w & 0xffff0000u); }
__device__ __forceinline__ unsigned pk2(float lo, float hi) { return pg8::cvt_pk_bf16(lo, hi); }
__device__ __forceinline__ float sigmoidf_(float x) { return __builtin_amdgcn_rcpf(1.f + __builtin_amdgcn_exp2f(-1.44269504f * x)); }
#define UNPACK8(V_, F_) do { F_[0] = bf_lo((V_)[0]); F_[1] = bf_hi((V_)[0]); F_[2] = bf_lo((V_)[1]); F_[3] = bf_hi((V_)[1]); F_[4] = bf_lo((V_)[2]); F_[5] = bf_hi((V_)[2]); F_[6] = bf_lo((V_)[3]); F_[7] = bf_hi((V_)[3]); } while (0)

struct Args { const float* in[19]; float* out; unsigned char* ws; };
typedef const __attribute__((address_space(4))) Args* KArgs;
__device__ __forceinline__ Args load_args(KArgs kp) {
    asm volatile("" : "+s"(kp)); Args a;
#pragma unroll
    for (int i = 0; i < 19; ++i) a.in[i] = kp->in[i];
    a.out = kp->out; a.ws = kp->ws; return a;
}

__device__ __forceinline__ void unit_rstd(const float* ssq, int pm, int wr, int fr, int fq, float (&r)[2][4]) {
    const int lane = fq * 16 + fr;
#pragma unroll
    for (int ai = 0; ai < 2; ++ai) {
        const f32x4* p = (const f32x4*)(ssq + (size_t)(pm * 256 + ai * 128 + wr * 64 + lane) * 16);
        const f32x4 a = p[0], b = p[1], c = p[2], d = p[3];
        const float s = ((a.x + a.y) + (a.z + a.w)) + ((b.x + b.y) + (b.z + b.w)) + ((c.x + c.y) + (c.z + c.w)) + ((d.x + d.y) + (d.z + d.w));
        const float rs = 1.0f / sqrtf(s * (1.0f / D) + EPS);
#pragma unroll
        for (int m = 0; m < 4; ++m) r[ai][m] = __shfl(rs, m * 16 + fr);
    }
}

template <class T> __device__ __forceinline__ T* launder_s(T* p) { asm volatile("" : "+s"(p)); return p; }
struct EpiProj {
    static constexpr bool PERM = true, AFTER_DRAIN = false;
    KArgs kp; int l;
    __device__ __forceinline__ void operator()(const f32x4 (&acc)[2][2][4][2], const pg8::Unit& u, int wr, int wc, int fr, int fq) const {
        const Args a_ = load_args(kp); unsigned char* w_ = a_.ws; float* o_ = a_.out; const float* b_gate = a_.in[7] + (size_t)l * 2 * D; const float* pool_scale = a_.in[9] + (size_t)l * D;
        float r[2][4]; unit_rstd((const float*)(w_ + WS_SSQ), u.pm, wr, fr, fq, r);
        const int pm = u.pm, pn = u.pn;
        const int lc0 = wc * 32 + 8 * fq;
        const bool samp = pm >= NTP;
        if (pn < 4) {
            bf16* O = (bf16*)(w_ + ((pn < 2) ? WS_UPOOL : WS_GB)); const int cb = (pn & 1) * 256 + lc0;
#pragma unroll
            for (int ai = 0; ai < 2; ++ai)
#pragma unroll
                for (int m = 0; m < 4; ++m) { const size_t row = (size_t)pm * 256 + ai * 128 + wr * 64 + m * 16 + fr; const float rr = r[ai][m];
#pragma unroll
                    for (int bj = 0; bj < 2; ++bj) { const f32x4 v0 = acc[ai][bj][m][0] * rr, v1 = acc[ai][bj][m][1] * rr; u32x4 w;
                        w.x = pk2(v0[0], v0[1]); w.y = pk2(v0[2], v0[3]); w.z = pk2(v1[0], v1[1]); w.w = pk2(v1[2], v1[3]);
                        *(u32x4*)(O + row * 512 + cb + bj * 128) = w; } }
            if (pn < 2 && (samp || ((pm & 15) == 15 && wr == 1)) && fr >= 1) {
                float* pool_p = o_ + O_POOLP + (size_t)l * 8 * 15 * 512; float* pool_s = o_ + O_POOLS + (size_t)l * 16 * 15 * 512;
#pragma unroll
                for (int ai = 0; ai < 2; ++ai) { if (!samp && ai == 0) continue;
                    float* sp = samp ? pool_s + ((size_t)((pm - NTP) * 4 + ai * 2 + wr) * 15 + (fr - 1)) * 512 : pool_p + ((size_t)(pm >> 4) * 15 + (fr - 1)) * 512;
                    const float rr = r[ai][3];
#pragma unroll
                    for (int bj = 0; bj < 2; ++bj) { *(f32x4*)(sp + cb + bj * 128) = acc[ai][bj][3][0] * rr; *(f32x4*)(sp + cb + bj * 128 + 4) = acc[ai][bj][3][1] * rr; } }
            }
        } else if (pn < 8) {
            const int cb = (pn - 4) * 128 + lc0; bf16* CVIN = (bf16*)(w_ + WS_CVIN);
            float* conv_p = o_ + O_CONVP + (size_t)l * 8 * 2 * 512; float* conv_s = o_ + O_CONVS + (size_t)l * 16 * 2 * 512;
#pragma unroll
            for (int ai = 0; ai < 2; ++ai)
#pragma unroll
                for (int m = 0; m < 4; ++m) { const size_t row = (size_t)pm * 256 + ai * 128 + wr * 64 + m * 16 + fr; const float rr = r[ai][m] * r[ai][m];
                    const f32x4 v0 = acc[ai][0][m][0] * acc[ai][1][m][0] * rr, v1 = acc[ai][0][m][1] * acc[ai][1][m][1] * rr; u32x4 w;
                    w.x = pk2(v0[0], v0[1]); w.y = pk2(v0[2], v0[3]); w.z = pk2(v1[0], v1[1]); w.w = pk2(v1[2], v1[3]);
                    *(u32x4*)(CVIN + row * 512 + cb) = w;
                    if (m == 3 && fr >= 14 && (samp || ((pm & 15) == 15 && wr == 1 && ai == 1))) {
                        float* sp = samp ? conv_s + ((size_t)((pm - NTP) * 4 + ai * 2 + wr) * 2 + (fr - 14)) * 512 : conv_p + ((size_t)(pm >> 4) * 2 + (fr - 14)) * 512;
                        *(f32x4*)(sp + cb) = v0; *(f32x4*)(sp + cb + 4) = v1; } }
        } else {
            const bool ga = pn < 12; bf16* O = (bf16*)(w_ + (ga ? WS_SA : WS_SB)); const int cb = ((pn - 8) & 3) * 256 + lc0; const float* bg = b_gate + (ga ? 0 : D);
#pragma unroll
            for (int bj = 0; bj < 2; ++bj) { const int c = cb + bj * 128;
                const f32x4 b0 = *(const f32x4*)(bg + c), b1 = *(const f32x4*)(bg + c + 4);
                f32x4 s0 = (f32x4){1.f, 1.f, 1.f, 1.f}, s1 = s0; if (ga) { s0 = *(const f32x4*)(pool_scale + c); s1 = *(const f32x4*)(pool_scale + c + 4); }
#pragma unroll
                for (int ai = 0; ai < 2; ++ai)
#pragma unroll
                    for (int m = 0; m < 4; ++m) { const size_t row = (size_t)pm * 256 + ai * 128 + wr * 64 + m * 16 + fr; const float rr = r[ai][m];
                        const f32x4 x0 = acc[ai][bj][m][0] * rr + b0, x1 = acc[ai][bj][m][1] * rr + b1; f32x4 v0, v1;
#pragma unroll
                        for (int e = 0; e < 4; ++e) { v0[e] = sigmoidf_(x0[e]) * s0[e]; v1[e] = sigmoidf_(x1[e]) * s1[e]; }
                        u32x4 w; w.x = pk2(v0[0], v0[1]); w.y = pk2(v0[2], v0[3]); w.z = pk2(v1[0], v1[1]); w.w = pk2(v1[2], v1[3]);
                        *(u32x4*)(O + row * 1024 + c) = w; } }
        }
    }
};

struct EpiMA {
    static constexpr bool PERM = true, AFTER_DRAIN = false;
    const bf16* SA; bf16* MA;
    __device__ __forceinline__ void operator()(const f32x4 (&acc)[2][2][4][2], const pg8::Unit& u, int wr, int wc, int fr, int fq) const {
        const int cb = u.pn * 256 + wc * 32 + 8 * fq;
#pragma unroll
        for (int ai = 0; ai < 2; ++ai)
#pragma unroll
            for (int m = 0; m < 4; ++m) { const size_t row = (size_t)u.pm * 256 + ai * 128 + wr * 64 + m * 16 + fr;
#pragma unroll
                for (int bj = 0; bj < 2; ++bj) { const size_t o = row * 1024 + cb + bj * 128; const u32x4 s = *(const u32x4*)(SA + o); float f[8]; UNPACK8(s, f);
                    const f32x4 a0 = acc[ai][bj][m][0], a1 = acc[ai][bj][m][1]; u32x4 w;
                    w.x = pk2(a0[0] * f[0], a0[1] * f[1]); w.y = pk2(a0[2] * f[2], a0[3] * f[3]); w.z = pk2(a1[0] * f[4], a1[1] * f[5]); w.w = pk2(a1[2] * f[6], a1[3] * f[7]);
                    *(u32x4*)(MA + o) = w; }
                asm volatile("" ::: "memory"); }
    }
};
struct EpiMerge {
    static constexpr bool PERM = true, AFTER_DRAIN = false;
    const bf16* SB; bf16* MA;
    __device__ __forceinline__ void operator()(const f32x4 (&acc)[2][2][4][2], const pg8::Unit& u, int wr, int wc, int fr, int fq) const {
        const int cb = u.pn * 256 + wc * 32 + 8 * fq;
#pragma unroll
        for (int ai = 0; ai < 2; ++ai)
#pragma unroll
            for (int m = 0; m < 4; ++m) { const size_t row = (size_t)u.pm * 256 + ai * 128 + wr * 64 + m * 16 + fr;
#pragma unroll
                for (int bj = 0; bj < 2; ++bj) { const size_t o = row * 1024 + cb + bj * 128; const u32x4 s = *(const u32x4*)(SB + o); const u32x4 p = *(const u32x4*)(MA + o);
                    float f[8], q[8]; UNPACK8(s, f); UNPACK8(p, q);
                    const f32x4 a0 = acc[ai][bj][m][0], a1 = acc[ai][bj][m][1]; u32x4 w;
                    w.x = pk2(a0[0] * f[0] + q[0], a0[1] * f[1] + q[1]); w.y = pk2(a0[2] * f[2] + q[2], a0[3] * f[3] + q[3]);
                    w.z = pk2(a1[0] * f[4] + q[4], a1[1] * f[5] + q[5]); w.w = pk2(a1[2] * f[6] + q[6], a1[3] * f[7] + q[7]);
                    *(u32x4*)(MA + o) = w; }
                asm volatile("" ::: "memory"); }
    }
};
struct EpiRes {
    static constexpr bool PERM = true, AFTER_DRAIN = false;
    bf16* xb; float* ssq;
    __device__ __forceinline__ void operator()(const f32x4 (&acc)[2][2][4][2], const pg8::Unit& u, int wr, int wc, int fr, int fq) const {
        const int pm = u.pm, cb = u.pn * 256 + wc * 32 + 8 * fq;
#pragma unroll
        for (int ai = 0; ai < 2; ++ai)
#pragma unroll
          for (int mh = 0; mh < 2; ++mh) {
            u32x4 old[2][2];
#pragma unroll
            for (int mm = 0; mm < 2; ++mm)
#pragma unroll
                for (int bj = 0; bj < 2; ++bj) old[mm][bj] = *(const u32x4*)(xb + ((size_t)pm * 256 + ai * 128 + wr * 64 + (2 * mh + mm) * 16 + fr) * D + cb + bj * 128);
#pragma unroll
            for (int mm = 0; mm < 2; ++mm) { const int m = 2 * mh + mm; const size_t row = (size_t)pm * 256 + ai * 128 + wr * 64 + m * 16 + fr; float s = 0.f;
#pragma unroll
                for (int bj = 0; bj < 2; ++bj) { float f[8]; UNPACK8(old[mm][bj], f);
                    const f32x4 a0 = acc[ai][bj][m][0], a1 = acc[ai][bj][m][1]; u32x4 w;
                    w.x = pk2(a0[0] + f[0], a0[1] + f[1]); w.y = pk2(a0[2] + f[2], a0[3] + f[3]); w.z = pk2(a1[0] + f[4], a1[1] + f[5]); w.w = pk2(a1[2] + f[6], a1[3] + f[7]);
                    *(u32x4*)(xb + row * D + cb + bj * 128) = w;
                    float g[8]; UNPACK8(w, g);
                    s += (g[0] * g[0] + g[1] * g[1]) + (g[2] * g[2] + g[3] * g[3]) + (g[4] * g[4] + g[5] * g[5]) + (g[6] * g[6] + g[7] * g[7]); }
                s += __shfl_xor(s, 16); s += __shfl_xor(s, 32);
                if (fq == 0) ssq[row * 16 + u.pn * 4 + wc] = s; }
            asm volatile("" ::: "memory");
          }
    }
};
template <int CTRL> __device__ __forceinline__ float dppf(float v) { return __builtin_bit_cast(float, __builtin_amdgcn_update_dpp(0, __builtin_bit_cast(int, v), CTRL, 0xf, 0xf, true)); }
#define DPP_SHR1 0x111
#define DPP_SHR2 0x112
#define DPP_SHL15 0x10F
#define DPP_SHL14 0x10E
struct EpiUpAct {
    static constexpr bool PERM = true, AFTER_DRAIN = false;
    KArgs kp; LAS unsigned char* ex; int l;
    __device__ __forceinline__ void operator()(const f32x4 (&acc)[2][2][4][2], const pg8::Unit& u, int wr, int wc, int fr, int fq) const {
        const Args a_ = load_args(kp); unsigned char* w_ = a_.ws; float* o_ = a_.out;
        const float* fw = a_.in[15] + (size_t)l * 3 * FF2; const float* fb = a_.in[16] + (size_t)l * FF2; const float* sffn = a_.in[4] + (size_t)l * 16 * 2 * FF2;
        const int pm = u.pm, pn = u.pn; const bool samp = pm >= NTP;
        float r[2][4]; unit_rstd((const float*)(w_ + WS_SSQ), pm, wr, fr, fq, r);
        const int lc0 = wc * 32 + 8 * fq;
        f32x4 x[2][2][4][2];
#pragma unroll
        for (int ai = 0; ai < 2; ++ai)
#pragma unroll
            for (int bj = 0; bj < 2; ++bj)
#pragma unroll
                for (int m = 0; m < 4; ++m)
#pragma unroll
                    for (int n = 0; n < 2; ++n) x[ai][bj][m][n] = acc[ai][bj][m][n] * r[ai][m];
        {
            float* ffn_p = o_ + O_FFNP + (size_t)l * 8 * 2 * FF2; float* ffn_s = o_ + O_FFNS + (size_t)l * 16 * 2 * FF2; float* HALO = (float*)(w_ + WS_HALO) + (size_t)pm * 4 * FF2;
            if (fr >= 14) {
#pragma unroll
                for (int ai = 0; ai < 2; ++ai) {
                    if (samp || ((pm & 15) == 15 && wr == 1 && ai == 1)) {
                        float* sp = samp ? ffn_s + ((size_t)((pm - NTP) * 4 + ai * 2 + wr) * 2 + (fr - 14)) * FF2 : ffn_p + ((size_t)(pm >> 4) * 2 + (fr - 14)) * FF2;
#pragma unroll
                        for (int bj = 0; bj < 2; ++bj) { const int oc = bj * FF + pn * 128 + lc0; *(f32x4*)(sp + oc) = x[ai][bj][3][0]; *(f32x4*)(sp + oc + 4) = x[ai][bj][3][1]; } }
                }
                if (wr == 1) {
#pragma unroll
                    for (int bj = 0; bj < 2; ++bj) { float* hp = HALO + (size_t)(2 + fr - 14) * FF2 + pn * 256 + bj * 128 + lc0; *(f32x4*)hp = x[1][bj][3][0]; *(f32x4*)(hp + 4) = x[1][bj][3][1]; } }
            }
            if (fr < 2 && wr == 0) {
#pragma unroll
                for (int bj = 0; bj < 2; ++bj) { float* hp = HALO + (size_t)fr * FF2 + pn * 256 + bj * 128 + lc0; *(f32x4*)hp = x[0][bj][0][0]; *(f32x4*)(hp + 4) = x[0][bj][0][1]; } }
        }
        if (!samp) {
            if (fr >= 14) {
#pragma unroll
                for (int ai = 0; ai < 2; ++ai)
#pragma unroll
                    for (int bj = 0; bj < 2; ++bj)
#pragma unroll
                        for (int n = 0; n < 2; ++n) *(LAS f32x4*)(ex + ((((2 * ai + wr) * 2 + (fr - 14)) * 256) + bj * 128 + lc0 + 4 * n) * 4) = x[ai][bj][3][n];
            }
            asm volatile("s_waitcnt lgkmcnt(0)" ::: "memory"); __builtin_amdgcn_s_barrier(); asm volatile("" ::: "memory");
        }
        bf16* ACT = (bf16*)(w_ + WS_ACT);
        unsigned pk[2][4][2];
#pragma unroll
        for (int n = 0; n < 2; ++n) {
            const int f = pn * 128 + lc0 + 4 * n;
            const f32x4 wv0 = *(const f32x4*)(fw + f), wv1 = *(const f32x4*)(fw + FF2 + f), wv2 = *(const f32x4*)(fw + 2 * FF2 + f), bv = *(const f32x4*)(fb + f);
            const f32x4 wg0 = *(const f32x4*)(fw + FF + f), wg1 = *(const f32x4*)(fw + FF2 + FF + f), wg2 = *(const f32x4*)(fw + 2 * FF2 + FF + f), bg = *(const f32x4*)(fb + FF + f);
#pragma unroll
            for (int ai = 0; ai < 2; ++ai) {
                const int B = 2 * ai + wr;
                f32x4 e1v = (f32x4){0.f, 0.f, 0.f, 0.f}, e2v = e1v, e1g = e1v, e2g = e1v;
                if (fr < 2) {
                    if (samp) {
                        const float* b0 = sffn + (size_t)((pm - NTP) * 4 + B) * 2 * FF2; const float* b1 = b0 + FF2;
                        const f32x4 v1 = *(const f32x4*)(b1 + f), g1 = *(const f32x4*)(b1 + FF + f);
                        if (fr == 0) { e1v = v1; e1g = g1; e2v = *(const f32x4*)(b0 + f); e2g = *(const f32x4*)(b0 + FF + f); } else { e2v = v1; e2g = g1; }
                    } else if (B > 0) {
                        const LAS unsigned char* eb = ex + ((B - 1) * 2 * 256 + lc0 + 4 * n) * 4;
                        const f32x4 v63 = *(const LAS f32x4*)(eb + 256 * 4), g63 = *(const LAS f32x4*)(eb + 256 * 4 + 128 * 4);
                        if (fr == 0) { e1v = v63; e1g = g63; e2v = *(const LAS f32x4*)eb; e2g = *(const LAS f32x4*)(eb + 128 * 4); } else { e2v = v63; e2g = g63; }
                    }
                }
#pragma unroll
                for (int m = 0; m < 4; ++m) {
                    float av[4];
#pragma unroll
                    for (int e = 0; e < 4; ++e) {
                        const float xv = x[ai][0][m][n][e], xg = x[ai][1][m][n][e];
                        float yv = bv[e] + wv2[e] * xv, yg = bg[e] + wg2[e] * xg;
                        if (m > 0) {
                            const float pv = x[ai][0][m > 0 ? m - 1 : 0][n][e], pg = x[ai][1][m > 0 ? m - 1 : 0][n][e];
                            asm volatile("s_nop 1\n\t"
                                "v_fmac_f32_dpp %0, %2, %4 row_shr:1 row_mask:0xf bank_mask:0xf bound_ctrl:1\n\t"
                                "v_fmac_f32_dpp %1, %3, %6 row_shr:1 row_mask:0xf bank_mask:0xf bound_ctrl:1\n\t"
                                "v_fmac_f32_dpp %0, %2, %5 row_shr:2 row_mask:0xf bank_mask:0xf bound_ctrl:1\n\t"
                                "v_fmac_f32_dpp %1, %3, %7 row_shr:2 row_mask:0xf bank_mask:0xf bound_ctrl:1\n\t"
                                "v_fmac_f32_dpp %0, %8, %4 row_shl:15 row_mask:0xf bank_mask:0xf bound_ctrl:1\n\t"
                                "v_fmac_f32_dpp %1, %9, %6 row_shl:15 row_mask:0xf bank_mask:0xf bound_ctrl:1\n\t"
                                "v_fmac_f32_dpp %0, %8, %5 row_shl:14 row_mask:0xf bank_mask:0xf bound_ctrl:1\n\t"
                                "v_fmac_f32_dpp %1, %9, %7 row_shl:14 row_mask:0xf bank_mask:0xf bound_ctrl:1"
                                : "+v"(yv), "+v"(yg) : "v"(xv), "v"(xg), "v"(wv1[e]), "v"(wv0[e]), "v"(wg1[e]), "v"(wg0[e]), "v"(pv), "v"(pg));
                        } else {
                            yv += wv1[e] * e1v[e] + wv0[e] * e2v[e]; yg += wg1[e] * e1g[e] + wg0[e] * e2g[e];
                            asm volatile("s_nop 1\n\t"
                                "v_fmac_f32_dpp %0, %2, %4 row_shr:1 row_mask:0xf bank_mask:0xf bound_ctrl:1\n\t"
                                "v_fmac_f32_dpp %1, %3, %6 row_shr:1 row_mask:0xf bank_mask:0xf bound_ctrl:1\n\t"
                                "v_fmac_f32_dpp %0, %2, %5 row_shr:2 row_mask:0xf bank_mask:0xf bound_ctrl:1\n\t"
                                "v_fmac_f32_dpp %1, %3, %7 row_shr:2 row_mask:0xf bank_mask:0xf bound_ctrl:1"
                                : "+v"(yv), "+v"(yg) : "v"(xv), "v"(xg), "v"(wv1[e]), "v"(wv0[e]), "v"(wg1[e]), "v"(wg0[e]));
                        }
                        av[e] = yg * sigmoidf_(yg) * yv;
                    }
                    const unsigned lo = pk2(av[0], av[1]), hi = pk2(av[2], av[3]);
                    if (n == 0) { pk[ai][m][0] = lo; pk[ai][m][1] = hi; }
                    else { u32x4 w; w.x = pk[ai][m][0]; w.y = pk[ai][m][1]; w.z = lo; w.w = hi;
                        *(u32x4*)(ACT + ((size_t)pm * 256 + ai * 128 + wr * 64 + m * 16 + fr) * FF + pn * 128 + lc0) = w; }
                }
            }
        }
    }
};

#define XB_TMO      128
#define XB_XCNT(j)  (256  + 64 * (j))
#define XB_XSUB(j)  (1280 + 64 * (j))
#define XB_XGEN(j)  (2304 + 64 * (j))
#define XB_TOP      3328
#define XB_TOPGEN   3392
#define XCD_BAR_WORDS 3456
#define XB_SPIN_CAP (1u << 18)
__device__ __forceinline__ unsigned xb_ld(unsigned* p)              { return __hip_atomic_load(p, __ATOMIC_RELAXED, __HIP_MEMORY_SCOPE_AGENT); }
__device__ __forceinline__ unsigned xb_add(unsigned* p, unsigned v) { return __hip_atomic_fetch_add(p, v, __ATOMIC_RELAXED, __HIP_MEMORY_SCOPE_AGENT); }
__device__ __forceinline__ unsigned xb_xcc_id() { return (unsigned)__builtin_amdgcn_s_getreg((3 << 11) | 20) & 0xFu; }
#define XB_SPIN(cond, bar) do { unsigned _sp = 0; while (cond) { __builtin_amdgcn_s_sleep(1); \
    if ((++_sp & 255u) == 0u) { if (xb_ld(&(bar)[XB_TMO])) break; if (_sp > XB_SPIN_CAP) { atomicAdd(&(bar)[XB_TMO], 1u); break; } } } } while (0)
struct XcdBarrier { unsigned* bar; unsigned x; volatile LAS unsigned* st; };
__device__ __forceinline__ XcdBarrier xcd_barrier_post(unsigned* bar, volatile LAS unsigned* st) {
    XcdBarrier b; b.bar = bar; b.x = xb_xcc_id(); b.st = st;
    if (threadIdx.x == 0) (void)xb_add(&bar[XB_XCNT(b.x)], 1u);
    return b;
}
__device__ __forceinline__ void xcd_barrier_complete(unsigned* bar, unsigned x, unsigned& nloc, unsigned& nx) {
    const unsigned G = gridDim.x * gridDim.y * gridDim.z;
    unsigned sum, cnt, mine, sp = 0u;
    for (;;) {
        sum = 0u; cnt = 0u; mine = 0u;
#pragma unroll
        for (unsigned j = 0; j < 16; ++j) { const unsigned c = xb_ld(&bar[XB_XCNT(j)]); sum += c; cnt += (c > 0u) ? 1u : 0u; mine = (j == x) ? c : mine; }
        if (sum == G) break;
        __builtin_amdgcn_s_sleep(1);
        if ((++sp & 255u) == 0u) { if (xb_ld(&bar[XB_TMO])) break; if (sp > XB_SPIN_CAP) { atomicAdd(&bar[XB_TMO], 1u); break; } }
    }
    nloc = mine > 0u ? mine : 1u; nx = cnt > 0u ? cnt : 1u;
}
__device__ __forceinline__ void xcd_barrier(const XcdBarrier& b) {
    asm volatile("s_waitcnt vmcnt(0)" ::: "memory");
    __syncthreads();
    if (threadIdx.x == 0) {
        unsigned* bar = b.bar;
        __builtin_amdgcn_s_waitcnt(0);
        unsigned nloc = b.st[0], nx = b.st[1];
        if (nloc == 0u) { xcd_barrier_complete(bar, b.x, nloc, nx); b.st[0] = nloc; b.st[1] = nx; }
        const unsigned old = xb_add(&bar[XB_XSUB(b.x)], 1u);
        const unsigned gen = old / nloc;
        if (old + 1u == (gen + 1u) * nloc) {
            __builtin_amdgcn_fence(__ATOMIC_RELEASE, "agent");
            asm volatile("s_waitcnt vmcnt(0)" ::: "memory");
            const unsigned og = xb_add(&bar[XB_TOP], 1u);
            const unsigned tg = og / nx;
            if (og + 1u == (tg + 1u) * nx) xb_add(&bar[XB_TOPGEN], 1u);
            else XB_SPIN(xb_ld(&bar[XB_TOPGEN]) == tg, bar);
            __builtin_amdgcn_fence(__ATOMIC_ACQUIRE, "agent");
            xb_add(&bar[XB_XGEN(b.x)], 1u);
            asm volatile("s_waitcnt vmcnt(0)" ::: "memory");
        } else {
            XB_SPIN(xb_ld(&bar[XB_XGEN(b.x)]) == gen, bar);
            __builtin_amdgcn_fence(__ATOMIC_ACQUIRE, "agent");
            asm volatile("s_waitcnt vmcnt(0)" ::: "memory");
        }
    }
    __syncthreads();
}


struct Frame {
    LAS unsigned char* lds;
    int tid, lane, wave, G, bid;
};

__device__ __forceinline__ float wave_sum(float v) {
#pragma unroll
    for (int o = 1; o < 64; o <<= 1) v += __shfl_xor(v, o);
    return v;
}

__device__ __forceinline__ void tr_item(const float* W, int ldw, int srccol, int ks0, const float* gs, bf16* WT, int Kd, int dst_row, int kd0, bool zero, LAS float* scr, int lane) {
    if (!zero) {
#pragma unroll 8
        for (int i = 0; i < 32; ++i) { const int kk = 2 * i + (lane >> 5); float v = W[(size_t)(ks0 + kk) * ldw + srccol + (lane & 31)]; if (gs) v *= gs[ks0 + kk]; scr[kk * 33 + (lane & 31)] = v; }
    }
    asm volatile("s_waitcnt lgkmcnt(0)" ::: "memory");
    const int c = lane & 7;
#pragma unroll
    for (int j = 0; j < 4; ++j) { const int n = (lane >> 3) + 8 * j; const LAS float* s = scr + (8 * c) * 33 + n;
        u32x4 o;
        if (zero) { o = (u32x4){0u, 0u, 0u, 0u}; }
        else { o.x = pk2(s[0 * 33], s[1 * 33]); o.y = pk2(s[2 * 33], s[3 * 33]); o.z = pk2(s[4 * 33], s[5 * 33]); o.w = pk2(s[6 * 33], s[7 * 33]); }
        *(u32x4*)(WT + (size_t)(dst_row + n) * Kd + kd0 + 8 * c) = o; }
    asm volatile("s_waitcnt lgkmcnt(0)" ::: "memory");
}

constexpr int I_IN = 16 * 128, I_UP = 16 * 176, I_DN = 44 * 32, I_O = 16 * 32, I_CO = 8 * 32, I_MAP = 128;
constexpr int ITEMS_L = I_IN + I_UP + I_DN + I_O + I_CO + I_MAP;

__device__ __forceinline__ void p0_prologue(const Frame& F, const Args& a) {
    int tid_ = threadIdx.x; asm volatile("" : "+v"(tid_)); const int TID = tid_, LANE = tid_ & 63, WAVE = __builtin_amdgcn_readfirstlane(tid_ >> 6);
    LAS float* scr = (LAS float*)(F.lds + WAVE * 16384);
    const int gw = F.bid * NWAVES + WAVE, NGW = F.G * NWAVES;
    unsigned char* ws = a.ws;
    for (int it = gw; it < 2 * ITEMS_L; it += NGW) {
        const int l = it / ITEMS_L; int r = it % ITEMS_L;
        unsigned char* wl = ws + WS_W + (size_t)l * W_LAYER;
        if (r < I_IN) { const int kb = r / 128, n0 = (r % 128) * 32;
            const int src = (n0 < 1024 || n0 >= 2048) ? n0 : 1024 + 512 * (((n0 - 1024) % 256) / 128) + 128 * ((n0 - 1024) / 256) + (n0 % 128);
            tr_item(a.in[6] + (size_t)l * D * INW, INW, src, kb * 64, a.in[5] + l * D, (bf16*)(wl + WO_IN), D, n0, kb * 64, false, scr, LANE); continue; } r -= I_IN;
        if (r < I_UP) { const int kb = r / 176, n0 = (r % 176) * 32;
            const int src = ((n0 % 256) / 128) * FF + 128 * (n0 / 256) + (n0 % 128);
            tr_item(a.in[14] + (size_t)l * D * FF2, FF2, src, kb * 64, a.in[13] + l * D, (bf16*)(wl + WO_UP), D, n0, kb * 64, false, scr, LANE); continue; } r -= I_UP;
        if (r < I_DN) { const int kb = r / 32, n0 = (r % 32) * 32;
            tr_item(a.in[17] + (size_t)l * FF * D, D, n0, kb * 64, nullptr, (bf16*)(wl + WO_DN), FF, n0, kb * 64, false, scr, LANE); continue; } r -= I_DN;
        if (r < I_O) { const int kb = r / 32, n0 = (r % 32) * 32;
            tr_item(a.in[12] + (size_t)l * D * D, D, n0, kb * 64, nullptr, (bf16*)(wl + WO_O), D, n0, kb * 64, false, scr, LANE); continue; } r -= I_O;
        if (r < I_CO) { const int kb = r / 32, n0 = (r % 32) * 32;
            tr_item(a.in[11] + (size_t)l * CW * D, D, n0, kb * 64, nullptr, (bf16*)(wl + WO_CO), CW, n0, kb * 64, false, scr, LANE); continue; } r -= I_CO;
        { const int g = r / 32, kb = (r % 32) / 8, nb = r % 8; const bool zero = (kb >> 1) != (g & 1);
            tr_item(a.in[8] + (size_t)l * 4 * 128 * 256 + (size_t)g * 128 * 256, 256, nb * 32, (kb & 1) * 64, nullptr, (bf16*)(wl + WO_MAP), 256, g * 256 + nb * 32, kb * 64, zero, scr, LANE); }
    }
    bf16* XB = (bf16*)(ws + WS_XB); float* SSQ = (float*)(ws + WS_SSQ);
    for (int m = gw; m < M; m += NGW) {
        const float* xrow = m < MP ? a.in[0] + (size_t)m * D : a.in[1] + (size_t)(m - MP) * D;
        const f32x4* xr = (const f32x4*)xrow + LANE; f32x4 v[4]; float s = 0.f;
#pragma unroll
        for (int j = 0; j < 4; ++j) { v[j] = xr[64 * j]; s += (v[j].x * v[j].x + v[j].y * v[j].y) + (v[j].z * v[j].z + v[j].w * v[j].w); }
        s = wave_sum(s);
        u32x2* o8 = (u32x2*)(XB + (size_t)m * D) + LANE;
#pragma unroll
        for (int j = 0; j < 4; ++j) { u32x2 w; w.x = pk2(v[j].x, v[j].y); w.y = pk2(v[j].z, v[j].w); o8[64 * j] = w; }
        if (LANE < 16) SSQ[(size_t)m * 16 + LANE] = LANE == 0 ? s : 0.f;
    }
}

constexpr int MIX_RB = 33;
__device__ __forceinline__ void mix_elt(const Frame& F, const Args& a, int l) {
    int tid_ = threadIdx.x; asm volatile("" : "+v"(tid_)); const int TID = tid_;
    unsigned char* ws = a.ws;
    const bf16* UPOOL = (const bf16*)(ws + WS_UPOOL); const bf16* CVIN = (const bf16*)(ws + WS_CVIN); const bf16* GB = (const bf16*)(ws + WS_GB);
    bf16* MIXED = (bf16*)(ws + WS_MIXED); bf16* GBCV = (bf16*)(ws + WS_GBCV);
    const float* spool = a.in[2] + (size_t)l * 16 * 15 * 512; const float* sconv = a.in[3] + (size_t)l * 16 * 2 * 512; const float* cw = a.in[10] + (size_t)l * 3 * 512;
    const int nrb = (M + MIX_RB - 1) / MIX_RB, total = nrb * 128, stride = F.G * NTHR;
    for (int idx = F.bid * NTHR + TID; idx < total; idx += stride) {
        const int rb = idx >> 7, c8 = idx & 127;
        const int r0 = rb * MIX_RB, r1 = (r0 + MIX_RB) < M ? (r0 + MIX_RB) : M;
        if (c8 < 64) {
            const int ch0 = c8 * 8, win = 2 << (c8 >> 4);
            float sum[8], f[8];
            for (int row = r0; row < r1; ++row) {
                const bool samp = row >= MP; int t, sq = 0;
                if (!samp) t = row & 4095; else { const int sr = row - MP; sq = sr >> 6; t = sr & 63; }
                const u32x4 uw = *(const u32x4*)(UPOOL + (size_t)row * 512 + ch0);
                if (row == r0 || t == 0) {
#pragma unroll
                    for (int e = 0; e < 8; ++e) sum[e] = 0.f;
                    for (int j = 1; j < win; ++j) {
                        const int tt = t - j;
                        if (tt >= 0) { const u32x4 w = *(const u32x4*)(UPOOL + (size_t)(row - j) * 512 + ch0); UNPACK8(w, f);
#pragma unroll
                            for (int e = 0; e < 8; ++e) sum[e] += f[e]; }
                        else if (samp) { const float* p = spool + ((size_t)sq * 15 + 15 + tt) * 512 + ch0; const f32x4 p0 = *(const f32x4*)p, p1 = *(const f32x4*)(p + 4);
#pragma unroll
                            for (int e = 0; e < 4; ++e) { sum[e] += p0[e]; sum[4 + e] += p1[e]; } }
                    }
                } else {
                    const int tt = t - win;
                    if (tt >= 0) { const u32x4 w = *(const u32x4*)(UPOOL + (size_t)(row - win) * 512 + ch0); UNPACK8(w, f);
#pragma unroll
                        for (int e = 0; e < 8; ++e) sum[e] -= f[e]; }
                    else if (samp) { const float* p = spool + ((size_t)sq * 15 + 15 + tt) * 512 + ch0; const f32x4 p0 = *(const f32x4*)p, p1 = *(const f32x4*)(p + 4);
#pragma unroll
                        for (int e = 0; e < 4; ++e) { sum[e] -= p0[e]; sum[4 + e] -= p1[e]; } }
                }
                UNPACK8(uw, f);
                const float cnt = samp ? (float)win : (float)(win < t + 1 ? win : t + 1), inv = 1.0f / cnt;
                float o[8];
#pragma unroll
                for (int e = 0; e < 8; ++e) { sum[e] += f[e]; o[e] = sum[e] * inv - f[e]; }
                u32x4 w; w.x = pk2(o[0], o[1]); w.y = pk2(o[2], o[3]); w.z = pk2(o[4], o[5]); w.w = pk2(o[6], o[7]);
                *(u32x4*)(MIXED + (size_t)row * 512 + ch0) = w;
            }
        } else {
            const int ch0 = (c8 - 64) * 8;
            float w0[8], w1[8], w2[8];
#pragma unroll
            for (int h = 0; h < 2; ++h) { const f32x4 a0 = *(const f32x4*)(cw + ch0 + 4 * h), a1 = *(const f32x4*)(cw + 512 + ch0 + 4 * h), a2 = *(const f32x4*)(cw + 1024 + ch0 + 4 * h);
#pragma unroll
                for (int e = 0; e < 4; ++e) { w0[4 * h + e] = a0[e]; w1[4 * h + e] = a1[e]; w2[4 * h + e] = a2[e]; } }
            float x0[8], x1[8], x2[8], gb[8];
#pragma unroll
            for (int e = 0; e < 8; ++e) { x1[e] = 0.f; x2[e] = 0.f; }
            for (int row = r0; row < r1; ++row) {
                const bool samp = row >= MP; int t, sq = 0;
                if (!samp) t = row & 4095; else { const int sr = row - MP; sq = sr >> 6; t = sr & 63; }
                { const u32x4 w = *(const u32x4*)(CVIN + (size_t)row * 512 + ch0); UNPACK8(w, x0); }
                { const u32x4 w = *(const u32x4*)(GB + (size_t)row * 512 + ch0); UNPACK8(w, gb); }
                if (row == r0 || t == 0) {
                    if (t >= 1) { const u32x4 w = *(const u32x4*)(CVIN + (size_t)(row - 1) * 512 + ch0); UNPACK8(w, x1); }
                    else if (samp) { const float* p = sconv + ((size_t)sq * 2 + 1) * 512 + ch0; const f32x4 p0 = *(const f32x4*)p, p1 = *(const f32x4*)(p + 4);
#pragma unroll
                        for (int e = 0; e < 4; ++e) { x1[e] = p0[e]; x1[4 + e] = p1[e]; } }
                    else {
#pragma unroll
                        for (int e = 0; e < 8; ++e) x1[e] = 0.f; }
                    if (t >= 2) { const u32x4 w = *(const u32x4*)(CVIN + (size_t)(row - 2) * 512 + ch0); UNPACK8(w, x2); }
                    else if (samp) { const float* p = sconv + ((size_t)sq * 2 + t) * 512 + ch0; const f32x4 p0 = *(const f32x4*)p, p1 = *(const f32x4*)(p + 4);
#pragma unroll
                        for (int e = 0; e < 4; ++e) { x2[e] = p0[e]; x2[4 + e] = p1[e]; } }
                    else {
#pragma unroll
                        for (int e = 0; e < 8; ++e) x2[e] = 0.f; }
                }
                float o[8];
#pragma unroll
                for (int e = 0; e < 8; ++e) { o[e] = gb[e] * (w0[e] * x2[e] + w1[e] * x1[e] + w2[e] * x0[e]); x2[e] = x1[e]; x1[e] = x0[e]; }
                u32x4 w; w.x = pk2(o[0], o[1]); w.y = pk2(o[2], o[3]); w.z = pk2(o[4], o[5]); w.w = pk2(o[6], o[7]);
                *(u32x4*)(GBCV + (size_t)row * 512 + ch0) = w;
            }
        }
    }
}

__device__ __forceinline__ void ffn_fixup(const Frame& F, const Args& a, int l) {
    int tid_ = threadIdx.x; asm volatile("" : "+v"(tid_)); const int TID = tid_;
    unsigned char* ws = a.ws;
    const float* HALO = (const float*)(ws + WS_HALO); bf16* ACT = (bf16*)(ws + WS_ACT);
    const float* fw = a.in[15] + (size_t)l * 3 * FF2; const float* fb = a.in[16] + (size_t)l * FF2;
    const int total = NTP * 2 * 352, stride = F.G * NTHR;
    for (int idx = F.bid * NTHR + TID; idx < total; idx += stride) {
        const int pm = idx / 704, rem = idx % 704, rr = rem / 352, c8 = rem % 352;
        if ((pm & 15) == 0) continue;
        const int f0 = c8 * 8, pn = f0 >> 7, j0 = f0 & 127;
        float res[2][8];
#pragma unroll
        for (int h = 0; h < 2; ++h) {
            const int pc = pn * 256 + h * 128 + j0, oc = h * FF + f0;
            const float* p0 = HALO + ((size_t)pm * 4 + rr) * FF2 + pc;
            const float* p1 = rr == 1 ? HALO + ((size_t)pm * 4 + 0) * FF2 + pc : HALO + ((size_t)(pm - 1) * 4 + 3) * FF2 + pc;
            const float* p2 = rr == 1 ? HALO + ((size_t)(pm - 1) * 4 + 3) * FF2 + pc : HALO + ((size_t)(pm - 1) * 4 + 2) * FF2 + pc;
#pragma unroll
            for (int q = 0; q < 2; ++q) { const f32x4 x0 = *(const f32x4*)(p0 + 4 * q), x1 = *(const f32x4*)(p1 + 4 * q), x2 = *(const f32x4*)(p2 + 4 * q);
                const f32x4 w0 = *(const f32x4*)(fw + oc + 4 * q), w1 = *(const f32x4*)(fw + FF2 + oc + 4 * q), w2 = *(const f32x4*)(fw + 2 * FF2 + oc + 4 * q), b = *(const f32x4*)(fb + oc + 4 * q);
#pragma unroll
                for (int e = 0; e < 4; ++e) res[h][4 * q + e] = w0[e] * x2[e] + w1[e] * x1[e] + w2[e] * x0[e] + b[e]; }
        }
        float o[8];
#pragma unroll
        for (int e = 0; e < 8; ++e) o[e] = res[1][e] * sigmoidf_(res[1][e]) * res[0][e];
        u32x4 w; w.x = pk2(o[0], o[1]); w.y = pk2(o[2], o[3]); w.z = pk2(o[4], o[5]); w.w = pk2(o[6], o[7]);
        *(u32x4*)(ACT + ((size_t)pm * 256 + rr) * FF + f0) = w;
    }
}

__device__ __forceinline__ void final_norm(const Frame& F, const Args& a) {
    int tid_ = threadIdx.x; asm volatile("" : "+v"(tid_)); const int LANE = tid_ & 63, WAVE = __builtin_amdgcn_readfirstlane(tid_ >> 6);
    const float* SSQ = (const float*)(a.ws + WS_SSQ); const bf16* XB = (const bf16*)(a.ws + WS_XB); const float* g = a.in[18];
    const int gw = F.bid * NWAVES + WAVE, NGW = F.G * NWAVES;
    f32x4 gv[2][2];
#pragma unroll
    for (int j = 0; j < 2; ++j) { gv[j][0] = *(const f32x4*)(g + 512 * j + 8 * LANE); gv[j][1] = *(const f32x4*)(g + 512 * j + 8 * LANE + 4); }
    for (int m = gw; m < M; m += NGW) {
        float s = LANE < 16 ? SSQ[(size_t)m * 16 + LANE] : 0.f;
        s = wave_sum(s);
        const float rs = 1.0f / sqrtf(s * (1.0f / D) + EPS);
        float* orow = a.out + (size_t)m * D;
#pragma unroll
        for (int j = 0; j < 2; ++j) { const u32x4 w = *(const u32x4*)(XB + (size_t)m * D + 512 * j + 8 * LANE); float f[8]; UNPACK8(w, f);
            f32x4 o0, o1;
#pragma unroll
            for (int e = 0; e < 4; ++e) { o0[e] = f[e] * rs * gv[j][0][e]; o1[e] = f[4 + e] * rs * gv[j][1][e]; }
            *(f32x4*)(orow + 512 * j + 8 * LANE) = o0; *(f32x4*)(orow + 512 * j + 8 * LANE + 4) = o1; }
    }
}

__global__ void __launch_bounds__(NTHR, 2) fwd_mega(Args a_unused) {
    extern __shared__ __attribute__((aligned(16))) unsigned char lds_raw[];
    cg::grid_group grid = cg::this_grid();
    KArgs kp = (KArgs)__builtin_amdgcn_kernarg_segment_ptr();
    Frame F;
    F.lds = (LAS unsigned char*)lds_raw;
    F.tid = threadIdx.x; F.lane = F.tid & 63; F.wave = __builtin_amdgcn_readfirstlane(F.tid >> 6);
    F.G = gridDim.x; F.bid = blockIdx.x;
    { const Args a = load_args(kp); unsigned* barw = (unsigned*)a.ws;
      if (blockIdx.x == 0) for (int i = threadIdx.x; i < XCD_BAR_WORDS; i += NTHR) __hip_atomic_store(barw + i, 0u, __ATOMIC_RELAXED, __HIP_MEMORY_SCOPE_AGENT);
      volatile LAS unsigned* bst = (volatile LAS unsigned*)(F.lds + BST_OFF);
      if (threadIdx.x < 4) bst[threadIdx.x] = 0u; }
    __syncthreads();

    if constexpr (PHMASK & 1) { const Args a = load_args(kp); p0_prologue(F, a); }
    if constexpr (PROBE == 2) { __syncthreads(); const Args a = load_args(kp); p0_prologue(F, a); }
    grid.sync();
    { const Args a = load_args(kp); (void)xcd_barrier_post((unsigned*)a.ws, (volatile LAS unsigned*)(F.lds + BST_OFF)); }
#define GRID_BAR() do { const Args a_ = load_args(kp); XcdBarrier b_; b_.bar = (unsigned*)a_.ws; b_.x = xb_xcc_id(); b_.st = (volatile LAS unsigned*)(F.lds + BST_OFF); xcd_barrier(b_); } while (0)

#pragma unroll 1
    for (int l = 0; l < 2; ++l) {
        if constexpr (PHMASK & 2) {
            const Args a = load_args(kp); unsigned char* ws = a.ws; unsigned char* wl = ws + WS_W + (size_t)l * W_LAYER;
            pg8::Gemm g{(const bf16*)(ws + WS_XB), (const bf16*)(wl + WO_IN), M, INW, D, D, 0, 0}; pg8::StaticOrder S; S.init(M, INW, F.G, F.bid);
            EpiProj E{kp, l};
            pg8::gemm_phase<EpiProj, pg8::StaticOrder, true, true>(F.lds, g, S, E);
            if constexpr (PROBE == 4) { __syncthreads(); pg8::gemm_phase<EpiProj, pg8::StaticOrder, true, true>(F.lds, g, S, E); }
        }
        GRID_BAR();
_Pragma("unroll 1")
        for (int rep = 0; rep < (PROBE == 3 ? 2 : 1); ++rep) { const Args a = load_args(kp); mix_elt(F, a, l); }
        GRID_BAR();
        if constexpr (PHMASK & 8) {
            const Args a = load_args(kp); unsigned char* ws = a.ws; unsigned char* wl = ws + WS_W + (size_t)l * W_LAYER;
            pg8::Gemm g{(const bf16*)(ws + WS_MIXED), (const bf16*)(wl + WO_MAP), M, D, 256, PW, 1, 512}; pg8::StaticOrder S; S.init(M, D, F.G, F.bid);
            EpiMA E{(const bf16*)(ws + WS_SA), (bf16*)(ws + WS_MA)};
            pg8::gemm_phase<EpiMA, pg8::StaticOrder, true, true>(F.lds, g, S, E);
        }
        if constexpr (PHMASK & 16) {
            const Args a = load_args(kp); unsigned char* ws = a.ws; unsigned char* wl = ws + WS_W + (size_t)l * W_LAYER;
            pg8::Gemm g{(const bf16*)(ws + WS_GBCV), (const bf16*)(wl + WO_CO), M, D, CW, CW, 0, 0}; pg8::StaticOrder S; S.init(M, D, F.G, F.bid);
            EpiMerge E{(const bf16*)(ws + WS_SB), (bf16*)(ws + WS_MA)};
            pg8::gemm_phase<EpiMerge, pg8::StaticOrder, true, true>(F.lds, g, S, E);
        }
        GRID_BAR();
        if constexpr (PHMASK & 32) {
            const Args a = load_args(kp); unsigned char* ws = a.ws; unsigned char* wl = ws + WS_W + (size_t)l * W_LAYER;
            pg8::Gemm g{(const bf16*)(ws + WS_MA), (const bf16*)(wl + WO_O), M, D, D, D, 0, 0}; pg8::StaticOrder S; S.init(M, D, F.G, F.bid);
            EpiRes E{(bf16*)(ws + WS_XB), (float*)(ws + WS_SSQ)};
            pg8::gemm_phase<EpiRes, pg8::StaticOrder, true, true>(F.lds, g, S, E);
        }
        GRID_BAR();
        if constexpr (PHMASK & 64) {
            const Args a = load_args(kp); unsigned char* ws = a.ws; unsigned char* wl = ws + WS_W + (size_t)l * W_LAYER;
            pg8::Gemm g{(const bf16*)(ws + WS_XB), (const bf16*)(wl + WO_UP), M, FF2, D, D, 0, 0}; pg8::StaticOrder S; S.init(M, FF2, F.G, F.bid);
            EpiUpAct E{kp, F.lds + EX_OFF, l};
            pg8::gemm_phase<EpiUpAct, pg8::StaticOrder, true, true>(F.lds, g, S, E);
            if constexpr (PROBE == 5) { __syncthreads(); pg8::gemm_phase<EpiUpAct, pg8::StaticOrder, true, true>(F.lds, g, S, E); }
        }
        GRID_BAR();
        if constexpr (PHMASK & 128) { const Args a = load_args(kp); ffn_fixup(F, a, l); }
        GRID_BAR();
        if constexpr (PHMASK & 256) {
            const Args a = load_args(kp); unsigned char* ws = a.ws; unsigned char* wl = ws + WS_W + (size_t)l * W_LAYER;
            pg8::Gemm g{(const bf16*)(ws + WS_ACT), (const bf16*)(wl + WO_DN), M, D, FF, FF, 0, 0}; pg8::StaticOrder S; S.init(M, D, F.G, F.bid);
            EpiRes E{(bf16*)(ws + WS_XB), (float*)(ws + WS_SSQ)};
            pg8::gemm_phase<EpiRes, pg8::StaticOrder, true, true>(F.lds, g, S, E);
        }
        GRID_BAR();
    }
    if constexpr (PHMASK & 512) { const Args a = load_args(kp); final_norm(F, a); }
    if constexpr (PROBE == 1) { for (int i = 0; i < 16; ++i) GRID_BAR(); }
}

extern "C" void kernel_launch(void* const* d_in, const int* in_sizes, int n_in, void* d_out, int out_size, void* d_ws, size_t ws_size, hipStream_t stream) {
    static int grid = 0;
    if (grid == 0) {
        if (n_in != 19 || in_sizes[0] != MP * D || (size_t)out_size != O_END || ws_size < WS_END) {
            fprintf(stderr, "kernel_launch: unexpected shapes: n_in %d in0 %d out %d ws %zu (need %zu)\n", n_in, n_in > 0 ? in_sizes[0] : -1, out_size, ws_size, (size_t)WS_END); grid = -1; return; }
        int dev = 0, cus = 0, per_cu = 0;
        hipGetDevice(&dev); hipDeviceGetAttribute(&cus, hipDeviceAttributeMultiprocessorCount, dev);
        if (hipFuncSetAttribute((const void*)fwd_mega, hipFuncAttributeMaxDynamicSharedMemorySize, LDS_BYTES) != hipSuccess) { fprintf(stderr, "kernel_launch: hipFuncSetAttribute failed\n"); grid = -1; return; }
        if (hipOccupancyMaxActiveBlocksPerMultiprocessor(&per_cu, (const void*)fwd_mega, NTHR, LDS_BYTES) != hipSuccess || per_cu < 1) { fprintf(stderr, "kernel_launch: occupancy query says %d\n", per_cu); per_cu = 1; }
        (void)hipGetLastError();
        grid = cus;
    }
    if (grid < 0) return;
    Args a{};
    for (int i = 0; i < 19; ++i) a.in[i] = (const float*)d_in[i];
    a.out = (float*)d_out; a.ws = (unsigned char*)d_ws;
    void* args[] = {&a};
    hipError_t e = hipLaunchCooperativeKernel((const void*)fwd_mega, dim3(grid), dim3(NTHR), args, LDS_BYTES, stream);
    if (e != hipSuccess) fprintf(stderr, "cooperative launch failed: %s (grid %d)\n", hipGetErrorString(e), grid);
}
```

```cpp
#include <hip/hip_runtime.h>
#include <hip/hip_cooperative_groups.h>
#include <cstdio>
#include <cstdint>
namespace cg = cooperative_groups;

namespace pg8 {
#define PG8_LAS __attribute__((address_space(3)))
typedef unsigned short bf16_t;
typedef short bf16x8 __attribute__((ext_vector_type(8)));
typedef float f32x4 __attribute__((ext_vector_type(4)));
typedef unsigned u32x4 __attribute__((ext_vector_type(4)));
constexpr int BM = 256, BK = 64, HALF = 128, HTB = HALF * BK * 2, STAGE_BYTES = 8 * HTB, NXCD = 8, WGM = 8;

__host__ __device__ __forceinline__ int lds_byte(int r, int c) { const int st = (r >> 4) * 2 + (c >> 5), rr = r & 15, cc = c & 31, ob = rr * 64 + cc * 2; return st * 1024 + (ob ^ (((ob >> 9) & 1) << 5)); }
__host__ __device__ __forceinline__ void stage_rc(int b, int& R, int& C) { const int st = b / 1024, sb = b % 1024, swz = sb ^ (((sb >> 9) & 1) << 5); R = (st >> 1) * 16 + swz / 64; C = (st & 1) * 32 + (swz % 64) / 2; }
__host__ __device__ __forceinline__ int perm32(int rho) { const int n = rho >> 4, i = rho & 15; return 8 * (i >> 2) + 4 * n + (i & 3); }

struct Unit { int pm, pn; };
struct Gemm { const bf16_t* A; const bf16_t* Bt; int M, N, K, lda, apn_shift, apn_bytes; };

struct StaticOrder {
    int nM, nN, nwg, G, c;
    __host__ __device__ void init(int M, int N, int G_, int c_) { nM = M / BM; nN = N / BM; nwg = nM * nN; G = G_; c = c_; }
    __host__ __device__ bool next(int i, Unit& u) const {
        const long L = (long)i * G + c; if (L >= nwg) return false;
        int wgid = (int)L; { const int q = nwg / NXCD, r = nwg % NXCD, xcd = wgid % NXCD, off = wgid / NXCD; wgid = (xcd < r ? xcd * (q + 1) : r * (q + 1) + (xcd - r) * q) + off; }
        const int nig = WGM * nN, gid = wgid / nig, fm = gid * WGM, gsz = (nM - fm) < WGM ? (nM - fm) : WGM;
        u.pm = fm + ((wgid % nig) % gsz); u.pn = (wgid % nig) / gsz; return true;
    }
    __device__ __forceinline__ void a_ready(const Unit&) const {}
    __device__ __forceinline__ void done(const Unit&) const {}
};

__device__ __forceinline__ unsigned cvt_pk_bf16(float lo, float hi) { unsigned r; asm volatile("v_cvt_pk_bf16_f32 %0, %1, %2" : "=v"(r) : "v"(lo), "v"(hi)); return r; }

template <class Epi, class Sched, bool ALIGN_EPI = false, bool SP2 = false>
__device__ __forceinline__ void gemm_phase(PG8_LAS unsigned char* lds, const Gemm g, const Sched& S, const Epi& E) {
    int tid_ = threadIdx.x; asm volatile("" : "+v"(tid_));
    const int tid = tid_, wid = __builtin_amdgcn_readfirstlane(tid >> 6), lane = tid & 63, wr = wid >> 2, wc = wid & 3, fr = lane & 15, fq = lane >> 4;
    const int K = g.K, nt = K / BK, lda = g.lda;
    unsigned voffA[2], voffB[2];
#pragma unroll
    for (int i = 0; i < 2; ++i) { int R, C; stage_rc(tid * 16 + i * 8192, R, C); const int Rb = Epi::PERM ? ((R & ~31) + perm32(R & 31)) : R;
        voffA[i] = (unsigned)(R * lda + C) * 2u; voffB[i] = (unsigned)(Rb * K + C) * 2u; }
    const size_t kstep = (size_t)(BK * 2);
    const size_t hstepA = (size_t)HALF * lda * 2, hstepB = (size_t)HALF * K * 2;
    const size_t tstepA = 2 * hstepA, tstepB = 2 * hstepB;
    const unsigned ldsw = (unsigned)wid * 1024u;
    const int aoff = lds_byte(wr * 64 + fr, fq * 8), boff = lds_byte(wc * 32 + fr, fq * 8);
#define PG8_SA(b, h) (((b) * 2 + (h)) * HTB)
#define PG8_SB(b, h) ((4 + (b) * 2 + (h)) * HTB)
#define PG8_STAGE(bufoff, gbase, voff) do { _Pragma("unroll") for (int _i = 0; _i < 2; ++_i) \
        __builtin_amdgcn_global_load_lds((const unsigned*)((const char*)(gbase) + (voff)[_i]), (PG8_LAS unsigned*)(lds + (bufoff) + ldsw + _i * 8192), 16, 0, 0); } while (0)
#define PG8_LDA(dst, b, h) do { _Pragma("unroll") for (int m = 0; m < 4; ++m) _Pragma("unroll") for (int k = 0; k < 2; ++k) dst[m][k] = *(const PG8_LAS bf16x8*)(lds + PG8_SA(b, h) + aoff + m * 2048 + k * 1024); } while (0)
#define PG8_LDB(dst, b, h) do { _Pragma("unroll") for (int n = 0; n < 2; ++n) _Pragma("unroll") for (int k = 0; k < 2; ++k) dst[n][k] = *(const PG8_LAS bf16x8*)(lds + PG8_SB(b, h) + boff + n * 2048 + k * 1024); } while (0)
#define PG8_MMA(ai, bj, At, Bt) do { __builtin_amdgcn_s_setprio(1); _Pragma("unroll") for (int m = 0; m < 4; ++m) _Pragma("unroll") for (int n = 0; n < 2; ++n) _Pragma("unroll") for (int k = 0; k < 2; ++k) \
        acc[ai][bj][m][n] = __builtin_amdgcn_mfma_f32_16x16x32_bf16(Bt[n][k], At[m][k], acc[ai][bj][m][n], 0, 0, 0); __builtin_amdgcn_s_setprio(0); } while (0)
#define PG8_WAIT_V(n) asm volatile("s_waitcnt vmcnt(" #n ")" ::: "memory")
#define PG8_WAIT_L(n) asm volatile("s_waitcnt lgkmcnt(" #n ")" ::: "memory")
#define PG8_BAR __builtin_amdgcn_s_barrier()
#define PG8_SCHED __builtin_amdgcn_sched_barrier(0)
    Unit cur, nxt; int ui = 0;
    if (!S.next(0, cur)) return;
    f32x4 acc[2][2][4][2];
#pragma unroll
    for (int a = 0; a < 2; ++a)
#pragma unroll
        for (int b = 0; b < 2; ++b)
#pragma unroll
            for (int m = 0; m < 4; ++m)
#pragma unroll
                for (int n = 0; n < 2; ++n) acc[a][b][m][n] = (f32x4){0.f, 0.f, 0.f, 0.f};
    bf16x8 At[4][2], B0[2][2], B1[2][2];
    const char* cA = (const char*)g.A + (size_t)cur.pm * tstepA + (size_t)(cur.pn >> g.apn_shift) * g.apn_bytes; const char* cB = (const char*)g.Bt + (size_t)cur.pn * tstepB;
    S.a_ready(cur);
    if constexpr (SP2) {
        PG8_STAGE(PG8_SB(0, 0), cB, voffB); PG8_STAGE(PG8_SB(0, 1), cB + hstepB, voffB); PG8_STAGE(PG8_SA(0, 0), cA, voffA); PG8_STAGE(PG8_SA(0, 1), cA + hstepA, voffA);
        if (wr == 1) PG8_BAR;
        PG8_WAIT_V(2); PG8_BAR;
        PG8_STAGE(PG8_SB(1, 0), cB + kstep, voffB); PG8_STAGE(PG8_SA(1, 0), cA + kstep, voffA); PG8_STAGE(PG8_SB(1, 1), cB + hstepB + kstep, voffB);
        PG8_WAIT_V(6); PG8_BAR;
    } else {
        PG8_STAGE(PG8_SB(0, 0), cB, voffB); PG8_STAGE(PG8_SA(0, 0), cA, voffA); PG8_STAGE(PG8_SB(0, 1), cB + hstepB, voffB); PG8_STAGE(PG8_SA(0, 1), cA + hstepA, voffA);
        if (wr == 1) PG8_BAR;
        PG8_WAIT_V(4); PG8_BAR;
        PG8_STAGE(PG8_SB(1, 0), cB + kstep, voffB); PG8_STAGE(PG8_SA(1, 0), cA + kstep, voffA); PG8_STAGE(PG8_SB(1, 1), cB + hstepB + kstep, voffB);
        PG8_WAIT_V(6); PG8_BAR;
    }
    for (;;) {
        const bool has_next = S.next(ui + 1, nxt);
        const char* nA = has_next ? (const char*)g.A + (size_t)nxt.pm * tstepA + (size_t)(nxt.pn >> g.apn_shift) * g.apn_bytes : cA; const char* nB = has_next ? (const char*)g.Bt + (size_t)nxt.pn * tstepB : cB;
#pragma unroll 1
        for (int t = 0; t < nt; t += 2) {
            const bool last = (t == nt - 2);
            const char* a1 = cA + (size_t)(t + 1) * kstep;
            const char* a2 = last ? nA : cA + (size_t)(t + 2) * kstep; const char* b2 = last ? nB : cB + (size_t)(t + 2) * kstep;
            const char* a3 = a2 + kstep; const char* b3 = b2 + kstep;
            if (last && has_next) S.a_ready(nxt);
            if constexpr (SP2) {
            PG8_LDB(B0, 0, 0); PG8_LDB(B1, 0, 1); PG8_SCHED; PG8_LDA(At, 0, 0); PG8_STAGE(PG8_SA(1, 1), a1 + hstepA, voffA);
            PG8_WAIT_V(8); PG8_WAIT_L(0); PG8_BAR; PG8_MMA(0, 0, At, B0); PG8_MMA(0, 1, At, B1); PG8_BAR; PG8_SCHED;
            PG8_LDA(At, 0, 1); PG8_STAGE(PG8_SB(0, 0), b2, voffB); PG8_STAGE(PG8_SB(0, 1), b2 + hstepB, voffB); PG8_STAGE(PG8_SA(0, 0), a2, voffA);
            PG8_WAIT_V(8); PG8_WAIT_L(0); PG8_BAR; PG8_MMA(1, 0, At, B0); PG8_MMA(1, 1, At, B1); PG8_BAR; PG8_SCHED;
            PG8_LDB(B0, 1, 0); PG8_LDB(B1, 1, 1); PG8_SCHED; PG8_LDA(At, 1, 0); PG8_STAGE(PG8_SA(0, 1), a2 + hstepA, voffA);
            PG8_WAIT_V(8); PG8_WAIT_L(0); PG8_BAR; PG8_MMA(0, 0, At, B0); PG8_MMA(0, 1, At, B1); PG8_BAR; PG8_SCHED;
            PG8_LDA(At, 1, 1); PG8_STAGE(PG8_SB(1, 0), b3, voffB); PG8_STAGE(PG8_SB(1, 1), b3 + hstepB, voffB); PG8_STAGE(PG8_SA(1, 0), a3, voffA);
            PG8_WAIT_V(8); PG8_WAIT_L(0); PG8_BAR; PG8_MMA(1, 0, At, B0); PG8_MMA(1, 1, At, B1); PG8_BAR; PG8_SCHED;
            } else {
            PG8_LDB(B0, 0, 0); PG8_SCHED; PG8_LDA(At, 0, 0); PG8_STAGE(PG8_SA(1, 1), a1 + hstepA, voffA);
            PG8_WAIT_L(8); PG8_BAR; PG8_WAIT_L(0); PG8_MMA(0, 0, At, B0); PG8_BAR; PG8_SCHED;
            PG8_LDB(B1, 0, 1); PG8_STAGE(PG8_SB(0, 0), b2, voffB);
            PG8_BAR; PG8_WAIT_L(0); PG8_MMA(0, 1, At, B1); PG8_BAR;
            PG8_LDA(At, 0, 1); PG8_STAGE(PG8_SA(0, 0), a2, voffA);
            PG8_BAR; PG8_WAIT_L(0); PG8_MMA(1, 0, At, B0); PG8_BAR; PG8_SCHED;
            PG8_STAGE(PG8_SB(0, 1), b2 + hstepB, voffB);
            PG8_WAIT_V(6); PG8_BAR; PG8_MMA(1, 1, At, B1); PG8_BAR;
            PG8_LDB(B0, 1, 0); PG8_SCHED; PG8_LDA(At, 1, 0); PG8_STAGE(PG8_SA(0, 1), a2 + hstepA, voffA);
            PG8_WAIT_L(8); PG8_BAR; PG8_WAIT_L(0); PG8_MMA(0, 0, At, B0); PG8_BAR; PG8_SCHED;
            PG8_LDB(B1, 1, 1); PG8_STAGE(PG8_SB(1, 0), b3, voffB);
            PG8_BAR; PG8_WAIT_L(0); PG8_MMA(0, 1, At, B1); PG8_BAR;
            PG8_LDA(At, 1, 1); PG8_STAGE(PG8_SA(1, 0), a3, voffA);
            PG8_BAR; PG8_WAIT_L(0); PG8_MMA(1, 0, At, B0); PG8_BAR; PG8_SCHED;
            PG8_STAGE(PG8_SB(1, 1), b3 + hstepB, voffB);
            PG8_WAIT_V(6); PG8_BAR; PG8_MMA(1, 1, At, B1); PG8_BAR;
            }
        }
        if constexpr (ALIGN_EPI) { if (wr == 0) PG8_BAR; }
        E(acc, cur, wr, wc, fr, fq); S.done(cur);
        if (!has_next) break;
#pragma unroll
        for (int a = 0; a < 2; ++a)
#pragma unroll
            for (int b = 0; b < 2; ++b)
#pragma unroll
                for (int m = 0; m < 4; ++m)
#pragma unroll
                    for (int n = 0; n < 2; ++n) acc[a][b][m][n] = (f32x4){0.f, 0.f, 0.f, 0.f};
        cur = nxt; cA = nA; cB = nB; ++ui;
        if constexpr (ALIGN_EPI) { if (wr == 1) PG8_BAR; }
    }
    PG8_WAIT_V(0);
    if constexpr (!ALIGN_EPI) { if (wr == 0) PG8_BAR; }
    PG8_BAR;
#undef PG8_SA
#undef PG8_SB
#undef PG8_STAGE
#undef PG8_LDA
#undef PG8_LDB
#undef PG8_MMA
#undef PG8_WAIT_V
#undef PG8_WAIT_L
#undef PG8_BAR
#undef PG8_SCHED
}
}

typedef unsigned short bf16;
typedef float f32x4 __attribute__((ext_vector_type(4)));
typedef unsigned u32x4 __attribute__((ext_vector_type(4)));
typedef unsigned u32x2 __attribute__((ext_vector_type(2)));
#define LAS __attribute__((address_space(3)))

constexpr int D = 1024, MP = 32768, MS = 1024, M = MP + MS, NTILE = M / 256, NTP = MP / 256;
constexpr int INW = 4096, PW = 512, CW = 512, FF = 2816, FF2 = 5632;
constexpr float EPS = 1e-6f;
constexpr int NWAVES = 8, NTHR = 512;
constexpr int LDS_BYTES = 147456;
#ifndef PHMASK
#define PHMASK 0xFFFF
#endif
#ifndef PROBE
#define PROBE 0
#endif

constexpr size_t O_POOLP = (size_t)M * D;
constexpr size_t O_CONVP = O_POOLP + 2 * 8 * 15 * 512;
constexpr size_t O_FFNP = O_CONVP + 2 * 8 * 2 * 512;
constexpr size_t O_POOLS = O_FFNP + 2 * 8 * 2 * 5632;
constexpr size_t O_CONVS = O_POOLS + 2 * 16 * 15 * 512;
constexpr size_t O_FFNS = O_CONVS + 2 * 16 * 2 * 512;
constexpr size_t O_END = O_FFNS + 2 * 16 * 2 * 5632;

constexpr size_t MiB = 1u << 20;
constexpr size_t WS_SSQ = 1 * MiB;
constexpr size_t WS_W = 4 * MiB, W_LAYER = 28 * MiB;
constexpr size_t WO_IN = 0, WO_UP = 8 * MiB, WO_DN = 19 * MiB, WO_O = 24 * MiB + MiB / 2, WO_CO = 26 * MiB + MiB / 2, WO_MAP = 27 * MiB + MiB / 2;
constexpr size_t WS_XB = 60 * MiB;
constexpr size_t WS_ACTV = 126 * MiB;
constexpr size_t WS_UPOOL = WS_ACTV, WS_CVIN = WS_ACTV + 33 * MiB, WS_GB = WS_ACTV + 66 * MiB, WS_SA = WS_ACTV + 99 * MiB, WS_SB = WS_ACTV + 165 * MiB,
                 WS_MIXED = WS_ACTV + 231 * MiB, WS_GBCV = WS_ACTV + 264 * MiB, WS_MA = WS_ACTV;
constexpr size_t WS_ACT = WS_ACTV;
constexpr size_t WS_HALO = WS_ACTV + 182 * MiB;
constexpr size_t WS_END = WS_ACTV + 297 * MiB;
constexpr int BST_OFF = 131072 + 8192;
constexpr int EX_OFF = 131072;

__device__ __forceinline__ float bf_lo(unsigned w) { return __builtin_bit_cast(float, w << 16); }
__device__ __forceinline__ float bf_hi(unsigned w) { return __builtin_bit_cast(float, w & 0xffff0000u); }
__device__ __forceinline__ unsigned pk2(float lo, float hi) { return pg8::cvt_pk_bf16(lo, hi); }
__device__ __forceinline__ float sigmoidf_(float x) { return __builtin_amdgcn_rcpf(1.f + __builtin_amdgcn_exp2f(-1.44269504f * x)); }
#define UNPACK8(V_, F_) do { F_[0] = bf_lo((V_)[0]); F_[1] = bf_hi((V_)[0]); F_[2] = bf_lo((V_)[1]); F_[3] = bf_hi((V_)[1]); F_[4] = bf_lo((V_)[2]); F_[5] = bf_hi((V_)[2]); F_[6] = bf_lo((V_)[3]); F_[7] = bf_hi((V_)[3]); } while (0)

struct Args { const float* in[19]; float* out; unsigned char* ws; };
typedef const __attribute__((address_space(4))) Args* KArgs;
__device__ __forceinline__ Args load_args(KArgs kp) {
    asm volatile("" : "+s"(kp)); Args a;
#pragma unroll
    for (int i = 0; i < 19; ++i) a.in[i] = kp->in[i];
    a.out = kp->out; a.ws = kp->ws; return a;
}

__device__ __forceinline__ void unit_rstd(const float* ssq, int pm, int wr, int fr, int fq, float (&r)[2][4]) {
    const int lane = fq * 16 + fr;
#pragma unroll
    for (int ai = 0; ai < 2; ++ai) {
        const f32x4* p = (const f32x4*)(ssq + (size_t)(pm * 256 + ai * 128 + wr * 64 + lane) * 16);
        const f32x4 a = p[0], b = p[1], c = p[2], d = p[3];
        const float s = ((a.x + a.y) + (a.z + a.w)) + ((b.x + b.y) + (b.z + b.w)) + ((c.x + c.y) + (c.z + c.w)) + ((d.x + d.y) + (d.z + d.w));
        const float rs = 1.0f / sqrtf(s * (1.0f / D) + EPS);
#pragma unroll
        for (int m = 0; m < 4; ++m) r[ai][m] = __shfl(rs, m * 16 + fr);
    }
}

template <class T> __device__ __forceinline__ T* launder_s(T* p) { asm volatile("" : "+s"(p)); return p; }
struct EpiProj {
    static constexpr bool PERM = true, AFTER_DRAIN = false;
    KArgs kp; int l;
    __device__ __forceinline__ void operator()(const f32x4 (&acc)[2][2][4][2], const pg8::Unit& u, int wr, int wc, int fr, int fq) const {
        const Args a_ = load_args(kp); unsigned char* w_ = a_.ws; float* o_ = a_.out; const float* b_gate = a_.in[7] + (size_t)l * 2 * D; const float* pool_scale = a_.in[9] + (size_t)l * D;
        float r[2][4]; unit_rstd((const float*)(w_ + WS_SSQ), u.pm, wr, fr, fq, r);
        const int pm = u.pm, pn = u.pn;
        const int lc0 = wc * 32 + 8 * fq;
        const bool samp = pm >= NTP;
        if (pn < 4) {
            bf16* O = (bf16*)(w_ + ((pn < 2) ? WS_UPOOL : WS_GB)); const int cb = (pn & 1) * 256 + lc0;
#pragma unroll
            for (int ai = 0; ai < 2; ++ai)
#pragma unroll
                for (int m = 0; m < 4; ++m) { const size_t row = (size_t)pm * 256 + ai * 128 + wr * 64 + m * 16 + fr; const float rr = r[ai][m];
#pragma unroll
                    for (int bj = 0; bj < 2; ++bj) { const f32x4 v0 = acc[ai][bj][m][0] * rr, v1 = acc[ai][bj][m][1] * rr; u32x4 w;
                        w.x = pk2(v0[0], v0[1]); w.y = pk2(v0[2], v0[3]); w.z = pk2(v1[0], v1[1]); w.w = pk2(v1[2], v1[3]);
                        *(u32x4*)(O + row * 512 + cb + bj * 128) = w; } }
            if (pn < 2 && (samp || ((pm & 15) == 15 && wr == 1)) && fr >= 1) {
                float* pool_p = o_ + O_POOLP + (size_t)l * 8 * 15 * 512; float* pool_s = o_ + O_POOLS + (size_t)l * 16 * 15 * 512;
#pragma unroll
                for (int ai = 0; ai < 2; ++ai) { if (!samp && ai == 0) continue;
                    float* sp = samp ? pool_s + ((size_t)((pm - NTP) * 4 + ai * 2 + wr) * 15 + (fr - 1)) * 512 : pool_p + ((size_t)(pm >> 4) * 15 + (fr - 1)) * 512;
                    const float rr = r[ai][3];
#pragma unroll
                    for (int bj = 0; bj < 2; ++bj) { *(f32x4*)(sp + cb + bj * 128) = acc[ai][bj][3][0] * rr; *(f32x4*)(sp + cb + bj * 128 + 4) = acc[ai][bj][3][1] * rr; } }
            }
        } else if (pn < 8) {
            const int cb = (pn - 4) * 128 + lc0; bf16* CVIN = (bf16*)(w_ + WS_CVIN);
            float* conv_p = o_ + O_CONVP + (size_t)l * 8 * 2 * 512; float* conv_s = o_ + O_CONVS + (size_t)l * 16 * 2 * 512;
#pragma unroll
            for (int ai = 0; ai < 2; ++ai)
#pragma unroll
                for (int m = 0; m < 4; ++m) { const size_t row = (size_t)pm * 256 + ai * 128 + wr * 64 + m * 16 + fr; const float rr = r[ai][m] * r[ai][m];
                    const f32x4 v0 = acc[ai][0][m][0] * acc[ai][1][m][0] * rr, v1 = acc[ai][0][m][1] * acc[ai][1][m][1] * rr; u32x4 w;
                    w.x = pk2(v0[0], v0[1]); w.y = pk2(v0[2], v0[3]); w.z = pk2(v1[0], v1[1]); w.w = pk2(v1[2], v1[3]);
                    *(u32x4*)(CVIN + row * 512 + cb) = w;
                    if (m == 3 && fr >= 14 && (samp || ((pm & 15) == 15 && wr == 1 && ai == 1))) {
                        float* sp = samp ? conv_s + ((size_t)((pm - NTP) * 4 + ai * 2 + wr) * 2 + (fr - 14)) * 512 : conv_p + ((size_t)(pm >> 4) * 2 + (fr - 14)) * 512;
                        *(f32x4*)(sp + cb) = v0; *(f32x4*)(sp + cb + 4) = v1; } }
        } else {
            const bool ga = pn < 12; bf16* O = (bf16*)(w_ + (ga ? WS_SA : WS_SB)); const int cb = ((pn - 8) & 3) * 256 + lc0; const float* bg = b_gate + (ga ? 0 : D);
#pragma unroll
            for (int bj = 0; bj < 2; ++bj) { const int c = cb + bj * 128;
                const f32x4 b0 = *(const f32x4*)(bg + c), b1 = *(const f32x4*)(bg + c + 4);
                f32x4 s0 = (f32x4){1.f, 1.f, 1.f, 1.f}, s1 = s0; if (ga) { s0 = *(const f32x4*)(pool_scale + c); s1 = *(const f32x4*)(pool_scale + c + 4); }
#pragma unroll
                for (int ai = 0; ai < 2; ++ai)
#pragma unroll
                    for (int m = 0; m < 4; ++m) { const size_t row = (size_t)pm * 256 + ai * 128 + wr * 64 + m * 16 + fr; const float rr = r[ai][m];
                        const f32x4 x0 = acc[ai][bj][m][0] * rr + b0, x1 = acc[ai][bj][m][1] * rr + b1; f32x4 v0, v1;
#pragma unroll
                        for (int e = 0; e < 4; ++e) { v0[e] = sigmoidf_(x0[e]) * s0[e]; v1[e] = sigmoidf_(x1[e]) * s1[e]; }
                        u32x4 w; w.x = pk2(v0[0], v0[1]); w.y = pk2(v0[2], v0[3]); w.z = pk2(v1[0], v1[1]); w.w = pk2(v1[2], v1[3]);
                        *(u32x4*)(O + row * 1024 + c) = w; } }
        }
    }
};

struct EpiNull {
    static constexpr bool PERM = true, AFTER_DRAIN = false;
    float* sink;
    __device__ __forceinline__ void operator()(const f32x4 (&acc)[2][2][4][2], const pg8::Unit& u, int wr, int wc, int fr, int fq) const {
        float s = 0.f;
#pragma unroll
        for (int ai = 0; ai < 2; ++ai)
#pragma unroll
            for (int bj = 0; bj < 2; ++bj)
#pragma unroll
                for (int m = 0; m < 4; ++m)
#pragma unroll
                    for (int n = 0; n < 2; ++n) s += acc[ai][bj][m][n][0] + acc[ai][bj][m][n][1] + acc[ai][bj][m][n][2] + acc[ai][bj][m][n][3];
        if (s == 123456.789f) sink[0] = s;
    }
};
struct EpiMA {
    static constexpr bool PERM = true, AFTER_DRAIN = false;
    const bf16* SA; bf16* MA;
    __device__ __forceinline__ void operator()(const f32x4 (&acc)[2][2][4][2], const pg8::Unit& u, int wr, int wc, int fr, int fq) const {
        const int cb = u.pn * 256 + wc * 32 + 8 * fq;
#pragma unroll
        for (int ai = 0; ai < 2; ++ai)
#pragma unroll
            for (int m = 0; m < 4; ++m) { const size_t row = (size_t)u.pm * 256 + ai * 128 + wr * 64 + m * 16 + fr;
#pragma unroll
                for (int bj = 0; bj < 2; ++bj) { const size_t o = row * 1024 + cb + bj * 128; const u32x4 s = *(const u32x4*)(SA + o); float f[8]; UNPACK8(s, f);
                    const f32x4 a0 = acc[ai][bj][m][0], a1 = acc[ai][bj][m][1]; u32x4 w;
                    w.x = pk2(a0[0] * f[0], a0[1] * f[1]); w.y = pk2(a0[2] * f[2], a0[3] * f[3]); w.z = pk2(a1[0] * f[4], a1[1] * f[5]); w.w = pk2(a1[2] * f[6], a1[3] * f[7]);
                    *(u32x4*)(MA + o) = w; }
                asm volatile("" ::: "memory"); }
    }
};
struct EpiMerge {
    static constexpr bool PERM = true, AFTER_DRAIN = false;
    const bf16* SB; bf16* MA;
    __device__ __forceinline__ void operator()(const f32x4 (&acc)[2][2][4][2], const pg8::Unit& u, int wr, int wc, int fr, int fq) const {
        const int cb = u.pn * 256 + wc * 32 + 8 * fq;
#pragma unroll
        for (int ai = 0; ai < 2; ++ai)
#pragma unroll
            for (int m = 0; m < 4; ++m) { const size_t row = (size_t)u.pm * 256 + ai * 128 + wr * 64 + m * 16 + fr;
#pragma unroll
                for (int bj = 0; bj < 2; ++bj) { const size_t o = row * 1024 + cb + bj * 128; const u32x4 s = *(const u32x4*)(SB + o); const u32x4 p = *(const u32x4*)(MA + o);
                    float f[8], q[8]; UNPACK8(s, f); UNPACK8(p, q);
                    const f32x4 a0 = acc[ai][bj][m][0], a1 = acc[ai][bj][m][1]; u32x4 w;
                    w.x = pk2(a0[0] * f[0] + q[0], a0[1] * f[1] + q[1]); w.y = pk2(a0[2] * f[2] + q[2], a0[3] * f[3] + q[3]);
                    w.z = pk2(a1[0] * f[4] + q[4], a1[1] * f[5] + q[5]); w.w = pk2(a1[2] * f[6] + q[6], a1[3] * f[7] + q[7]);
                    *(u32x4*)(MA + o) = w; }
                asm volatile("" ::: "memory"); }
    }
};
struct EpiRes {
    static constexpr bool PERM = true, AFTER_DRAIN = false;
    bf16* xb; float* ssq;
    __device__ __forceinline__ void operator()(const f32x4 (&acc)[2][2][4][2], const pg8::Unit& u, int wr, int wc, int fr, int fq) const {
        const int pm = u.pm, cb = u.pn * 256 + wc * 32 + 8 * fq;
#pragma unroll
        for (int ai = 0; ai < 2; ++ai)
#pragma unroll
          for (int mh = 0; mh < 2; ++mh) {
            u32x4 old[2][2];
#pragma unroll
            for (int mm = 0; mm < 2; ++mm)
#pragma unroll
                for (int bj = 0; bj < 2; ++bj) old[mm][bj] = *(const u32x4*)(xb + ((size_t)pm * 256 + ai * 128 + wr * 64 + (2 * mh + mm) * 16 + fr) * D + cb + bj * 128);
#pragma unroll
            for (int mm = 0; mm < 2; ++mm) { const int m = 2 * mh + mm; const size_t row = (size_t)pm * 256 + ai * 128 + wr * 64 + m * 16 + fr; float s = 0.f;
#pragma unroll
                for (int bj = 0; bj < 2; ++bj) { float f[8]; UNPACK8(old[mm][bj], f);
                    const f32x4 a0 = acc[ai][bj][m][0], a1 = acc[ai][bj][m][1]; u32x4 w;
                    w.x = pk2(a0[0] + f[0], a0[1] + f[1]); w.y = pk2(a0[2] + f[2], a0[3] + f[3]); w.z = pk2(a1[0] + f[4], a1[1] + f[5]); w.w = pk2(a1[2] + f[6], a1[3] + f[7]);
                    *(u32x4*)(xb + row * D + cb + bj * 128) = w;
                    float g[8]; UNPACK8(w, g);
                    s += (g[0] * g[0] + g[1] * g[1]) + (g[2] * g[2] + g[3] * g[3]) + (g[4] * g[4] + g[5] * g[5]) + (g[6] * g[6] + g[7] * g[7]); }
                s += __shfl_xor(s, 16); s += __shfl_xor(s, 32);
                if (fq == 0) ssq[row * 16 + u.pn * 4 + wc] = s; }
            asm volatile("" ::: "memory");
          }
    }
};
template <int CTRL> __device__ __forceinline__ float dppf(float v) { return __builtin_bit_cast(float, __builtin_amdgcn_update_dpp(0, __builtin_bit_cast(int, v), CTRL, 0xf, 0xf, true)); }
#define DPP_SHR1 0x111
#define DPP_SHR2 0x112
#define DPP_SHL15 0x10F
#define DPP_SHL14 0x10E
struct EpiUpAct {
    static constexpr bool PERM = true, AFTER_DRAIN = false;
    KArgs kp; LAS unsigned char* ex; int l;
    __device__ __forceinline__ void operator()(const f32x4 (&acc)[2][2][4][2], const pg8::Unit& u, int wr, int wc, int fr, int fq) const {
        const Args a_ = load_args(kp); unsigned char* w_ = a_.ws; float* o_ = a_.out;
        const float* fw = a_.in[15] + (size_t)l * 3 * FF2; const float* fb = a_.in[16] + (size_t)l * FF2; const float* sffn = a_.in[4] + (size_t)l * 16 * 2 * FF2;
        const int pm = u.pm, pn = u.pn; const bool samp = pm >= NTP;
        float r[2][4]; unit_rstd((const float*)(w_ + WS_SSQ), pm, wr, fr, fq, r);
        const int lc0 = wc * 32 + 8 * fq;
        f32x4 x[2][2][4][2];
#pragma unroll
        for (int ai = 0; ai < 2; ++ai)
#pragma unroll
            for (int bj = 0; bj < 2; ++bj)
#pragma unroll
                for (int m = 0; m < 4; ++m)
#pragma unroll
                    for (int n = 0; n < 2; ++n) x[ai][bj][m][n] = acc[ai][bj][m][n] * r[ai][m];
        {
            float* ffn_p = o_ + O_FFNP + (size_t)l * 8 * 2 * FF2; float* ffn_s = o_ + O_FFNS + (size_t)l * 16 * 2 * FF2; float* HALO = (float*)(w_ + WS_HALO) + (size_t)pm * 4 * FF2;
            if (fr >= 14) {
#pragma unroll
                for (int ai = 0; ai < 2; ++ai) {
                    if (samp || ((pm & 15) == 15 && wr == 1 && ai == 1)) {
                        float* sp = samp ? ffn_s + ((size_t)((pm - NTP) * 4 + ai * 2 + wr) * 2 + (fr - 14)) * FF2 : ffn_p + ((size_t)(pm >> 4) * 2 + (fr - 14)) * FF2;
#pragma unroll
                        for (int bj = 0; bj < 2; ++bj) { const int oc = bj * FF + pn * 128 + lc0; *(f32x4*)(sp + oc) = x[ai][bj][3][0]; *(f32x4*)(sp + oc + 4) = x[ai][bj][3][1]; } }
                }
                if (wr == 1) {
#pragma unroll
                    for (int bj = 0; bj < 2; ++bj) { float* hp = HALO + (size_t)(2 + fr - 14) * FF2 + pn * 256 + bj * 128 + lc0; *(f32x4*)hp = x[1][bj][3][0]; *(f32x4*)(hp + 4) = x[1][bj][3][1]; } }
            }
            if (fr < 2 && wr == 0) {
#pragma unroll
                for (int bj = 0; bj < 2; ++bj) { float* hp = HALO + (size_t)fr * FF2 + pn * 256 + bj * 128 + lc0; *(f32x4*)hp = x[0][bj][0][0]; *(f32x4*)(hp + 4) = x[0][bj][0][1]; } }
        }
        if (!samp) {
            if (fr >= 14) {
#pragma unroll
                for (int ai = 0; ai < 2; ++ai)
#pragma unroll
                    for (int bj = 0; bj < 2; ++bj)
#pragma unroll
                        for (int n = 0; n < 2; ++n) *(LAS f32x4*)(ex + ((((2 * ai + wr) * 2 + (fr - 14)) * 256) + bj * 128 + lc0 + 4 * n) * 4) = x[ai][bj][3][n];
            }
            asm volatile("s_waitcnt lgkmcnt(0)" ::: "memory"); __builtin_amdgcn_s_barrier(); asm volatile("" ::: "memory");
        }
        bf16* ACT = (bf16*)(w_ + WS_ACT);
        unsigned pk[2][4][2];
#pragma unroll
        for (int n = 0; n < 2; ++n) {
            const int f = pn * 128 + lc0 + 4 * n;
            const f32x4 wv0 = *(const f32x4*)(fw + f), wv1 = *(const f32x4*)(fw + FF2 + f), wv2 = *(const f32x4*)(fw + 2 * FF2 + f), bv = *(const f32x4*)(fb + f);
            const f32x4 wg0 = *(const f32x4*)(fw + FF + f), wg1 = *(const f32x4*)(fw + FF2 + FF + f), wg2 = *(const f32x4*)(fw + 2 * FF2 + FF + f), bg = *(const f32x4*)(fb + FF + f);
#pragma unroll
            for (int ai = 0; ai < 2; ++ai) {
                const int B = 2 * ai + wr;
                f32x4 e1v = (f32x4){0.f, 0.f, 0.f, 0.f}, e2v = e1v, e1g = e1v, e2g = e1v;
                if (fr < 2) {
                    if (samp) {
                        const float* b0 = sffn + (size_t)((pm - NTP) * 4 + B) * 2 * FF2; const float* b1 = b0 + FF2;
                        const f32x4 v1 = *(const f32x4*)(b1 + f), g1 = *(const f32x4*)(b1 + FF + f);
                        if (fr == 0) { e1v = v1; e1g = g1; e2v = *(const f32x4*)(b0 + f); e2g = *(const f32x4*)(b0 + FF + f); } else { e2v = v1; e2g = g1; }
                    } else if (B > 0) {
                        const LAS unsigned char* eb = ex + ((B - 1) * 2 * 256 + lc0 + 4 * n) * 4;
                        const f32x4 v63 = *(const LAS f32x4*)(eb + 256 * 4), g63 = *(const LAS f32x4*)(eb + 256 * 4 + 128 * 4);
                        if (fr == 0) { e1v = v63; e1g = g63; e2v = *(const LAS f32x4*)eb; e2g = *(const LAS f32x4*)(eb + 128 * 4); } else { e2v = v63; e2g = g63; }
                    }
                }
#pragma unroll
                for (int m = 0; m < 4; ++m) {
                    float av[4];
#pragma unroll
                    for (int e = 0; e < 4; ++e) {
                        const float xv = x[ai][0][m][n][e], xg = x[ai][1][m][n][e];
                        float yv = bv[e] + wv2[e] * xv, yg = bg[e] + wg2[e] * xg;
                        if (m > 0) {
                            const float pv = x[ai][0][m > 0 ? m - 1 : 0][n][e], pg = x[ai][1][m > 0 ? m - 1 : 0][n][e];
                            asm volatile("s_nop 4\n\t"
                                "v_fmac_f32_dpp %0, %2, %4 row_shr:1 row_mask:0xf bank_mask:0xf bound_ctrl:1\n\t"
                                "v_fmac_f32_dpp %1, %3, %6 row_shr:1 row_mask:0xf bank_mask:0xf bound_ctrl:1\n\t"
                                "v_fmac_f32_dpp %0, %2, %5 row_shr:2 row_mask:0xf bank_mask:0xf bound_ctrl:1\n\t"
                                "v_fmac_f32_dpp %1, %3, %7 row_shr:2 row_mask:0xf bank_mask:0xf bound_ctrl:1\n\t"
                                "v_fmac_f32_dpp %0, %8, %4 row_shl:15 row_mask:0xf bank_mask:0xf bound_ctrl:1\n\t"
                                "v_fmac_f32_dpp %1, %9, %6 row_shl:15 row_mask:0xf bank_mask:0xf bound_ctrl:1\n\t"
                                "v_fmac_f32_dpp %0, %8, %5 row_shl:14 row_mask:0xf bank_mask:0xf bound_ctrl:1\n\t"
                                "v_fmac_f32_dpp %1, %9, %7 row_shl:14 row_mask:0xf bank_mask:0xf bound_ctrl:1"
                                : "+v"(yv), "+v"(yg) : "v"(xv), "v"(xg), "v"(wv1[e]), "v"(wv0[e]), "v"(wg1[e]), "v"(wg0[e]), "v"(pv), "v"(pg));
                        } else {
                            yv += wv1[e] * e1v[e] + wv0[e] * e2v[e]; yg += wg1[e] * e1g[e] + wg0[e] * e2g[e];
                            asm volatile("s_nop 4\n\t"
                                "v_fmac_f32_dpp %0, %2, %4 row_shr:1 row_mask:0xf bank_mask:0xf bound_ctrl:1\n\t"
                                "v_fmac_f32_dpp %1, %3, %6 row_shr:1 row_mask:0xf bank_mask:0xf bound_ctrl:1\n\t"
                                "v_fmac_f32_dpp %0, %2, %5 row_shr:2 row_mask:0xf bank_mask:0xf bound_ctrl:1\n\t"
                                "v_fmac_f32_dpp %1, %3, %7 row_shr:2 row_mask:0xf bank_mask:0xf bound_ctrl:1"
                                : "+v"(yv), "+v"(yg) : "v"(xv), "v"(xg), "v"(wv1[e]), "v"(wv0[e]), "v"(wg1[e]), "v"(wg0[e]));
                        }
                        av[e] = yg * sigmoidf_(yg) * yv;
                    }
                    const unsigned lo = pk2(av[0], av[1]), hi = pk2(av[2], av[3]);
                    if (n == 0) { pk[ai][m][0] = lo; pk[ai][m][1] = hi; }
                    else { u32x4 w; w.x = pk[ai][m][0]; w.y = pk[ai][m][1]; w.z = lo; w.w = hi;
                        *(u32x4*)(ACT + ((size_t)pm * 256 + ai * 128 + wr * 64 + m * 16 + fr) * FF + pn * 128 + lc0) = w; }
                }
            }
        }
    }
};

#define XB_TMO      128
#define XB_XCNT(j)  (256  + 64 * (j))
#define XB_XSUB(j)  (1280 + 64 * (j))
#define XB_XGEN(j)  (2304 + 64 * (j))
#define XB_TOP      3328
#define XB_TOPGEN   3392
#define XCD_BAR_WORDS 3456
#define XB_SPIN_CAP (1u << 18)
__device__ __forceinline__ unsigned xb_ld(unsigned* p)              { return __hip_atomic_load(p, __ATOMIC_RELAXED, __HIP_MEMORY_SCOPE_AGENT); }
__device__ __forceinline__ unsigned xb_add(unsigned* p, unsigned v) { return __hip_atomic_fetch_add(p, v, __ATOMIC_RELAXED, __HIP_MEMORY_SCOPE_AGENT); }
__device__ __forceinline__ unsigned xb_xcc_id() { return (unsigned)__builtin_amdgcn_s_getreg((3 << 11) | 20) & 0xFu; }
#define XB_SPIN(cond, bar) do { unsigned _sp = 0; while (cond) { __builtin_amdgcn_s_sleep(1); \
    if ((++_sp & 255u) == 0u) { if (xb_ld(&(bar)[XB_TMO])) break; if (_sp > XB_SPIN_CAP) { atomicAdd(&(bar)[XB_TMO], 1u); break; } } } } while (0)
struct XcdBarrier { unsigned* bar; unsigned x; volatile LAS unsigned* st; };
__device__ __forceinline__ XcdBarrier xcd_barrier_post(unsigned* bar, volatile LAS unsigned* st) {
    XcdBarrier b; b.bar = bar; b.x = xb_xcc_id(); b.st = st;
    if (threadIdx.x == 0) (void)xb_add(&bar[XB_XCNT(b.x)], 1u);
    return b;
}
__device__ __forceinline__ void xcd_barrier_complete(unsigned* bar, unsigned x, unsigned& nloc, unsigned& nx) {
    const unsigned G = gridDim.x * gridDim.y * gridDim.z;
    unsigned sum, cnt, mine, sp = 0u;
    for (;;) {
        sum = 0u; cnt = 0u; mine = 0u;
#pragma unroll
        for (unsigned j = 0; j < 16; ++j) { const unsigned c = xb_ld(&bar[XB_XCNT(j)]); sum += c; cnt += (c > 0u) ? 1u : 0u; mine = (j == x) ? c : mine; }
        if (sum == G) break;
        __builtin_amdgcn_s_sleep(1);
        if ((++sp & 255u) == 0u) { if (xb_ld(&bar[XB_TMO])) break; if (sp > XB_SPIN_CAP) { atomicAdd(&bar[XB_TMO], 1u); break; } }
    }
    nloc = mine > 0u ? mine : 1u; nx = cnt > 0u ? cnt : 1u;
}
__device__ __forceinline__ void xcd_barrier(const XcdBarrier& b) {
    asm volatile("s_waitcnt vmcnt(0)" ::: "memory");
    __syncthreads();
    if (threadIdx.x == 0) {
        unsigned* bar = b.bar;
        __builtin_amdgcn_s_waitcnt(0);
        unsigned nloc = b.st[0], nx = b.st[1];
        if (nloc == 0u) { xcd_barrier_complete(bar, b.x, nloc, nx); b.st[0] = nloc; b.st[1] = nx; }
        const unsigned old = xb_add(&bar[XB_XSUB(b.x)], 1u);
        const unsigned gen = old / nloc;
        if (old + 1u == (gen + 1u) * nloc) {
            __builtin_amdgcn_fence(__ATOMIC_RELEASE, "agent");
            asm volatile("s_waitcnt vmcnt(0)" ::: "memory");
            const unsigned og = xb_add(&bar[XB_TOP], 1u);
            const unsigned tg = og / nx;
            if (og + 1u == (tg + 1u) * nx) xb_add(&bar[XB_TOPGEN], 1u);
            else XB_SPIN(xb_ld(&bar[XB_TOPGEN]) == tg, bar);
            __builtin_amdgcn_fence(__ATOMIC_ACQUIRE, "agent");
            xb_add(&bar[XB_XGEN(b.x)], 1u);
            asm volatile("s_waitcnt vmcnt(0)" ::: "memory");
        } else {
            XB_SPIN(xb_ld(&bar[XB_XGEN(b.x)]) == gen, bar);
            __builtin_amdgcn_fence(__ATOMIC_ACQUIRE, "agent");
            asm volatile("s_waitcnt vmcnt(0)" ::: "memory");
        }
    }
    __syncthreads();
}


struct Frame {
    LAS unsigned char* lds;
    int tid, lane, wave, G, bid;
};

__device__ __forceinline__ float wave_sum(float v) {
#pragma unroll
    for (int o = 1; o < 64; o <<= 1) v += __shfl_xor(v, o);
    return v;
}

__device__ __forceinline__ void tr_item(const float* W, int ldw, int srccol, int ks0, const float* gs, bf16* WT, int Kd, int dst_row, int kd0, bool zero, LAS float* scr, int lane) {
    if (!zero) {
#pragma unroll 8
        for (int i = 0; i < 32; ++i) { const int kk = 2 * i + (lane >> 5); float v = W[(size_t)(ks0 + kk) * ldw + srccol + (lane & 31)]; if (gs) v *= gs[ks0 + kk]; scr[kk * 33 + (lane & 31)] = v; }
    }
    asm volatile("s_waitcnt lgkmcnt(0)" ::: "memory");
    const int c = lane & 7;
#pragma unroll
    for (int j = 0; j < 4; ++j) { const int n = (lane >> 3) + 8 * j; const LAS float* s = scr + (8 * c) * 33 + n;
        u32x4 o;
        if (zero) { o = (u32x4){0u, 0u, 0u, 0u}; }
        else { o.x = pk2(s[0 * 33], s[1 * 33]); o.y = pk2(s[2 * 33], s[3 * 33]); o.z = pk2(s[4 * 33], s[5 * 33]); o.w = pk2(s[6 * 33], s[7 * 33]); }
        *(u32x4*)(WT + (size_t)(dst_row + n) * Kd + kd0 + 8 * c) = o; }
    asm volatile("s_waitcnt lgkmcnt(0)" ::: "memory");
}

constexpr int I_IN = 16 * 128, I_UP = 16 * 176, I_DN = 44 * 32, I_O = 16 * 32, I_CO = 8 * 32, I_MAP = 128;
constexpr int ITEMS_L = I_IN + I_UP + I_DN + I_O + I_CO + I_MAP;

__device__ __forceinline__ void p0_prologue(const Frame& F, const Args& a) {
    int tid_ = threadIdx.x; asm volatile("" : "+v"(tid_)); const int TID = tid_, LANE = tid_ & 63, WAVE = __builtin_amdgcn_readfirstlane(tid_ >> 6);
    LAS float* scr = (LAS float*)(F.lds + WAVE * 16384);
    const int gw = F.bid * NWAVES + WAVE, NGW = F.G * NWAVES;
    unsigned char* ws = a.ws;
    for (int it = gw; it < 2 * ITEMS_L; it += NGW) {
        const int l = it / ITEMS_L; int r = it % ITEMS_L;
        unsigned char* wl = ws + WS_W + (size_t)l * W_LAYER;
        if (r < I_IN) { const int kb = r / 128, n0 = (r % 128) * 32;
            const int src = (n0 < 1024 || n0 >= 2048) ? n0 : 1024 + 512 * (((n0 - 1024) % 256) / 128) + 128 * ((n0 - 1024) / 256) + (n0 % 128);
            tr_item(a.in[6] + (size_t)l * D * INW, INW, src, kb * 64, a.in[5] + l * D, (bf16*)(wl + WO_IN), D, n0, kb * 64, false, scr, LANE); continue; } r -= I_IN;
        if (r < I_UP) { const int kb = r / 176, n0 = (r % 176) * 32;
            const int src = ((n0 % 256) / 128) * FF + 128 * (n0 / 256) + (n0 % 128);
            tr_item(a.in[14] + (size_t)l * D * FF2, FF2, src, kb * 64, a.in[13] + l * D, (bf16*)(wl + WO_UP), D, n0, kb * 64, false, scr, LANE); continue; } r -= I_UP;
        if (r < I_DN) { const int kb = r / 32, n0 = (r % 32) * 32;
            tr_item(a.in[17] + (size_t)l * FF * D, D, n0, kb * 64, nullptr, (bf16*)(wl + WO_DN), FF, n0, kb * 64, false, scr, LANE); continue; } r -= I_DN;
        if (r < I_O) { const int kb = r / 32, n0 = (r % 32) * 32;
            tr_item(a.in[12] + (size_t)l * D * D, D, n0, kb * 64, nullptr, (bf16*)(wl + WO_O), D, n0, kb * 64, false, scr, LANE); continue; } r -= I_O;
        if (r < I_CO) { const int kb = r / 32, n0 = (r % 32) * 32;
            tr_item(a.in[11] + (size_t)l * CW * D, D, n0, kb * 64, nullptr, (bf16*)(wl + WO_CO), CW, n0, kb * 64, false, scr, LANE); continue; } r -= I_CO;
        { const int g = r / 32, kb = (r % 32) / 8, nb = r % 8; const bool zero = (kb >> 1) != (g & 1);
            tr_item(a.in[8] + (size_t)l * 4 * 128 * 256 + (size_t)g * 128 * 256, 256, nb * 32, (kb & 1) * 64, nullptr, (bf16*)(wl + WO_MAP), 256, g * 256 + nb * 32, kb * 64, zero, scr, LANE); }
    }
    bf16* XB = (bf16*)(ws + WS_XB); float* SSQ = (float*)(ws + WS_SSQ);
    for (int m = gw; m < M; m += NGW) {
        const float* xrow = m < MP ? a.in[0] + (size_t)m * D : a.in[1] + (size_t)(m - MP) * D;
        const f32x4* xr = (const f32x4*)xrow + LANE; f32x4 v[4]; float s = 0.f;
#pragma unroll
        for (int j = 0; j < 4; ++j) { v[j] = xr[64 * j]; s += (v[j].x * v[j].x + v[j].y * v[j].y) + (v[j].z * v[j].z + v[j].w * v[j].w); }
        s = wave_sum(s);
        u32x2* o8 = (u32x2*)(XB + (size_t)m * D) + LANE;
#pragma unroll
        for (int j = 0; j < 4; ++j) { u32x2 w; w.x = pk2(v[j].x, v[j].y); w.y = pk2(v[j].z, v[j].w); o8[64 * j] = w; }
        if (LANE < 16) SSQ[(size_t)m * 16 + LANE] = LANE == 0 ? s : 0.f;
    }
}

constexpr int MIX_RB = 33;
__device__ __forceinline__ void mix_elt(const Frame& F, const Args& a, int l) {
    int tid_ = threadIdx.x; asm volatile("" : "+v"(tid_)); const int TID = tid_;
    unsigned char* ws = a.ws;
    const bf16* UPOOL = (const bf16*)(ws + WS_UPOOL); const bf16* CVIN = (const bf16*)(ws + WS_CVIN); const bf16* GB = (const bf16*)(ws + WS_GB);
    bf16* MIXED = (bf16*)(ws + WS_MIXED); bf16* GBCV = (bf16*)(ws + WS_GBCV);
    const float* spool = a.in[2] + (size_t)l * 16 * 15 * 512; const float* sconv = a.in[3] + (size_t)l * 16 * 2 * 512; const float* cw = a.in[10] + (size_t)l * 3 * 512;
    const int nrb = (M + MIX_RB - 1) / MIX_RB, total = nrb * 128, stride = F.G * NTHR;
    for (int idx = F.bid * NTHR + TID; idx < total; idx += stride) {
        const int rb = idx >> 7, c8 = idx & 127;
        const int r0 = rb * MIX_RB, r1 = (r0 + MIX_RB) < M ? (r0 + MIX_RB) : M;
        if (c8 < 64) {
            const int ch0 = c8 * 8, win = 2 << (c8 >> 4);
            float sum[8], f[8];
            for (int row = r0; row < r1; ++row) {
                const bool samp = row >= MP; int t, sq = 0;
                if (!samp) t = row & 4095; else { const int sr = row - MP; sq = sr >> 6; t = sr & 63; }
                const u32x4 uw = *(const u32x4*)(UPOOL + (size_t)row * 512 + ch0);
                if (row == r0 || t == 0) {
#pragma unroll
                    for (int e = 0; e < 8; ++e) sum[e] = 0.f;
                    for (int j = 1; j < win; ++j) {
                        const int tt = t - j;
                        if (tt >= 0) { const u32x4 w = *(const u32x4*)(UPOOL + (size_t)(row - j) * 512 + ch0); UNPACK8(w, f);
#pragma unroll
                            for (int e = 0; e < 8; ++e) sum[e] += f[e]; }
                        else if (samp) { const float* p = spool + ((size_t)sq * 15 + 15 + tt) * 512 + ch0; const f32x4 p0 = *(const f32x4*)p, p1 = *(const f32x4*)(p + 4);
#pragma unroll
                            for (int e = 0; e < 4; ++e) { sum[e] += p0[e]; sum[4 + e] += p1[e]; } }
                    }
                } else {
                    const int tt = t - win;
                    if (tt >= 0) { const u32x4 w = *(const u32x4*)(UPOOL + (size_t)(row - win) * 512 + ch0); UNPACK8(w, f);
#pragma unroll
                        for (int e = 0; e < 8; ++e) sum[e] -= f[e]; }
                    else if (samp) { const float* p = spool + ((size_t)sq * 15 + 15 + tt) * 512 + ch0; const f32x4 p0 = *(const f32x4*)p, p1 = *(const f32x4*)(p + 4);
#pragma unroll
                        for (int e = 0; e < 4; ++e) { sum[e] -= p0[e]; sum[4 + e] -= p1[e]; } }
                }
                UNPACK8(uw, f);
                const float cnt = samp ? (float)win : (float)(win < t + 1 ? win : t + 1), inv = 1.0f / cnt;
                float o[8];
#pragma unroll
                for (int e = 0; e < 8; ++e) { sum[e] += f[e]; o[e] = sum[e] * inv - f[e]; }
                u32x4 w; w.x = pk2(o[0], o[1]); w.y = pk2(o[2], o[3]); w.z = pk2(o[4], o[5]); w.w = pk2(o[6], o[7]);
                *(u32x4*)(MIXED + (size_t)row * 512 + ch0) = w;
            }
        } else {
            const int ch0 = (c8 - 64) * 8;
            float w0[8], w1[8], w2[8];
#pragma unroll
            for (int h = 0; h < 2; ++h) { const f32x4 a0 = *(const f32x4*)(cw + ch0 + 4 * h), a1 = *(const f32x4*)(cw + 512 + ch0 + 4 * h), a2 = *(const f32x4*)(cw + 1024 + ch0 + 4 * h);
#pragma unroll
                for (int e = 0; e < 4; ++e) { w0[4 * h + e] = a0[e]; w1[4 * h + e] = a1[e]; w2[4 * h + e] = a2[e]; } }
            float x0[8], x1[8], x2[8], gb[8];
#pragma unroll
            for (int e = 0; e < 8; ++e) { x1[e] = 0.f; x2[e] = 0.f; }
            for (int row = r0; row < r1; ++row) {
                const bool samp = row >= MP; int t, sq = 0;
                if (!samp) t = row & 4095; else { const int sr = row - MP; sq = sr >> 6; t = sr & 63; }
                { const u32x4 w = *(const u32x4*)(CVIN + (size_t)row * 512 + ch0); UNPACK8(w, x0); }
                { const u32x4 w = *(const u32x4*)(GB + (size_t)row * 512 + ch0); UNPACK8(w, gb); }
                if (row == r0 || t == 0) {
                    if (t >= 1) { const u32x4 w = *(const u32x4*)(CVIN + (size_t)(row - 1) * 512 + ch0); UNPACK8(w, x1); }
                    else if (samp) { const float* p = sconv + ((size_t)sq * 2 + 1) * 512 + ch0; const f32x4 p0 = *(const f32x4*)p, p1 = *(const f32x4*)(p + 4);
#pragma unroll
                        for (int e = 0; e < 4; ++e) { x1[e] = p0[e]; x1[4 + e] = p1[e]; } }
                    else {
#pragma unroll
                        for (int e = 0; e < 8; ++e) x1[e] = 0.f; }
                    if (t >= 2) { const u32x4 w = *(const u32x4*)(CVIN + (size_t)(row - 2) * 512 + ch0); UNPACK8(w, x2); }
                    else if (samp) { const float* p = sconv + ((size_t)sq * 2 + t) * 512 + ch0; const f32x4 p0 = *(const f32x4*)p, p1 = *(const f32x4*)(p + 4);
#pragma unroll
                        for (int e = 0; e < 4; ++e) { x2[e] = p0[e]; x2[4 + e] = p1[e]; } }
                    else {
#pragma unroll
                        for (int e = 0; e < 8; ++e) x2[e] = 0.f; }
                }
                float o[8];
#pragma unroll
                for (int e = 0; e < 8; ++e) { o[e] = gb[e] * (w0[e] * x2[e] + w1[e] * x1[e] + w2[e] * x0[e]); x2[e] = x1[e]; x1[e] = x0[e]; }
                u32x4 w; w.x = pk2(o[0], o[1]); w.y = pk2(o[2], o[3]); w.z = pk2(o[4], o[5]); w.w = pk2(o[6], o[7]);
                *(u32x4*)(GBCV + (size_t)row * 512 + ch0) = w;
            }
        }
    }
}

__device__ __forceinline__ void ffn_fixup(const Frame& F, const Args& a, int l) {
    int tid_ = threadIdx.x; asm volatile("" : "+v"(tid_)); const int TID = tid_;
    unsigned char* ws = a.ws;
    const float* HALO = (const float*)(ws + WS_HALO); bf16* ACT = (bf16*)(ws + WS_ACT);
    const float* fw = a.in[15] + (size_t)l * 3 * FF2; const float* fb = a.in[16] + (size_t)l * FF2;
    const int total = NTP * 2 * 352, stride = F.G * NTHR;
    for (int idx = F.bid * NTHR + TID; idx < total; idx += stride) {
        const int pm = idx / 704, rem = idx % 704, rr = rem / 352, c8 = rem % 352;
        if ((pm & 15) == 0) continue;
        const int f0 = c8 * 8, pn = f0 >> 7, j0 = f0 & 127;
        float res[2][8];
#pragma unroll
        for (int h = 0; h < 2; ++h) {
            const int pc = pn * 256 + h * 128 + j0, oc = h * FF + f0;
            const float* p0 = HALO + ((size_t)pm * 4 + rr) * FF2 + pc;
            const float* p1 = rr == 1 ? HALO + ((size_t)pm * 4 + 0) * FF2 + pc : HALO + ((size_t)(pm - 1) * 4 + 3) * FF2 + pc;
            const float* p2 = rr == 1 ? HALO + ((size_t)(pm - 1) * 4 + 3) * FF2 + pc : HALO + ((size_t)(pm - 1) * 4 + 2) * FF2 + pc;
#pragma unroll
            for (int q = 0; q < 2; ++q) { const f32x4 x0 = *(const f32x4*)(p0 + 4 * q), x1 = *(const f32x4*)(p1 + 4 * q), x2 = *(const f32x4*)(p2 + 4 * q);
                const f32x4 w0 = *(const f32x4*)(fw + oc + 4 * q), w1 = *(const f32x4*)(fw + FF2 + oc + 4 * q), w2 = *(const f32x4*)(fw + 2 * FF2 + oc + 4 * q), b = *(const f32x4*)(fb + oc + 4 * q);
#pragma unroll
                for (int e = 0; e < 4; ++e) res[h][4 * q + e] = w0[e] * x2[e] + w1[e] * x1[e] + w2[e] * x0[e] + b[e]; }
        }
        float o[8];
#pragma unroll
        for (int e = 0; e < 8; ++e) o[e] = res[1][e] * sigmoidf_(res[1][e]) * res[0][e];
        u32x4 w; w.x = pk2(o[0], o[1]); w.y = pk2(o[2], o[3]); w.z = pk2(o[4], o[5]); w.w = pk2(o[6], o[7]);
        *(u32x4*)(ACT + ((size_t)pm * 256 + rr) * FF + f0) = w;
    }
}

__device__ __forceinline__ void final_norm(const Frame& F, const Args& a) {
    int tid_ = threadIdx.x; asm volatile("" : "+v"(tid_)); const int LANE = tid_ & 63, WAVE = __builtin_amdgcn_readfirstlane(tid_ >> 6);
    const float* SSQ = (const float*)(a.ws + WS_SSQ); const bf16* XB = (const bf16*)(a.ws + WS_XB); const float* g = a.in[18];
    const int gw = F.bid * NWAVES + WAVE, NGW = F.G * NWAVES;
    f32x4 gv[2][2];
#pragma unroll
    for (int j = 0; j < 2; ++j) { gv[j][0] = *(const f32x4*)(g + 512 * j + 8 * LANE); gv[j][1] = *(const f32x4*)(g + 512 * j + 8 * LANE + 4); }
    for (int m = gw; m < M; m += NGW) {
        float s = LANE < 16 ? SSQ[(size_t)m * 16 + LANE] : 0.f;
        s = wave_sum(s);
        const float rs = 1.0f / sqrtf(s * (1.0f / D) + EPS);
        float* orow = a.out + (size_t)m * D;
#pragma unroll
        for (int j = 0; j < 2; ++j) { const u32x4 w = *(const u32x4*)(XB + (size_t)m * D + 512 * j + 8 * LANE); float f[8]; UNPACK8(w, f);
            f32x4 o0, o1;
#pragma unroll
            for (int e = 0; e < 4; ++e) { o0[e] = f[e] * rs * gv[j][0][e]; o1[e] = f[4 + e] * rs * gv[j][1][e]; }
            *(f32x4*)(orow + 512 * j + 8 * LANE) = o0; *(f32x4*)(orow + 512 * j + 8 * LANE + 4) = o1; }
    }
}

__global__ void __launch_bounds__(NTHR, 2) fwd_mega(Args a_unused) {
    extern __shared__ __attribute__((aligned(16))) unsigned char lds_raw[];
    cg::grid_group grid = cg::this_grid();
    KArgs kp = (KArgs)__builtin_amdgcn_kernarg_segment_ptr();
    Frame F;
    F.lds = (LAS unsigned char*)lds_raw;
    F.tid = threadIdx.x; F.lane = F.tid & 63; F.wave = __builtin_amdgcn_readfirstlane(F.tid >> 6);
    F.G = gridDim.x; F.bid = blockIdx.x;
    { const Args a = load_args(kp); unsigned* barw = (unsigned*)a.ws;
      if (blockIdx.x == 0) for (int i = threadIdx.x; i < XCD_BAR_WORDS; i += NTHR) __hip_atomic_store(barw + i, 0u, __ATOMIC_RELAXED, __HIP_MEMORY_SCOPE_AGENT);
      volatile LAS unsigned* bst = (volatile LAS unsigned*)(F.lds + BST_OFF);
      if (threadIdx.x < 4) bst[threadIdx.x] = 0u; }
    __syncthreads();

    if constexpr (PHMASK & 1) { const Args a = load_args(kp); p0_prologue(F, a); }
    if constexpr (PROBE == 2) { __syncthreads(); const Args a = load_args(kp); p0_prologue(F, a); }
    grid.sync();
    { const Args a = load_args(kp); (void)xcd_barrier_post((unsigned*)a.ws, (volatile LAS unsigned*)(F.lds + BST_OFF)); }
#define GRID_BAR() do { const Args a_ = load_args(kp); XcdBarrier b_; b_.bar = (unsigned*)a_.ws; b_.x = xb_xcc_id(); b_.st = (volatile LAS unsigned*)(F.lds + BST_OFF); xcd_barrier(b_); } while (0)

#pragma unroll 1
    for (int l = 0; l < 2; ++l) {
        if constexpr (PHMASK & 2) {
            const Args a = load_args(kp); unsigned char* ws = a.ws; unsigned char* wl = ws + WS_W + (size_t)l * W_LAYER;
            pg8::Gemm g{(const bf16*)(ws + WS_XB), (const bf16*)(wl + WO_IN), M, INW, D, D, 0, 0}; pg8::StaticOrder S; S.init(M, INW, F.G, F.bid);
            EpiProj E{kp, l};
            pg8::gemm_phase<EpiProj, pg8::StaticOrder, true, true>(F.lds, g, S, E);
            if constexpr (PROBE == 4) { __syncthreads(); pg8::gemm_phase<EpiProj, pg8::StaticOrder, true, true>(F.lds, g, S, E); }
            if constexpr (PROBE == 8) { __syncthreads(); EpiNull EN{(float*)(ws + WS_HALO)}; pg8::gemm_phase<EpiNull, pg8::StaticOrder, true, true>(F.lds, g, S, EN); }
        }
        GRID_BAR();
_Pragma("unroll 1")
        for (int rep = 0; rep < (PROBE == 3 ? 2 : 1); ++rep) { const Args a = load_args(kp); mix_elt(F, a, l); }
        GRID_BAR();
        if constexpr (PHMASK & 8) {
            const Args a = load_args(kp); unsigned char* ws = a.ws; unsigned char* wl = ws + WS_W + (size_t)l * W_LAYER;
            pg8::Gemm g{(const bf16*)(ws + WS_MIXED), (const bf16*)(wl + WO_MAP), M, D, 256, PW, 1, 512}; pg8::StaticOrder S; S.init(M, D, F.G, F.bid);
            EpiMA E{(const bf16*)(ws + WS_SA), (bf16*)(ws + WS_MA)};
            pg8::gemm_phase<EpiMA, pg8::StaticOrder, true, true>(F.lds, g, S, E);
        }
        if constexpr (PHMASK & 16) {
            const Args a = load_args(kp); unsigned char* ws = a.ws; unsigned char* wl = ws + WS_W + (size_t)l * W_LAYER;
            pg8::Gemm g{(const bf16*)(ws + WS_GBCV), (const bf16*)(wl + WO_CO), M, D, CW, CW, 0, 0}; pg8::StaticOrder S; S.init(M, D, F.G, F.bid);
            EpiMerge E{(const bf16*)(ws + WS_SB), (bf16*)(ws + WS_MA)};
            pg8::gemm_phase<EpiMerge, pg8::StaticOrder, true, true>(F.lds, g, S, E);
        }
        GRID_BAR();
        if constexpr (PHMASK & 32) {
            const Args a = load_args(kp); unsigned char* ws = a.ws; unsigned char* wl = ws + WS_W + (size_t)l * W_LAYER;
            pg8::Gemm g{(const bf16*)(ws + WS_MA), (const bf16*)(wl + WO_O), M, D, D, D, 0, 0}; pg8::StaticOrder S; S.init(M, D, F.G, F.bid);
            EpiRes E{(bf16*)(ws + WS_XB), (float*)(ws + WS_SSQ)};
            pg8::gemm_phase<EpiRes, pg8::StaticOrder, true, true>(F.lds, g, S, E);
        }
        GRID_BAR();
        if constexpr (PHMASK & 64) {
            const Args a = load_args(kp); unsigned char* ws = a.ws; unsigned char* wl = ws + WS_W + (size_t)l * W_LAYER;
            pg8::Gemm g{(const bf16*)(ws + WS_XB), (const bf16*)(wl + WO_UP), M, FF2, D, D, 0, 0}; pg8::StaticOrder S; S.init(M, FF2, F.G, F.bid);
            EpiUpAct E{kp, F.lds + EX_OFF, l};
            pg8::gemm_phase<EpiUpAct, pg8::StaticOrder, true, true>(F.lds, g, S, E);
            if constexpr (PROBE == 5) { __syncthreads(); pg8::gemm_phase<EpiUpAct, pg8::StaticOrder, true, true>(F.lds, g, S, E); }
        }
        GRID_BAR();
        if constexpr (PHMASK & 128) { const Args a = load_args(kp); ffn_fixup(F, a, l); }
        GRID_BAR();
        if constexpr (PHMASK & 256) {
            const Args a = load_args(kp); unsigned char* ws = a.ws; unsigned char* wl = ws + WS_W + (size_t)l * W_LAYER;
            pg8::Gemm g{(const bf16*)(ws + WS_ACT), (const bf16*)(wl + WO_DN), M, D, FF, FF, 0, 0}; pg8::StaticOrder S; S.init(M, D, F.G, F.bid);
            EpiRes E{(bf16*)(ws + WS_XB), (float*)(ws + WS_SSQ)};
            pg8::gemm_phase<EpiRes, pg8::StaticOrder, true, true>(F.lds, g, S, E);
        }
        GRID_BAR();
    }
    if constexpr (PHMASK & 512) { const Args a = load_args(kp); final_norm(F, a); }
    if constexpr (PROBE == 1) { for (int i = 0; i < 16; ++i) GRID_BAR(); }
}

extern "C" void kernel_launch(void* const* d_in, const int* in_sizes, int n_in, void* d_out, int out_size, void* d_ws, size_t ws_size, hipStream_t stream) {
    static int grid = 0;
    if (grid == 0) {
        if (n_in != 19 || in_sizes[0] != MP * D || (size_t)out_size != O_END || ws_size < WS_END) {
            fprintf(stderr, "kernel_launch: unexpected shapes: n_in %d in0 %d out %d ws %zu (need %zu)\n", n_in, n_in > 0 ? in_sizes[0] : -1, out_size, ws_size, (size_t)WS_END); grid = -1; return; }
        int dev = 0, cus = 0, per_cu = 0;
        hipGetDevice(&dev); hipDeviceGetAttribute(&cus, hipDeviceAttributeMultiprocessorCount, dev);
        if (hipFuncSetAttribute((const void*)fwd_mega, hipFuncAttributeMaxDynamicSharedMemorySize, LDS_BYTES) != hipSuccess) { fprintf(stderr, "kernel_launch: hipFuncSetAttribute failed\n"); grid = -1; return; }
        if (hipOccupancyMaxActiveBlocksPerMultiprocessor(&per_cu, (const void*)fwd_mega, NTHR, LDS_BYTES) != hipSuccess || per_cu < 1) { fprintf(stderr, "kernel_launch: occupancy query says %d\n", per_cu); per_cu = 1; }
        (void)hipGetLastError();
        grid = cus;
    }
    if (grid < 0) return;
    Args a{};
    for (int i = 0; i < 19; ++i) a.in[i] = (const float*)d_in[i];
    a.out = (float*)d_out; a.ws = (unsigned char*)d_ws;
    void* args[] = {&a};
    hipError_t e = hipLaunchCooperativeKernel((const void*)fwd_mega, dim3(grid), dim3(NTHR), args, LDS_BYTES, stream);
    if (e != hipSuccess) fprintf(stderr, "cooperative launch failed: %s (grid %d)\n", hipGetErrorString(e), grid);
}
```

```cpp
#include <hip/hip_runtime.h>
#include <hip/hip_cooperative_groups.h>
#include <cstdio>
#include <cstdint>
namespace cg = cooperative_groups;

namespace pg8 {
#define PG8_LAS __attribute__((address_space(3)))
typedef unsigned short bf16_t;
typedef short bf16x8 __attribute__((ext_vector_type(8)));
typedef float f32x4 __attribute__((ext_vector_type(4)));
typedef unsigned u32x4 __attribute__((ext_vector_type(4)));
constexpr int BM = 256, BK = 64, HALF = 128, HTB = HALF * BK * 2, STAGE_BYTES = 8 * HTB, NXCD = 8, WGM = 8;

__host__ __device__ __forceinline__ int lds_byte(int r, int c) { const int st = (r >> 4) * 2 + (c >> 5), rr = r & 15, cc = c & 31, ob = rr * 64 + cc * 2; return st * 1024 + (ob ^ (((ob >> 9) & 1) << 5)); }
__host__ __device__ __forceinline__ void stage_rc(int b, int& R, int& C) { const int st = b / 1024, sb = b % 1024, swz = sb ^ (((sb >> 9) & 1) << 5); R = (st >> 1) * 16 + swz / 64; C = (st & 1) * 32 + (swz % 64) / 2; }
__host__ __device__ __forceinline__ int perm32(int rho) { const int n = rho >> 4, i = rho & 15; return 8 * (i >> 2) + 4 * n + (i & 3); }

struct Unit { int pm, pn; };
struct Gemm { const bf16_t* A; const bf16_t* Bt; int M, N, K, lda, apn_shift, apn_bytes; };

struct StaticOrder {
    int nM, nN, nwg, G, c;
    __host__ __device__ void init(int M, int N, int G_, int c_) { nM = M / BM; nN = N / BM; nwg = nM * nN; G = G_; c = c_; }
    __host__ __device__ bool next(int i, Unit& u) const {
        const long L = (long)i * G + c; if (L >= nwg) return false;
        int wgid = (int)L; { const int q = nwg / NXCD, r = nwg % NXCD, xcd = wgid % NXCD, off = wgid / NXCD; wgid = (xcd < r ? xcd * (q + 1) : r * (q + 1) + (xcd - r) * q) + off; }
        const int nig = WGM * nN, gid = wgid / nig, fm = gid * WGM, gsz = (nM - fm) < WGM ? (nM - fm) : WGM;
        u.pm = fm + ((wgid % nig) % gsz); u.pn = (wgid % nig) / gsz; return true;
    }
    __device__ __forceinline__ void a_ready(const Unit&) const {}
    __device__ __forceinline__ void done(const Unit&) const {}
};

__device__ __forceinline__ unsigned cvt_pk_bf16(float lo, float hi) { unsigned r; asm volatile("v_cvt_pk_bf16_f32 %0, %1, %2" : "=v"(r) : "v"(lo), "v"(hi)); return r; }

template <class Epi, class Sched, bool ALIGN_EPI = false, bool SP2 = false>
__device__ __forceinline__ void gemm_phase(PG8_LAS unsigned char* lds, const Gemm g, const Sched& S, const Epi& E) {
    int tid_ = threadIdx.x; asm volatile("" : "+v"(tid_));
    const int tid = tid_, wid = __builtin_amdgcn_readfirstlane(tid >> 6), lane = tid & 63, wr = wid >> 2, wc = wid & 3, fr = lane & 15, fq = lane >> 4;
    const int K = g.K, nt = K / BK, lda = g.lda;
    unsigned voffA[2], voffB[2];
#pragma unroll
    for (int i = 0; i < 2; ++i) { int R, C; stage_rc(tid * 16 + i * 8192, R, C); const int Rb = Epi::PERM ? ((R & ~31) + perm32(R & 31)) : R;
        voffA[i] = (unsigned)(R * lda + C) * 2u; voffB[i] = (unsigned)(Rb * K + C) * 2u; }
    const size_t kstep = (size_t)(BK * 2);
    const size_t hstepA = (size_t)HALF * lda * 2, hstepB = (size_t)HALF * K * 2;
    const size_t tstepA = 2 * hstepA, tstepB = 2 * hstepB;
    const unsigned ldsw = (unsigned)wid * 1024u;
    const int aoff = lds_byte(wr * 64 + fr, fq * 8), boff = lds_byte(wc * 32 + fr, fq * 8);
#define PG8_SA(b, h) (((b) * 2 + (h)) * HTB)
#define PG8_SB(b, h) ((4 + (b) * 2 + (h)) * HTB)
#define PG8_STAGE(bufoff, gbase, voff) do { _Pragma("unroll") for (int _i = 0; _i < 2; ++_i) \
        __builtin_amdgcn_global_load_lds((const unsigned*)((const char*)(gbase) + (voff)[_i]), (PG8_LAS unsigned*)(lds + (bufoff) + ldsw + _i * 8192), 16, 0, 0); } while (0)
#define PG8_LDA(dst, b, h) do { _Pragma("unroll") for (int m = 0; m < 4; ++m) _Pragma("unroll") for (int k = 0; k < 2; ++k) dst[m][k] = *(const PG8_LAS bf16x8*)(lds + PG8_SA(b, h) + aoff + m * 2048 + k * 1024); } while (0)
#define PG8_LDB(dst, b, h) do { _Pragma("unroll") for (int n = 0; n < 2; ++n) _Pragma("unroll") for (int k = 0; k < 2; ++k) dst[n][k] = *(const PG8_LAS bf16x8*)(lds + PG8_SB(b, h) + boff + n * 2048 + k * 1024); } while (0)
#define PG8_MMA(ai, bj, At, Bt) do { __builtin_amdgcn_s_setprio(1); _Pragma("unroll") for (int m = 0; m < 4; ++m) _Pragma("unroll") for (int n = 0; n < 2; ++n) _Pragma("unroll") for (int k = 0; k < 2; ++k) \
        acc[ai][bj][m][n] = __builtin_amdgcn_mfma_f32_16x16x32_bf16(Bt[n][k], At[m][k], acc[ai][bj][m][n], 0, 0, 0); __builtin_amdgcn_s_setprio(0); } while (0)
#define PG8_WAIT_V(n) asm volatile("s_waitcnt vmcnt(" #n ")" ::: "memory")
#define PG8_WAIT_L(n) asm volatile("s_waitcnt lgkmcnt(" #n ")" ::: "memory")
#define PG8_BAR __builtin_amdgcn_s_barrier()
#define PG8_SCHED __builtin_amdgcn_sched_barrier(0)
    Unit cur, nxt; int ui = 0;
    if (!S.next(0, cur)) return;
    f32x4 acc[2][2][4][2];
#pragma unroll
    for (int a = 0; a < 2; ++a)
#pragma unroll
        for (int b = 0; b < 2; ++b)
#pragma unroll
            for (int m = 0; m < 4; ++m)
#pragma unroll
                for (int n = 0; n < 2; ++n) acc[a][b][m][n] = (f32x4){0.f, 0.f, 0.f, 0.f};
    bf16x8 At[4][2], B0[2][2], B1[2][2];
    const char* cA = (const char*)g.A + (size_t)cur.pm * tstepA + (size_t)(cur.pn >> g.apn_shift) * g.apn_bytes; const char* cB = (const char*)g.Bt + (size_t)cur.pn * tstepB;
    S.a_ready(cur);
    if constexpr (SP2) {
        PG8_STAGE(PG8_SB(0, 0), cB, voffB); PG8_STAGE(PG8_SB(0, 1), cB + hstepB, voffB); PG8_STAGE(PG8_SA(0, 0), cA, voffA); PG8_STAGE(PG8_SA(0, 1), cA + hstepA, voffA);
        if (wr == 1) PG8_BAR;
        PG8_WAIT_V(2); PG8_BAR;
        PG8_STAGE(PG8_SB(1, 0), cB + kstep, voffB); PG8_STAGE(PG8_SA(1, 0), cA + kstep, voffA); PG8_STAGE(PG8_SB(1, 1), cB + hstepB + kstep, voffB);
        PG8_WAIT_V(6); PG8_BAR;
    } else {
        PG8_STAGE(PG8_SB(0, 0), cB, voffB); PG8_STAGE(PG8_SA(0, 0), cA, voffA); PG8_STAGE(PG8_SB(0, 1), cB + hstepB, voffB); PG8_STAGE(PG8_SA(0, 1), cA + hstepA, voffA);
        if (wr == 1) PG8_BAR;
        PG8_WAIT_V(4); PG8_BAR;
        PG8_STAGE(PG8_SB(1, 0), cB + kstep, voffB); PG8_STAGE(PG8_SA(1, 0), cA + kstep, voffA); PG8_STAGE(PG8_SB(1, 1), cB + hstepB + kstep, voffB);
        PG8_WAIT_V(6); PG8_BAR;
    }
    for (;;) {
        const bool has_next = S.next(ui + 1, nxt);
        const char* nA = has_next ? (const char*)g.A + (size_t)nxt.pm * tstepA + (size_t)(nxt.pn >> g.apn_shift) * g.apn_bytes : cA; const char* nB = has_next ? (const char*)g.Bt + (size_t)nxt.pn * tstepB : cB;
#pragma unroll 1
        for (int t = 0; t < nt; t += 2) {
            const bool last = (t == nt - 2);
            const char* a1 = cA + (size_t)(t + 1) * kstep;
            const char* a2 = last ? nA : cA + (size_t)(t + 2) * kstep; const char* b2 = last ? nB : cB + (size_t)(t + 2) * kstep;
            const char* a3 = a2 + kstep; const char* b3 = b2 + kstep;
            if (last && has_next) S.a_ready(nxt);
            if constexpr (SP2) {
            PG8_LDB(B0, 0, 0); PG8_LDB(B1, 0, 1); PG8_SCHED; PG8_LDA(At, 0, 0); PG8_STAGE(PG8_SA(1, 1), a1 + hstepA, voffA);
            PG8_WAIT_V(8); PG8_WAIT_L(0); PG8_BAR; PG8_MMA(0, 0, At, B0); PG8_MMA(0, 1, At, B1); PG8_BAR; PG8_SCHED;
            PG8_LDA(At, 0, 1); PG8_STAGE(PG8_SB(0, 0), b2, voffB); PG8_STAGE(PG8_SB(0, 1), b2 + hstepB, voffB); PG8_STAGE(PG8_SA(0, 0), a2, voffA);
            PG8_WAIT_V(8); PG8_WAIT_L(0); PG8_BAR; PG8_MMA(1, 0, At, B0); PG8_MMA(1, 1, At, B1); PG8_BAR; PG8_SCHED;
            PG8_LDB(B0, 1, 0); PG8_LDB(B1, 1, 1); PG8_SCHED; PG8_LDA(At, 1, 0); PG8_STAGE(PG8_SA(0, 1), a2 + hstepA, voffA);
            PG8_WAIT_V(8); PG8_WAIT_L(0); PG8_BAR; PG8_MMA(0, 0, At, B0); PG8_MMA(0, 1, At, B1); PG8_BAR; PG8_SCHED;
            PG8_LDA(At, 1, 1); PG8_STAGE(PG8_SB(1, 0), b3, voffB); PG8_STAGE(PG8_SB(1, 1), b3 + hstepB, voffB); PG8_STAGE(PG8_SA(1, 0), a3, voffA);
            PG8_WAIT_V(8); PG8_WAIT_L(0); PG8_BAR; PG8_MMA(1, 0, At, B0); PG8_MMA(1, 1, At, B1); PG8_BAR; PG8_SCHED;
            } else {
            PG8_LDB(B0, 0, 0); PG8_SCHED; PG8_LDA(At, 0, 0); PG8_STAGE(PG8_SA(1, 1), a1 + hstepA, voffA);
            PG8_WAIT_L(8); PG8_BAR; PG8_WAIT_L(0); PG8_MMA(0, 0, At, B0); PG8_BAR; PG8_SCHED;
            PG8_LDB(B1, 0, 1); PG8_STAGE(PG8_SB(0, 0), b2, voffB);
            PG8_BAR; PG8_WAIT_L(0); PG8_MMA(0, 1, At, B1); PG8_BAR;
            PG8_LDA(At, 0, 1); PG8_STAGE(PG8_SA(0, 0), a2, voffA);
            PG8_BAR; PG8_WAIT_L(0); PG8_MMA(1, 0, At, B0); PG8_BAR; PG8_SCHED;
            PG8_STAGE(PG8_SB(0, 1), b2 + hstepB, voffB);
            PG8_WAIT_V(6); PG8_BAR; PG8_MMA(1, 1, At, B1); PG8_BAR;
            PG8_LDB(B0, 1, 0); PG8_SCHED; PG8_LDA(At, 1, 0); PG8_STAGE(PG8_SA(0, 1), a2 + hstepA, voffA);
            PG8_WAIT_L(8); PG8_BAR; PG8_WAIT_L(0); PG8_MMA(0, 0, At, B0); PG8_BAR; PG8_SCHED;
            PG8_LDB(B1, 1, 1); PG8_STAGE(PG8_SB(1, 0), b3, voffB);
            PG8_BAR; PG8_WAIT_L(0); PG8_MMA(0, 1, At, B1); PG8_BAR;
            PG8_LDA(At, 1, 1); PG8_STAGE(PG8_SA(1, 0), a3, voffA);
            PG8_BAR; PG8_WAIT_L(0); PG8_MMA(1, 0, At, B0); PG8_BAR; PG8_SCHED;
            PG8_STAGE(PG8_SB(1, 1), b3 + hstepB, voffB);
            PG8_WAIT_V(6); PG8_BAR; PG8_MMA(1, 1, At, B1); PG8_BAR;
            }
        }
        if constexpr (ALIGN_EPI) { if (wr == 0) PG8_BAR; }
        E(acc, cur, wr, wc, fr, fq); S.done(cur);
        if (!has_next) break;
#pragma unroll
        for (int a = 0; a < 2; ++a)
#pragma unroll
            for (int b = 0; b < 2; ++b)
#pragma unroll
                for (int m = 0; m < 4; ++m)
#pragma unroll
                    for (int n = 0; n < 2; ++n) acc[a][b][m][n] = (f32x4){0.f, 0.f, 0.f, 0.f};
        cur = nxt; cA = nA; cB = nB; ++ui;
        if constexpr (ALIGN_EPI) { if (wr == 1) PG8_BAR; }
    }
    PG8_WAIT_V(0);
    if constexpr (!ALIGN_EPI) { if (wr == 0) PG8_BAR; }
    PG8_BAR;
#undef PG8_SA
#undef PG8_SB
#undef PG8_STAGE
#undef PG8_LDA
#undef PG8_LDB
#undef PG8_MMA
#undef PG8_WAIT_V
#undef PG8_WAIT_L
#undef PG8_BAR
#undef PG8_SCHED
}
}

typedef unsigned short bf16;
typedef float f32x4 __attribute__((ext_vector_type(4)));
typedef unsigned u32x4 __attribute__((ext_vector_type(4)));
typedef unsigned u32x2 __attribute__((ext_vector_type(2)));
#define LAS __attribute__((address_space(3)))

constexpr int D = 1024, MP = 32768, MS = 1024, M = MP + MS, NTILE = M / 256, NTP = MP / 256;
constexpr int INW = 4096, PW = 512, CW = 512, FF = 2816, FF2 = 5632;
constexpr float EPS = 1e-6f;
constexpr int NWAVES = 8, NTHR = 512;
constexpr int LDS_BYTES = 147456;
#ifndef PHMASK
#define PHMASK 0xFFFF
#endif
#ifndef PROBE
#define PROBE 0
#endif

constexpr size_t O_POOLP = (size_t)M * D;
constexpr size_t O_CONVP = O_POOLP + 2 * 8 * 15 * 512;
constexpr size_t O_FFNP = O_CONVP + 2 * 8 * 2 * 512;
constexpr size_t O_POOLS = O_FFNP + 2 * 8 * 2 * 5632;
constexpr size_t O_CONVS = O_POOLS + 2 * 16 * 15 * 512;
constexpr size_t O_FFNS = O_CONVS + 2 * 16 * 2 * 512;
constexpr size_t O_END = O_FFNS + 2 * 16 * 2 * 5632;

constexpr size_t MiB = 1u << 20;
constexpr size_t WS_SSQ = 1 * MiB;
constexpr size_t WS_W = 4 * MiB, W_LAYER = 28 * MiB;
constexpr size_t WO_IN = 0, WO_UP = 8 * MiB, WO_DN = 19 * MiB, WO_O = 24 * MiB + MiB / 2, WO_CO = 26 * MiB + MiB / 2, WO_MAP = 27 * MiB + MiB / 2;
constexpr size_t WS_XB = 60 * MiB;
constexpr size_t WS_ACTV = 126 * MiB;
constexpr size_t WS_UPOOL = WS_ACTV, WS_CVIN = WS_ACTV + 33 * MiB, WS_GB = WS_ACTV + 66 * MiB, WS_SA = WS_ACTV + 99 * MiB, WS_SB = WS_ACTV + 165 * MiB,
                 WS_MIXED = WS_ACTV + 231 * MiB, WS_GBCV = WS_ACTV + 264 * MiB, WS_MA = WS_ACTV;
constexpr size_t WS_ACT = WS_ACTV;
constexpr size_t WS_HALO = WS_ACTV + 182 * MiB;
constexpr size_t WS_END = WS_ACTV + 297 * MiB;
constexpr int BST_OFF = 131072 + 8192;
constexpr int EX_OFF = 131072;

__device__ __forceinline__ float bf_lo(unsigned w) { return __builtin_bit_cast(float, w << 16); }
__device__ __forceinline__ float bf_hi(unsigned w) { return __builtin_bit_cast(float, w & 0xffff0000u); }
__device__ __forceinline__ unsigned pk2(float lo, float hi) { return pg8::cvt_pk_bf16(lo, hi); }
__device__ __forceinline__ float sigmoidf_(float x) { return __builtin_amdgcn_rcpf(1.f + __builtin_amdgcn_exp2f(-1.44269504f * x)); }
#define UNPACK8(V_, F_) do { F_[0] = bf_lo((V_)[0]); F_[1] = bf_hi((V_)[0]); F_[2] = bf_lo((V_)[1]); F_[3] = bf_hi((V_)[1]); F_[4] = bf_lo((V_)[2]); F_[5] = bf_hi((V_)[2]); F_[6] = bf_lo((V_)[3]); F_[7] = bf_hi((V_)[3]); } while (0)

struct Args { const float* in[19]; float* out; unsigned char* ws; };
typedef const __attribute__((address_space(4))) Args* KArgs;
__device__ __forceinline__ Args load_args(KArgs kp) {
    asm volatile("" : "+s"(kp)); Args a;
#pragma unroll
    for (int i = 0; i < 19; ++i) a.in[i] = kp->in[i];
    a.out = kp->out; a.ws = kp->ws; return a;
}

__device__ __forceinline__ void unit_rstd(const float* ssq, int pm, int wr, int fr, int fq, float (&r)[2][4]) {
    const int lane = fq * 16 + fr;
#pragma unroll
    for (int ai = 0; ai < 2; ++ai) {
        const f32x4* p = (const f32x4*)(ssq + (size_t)(pm * 256 + ai * 128 + wr * 64 + lane) * 16);
        const f32x4 a = p[0], b = p[1], c = p[2], d = p[3];
        const float s = ((a.x + a.y) + (a.z + a.w)) + ((b.x + b.y) + (b.z + b.w)) + ((c.x + c.y) + (c.z + c.w)) + ((d.x + d.y) + (d.z + d.w));
        const float rs = 1.0f / sqrtf(s * (1.0f / D) + EPS);
#pragma unroll
        for (int m = 0; m < 4; ++m) r[ai][m] = __shfl(rs, m * 16 + fr);
    }
}

template <class T> __device__ __forceinline__ T* launder_s(T* p) { asm volatile("" : "+s"(p)); return p; }
struct EpiProj {
    static constexpr bool PERM = true, AFTER_DRAIN = false;
    KArgs kp; int l;
    __device__ __forceinline__ void operator()(const f32x4 (&acc)[2][2][4][2], const pg8::Unit& u, int wr, int wc, int fr, int fq) const {
        const Args a_ = load_args(kp); unsigned char* w_ = a_.ws; float* o_ = a_.out; const float* b_gate = a_.in[7] + (size_t)l * 2 * D; const float* pool_scale = a_.in[9] + (size_t)l * D;
        float r[2][4]; unit_rstd((const float*)(w_ + WS_SSQ), u.pm, wr, fr, fq, r);
        const int pm = u.pm, pn = u.pn;
        const int lc0 = wc * 32 + 8 * fq;
        const bool samp = pm >= NTP;
        if (pn < 4) {
            bf16* O = (bf16*)(w_ + ((pn < 2) ? WS_UPOOL : WS_GB)); const int cb = (pn & 1) * 256 + lc0;
#pragma unroll
            for (int ai = 0; ai < 2; ++ai)
#pragma unroll
                for (int m = 0; m < 4; ++m) { const size_t row = (size_t)pm * 256 + ai * 128 + wr * 64 + m * 16 + fr; const float rr = r[ai][m];
#pragma unroll
                    for (int bj = 0; bj < 2; ++bj) { const f32x4 v0 = acc[ai][bj][m][0] * rr, v1 = acc[ai][bj][m][1] * rr; u32x4 w;
                        w.x = pk2(v0[0], v0[1]); w.y = pk2(v0[2], v0[3]); w.z = pk2(v1[0], v1[1]); w.w = pk2(v1[2], v1[3]);
                        *(u32x4*)(O + row * 512 + cb + bj * 128) = w; } }
            if (pn < 2 && (samp || ((pm & 15) == 15 && wr == 1)) && fr >= 1) {
                float* pool_p = o_ + O_POOLP + (size_t)l * 8 * 15 * 512; float* pool_s = o_ + O_POOLS + (size_t)l * 16 * 15 * 512;
#pragma unroll
                for (int ai = 0; ai < 2; ++ai) { if (!samp && ai == 0) continue;
                    float* sp = samp ? pool_s + ((size_t)((pm - NTP) * 4 + ai * 2 + wr) * 15 + (fr - 1)) * 512 : pool_p + ((size_t)(pm >> 4) * 15 + (fr - 1)) * 512;
                    const float rr = r[ai][3];
#pragma unroll
                    for (int bj = 0; bj < 2; ++bj) { *(f32x4*)(sp + cb + bj * 128) = acc[ai][bj][3][0] * rr; *(f32x4*)(sp + cb + bj * 128 + 4) = acc[ai][bj][3][1] * rr; } }
            }
        } else if (pn < 8) {
            const int cb = (pn - 4) * 128 + lc0; bf16* CVIN = (bf16*)(w_ + WS_CVIN);
            float* conv_p = o_ + O_CONVP + (size_t)l * 8 * 2 * 512; float* conv_s = o_ + O_CONVS + (size_t)l * 16 * 2 * 512;
#pragma unroll
            for (int ai = 0; ai < 2; ++ai)
#pragma unroll
                for (int m = 0; m < 4; ++m) { const size_t row = (size_t)pm * 256 + ai * 128 + wr * 64 + m * 16 + fr; const float rr = r[ai][m] * r[ai][m];
                    const f32x4 v0 = acc[ai][0][m][0] * acc[ai][1][m][0] * rr, v1 = acc[ai][0][m][1] * acc[ai][1][m][1] * rr; u32x4 w;
                    w.x = pk2(v0[0], v0[1]); w.y = pk2(v0[2], v0[3]); w.z = pk2(v1[0], v1[1]); w.w = pk2(v1[2], v1[3]);
                    *(u32x4*)(CVIN + row * 512 + cb) = w;
                    if (m == 3 && fr >= 14 && (samp || ((pm & 15) == 15 && wr == 1 && ai == 1))) {
                        float* sp = samp ? conv_s + ((size_t)((pm - NTP) * 4 + ai * 2 + wr) * 2 + (fr - 14)) * 512 : conv_p + ((size_t)(pm >> 4) * 2 + (fr - 14)) * 512;
                        *(f32x4*)(sp + cb) = v0; *(f32x4*)(sp + cb + 4) = v1; } }
        } else {
            const bool ga = pn < 12; bf16* O = (bf16*)(w_ + (ga ? WS_SA : WS_SB)); const int cb = ((pn - 8) & 3) * 256 + lc0; const float* bg = b_gate + (ga ? 0 : D);
#pragma unroll
            for (int bj = 0; bj < 2; ++bj) { const int c = cb + bj * 128;
                const f32x4 b0 = *(const f32x4*)(bg + c), b1 = *(const f32x4*)(bg + c + 4);
                f32x4 s0 = (f32x4){1.f, 1.f, 1.f, 1.f}, s1 = s0; if (ga) { s0 = *(const f32x4*)(pool_scale + c); s1 = *(const f32x4*)(pool_scale + c + 4); }
#pragma unroll
                for (int ai = 0; ai < 2; ++ai)
#pragma unroll
                    for (int m = 0; m < 4; ++m) { const size_t row = (size_t)pm * 256 + ai * 128 + wr * 64 + m * 16 + fr; const float rr = r[ai][m];
                        const f32x4 x0 = acc[ai][bj][m][0] * rr + b0, x1 = acc[ai][bj][m][1] * rr + b1; f32x4 v0, v1;
#pragma unroll
                        for (int e = 0; e < 4; ++e) { v0[e] = sigmoidf_(x0[e]) * s0[e]; v1[e] = sigmoidf_(x1[e]) * s1[e]; }
                        u32x4 w; w.x = pk2(v0[0], v0[1]); w.y = pk2(v0[2], v0[3]); w.z = pk2(v1[0], v1[1]); w.w = pk2(v1[2], v1[3]);
                        *(u32x4*)(O + row * 1024 + c) = w; } }
        }
    }
};

struct EpiNull {
    static constexpr bool PERM = true, AFTER_DRAIN = false;
    float* sink;
    __device__ __forceinline__ void operator()(const f32x4 (&acc)[2][2][4][2], const pg8::Unit& u, int wr, int wc, int fr, int fq) const {
        float s = 0.f;
#pragma unroll
        for (int ai = 0; ai < 2; ++ai)
#pragma unroll
            for (int bj = 0; bj < 2; ++bj)
#pragma unroll
                for (int m = 0; m < 4; ++m)
#pragma unroll
                    for (int n = 0; n < 2; ++n) s += acc[ai][bj][m][n][0] + acc[ai][bj][m][n][1] + acc[ai][bj][m][n][2] + acc[ai][bj][m][n][3];
        if (s == 123456.789f) sink[0] = s;
    }
};
struct EpiMA {
    static constexpr bool PERM = true, AFTER_DRAIN = false;
    const bf16* SA; bf16* MA;
    __device__ __forceinline__ void operator()(const f32x4 (&acc)[2][2][4][2], const pg8::Unit& u, int wr, int wc, int fr, int fq) const {
        const int cb = u.pn * 256 + wc * 32 + 8 * fq;
#pragma unroll
        for (int ai = 0; ai < 2; ++ai)
#pragma unroll
            for (int m = 0; m < 4; ++m) { const size_t row = (size_t)u.pm * 256 + ai * 128 + wr * 64 + m * 16 + fr;
#pragma unroll
                for (int bj = 0; bj < 2; ++bj) { const size_t o = row * 1024 + cb + bj * 128; const u32x4 s = *(const u32x4*)(SA + o); float f[8]; UNPACK8(s, f);
                    const f32x4 a0 = acc[ai][bj][m][0], a1 = acc[ai][bj][m][1]; u32x4 w;
                    w.x = pk2(a0[0] * f[0], a0[1] * f[1]); w.y = pk2(a0[2] * f[2], a0[3] * f[3]); w.z = pk2(a1[0] * f[4], a1[1] * f[5]); w.w = pk2(a1[2] * f[6], a1[3] * f[7]);
                    *(u32x4*)(MA + o) = w; }
                asm volatile("" ::: "memory"); }
    }
};
struct EpiMerge {
    static constexpr bool PERM = true, AFTER_DRAIN = false;
    const bf16* SB; bf16* MA;
    __device__ __forceinline__ void operator()(const f32x4 (&acc)[2][2][4][2], const pg8::Unit& u, int wr, int wc, int fr, int fq) const {
        const int cb = u.pn * 256 + wc * 32 + 8 * fq;
#pragma unroll
        for (int ai = 0; ai < 2; ++ai)
#pragma unroll
            for (int m = 0; m < 4; ++m) { const size_t row = (size_t)u.pm * 256 + ai * 128 + wr * 64 + m * 16 + fr;
#pragma unroll
                for (int bj = 0; bj < 2; ++bj) { const size_t o = row * 1024 + cb + bj * 128; const u32x4 s = *(const u32x4*)(SB + o); const u32x4 p = *(const u32x4*)(MA + o);
                    float f[8], q[8]; UNPACK8(s, f); UNPACK8(p, q);
                    const f32x4 a0 = acc[ai][bj][m][0], a1 = acc[ai][bj][m][1]; u32x4 w;
                    w.x = pk2(a0[0] * f[0] + q[0], a0[1] * f[1] + q[1]); w.y = pk2(a0[2] * f[2] + q[2], a0[3] * f[3] + q[3]);
                    w.z = pk2(a1[0] * f[4] + q[4], a1[1] * f[5] + q[5]); w.w = pk2(a1[2] * f[6] + q[6], a1[3] * f[7] + q[7]);
                    *(u32x4*)(MA + o) = w; }
                asm volatile("" ::: "memory"); }
    }
};
struct EpiRes {
    static constexpr bool PERM = true, AFTER_DRAIN = false;
    bf16* xb; float* ssq;
    __device__ __forceinline__ void operator()(const f32x4 (&acc)[2][2][4][2], const pg8::Unit& u, int wr, int wc, int fr, int fq) const {
        const int pm = u.pm, cb = u.pn * 256 + wc * 32 + 8 * fq;
#pragma unroll
        for (int ai = 0; ai < 2; ++ai)
#pragma unroll
          for (int mh = 0; mh < 2; ++mh) {
            u32x4 old[2][2];
#pragma unroll
            for (int mm = 0; mm < 2; ++mm)
#pragma unroll
                for (int bj = 0; bj < 2; ++bj) old[mm][bj] = *(const u32x4*)(xb + ((size_t)pm * 256 + ai * 128 + wr * 64 + (2 * mh + mm) * 16 + fr) * D + cb + bj * 128);
#pragma unroll
            for (int mm = 0; mm < 2; ++mm) { const int m = 2 * mh + mm; const size_t row = (size_t)pm * 256 + ai * 128 + wr * 64 + m * 16 + fr; float s = 0.f;
#pragma unroll
                for (int bj = 0; bj < 2; ++bj) { float f[8]; UNPACK8(old[mm][bj], f);
                    const f32x4 a0 = acc[ai][bj][m][0], a1 = acc[ai][bj][m][1]; u32x4 w;
                    w.x = pk2(a0[0] + f[0], a0[1] + f[1]); w.y = pk2(a0[2] + f[2], a0[3] + f[3]); w.z = pk2(a1[0] + f[4], a1[1] + f[5]); w.w = pk2(a1[2] + f[6], a1[3] + f[7]);
                    *(u32x4*)(xb + row * D + cb + bj * 128) = w;
                    float g[8]; UNPACK8(w, g);
                    s += (g[0] * g[0] + g[1] * g[1]) + (g[2] * g[2] + g[3] * g[3]) + (g[4] * g[4] + g[5] * g[5]) + (g[6] * g[6] + g[7] * g[7]); }
                s += __shfl_xor(s, 16); s += __shfl_xor(s, 32);
                if (fq == 0) ssq[row * 16 + u.pn * 4 + wc] = s; }
            asm volatile("" ::: "memory");
          }
    }
};
template <int CTRL> __device__ __forceinline__ float dppf(float v) { return __builtin_bit_cast(float, __builtin_amdgcn_update_dpp(0, __builtin_bit_cast(int, v), CTRL, 0xf, 0xf, true)); }
#define DPP_SHR1 0x111
#define DPP_SHR2 0x112
#define DPP_SHL15 0x10F
#define DPP_SHL14 0x10E
struct EpiUpAct {
    static constexpr bool PERM = true, AFTER_DRAIN = false;
    KArgs kp; LAS unsigned char* ex; int l;
    __device__ __forceinline__ void operator()(const f32x4 (&acc)[2][2][4][2], const pg8::Unit& u, int wr, int wc, int fr, int fq) const {
        const Args a_ = load_args(kp); unsigned char* w_ = a_.ws; float* o_ = a_.out;
        const float* fw = a_.in[15] + (size_t)l * 3 * FF2; const float* fb = a_.in[16] + (size_t)l * FF2; const float* sffn = a_.in[4] + (size_t)l * 16 * 2 * FF2;
        const int pm = u.pm, pn = u.pn; const bool samp = pm >= NTP;
        float r[2][4]; unit_rstd((const float*)(w_ + WS_SSQ), pm, wr, fr, fq, r);
        const int lc0 = wc * 32 + 8 * fq;
        f32x4 x[2][2][4][2];
#pragma unroll
        for (int ai = 0; ai < 2; ++ai)
#pragma unroll
            for (int bj = 0; bj < 2; ++bj)
#pragma unroll
                for (int m = 0; m < 4; ++m)
#pragma unroll
                    for (int n = 0; n < 2; ++n) x[ai][bj][m][n] = acc[ai][bj][m][n] * r[ai][m];
        {
            float* ffn_p = o_ + O_FFNP + (size_t)l * 8 * 2 * FF2; float* ffn_s = o_ + O_FFNS + (size_t)l * 16 * 2 * FF2; float* HALO = (float*)(w_ + WS_HALO) + (size_t)pm * 4 * FF2;
            if (fr >= 14) {
#pragma unroll
                for (int ai = 0; ai < 2; ++ai) {
                    if (samp || ((pm & 15) == 15 && wr == 1 && ai == 1)) {
                        float* sp = samp ? ffn_s + ((size_t)((pm - NTP) * 4 + ai * 2 + wr) * 2 + (fr - 14)) * FF2 : ffn_p + ((size_t)(pm >> 4) * 2 + (fr - 14)) * FF2;
#pragma unroll
                        for (int bj = 0; bj < 2; ++bj) { const int oc = bj * FF + pn * 128 + lc0; *(f32x4*)(sp + oc) = x[ai][bj][3][0]; *(f32x4*)(sp + oc + 4) = x[ai][bj][3][1]; } }
                }
                if (wr == 1) {
#pragma unroll
                    for (int bj = 0; bj < 2; ++bj) { float* hp = HALO + (size_t)(2 + fr - 14) * FF2 + pn * 256 + bj * 128 + lc0; *(f32x4*)hp = x[1][bj][3][0]; *(f32x4*)(hp + 4) = x[1][bj][3][1]; } }
            }
            if (fr < 2 && wr == 0) {
#pragma unroll
                for (int bj = 0; bj < 2; ++bj) { float* hp = HALO + (size_t)fr * FF2 + pn * 256 + bj * 128 + lc0; *(f32x4*)hp = x[0][bj][0][0]; *(f32x4*)(hp + 4) = x[0][bj][0][1]; } }
        }
        if (!samp) {
            if (fr >= 14) {
#pragma unroll
                for (int ai = 0; ai < 2; ++ai)
#pragma unroll
                    for (int bj = 0; bj < 2; ++bj)
#pragma unroll
                        for (int n = 0; n < 2; ++n) *(LAS f32x4*)(ex + ((((2 * ai + wr) * 2 + (fr - 14)) * 256) + bj * 128 + lc0 + 4 * n) * 4) = x[ai][bj][3][n];
            }
            asm volatile("s_waitcnt lgkmcnt(0)" ::: "memory"); __builtin_amdgcn_s_barrier(); asm volatile("" ::: "memory");
        }
        bf16* ACT = (bf16*)(w_ + WS_ACT);
        unsigned pk[2][4][2];
#pragma unroll
        for (int n = 0; n < 2; ++n) {
            const int f = pn * 128 + lc0 + 4 * n;
            const f32x4 wv0 = *(const f32x4*)(fw + f), wv1 = *(const f32x4*)(fw + FF2 + f), wv2 = *(const f32x4*)(fw + 2 * FF2 + f), bv = *(const f32x4*)(fb + f);
            const f32x4 wg0 = *(const f32x4*)(fw + FF + f), wg1 = *(const f32x4*)(fw + FF2 + FF + f), wg2 = *(const f32x4*)(fw + 2 * FF2 + FF + f), bg = *(const f32x4*)(fb + FF + f);
#pragma unroll
            for (int ai = 0; ai < 2; ++ai) {
                const int B = 2 * ai + wr;
                f32x4 e1v = (f32x4){0.f, 0.f, 0.f, 0.f}, e2v = e1v, e1g = e1v, e2g = e1v;
                if (fr < 2) {
                    if (samp) {
                        const float* b0 = sffn + (size_t)((pm - NTP) * 4 + B) * 2 * FF2; const float* b1 = b0 + FF2;
                        const f32x4 v1 = *(const f32x4*)(b1 + f), g1 = *(const f32x4*)(b1 + FF + f);
                        if (fr == 0) { e1v = v1; e1g = g1; e2v = *(const f32x4*)(b0 + f); e2g = *(const f32x4*)(b0 + FF + f); } else { e2v = v1; e2g = g1; }
                    } else if (B > 0) {
                        const LAS unsigned char* eb = ex + ((B - 1) * 2 * 256 + lc0 + 4 * n) * 4;
                        const f32x4 v63 = *(const LAS f32x4*)(eb + 256 * 4), g63 = *(const LAS f32x4*)(eb + 256 * 4 + 128 * 4);
                        if (fr == 0) { e1v = v63; e1g = g63; e2v = *(const LAS f32x4*)eb; e2g = *(const LAS f32x4*)(eb + 128 * 4); } else { e2v = v63; e2g = g63; }
                    }
                }
#pragma unroll
                for (int m = 0; m < 4; ++m) {
                    float av[4];
#pragma unroll
                    for (int e = 0; e < 4; ++e) {
                        const float xv = x[ai][0][m][n][e], xg = x[ai][1][m][n][e];
                        float yv = bv[e] + wv2[e] * xv, yg = bg[e] + wg2[e] * xg;
                        if (m > 0) {
                            const float pv = x[ai][0][m > 0 ? m - 1 : 0][n][e], pg = x[ai][1][m > 0 ? m - 1 : 0][n][e];
                            asm volatile("s_nop 4\n\t"
                                "v_fmac_f32_dpp %0, %2, %4 row_shr:1 row_mask:0xf bank_mask:0xf bound_ctrl:1\n\t"
                                "v_fmac_f32_dpp %1, %3, %6 row_shr:1 row_mask:0xf bank_mask:0xf bound_ctrl:1\n\t"
                                "v_fmac_f32_dpp %0, %2, %5 row_shr:2 row_mask:0xf bank_mask:0xf bound_ctrl:1\n\t"
                                "v_fmac_f32_dpp %1, %3, %7 row_shr:2 row_mask:0xf bank_mask:0xf bound_ctrl:1\n\t"
                                "v_fmac_f32_dpp %0, %8, %4 row_shl:15 row_mask:0xf bank_mask:0xf bound_ctrl:1\n\t"
                                "v_fmac_f32_dpp %1, %9, %6 row_shl:15 row_mask:0xf bank_mask:0xf bound_ctrl:1\n\t"
                                "v_fmac_f32_dpp %0, %8, %5 row_shl:14 row_mask:0xf bank_mask:0xf bound_ctrl:1\n\t"
                                "v_fmac_f32_dpp %1, %9, %7 row_shl:14 row_mask:0xf bank_mask:0xf bound_ctrl:1"
                                : "+v"(yv), "+v"(yg) : "v"(xv), "v"(xg), "v"(wv1[e]), "v"(wv0[e]), "v"(wg1[e]), "v"(wg0[e]), "v"(pv), "v"(pg));
                        } else {
                            yv += wv1[e] * e1v[e] + wv0[e] * e2v[e]; yg += wg1[e] * e1g[e] + wg0[e] * e2g[e];
                            asm volatile("s_nop 4\n\t"
                                "v_fmac_f32_dpp %0, %2, %4 row_shr:1 row_mask:0xf bank_mask:0xf bound_ctrl:1\n\t"
                                "v_fmac_f32_dpp %1, %3, %6 row_shr:1 row_mask:0xf bank_mask:0xf bound_ctrl:1\n\t"
                                "v_fmac_f32_dpp %0, %2, %5 row_shr:2 row_mask:0xf bank_mask:0xf bound_ctrl:1\n\t"
                                "v_fmac_f32_dpp %1, %3, %7 row_shr:2 row_mask:0xf bank_mask:0xf bound_ctrl:1"
                                : "+v"(yv), "+v"(yg) : "v"(xv), "v"(xg), "v"(wv1[e]), "v"(wv0[e]), "v"(wg1[e]), "v"(wg0[e]));
                        }
                        av[e] = yg * sigmoidf_(yg) * yv;
                    }
                    const unsigned lo = pk2(av[0], av[1]), hi = pk2(av[2], av[3]);
                    if (n == 0) { pk[ai][m][0] = lo; pk[ai][m][1] = hi; }
                    else { u32x4 w; w.x = pk[ai][m][0]; w.y = pk[ai][m][1]; w.z = lo; w.w = hi;
                        *(u32x4*)(ACT + ((size_t)pm * 256 + ai * 128 + wr * 64 + m * 16 + fr) * FF + pn * 128 + lc0) = w; }
                }
            }
        }
    }
};

#define XB_TMO      128
#define XB_XCNT(j)  (256  + 64 * (j))
#define XB_XSUB(j)  (1280 + 64 * (j))
#define XB_XGEN(j)  (2304 + 64 * (j))
#define XB_TOP      3328
#define XB_TOPGEN   3392
#define XCD_BAR_WORDS 3456
#define XB_SPIN_CAP (1u << 18)
__device__ __forceinline__ unsigned xb_ld(unsigned* p)              { return __hip_atomic_load(p, __ATOMIC_RELAXED, __HIP_MEMORY_SCOPE_AGENT); }
__device__ __forceinline__ unsigned xb_add(unsigned* p, unsigned v) { return __hip_atomic_fetch_add(p, v, __ATOMIC_RELAXED, __HIP_MEMORY_SCOPE_AGENT); }
__device__ __forceinline__ unsigned xb_xcc_id() { return (unsigned)__builtin_amdgcn_s_getreg((3 << 11) | 20) & 0xFu; }
#define XB_SPIN(cond, bar) do { unsigned _sp = 0; while (cond) { __builtin_amdgcn_s_sleep(1); \
    if ((++_sp & 255u) == 0u) { if (xb_ld(&(bar)[XB_TMO])) break; if (_sp > XB_SPIN_CAP) { atomicAdd(&(bar)[XB_TMO], 1u); break; } } } } while (0)
struct XcdBarrier { unsigned* bar; unsigned x; volatile LAS unsigned* st; };
__device__ __forceinline__ XcdBarrier xcd_barrier_post(unsigned* bar, volatile LAS unsigned* st) {
    XcdBarrier b; b.bar = bar; b.x = xb_xcc_id(); b.st = st;
    if (threadIdx.x == 0) (void)xb_add(&bar[XB_XCNT(b.x)], 1u);
    return b;
}
__device__ __forceinline__ void xcd_barrier_complete(unsigned* bar, unsigned x, unsigned& nloc, unsigned& nx) {
    const unsigned G = gridDim.x * gridDim.y * gridDim.z;
    unsigned sum, cnt, mine, sp = 0u;
    for (;;) {
        sum = 0u; cnt = 0u; mine = 0u;
#pragma unroll
        for (unsigned j = 0; j < 16; ++j) { const unsigned c = xb_ld(&bar[XB_XCNT(j)]); sum += c; cnt += (c > 0u) ? 1u : 0u; mine = (j == x) ? c : mine; }
        if (sum == G) break;
        __builtin_amdgcn_s_sleep(1);
        if ((++sp & 255u) == 0u) { if (xb_ld(&bar[XB_TMO])) break; if (sp > XB_SPIN_CAP) { atomicAdd(&bar[XB_TMO], 1u); break; } }
    }
    nloc = mine > 0u ? mine : 1u; nx = cnt > 0u ? cnt : 1u;
}
__device__ __forceinline__ void xcd_barrier(const XcdBarrier& b) {
    asm volatile("s_waitcnt vmcnt(0)" ::: "memory");
    __syncthreads();
    if (threadIdx.x == 0) {
        unsigned* bar = b.bar;
        __builtin_amdgcn_s_waitcnt(0);
        unsigned nloc = b.st[0], nx = b.st[1];
        if (nloc == 0u) { xcd_barrier_complete(bar, b.x, nloc, nx); b.st[0] = nloc; b.st[1] = nx; }
        const unsigned old = xb_add(&bar[XB_XSUB(b.x)], 1u);
        const unsigned gen = old / nloc;
        if (old + 1u == (gen + 1u) * nloc) {
            __builtin_amdgcn_fence(__ATOMIC_RELEASE, "agent");
            asm volatile("s_waitcnt vmcnt(0)" ::: "memory");
            const unsigned og = xb_add(&bar[XB_TOP], 1u);
            const unsigned tg = og / nx;
            if (og + 1u == (tg + 1u) * nx) xb_add(&bar[XB_TOPGEN], 1u);
            else XB_SPIN(xb_ld(&bar[XB_TOPGEN]) == tg, bar);
            __builtin_amdgcn_fence(__ATOMIC_ACQUIRE, "agent");
            xb_add(&bar[XB_XGEN(b.x)], 1u);
            asm volatile("s_waitcnt vmcnt(0)" ::: "memory");
        } else {
            XB_SPIN(xb_ld(&bar[XB_XGEN(b.x)]) == gen, bar);
            __builtin_amdgcn_fence(__ATOMIC_ACQUIRE, "agent");
            asm volatile("s_waitcnt vmcnt(0)" ::: "memory");
        }
    }
    __syncthreads();
}


struct Frame {
    LAS unsigned char* lds;
    int tid, lane, wave, G, bid;
};

__device__ __forceinline__ float wave_sum(float v) {
#pragma unroll
    for (int o = 1; o < 64; o <<= 1) v += __shfl_xor(v, o);
    return v;
}

__device__ __forceinline__ void tr_item(const float* W, int ldw, int srccol, int ks0, const float* gs, bf16* WT, int Kd, int dst_row, int kd0, bool zero, LAS float* scr, int lane) {
    if (!zero) {
#pragma unroll 8
        for (int i = 0; i < 32; ++i) { const int kk = 2 * i + (lane >> 5); float v = W[(size_t)(ks0 + kk) * ldw + srccol + (lane & 31)]; if (gs) v *= gs[ks0 + kk]; scr[kk * 33 + (lane & 31)] = v; }
    }
    asm volatile("s_waitcnt lgkmcnt(0)" ::: "memory");
    const int c = lane & 7;
#pragma unroll
    for (int j = 0; j < 4; ++j) { const int n = (lane >> 3) + 8 * j; const LAS float* s = scr + (8 * c) * 33 + n;
        u32x4 o;
        if (zero) { o = (u32x4){0u, 0u, 0u, 0u}; }
        else { o.x = pk2(s[0 * 33], s[1 * 33]); o.y = pk2(s[2 * 33], s[3 * 33]); o.z = pk2(s[4 * 33], s[5 * 33]); o.w = pk2(s[6 * 33], s[7 * 33]); }
        *(u32x4*)(WT + (size_t)(dst_row + n) * Kd + kd0 + 8 * c) = o; }
    asm volatile("s_waitcnt lgkmcnt(0)" ::: "memory");
}

constexpr int I_IN = 16 * 128, I_UP = 16 * 176, I_DN = 44 * 32, I_O = 16 * 32, I_CO = 8 * 32, I_MAP = 128;
constexpr int ITEMS_L = I_IN + I_UP + I_DN + I_O + I_CO + I_MAP;

__device__ __forceinline__ void p0_prologue(const Frame& F, const Args& a) {
    int tid_ = threadIdx.x; asm volatile("" : "+v"(tid_)); const int TID = tid_, LANE = tid_ & 63, WAVE = __builtin_amdgcn_readfirstlane(tid_ >> 6);
    LAS float* scr = (LAS float*)(F.lds + WAVE * 16384);
    const int gw = F.bid * NWAVES + WAVE, NGW = F.G * NWAVES;
    unsigned char* ws = a.ws;
    for (int it = gw; it < 2 * ITEMS_L; it += NGW) {
        const int l = it / ITEMS_L; int r = it % ITEMS_L;
        unsigned char* wl = ws + WS_W + (size_t)l * W_LAYER;
        if (r < I_IN) { const int kb = r / 128, n0 = (r % 128) * 32;
            const int src = (n0 < 1024 || n0 >= 2048) ? n0 : 1024 + 512 * (((n0 - 1024) % 256) / 128) + 128 * ((n0 - 1024) / 256) + (n0 % 128);
            tr_item(a.in[6] + (size_t)l * D * INW, INW, src, kb * 64, a.in[5] + l * D, (bf16*)(wl + WO_IN), D, n0, kb * 64, false, scr, LANE); continue; } r -= I_IN;
        if (r < I_UP) { const int kb = r / 176, n0 = (r % 176) * 32;
            const int src = ((n0 % 256) / 128) * FF + 128 * (n0 / 256) + (n0 % 128);
            tr_item(a.in[14] + (size_t)l * D * FF2, FF2, src, kb * 64, a.in[13] + l * D, (bf16*)(wl + WO_UP), D, n0, kb * 64, false, scr, LANE); continue; } r -= I_UP;
        if (r < I_DN) { const int kb = r / 32, n0 = (r % 32) * 32;
            tr_item(a.in[17] + (size_t)l * FF * D, D, n0, kb * 64, nullptr, (bf16*)(wl + WO_DN), FF, n0, kb * 64, false, scr, LANE); continue; } r -= I_DN;
        if (r < I_O) { const int kb = r / 32, n0 = (r % 32) * 32;
            tr_item(a.in[12] + (size_t)l * D * D, D, n0, kb * 64, nullptr, (bf16*)(wl + WO_O), D, n0, kb * 64, false, scr, LANE); continue; } r -= I_O;
        if (r < I_CO) { const int kb = r / 32, n0 = (r % 32) * 32;
            tr_item(a.in[11] + (size_t)l * CW * D, D, n0, kb * 64, nullptr, (bf16*)(wl + WO_CO), CW, n0, kb * 64, false, scr, LANE); continue; } r -= I_CO;
        { const int g = r / 32, kb = (r % 32) / 8, nb = r % 8; const bool zero = (kb >> 1) != (g & 1);
            tr_item(a.in[8] + (size_t)l * 4 * 128 * 256 + (size_t)g * 128 * 256, 256, nb * 32, (kb & 1) * 64, nullptr, (bf16*)(wl + WO_MAP), 256, g * 256 + nb * 32, kb * 64, zero, scr, LANE); }
    }
    bf16* XB = (bf16*)(ws + WS_XB); float* SSQ = (float*)(ws + WS_SSQ);
    for (int m = gw; m < M; m += NGW) {
        const float* xrow = m < MP ? a.in[0] + (size_t)m * D : a.in[1] + (size_t)(m - MP) * D;
        const f32x4* xr = (const f32x4*)xrow + LANE; f32x4 v[4]; float s = 0.f;
#pragma unroll
        for (int j = 0; j < 4; ++j) { v[j] = xr[64 * j]; s += (v[j].x * v[j].x + v[j].y * v[j].y) + (v[j].z * v[j].z + v[j].w * v[j].w); }
        s = wave_sum(s);
        u32x2* o8 = (u32x2*)(XB + (size_t)m * D) + LANE;
#pragma unroll
        for (int j = 0; j < 4; ++j) { u32x2 w; w.x = pk2(v[j].x, v[j].y); w.y = pk2(v[j].z, v[j].w); o8[64 * j] = w; }
        if (LANE < 16) SSQ[(size_t)m * 16 + LANE] = LANE == 0 ? s : 0.f;
    }
}

constexpr int MIX_RB = 33;
__device__ __forceinline__ void mix_elt(const Frame& F, const Args& a, int l) {
    int tid_ = threadIdx.x; asm volatile("" : "+v"(tid_)); const int TID = tid_;
    unsigned char* ws = a.ws;
    const bf16* UPOOL = (const bf16*)(ws + WS_UPOOL); const bf16* CVIN = (const bf16*)(ws + WS_CVIN); const bf16* GB = (const bf16*)(ws + WS_GB);
    bf16* MIXED = (bf16*)(ws + WS_MIXED); bf16* GBCV = (bf16*)(ws + WS_GBCV);
    const float* spool = a.in[2] + (size_t)l * 16 * 15 * 512; const float* sconv = a.in[3] + (size_t)l * 16 * 2 * 512; const float* cw = a.in[10] + (size_t)l * 3 * 512;
    const int nrb = (M + MIX_RB - 1) / MIX_RB, total = nrb * 128, stride = F.G * NTHR;
    for (int idx = F.bid * NTHR + TID; idx < total; idx += stride) {
        const int rb = idx >> 7, c8 = idx & 127;
        const int r0 = rb * MIX_RB, r1 = (r0 + MIX_RB) < M ? (r0 + MIX_RB) : M;
        if (c8 < 64) {
            const int ch0 = c8 * 8, win = 2 << (c8 >> 4);
            float sum[8], f[8];
            for (int row = r0; row < r1; ++row) {
                const bool samp = row >= MP; int t, sq = 0;
                if (!samp) t = row & 4095; else { const int sr = row - MP; sq = sr >> 6; t = sr & 63; }
                const u32x4 uw = *(const u32x4*)(UPOOL + (size_t)row * 512 + ch0);
                if (row == r0 || t == 0) {
#pragma unroll
                    for (int e = 0; e < 8; ++e) sum[e] = 0.f;
                    for (int j = 1; j < win; ++j) {
                        const int tt = t - j;
                        if (tt >= 0) { const u32x4 w = *(const u32x4*)(UPOOL + (size_t)(row - j) * 512 + ch0); UNPACK8(w, f);
#pragma unroll
                            for (int e = 0; e < 8; ++e) sum[e] += f[e]; }
                        else if (samp) { const float* p = spool + ((size_t)sq * 15 + 15 + tt) * 512 + ch0; const f32x4 p0 = *(const f32x4*)p, p1 = *(const f32x4*)(p + 4);
#pragma unroll
                            for (int e = 0; e < 4; ++e) { sum[e] += p0[e]; sum[4 + e] += p1[e]; } }
                    }
                } else {
                    const int tt = t - win;
                    if (tt >= 0) { const u32x4 w = *(const u32x4*)(UPOOL + (size_t)(row - win) * 512 + ch0); UNPACK8(w, f);
#pragma unroll
                        for (int e = 0; e < 8; ++e) sum[e] -= f[e]; }
                    else if (samp) { const float* p = spool + ((size_t)sq * 15 + 15 + tt) * 512 + ch0; const f32x4 p0 = *(const f32x4*)p, p1 = *(const f32x4*)(p + 4);
#pragma unroll
                        for (int e = 0; e < 4; ++e) { sum[e] -= p0[e]; sum[4 + e] -= p1[e]; } }
                }
                UNPACK8(uw, f);
                const float cnt = samp ? (float)win : (float)(win < t + 1 ? win : t + 1), inv = 1.0f / cnt;
                float o[8];
#pragma unroll
                for (int e = 0; e < 8; ++e) { sum[e] += f[e]; o[e] = sum[e] * inv - f[e]; }
                u32x4 w; w.x = pk2(o[0], o[1]); w.y = pk2(o[2], o[3]); w.z = pk2(o[4], o[5]); w.w = pk2(o[6], o[7]);
                *(u32x4*)(MIXED + (size_t)row * 512 + ch0) = w;
            }
        } else {
            const int ch0 = (c8 - 64) * 8;
            float w0[8], w1[8], w2[8];
#pragma unroll
            for (int h = 0; h < 2; ++h) { const f32x4 a0 = *(const f32x4*)(cw + ch0 + 4 * h), a1 = *(const f32x4*)(cw + 512 + ch0 + 4 * h), a2 = *(const f32x4*)(cw + 1024 + ch0 + 4 * h);
#pragma unroll
                for (int e = 0; e < 4; ++e) { w0[4 * h + e] = a0[e]; w1[4 * h + e] = a1[e]; w2[4 * h + e] = a2[e]; } }
            float x0[8], x1[8], x2[8], gb[8];
#pragma unroll
            for (int e = 0; e < 8; ++e) { x1[e] = 0.f; x2[e] = 0.f; }
            for (int row = r0; row < r1; ++row) {
                const bool samp = row >= MP; int t, sq = 0;
                if (!samp) t = row & 4095; else { const int sr = row - MP; sq = sr >> 6; t = sr & 63; }
                { const u32x4 w = *(const u32x4*)(CVIN + (size_t)row * 512 + ch0); UNPACK8(w, x0); }
                { const u32x4 w = *(const u32x4*)(GB + (size_t)row * 512 + ch0); UNPACK8(w, gb); }
                if (row == r0 || t == 0) {
                    if (t >= 1) { const u32x4 w = *(const u32x4*)(CVIN + (size_t)(row - 1) * 512 + ch0); UNPACK8(w, x1); }
                    else if (samp) { const float* p = sconv + ((size_t)sq * 2 + 1) * 512 + ch0; const f32x4 p0 = *(const f32x4*)p, p1 = *(const f32x4*)(p + 4);
#pragma unroll
                        for (int e = 0; e < 4; ++e) { x1[e] = p0[e]; x1[4 + e] = p1[e]; } }
                    else {
#pragma unroll
                        for (int e = 0; e < 8; ++e) x1[e] = 0.f; }
                    if (t >= 2) { const u32x4 w = *(const u32x4*)(CVIN + (size_t)(row - 2) * 512 + ch0); UNPACK8(w, x2); }
                    else if (samp) { const float* p = sconv + ((size_t)sq * 2 + t) * 512 + ch0; const f32x4 p0 = *(const f32x4*)p, p1 = *(const f32x4*)(p + 4);
#pragma unroll
                        for (int e = 0; e < 4; ++e) { x2[e] = p0[e]; x2[4 + e] = p1[e]; } }
                    else {
#pragma unroll
                        for (int e = 0; e < 8; ++e) x2[e] = 0.f; }
                }
                float o[8];
#pragma unroll
                for (int e = 0; e < 8; ++e) { o[e] = gb[e] * (w0[e] * x2[e] + w1[e] * x1[e] + w2[e] * x0[e]); x2[e] = x1[e]; x1[e] = x0[e]; }
                u32x4 w; w.x = pk2(o[0], o[1]); w.y = pk2(o[2], o[3]); w.z = pk2(o[4], o[5]); w.w = pk2(o[6], o[7]);
                *(u32x4*)(GBCV + (size_t)row * 512 + ch0) = w;
            }
        }
    }
}

__device__ __forceinline__ void ffn_fixup(const Frame& F, const Args& a, int l) {
    int tid_ = threadIdx.x; asm volatile("" : "+v"(tid_)); const int TID = tid_;
    unsigned char* ws = a.ws;
    const float* HALO = (const float*)(ws + WS_HALO); bf16* ACT = (bf16*)(ws + WS_ACT);
    const float* fw = a.in[15] + (size_t)l * 3 * FF2; const float* fb = a.in[16] + (size_t)l * FF2;
    const int total = NTP * 2 * 352, stride = F.G * NTHR;
    for (int idx = F.bid * NTHR + TID; idx < total; idx += stride) {
        const int pm = idx / 704, rem = idx % 704, rr = rem / 352, c8 = rem % 352;
        if ((pm & 15) == 0) continue;
        const int f0 = c8 * 8, pn = f0 >> 7, j0 = f0 & 127;
        float res[2][8];
#pragma unroll
        for (int h = 0; h < 2; ++h) {
            const int pc = pn * 256 + h * 128 + j0, oc = h * FF + f0;
            const float* p0 = HALO + ((size_t)pm * 4 + rr) * FF2 + pc;
            const float* p1 = rr == 1 ? HALO + ((size_t)pm * 4 + 0) * FF2 + pc : HALO + ((size_t)(pm - 1) * 4 + 3) * FF2 + pc;
            const float* p2 = rr == 1 ? HALO + ((size_t)(pm - 1) * 4 + 3) * FF2 + pc : HALO + ((size_t)(pm - 1) * 4 + 2) * FF2 + pc;
#pragma unroll
            for (int q = 0; q < 2; ++q) { const f32x4 x0 = *(const f32x4*)(p0 + 4 * q), x1 = *(const f32x4*)(p1 + 4 * q), x2 = *(const f32x4*)(p2 + 4 * q);
                const f32x4 w0 = *(const f32x4*)(fw + oc + 4 * q), w1 = *(const f32x4*)(fw + FF2 + oc + 4 * q), w2 = *(const f32x4*)(fw + 2 * FF2 + oc + 4 * q), b = *(const f32x4*)(fb + oc + 4 * q);
#pragma unroll
                for (int e = 0; e < 4; ++e) res[h][4 * q + e] = w0[e] * x2[e] + w1[e] * x1[e] + w2[e] * x0[e] + b[e]; }
        }
        float o[8];
#pragma unroll
        for (int e = 0; e < 8; ++e) o[e] = res[1][e] * sigmoidf_(res[1][e]) * res[0][e];
        u32x4 w; w.x = pk2(o[0], o[1]); w.y = pk2(o[2], o[3]); w.z = pk2(o[4], o[5]); w.w = pk2(o[6], o[7]);
        *(u32x4*)(ACT + ((size_t)pm * 256 + rr) * FF + f0) = w;
    }
}

__device__ __forceinline__ void final_norm(const Frame& F, const Args& a) {
    int tid_ = threadIdx.x; asm volatile("" : "+v"(tid_)); const int LANE = tid_ & 63, WAVE = __builtin_amdgcn_readfirstlane(tid_ >> 6);
    const float* SSQ = (const float*)(a.ws + WS_SSQ); const bf16* XB = (const bf16*)(a.ws + WS_XB); const float* g = a.in[18];
    const int gw = F.bid * NWAVES + WAVE, NGW = F.G * NWAVES;
    f32x4 gv[2][2];
#pragma unroll
    for (int j = 0; j < 2; ++j) { gv[j][0] = *(const f32x4*)(g + 512 * j + 8 * LANE); gv[j][1] = *(const f32x4*)(g + 512 * j + 8 * LANE + 4); }
    for (int m = gw; m < M; m += NGW) {
        float s = LANE < 16 ? SSQ[(size_t)m * 16 + LANE] : 0.f;
        s = wave_sum(s);
        const float rs = 1.0f / sqrtf(s * (1.0f / D) + EPS);
        float* orow = a.out + (size_t)m * D;
#pragma unroll
        for (int j = 0; j < 2; ++j) { const u32x4 w = *(const u32x4*)(XB + (size_t)m * D + 512 * j + 8 * LANE); float f[8]; UNPACK8(w, f);
            f32x4 o0, o1;
#pragma unroll
            for (int e = 0; e < 4; ++e) { o0[e] = f[e] * rs * gv[j][0][e]; o1[e] = f[4 + e] * rs * gv[j][1][e]; }
            *(f32x4*)(orow + 512 * j + 8 * LANE) = o0; *(f32x4*)(orow + 512 * j + 8 * LANE + 4) = o1; }
    }
}

template <int MODE>
__device__ __forceinline__ void small_gemm(const Frame& F, const bf16* A, int lda, int grp_cols, const bf16* Bt, int K, const bf16* G0, bf16* O, float* ssq) {
    int tid_ = threadIdx.x; asm volatile("" : "+v"(tid_)); const int TID = tid_, LANE = tid_ & 63, WAVE = __builtin_amdgcn_readfirstlane(tid_ >> 6);
    const int rb = WAVE >> 2, cg = WAVE & 3, fr = LANE & 15, fq = LANE >> 4;
    LAS float* red = (LAS float*)(F.lds + EX_OFF);
    for (int T = F.bid; T < 256; T += F.G) {
        const int tr = T >> 3, tc = T & 7;
        const int row = MP + tr * 32 + rb * 16 + fr, c0 = tc * 128 + cg * 32;
        const bf16* ap = A + (size_t)row * lda + (grp_cols ? (tc >> 2) * grp_cols : 0) + 8 * fq;
        const bf16* bp0 = Bt + (size_t)(c0 + fr) * K + 8 * fq; const bf16* bp1 = bp0 + (size_t)16 * K;
        f32x4 acc0 = (f32x4){0.f, 0.f, 0.f, 0.f}, acc1 = acc0;
#pragma unroll 8
        for (int k = 0; k < K; k += 32) {
            const pg8::bf16x8 a = *(const pg8::bf16x8*)(ap + k), b0 = *(const pg8::bf16x8*)(bp0 + k), b1 = *(const pg8::bf16x8*)(bp1 + k);
            acc0 = __builtin_amdgcn_mfma_f32_16x16x32_bf16(b0, a, acc0, 0, 0, 0);
            acc1 = __builtin_amdgcn_mfma_f32_16x16x32_bf16(b1, a, acc1, 0, 0, 0);
        }
        float ssum = 0.f;
#pragma unroll
        for (int n2 = 0; n2 < 2; ++n2) {
            const f32x4 av = n2 ? acc1 : acc0; const size_t o = (size_t)row * D + c0 + 16 * n2 + 4 * fq;
            if (MODE == 0) { const u32x2 g = *(const u32x2*)(G0 + o); u32x2 w; w.x = pk2(av[0] * bf_lo(g.x), av[1] * bf_hi(g.x)); w.y = pk2(av[2] * bf_lo(g.y), av[3] * bf_hi(g.y)); *(u32x2*)(O + o) = w; }
            else if (MODE == 1) { const u32x2 g = *(const u32x2*)(G0 + o); const u32x2 q = *(const u32x2*)(O + o); u32x2 w;
                w.x = pk2(av[0] * bf_lo(g.x) + bf_lo(q.x), av[1] * bf_hi(g.x) + bf_hi(q.x)); w.y = pk2(av[2] * bf_lo(g.y) + bf_lo(q.y), av[3] * bf_hi(g.y) + bf_hi(q.y)); *(u32x2*)(O + o) = w; }
            else { const u32x2 q = *(const u32x2*)(O + o); u32x2 w; w.x = pk2(av[0] + bf_lo(q.x), av[1] + bf_hi(q.x)); w.y = pk2(av[2] + bf_lo(q.y), av[3] + bf_hi(q.y)); *(u32x2*)(O + o) = w;
                const float g0 = bf_lo(w.x), g1 = bf_hi(w.x), g2 = bf_lo(w.y), g3 = bf_hi(w.y); ssum += (g0 * g0 + g1 * g1) + (g2 * g2 + g3 * g3); }
        }
        if (MODE == 2) {
            ssum += __shfl_xor(ssum, 16); ssum += __shfl_xor(ssum, 32);
            __syncthreads();
            if (fq == 0) red[WAVE * 16 + fr] = ssum;
            __syncthreads();
            if (TID < 32) { const int b = TID >> 4, r = TID & 15; const float t = (red[(b * 4 + 0) * 16 + r] + red[(b * 4 + 1) * 16 + r]) + (red[(b * 4 + 2) * 16 + r] + red[(b * 4 + 3) * 16 + r]);
                float* sp = ssq + (size_t)(MP + tr * 32 + TID) * 16; sp[tc] = t; if (tc == 0) { *(f32x4*)(sp + 8) = (f32x4){0.f, 0.f, 0.f, 0.f}; *(f32x4*)(sp + 12) = (f32x4){0.f, 0.f, 0.f, 0.f}; } }
        }
    }
}

__global__ void __launch_bounds__(NTHR, 2) fwd_mega(Args a_unused) {
    extern __shared__ __attribute__((aligned(16))) unsigned char lds_raw[];
    cg::grid_group grid = cg::this_grid();
    KArgs kp = (KArgs)__builtin_amdgcn_kernarg_segment_ptr();
    Frame F;
    F.lds = (LAS unsigned char*)lds_raw;
    F.tid = threadIdx.x; F.lane = F.tid & 63; F.wave = __builtin_amdgcn_readfirstlane(F.tid >> 6);
    F.G = gridDim.x; F.bid = blockIdx.x;
    { const Args a = load_args(kp); unsigned* barw = (unsigned*)a.ws;
      if (blockIdx.x == 0) for (int i = threadIdx.x; i < XCD_BAR_WORDS; i += NTHR) __hip_atomic_store(barw + i, 0u, __ATOMIC_RELAXED, __HIP_MEMORY_SCOPE_AGENT);
      volatile LAS unsigned* bst = (volatile LAS unsigned*)(F.lds + BST_OFF);
      if (threadIdx.x < 4) bst[threadIdx.x] = 0u; }
    __syncthreads();

    if constexpr (PHMASK & 1) { const Args a = load_args(kp); p0_prologue(F, a); }
    if constexpr (PROBE == 2) { __syncthreads(); const Args a = load_args(kp); p0_prologue(F, a); }
    grid.sync();
    { const Args a = load_args(kp); (void)xcd_barrier_post((unsigned*)a.ws, (volatile LAS unsigned*)(F.lds + BST_OFF)); }
#define GRID_BAR() do { const Args a_ = load_args(kp); XcdBarrier b_; b_.bar = (unsigned*)a_.ws; b_.x = xb_xcc_id(); b_.st = (volatile LAS unsigned*)(F.lds + BST_OFF); xcd_barrier(b_); } while (0)

#pragma unroll 1
    for (int l = 0; l < 2; ++l) {
        if constexpr (PHMASK & 2) {
            const Args a = load_args(kp); unsigned char* ws = a.ws; unsigned char* wl = ws + WS_W + (size_t)l * W_LAYER;
            pg8::Gemm g{(const bf16*)(ws + WS_XB), (const bf16*)(wl + WO_IN), M, INW, D, D, 0, 0}; pg8::StaticOrder S; S.init(M, INW, F.G, F.bid);
            EpiProj E{kp, l};
            pg8::gemm_phase<EpiProj, pg8::StaticOrder, true, true>(F.lds, g, S, E);
            if constexpr (PROBE == 4) { __syncthreads(); pg8::gemm_phase<EpiProj, pg8::StaticOrder, true, true>(F.lds, g, S, E); }
            if constexpr (PROBE == 8) { __syncthreads(); EpiNull EN{(float*)(ws + WS_HALO)}; pg8::gemm_phase<EpiNull, pg8::StaticOrder, true, true>(F.lds, g, S, EN); }
        }
        GRID_BAR();
_Pragma("unroll 1")
        for (int rep = 0; rep < (PROBE == 3 ? 2 : 1); ++rep) { const Args a = load_args(kp); mix_elt(F, a, l); }
        GRID_BAR();
        if constexpr (PHMASK & 8) {
            const Args a = load_args(kp); unsigned char* ws = a.ws; unsigned char* wl = ws + WS_W + (size_t)l * W_LAYER;
            pg8::Gemm g{(const bf16*)(ws + WS_MIXED), (const bf16*)(wl + WO_MAP), MP, D, 256, PW, 1, 512}; pg8::StaticOrder S; S.init(MP, D, F.G, F.bid);
            EpiMA E{(const bf16*)(ws + WS_SA), (bf16*)(ws + WS_MA)};
            pg8::gemm_phase<EpiMA, pg8::StaticOrder, true, true>(F.lds, g, S, E);
            small_gemm<0>(F, (const bf16*)(ws + WS_MIXED), PW, 256, (const bf16*)(wl + WO_MAP), 256, (const bf16*)(ws + WS_SA), (bf16*)(ws + WS_MA), nullptr);
        }
        if constexpr (PHMASK & 16) {
            const Args a = load_args(kp); unsigned char* ws = a.ws; unsigned char* wl = ws + WS_W + (size_t)l * W_LAYER;
            pg8::Gemm g{(const bf16*)(ws + WS_GBCV), (const bf16*)(wl + WO_CO), MP, D, CW, CW, 0, 0}; pg8::StaticOrder S; S.init(MP, D, F.G, F.bid);
            EpiMerge E{(const bf16*)(ws + WS_SB), (bf16*)(ws + WS_MA)};
            pg8::gemm_phase<EpiMerge, pg8::StaticOrder, true, true>(F.lds, g, S, E);
            small_gemm<1>(F, (const bf16*)(ws + WS_GBCV), CW, 0, (const bf16*)(wl + WO_CO), CW, (const bf16*)(ws + WS_SB), (bf16*)(ws + WS_MA), nullptr);
        }
        GRID_BAR();
        if constexpr (PHMASK & 32) {
            const Args a = load_args(kp); unsigned char* ws = a.ws; unsigned char* wl = ws + WS_W + (size_t)l * W_LAYER;
            pg8::Gemm g{(const bf16*)(ws + WS_MA), (const bf16*)(wl + WO_O), MP, D, D, D, 0, 0}; pg8::StaticOrder S; S.init(MP, D, F.G, F.bid);
            EpiRes E{(bf16*)(ws + WS_XB), (float*)(ws + WS_SSQ)};
            pg8::gemm_phase<EpiRes, pg8::StaticOrder, true, true>(F.lds, g, S, E);
            small_gemm<2>(F, (const bf16*)(ws + WS_MA), D, 0, (const bf16*)(wl + WO_O), D, nullptr, (bf16*)(ws + WS_XB), (float*)(ws + WS_SSQ));
        }
        GRID_BAR();
        if constexpr (PHMASK & 64) {
            const Args a = load_args(kp); unsigned char* ws = a.ws; unsigned char* wl = ws + WS_W + (size_t)l * W_LAYER;
            pg8::Gemm g{(const bf16*)(ws + WS_XB), (const bf16*)(wl + WO_UP), M, FF2, D, D, 0, 0}; pg8::StaticOrder S; S.init(M, FF2, F.G, F.bid);
            EpiUpAct E{kp, F.lds + EX_OFF, l};
            pg8::gemm_phase<EpiUpAct, pg8::StaticOrder, true, true>(F.lds, g, S, E);
            if constexpr (PROBE == 5) { __syncthreads(); pg8::gemm_phase<EpiUpAct, pg8::StaticOrder, true, true>(F.lds, g, S, E); }
        }
        GRID_BAR();
        if constexpr (PHMASK & 128) { const Args a = load_args(kp); ffn_fixup(F, a, l); }
        GRID_BAR();
        if constexpr (PHMASK & 256) {
            const Args a = load_args(kp); unsigned char* ws = a.ws; unsigned char* wl = ws + WS_W + (size_t)l * W_LAYER;
            pg8::Gemm g{(const bf16*)(ws + WS_ACT), (const bf16*)(wl + WO_DN), MP, D, FF, FF, 0, 0}; pg8::StaticOrder S; S.init(MP, D, F.G, F.bid);
            EpiRes E{(bf16*)(ws + WS_XB), (float*)(ws + WS_SSQ)};
            pg8::gemm_phase<EpiRes, pg8::StaticOrder, true, true>(F.lds, g, S, E);
            small_gemm<2>(F, (const bf16*)(ws + WS_ACT), FF, 0, (const bf16*)(wl + WO_DN), FF, nullptr, (bf16*)(ws + WS_XB), (float*)(ws + WS_SSQ));
        }
        GRID_BAR();
    }
    if constexpr (PHMASK & 512) { const Args a = load_args(kp); final_norm(F, a); }
    if constexpr (PROBE == 1) { for (int i = 0; i < 16; ++i) GRID_BAR(); }
}

extern "C" void kernel_launch(void* const* d_in, const int* in_sizes, int n_in, void* d_out, int out_size, void* d_ws, size_t ws_size, hipStream_t stream) {
    static int grid = 0;
    if (grid == 0) {
        if (n_in != 19 || in_sizes[0] != MP * D || (size_t)out_size != O_END || ws_size < WS_END) {
            fprintf(stderr, "kernel_launch: unexpected shapes: n_in %d in0 %d out %d ws %zu (need %zu)\n", n_in, n_in > 0 ? in_sizes[0] : -1, out_size, ws_size, (size_t)WS_END); grid = -1; return; }
        int dev = 0, cus = 0, per_cu = 0;
        hipGetDevice(&dev); hipDeviceGetAttribute(&cus, hipDeviceAttributeMultiprocessorCount, dev);
        if (hipFuncSetAttribute((const void*)fwd_mega, hipFuncAttributeMaxDynamicSharedMemorySize, LDS_BYTES) != hipSuccess) { fprintf(stderr, "kernel_launch: hipFuncSetAttribute failed\n"); grid = -1; return; }
        if (hipOccupancyMaxActiveBlocksPerMultiprocessor(&per_cu, (const void*)fwd_mega, NTHR, LDS_BYTES) != hipSuccess || per_cu < 1) { fprintf(stderr, "kernel_launch: occupancy query says %d\n", per_cu); per_cu = 1; }
        (void)hipGetLastError();
        grid = cus;
    }
    if (grid < 0) return;
    Args a{};
    for (int i = 0; i < 19; ++i) a.in[i] = (const float*)d_in[i];
    a.out = (float*)d_out; a.ws = (unsigned char*)d_ws;
    void* args[] = {&a};
    hipError_t e = hipLaunchCooperativeKernel((const void*)fwd_mega, dim3(grid), dim3(NTHR), args, LDS_BYTES, stream);
    if (e != hipSuccess) fprintf(stderr, "cooperative launch failed: %s (grid %d)\n", hipGetErrorString(e), grid);
}
```

```cpp
#include <hip/hip_runtime.h>
#include <hip/hip_cooperative_groups.h>
#include <cstdio>
#include <cstdint>
namespace cg = cooperative_groups;

namespace pg8 {
#define PG8_LAS __attribute__((address_space(3)))
typedef unsigned short bf16_t;
typedef short bf16x8 __attribute__((ext_vector_type(8)));
typedef float f32x4 __attribute__((ext_vector_type(4)));
typedef unsigned u32x4 __attribute__((ext_vector_type(4)));
constexpr int BM = 256, BK = 64, HALF = 128, HTB = HALF * BK * 2, STAGE_BYTES = 8 * HTB, NXCD = 8, WGM = 8;

__host__ __device__ __forceinline__ int lds_byte(int r, int c) { const int st = (r >> 4) * 2 + (c >> 5), rr = r & 15, cc = c & 31, ob = rr * 64 + cc * 2; return st * 1024 + (ob ^ (((ob >> 9) & 1) << 5)); }
__host__ __device__ __forceinline__ void stage_rc(int b, int& R, int& C) { const int st = b / 1024, sb = b % 1024, swz = sb ^ (((sb >> 9) & 1) << 5); R = (st >> 1) * 16 + swz / 64; C = (st & 1) * 32 + (swz % 64) / 2; }
__host__ __device__ __forceinline__ int perm32(int rho) { const int n = rho >> 4, i = rho & 15; return 8 * (i >> 2) + 4 * n + (i & 3); }

struct Unit { int pm, pn; };
struct Gemm { const bf16_t* A; const bf16_t* Bt; int M, N, K, lda, apn_shift, apn_bytes; };

struct StaticOrder {
    int nM, nN, nwg, G, c;
    __host__ __device__ void init(int M, int N, int G_, int c_) { nM = M / BM; nN = N / BM; nwg = nM * nN; G = G_; c = c_; }
    __host__ __device__ bool next(int i, Unit& u) const {
        const long L = (long)i * G + c; if (L >= nwg) return false;
        int wgid = (int)L; { const int q = nwg / NXCD, r = nwg % NXCD, xcd = wgid % NXCD, off = wgid / NXCD; wgid = (xcd < r ? xcd * (q + 1) : r * (q + 1) + (xcd - r) * q) + off; }
        const int nig = WGM * nN, gid = wgid / nig, fm = gid * WGM, gsz = (nM - fm) < WGM ? (nM - fm) : WGM;
        u.pm = fm + ((wgid % nig) % gsz); u.pn = (wgid % nig) / gsz; return true;
    }
    __device__ __forceinline__ void a_ready(const Unit&) const {}
    __device__ __forceinline__ void done(const Unit&) const {}
};

__device__ __forceinline__ unsigned cvt_pk_bf16(float lo, float hi) { unsigned r; asm volatile("v_cvt_pk_bf16_f32 %0, %1, %2" : "=v"(r) : "v"(lo), "v"(hi)); return r; }

template <class Epi, class Sched, bool ALIGN_EPI = false, bool SP2 = false>
__device__ __forceinline__ void gemm_phase(PG8_LAS unsigned char* lds, const Gemm g, const Sched& S_in, const Epi& E) {
    int tid_ = threadIdx.x; asm volatile("" : "+v"(tid_));
    const int tid = tid_, wid = __builtin_amdgcn_readfirstlane(tid >> 6), lane = tid & 63, wr = wid >> 2, wc = wid & 3, fr = lane & 15, fq = lane >> 4;
    const int K = g.K, nt = K / BK, lda = g.lda;
    unsigned voffA[2], voffB[2];
#pragma unroll
    for (int i = 0; i < 2; ++i) { int R, C; stage_rc(tid * 16 + i * 8192, R, C); const int Rb = Epi::PERM ? ((R & ~31) + perm32(R & 31)) : R;
        voffA[i] = (unsigned)(R * lda + C) * 2u; voffB[i] = (unsigned)(Rb * K + C) * 2u; }
    const size_t kstep = (size_t)(BK * 2);
    const size_t hstepA = (size_t)HALF * lda * 2, hstepB = (size_t)HALF * K * 2;
    const size_t tstepA = 2 * hstepA, tstepB = 2 * hstepB;
    const unsigned ldsw = (unsigned)wid * 1024u;
    const int aoff = lds_byte(wr * 64 + fr, fq * 8), boff = lds_byte(wc * 32 + fr, fq * 8);
#define PG8_SA(b, h) (((b) * 2 + (h)) * HTB)
#define PG8_SB(b, h) ((4 + (b) * 2 + (h)) * HTB)
#define PG8_STAGE(bufoff, gbase, voff) do { _Pragma("unroll") for (int _i = 0; _i < 2; ++_i) \
        __builtin_amdgcn_global_load_lds((const unsigned*)((const char*)(gbase) + (voff)[_i]), (PG8_LAS unsigned*)(lds + (bufoff) + ldsw + _i * 8192), 16, 0, 0); } while (0)
#define PG8_LDA(dst, b, h) do { _Pragma("unroll") for (int m = 0; m < 4; ++m) _Pragma("unroll") for (int k = 0; k < 2; ++k) dst[m][k] = *(const PG8_LAS bf16x8*)(lds + PG8_SA(b, h) + aoff + m * 2048 + k * 1024); } while (0)
#define PG8_LDB(dst, b, h) do { _Pragma("unroll") for (int n = 0; n < 2; ++n) _Pragma("unroll") for (int k = 0; k < 2; ++k) dst[n][k] = *(const PG8_LAS bf16x8*)(lds + PG8_SB(b, h) + boff + n * 2048 + k * 1024); } while (0)
#define PG8_MMA(ai, bj, At, Bt) do { __builtin_amdgcn_s_setprio(1); _Pragma("unroll") for (int m = 0; m < 4; ++m) _Pragma("unroll") for (int n = 0; n < 2; ++n) _Pragma("unroll") for (int k = 0; k < 2; ++k) \
        acc[ai][bj][m][n] = __builtin_amdgcn_mfma_f32_16x16x32_bf16(Bt[n][k], At[m][k], acc[ai][bj][m][n], 0, 0, 0); __builtin_amdgcn_s_setprio(0); } while (0)
#define PG8_WAIT_V(n) asm volatile("s_waitcnt vmcnt(" #n ")" ::: "memory")
#define PG8_WAIT_L(n) asm volatile("s_waitcnt lgkmcnt(" #n ")" ::: "memory")
#define PG8_BAR __builtin_amdgcn_s_barrier()
#define PG8_SCHED __builtin_amdgcn_sched_barrier(0)
    Unit cur, nxt; int ui = 0;
    Sched S = S_in; asm volatile("" : "+s"(S.c));
    if (!S.next(0, cur)) return;
    f32x4 acc[2][2][4][2];
#pragma unroll
    for (int a = 0; a < 2; ++a)
#pragma unroll
        for (int b = 0; b < 2; ++b)
#pragma unroll
            for (int m = 0; m < 4; ++m)
#pragma unroll
                for (int n = 0; n < 2; ++n) acc[a][b][m][n] = (f32x4){0.f, 0.f, 0.f, 0.f};
    bf16x8 At[4][2], B0[2][2], B1[2][2];
    const char* cA = (const char*)g.A + (size_t)cur.pm * tstepA + (size_t)(cur.pn >> g.apn_shift) * g.apn_bytes; const char* cB = (const char*)g.Bt + (size_t)cur.pn * tstepB;
    S.a_ready(cur);
    if constexpr (SP2) {
        PG8_STAGE(PG8_SB(0, 0), cB, voffB); PG8_STAGE(PG8_SB(0, 1), cB + hstepB, voffB); PG8_STAGE(PG8_SA(0, 0), cA, voffA); PG8_STAGE(PG8_SA(0, 1), cA + hstepA, voffA);
        if (wr == 1) PG8_BAR;
        PG8_WAIT_V(2); PG8_BAR;
        PG8_STAGE(PG8_SB(1, 0), cB + kstep, voffB); PG8_STAGE(PG8_SA(1, 0), cA + kstep, voffA); PG8_STAGE(PG8_SB(1, 1), cB + hstepB + kstep, voffB);
        PG8_WAIT_V(6); PG8_BAR;
    } else {
        PG8_STAGE(PG8_SB(0, 0), cB, voffB); PG8_STAGE(PG8_SA(0, 0), cA, voffA); PG8_STAGE(PG8_SB(0, 1), cB + hstepB, voffB); PG8_STAGE(PG8_SA(0, 1), cA + hstepA, voffA);
        if (wr == 1) PG8_BAR;
        PG8_WAIT_V(4); PG8_BAR;
        PG8_STAGE(PG8_SB(1, 0), cB + kstep, voffB); PG8_STAGE(PG8_SA(1, 0), cA + kstep, voffA); PG8_STAGE(PG8_SB(1, 1), cB + hstepB + kstep, voffB);
        PG8_WAIT_V(6); PG8_BAR;
    }
    for (;;) {
        const bool has_next = S.next(ui + 1, nxt);
        const char* nA = has_next ? (const char*)g.A + (size_t)nxt.pm * tstepA + (size_t)(nxt.pn >> g.apn_shift) * g.apn_bytes : cA; const char* nB = has_next ? (const char*)g.Bt + (size_t)nxt.pn * tstepB : cB;
#pragma unroll 1
        for (int t = 0; t < nt; t += 2) {
            const bool last = (t == nt - 2);
            const char* a1 = cA + (size_t)(t + 1) * kstep;
            const char* a2 = last ? nA : cA + (size_t)(t + 2) * kstep; const char* b2 = last ? nB : cB + (size_t)(t + 2) * kstep;
            const char* a3 = a2 + kstep; const char* b3 = b2 + kstep;
            if (last && has_next) S.a_ready(nxt);
            if (last) E.prefetch(cur, lds, wid, lane);
            if constexpr (SP2) {
            PG8_LDB(B0, 0, 0); PG8_LDB(B1, 0, 1); PG8_SCHED; PG8_LDA(At, 0, 0); PG8_STAGE(PG8_SA(1, 1), a1 + hstepA, voffA);
            PG8_WAIT_V(8); PG8_WAIT_L(0); PG8_BAR; PG8_MMA(0, 0, At, B0); PG8_MMA(0, 1, At, B1); PG8_BAR; PG8_SCHED;
            PG8_LDA(At, 0, 1); PG8_STAGE(PG8_SB(0, 0), b2, voffB); PG8_STAGE(PG8_SB(0, 1), b2 + hstepB, voffB); PG8_STAGE(PG8_SA(0, 0), a2, voffA);
            PG8_WAIT_V(8); PG8_WAIT_L(0); PG8_BAR; PG8_MMA(1, 0, At, B0); PG8_MMA(1, 1, At, B1); PG8_BAR; PG8_SCHED;
            PG8_LDB(B0, 1, 0); PG8_LDB(B1, 1, 1); PG8_SCHED; PG8_LDA(At, 1, 0); PG8_STAGE(PG8_SA(0, 1), a2 + hstepA, voffA);
            PG8_WAIT_V(8); PG8_WAIT_L(0); PG8_BAR; PG8_MMA(0, 0, At, B0); PG8_MMA(0, 1, At, B1); PG8_BAR; PG8_SCHED;
            PG8_LDA(At, 1, 1); PG8_STAGE(PG8_SB(1, 0), b3, voffB); PG8_STAGE(PG8_SB(1, 1), b3 + hstepB, voffB); PG8_STAGE(PG8_SA(1, 0), a3, voffA);
            PG8_WAIT_V(8); PG8_WAIT_L(0); PG8_BAR; PG8_MMA(1, 0, At, B0); PG8_MMA(1, 1, At, B1); PG8_BAR; PG8_SCHED;
            } else {
            PG8_LDB(B0, 0, 0); PG8_SCHED; PG8_LDA(At, 0, 0); PG8_STAGE(PG8_SA(1, 1), a1 + hstepA, voffA);
            PG8_WAIT_L(8); PG8_BAR; PG8_WAIT_L(0); PG8_MMA(0, 0, At, B0); PG8_BAR; PG8_SCHED;
            PG8_LDB(B1, 0, 1); PG8_STAGE(PG8_SB(0, 0), b2, voffB);
            PG8_BAR; PG8_WAIT_L(0); PG8_MMA(0, 1, At, B1); PG8_BAR;
            PG8_LDA(At, 0, 1); PG8_STAGE(PG8_SA(0, 0), a2, voffA);
            PG8_BAR; PG8_WAIT_L(0); PG8_MMA(1, 0, At, B0); PG8_BAR; PG8_SCHED;
            PG8_STAGE(PG8_SB(0, 1), b2 + hstepB, voffB);
            PG8_WAIT_V(6); PG8_BAR; PG8_MMA(1, 1, At, B1); PG8_BAR;
            PG8_LDB(B0, 1, 0); PG8_SCHED; PG8_LDA(At, 1, 0); PG8_STAGE(PG8_SA(0, 1), a2 + hstepA, voffA);
            PG8_WAIT_L(8); PG8_BAR; PG8_WAIT_L(0); PG8_MMA(0, 0, At, B0); PG8_BAR; PG8_SCHED;
            PG8_LDB(B1, 1, 1); PG8_STAGE(PG8_SB(1, 0), b3, voffB);
            PG8_BAR; PG8_WAIT_L(0); PG8_MMA(0, 1, At, B1); PG8_BAR;
            PG8_LDA(At, 1, 1); PG8_STAGE(PG8_SA(1, 0), a3, voffA);
            PG8_BAR; PG8_WAIT_L(0); PG8_MMA(1, 0, At, B0); PG8_BAR; PG8_SCHED;
            PG8_STAGE(PG8_SB(1, 1), b3 + hstepB, voffB);
            PG8_WAIT_V(6); PG8_BAR; PG8_MMA(1, 1, At, B1); PG8_BAR;
            }
        }
        if constexpr (ALIGN_EPI) { if (wr == 0) PG8_BAR; }
        E(acc, cur, wr, wc, fr, fq); S.done(cur);
        if (!has_next) break;
#pragma unroll
        for (int a = 0; a < 2; ++a)
#pragma unroll
            for (int b = 0; b < 2; ++b)
#pragma unroll
                for (int m = 0; m < 4; ++m)
#pragma unroll
                    for (int n = 0; n < 2; ++n) acc[a][b][m][n] = (f32x4){0.f, 0.f, 0.f, 0.f};
        cur = nxt; cA = nA; cB = nB; ++ui;
        if constexpr (ALIGN_EPI) { if (wr == 1) PG8_BAR; }
    }
    PG8_WAIT_V(0);
    if constexpr (!ALIGN_EPI) { if (wr == 0) PG8_BAR; }
    PG8_BAR;
#undef PG8_SA
#undef PG8_SB
#undef PG8_STAGE
#undef PG8_LDA
#undef PG8_LDB
#undef PG8_MMA
#undef PG8_WAIT_V
#undef PG8_WAIT_L
#undef PG8_BAR
#undef PG8_SCHED
}

struct Gemm2 { const bf16_t* A0; const bf16_t* B0; int K0, apn_shift0, apn_bytes0; const bf16_t* A1; const bf16_t* B1; int K1; int lda; };
template <class Epi, class Sched>
__device__ __forceinline__ void gemm_phase2(PG8_LAS unsigned char* lds, const Gemm2 g, const Sched& S_in, const Epi& E) {
    int tid_ = threadIdx.x; asm volatile("" : "+v"(tid_));
    const int tid = tid_, wid = __builtin_amdgcn_readfirstlane(tid >> 6), lane = tid & 63, wr = wid >> 2, wc = wid & 3, fr = lane & 15, fq = lane >> 4;
    const int lda = g.lda;
    unsigned voffA[2], voffB0[2], voffB1[2];
#pragma unroll
    for (int i = 0; i < 2; ++i) { int R, C; stage_rc(tid * 16 + i * 8192, R, C); const int Rb = Epi::PERM ? ((R & ~31) + perm32(R & 31)) : R;
        voffA[i] = (unsigned)(R * lda + C) * 2u; voffB0[i] = (unsigned)(Rb * g.K0 + C) * 2u; voffB1[i] = (unsigned)(Rb * g.K1 + C) * 2u; }
    const size_t kstep = (size_t)(BK * 2);
    const size_t hstepA = (size_t)HALF * lda * 2, tstepA = 2 * hstepA;
    const size_t hstepB0 = (size_t)HALF * g.K0 * 2, hstepB1 = (size_t)HALF * g.K1 * 2, tstepB0 = 2 * hstepB0, tstepB1 = 2 * hstepB1;
    const unsigned ldsw = (unsigned)wid * 1024u;
    const int aoff = lds_byte(wr * 64 + fr, fq * 8), boff = lds_byte(wc * 32 + fr, fq * 8);
#define PG8_SA(b, h) (((b) * 2 + (h)) * HTB)
#define PG8_SB(b, h) ((4 + (b) * 2 + (h)) * HTB)
#define PG8_STAGE(bufoff, gbase, voff) do { _Pragma("unroll") for (int _i = 0; _i < 2; ++_i) \
        __builtin_amdgcn_global_load_lds((const unsigned*)((const char*)(gbase) + (voff)[_i]), (PG8_LAS unsigned*)(lds + (bufoff) + ldsw + _i * 8192), 16, 0, 0); } while (0)
#define PG8_LDA(dst, b, h) do { _Pragma("unroll") for (int m = 0; m < 4; ++m) _Pragma("unroll") for (int k = 0; k < 2; ++k) dst[m][k] = *(const PG8_LAS bf16x8*)(lds + PG8_SA(b, h) + aoff + m * 2048 + k * 1024); } while (0)
#define PG8_LDB(dst, b, h) do { _Pragma("unroll") for (int n = 0; n < 2; ++n) _Pragma("unroll") for (int k = 0; k < 2; ++k) dst[n][k] = *(const PG8_LAS bf16x8*)(lds + PG8_SB(b, h) + boff + n * 2048 + k * 1024); } while (0)
#define PG8_MMA(ai, bj, At, Bt) do { __builtin_amdgcn_s_setprio(1); _Pragma("unroll") for (int m = 0; m < 4; ++m) _Pragma("unroll") for (int n = 0; n < 2; ++n) _Pragma("unroll") for (int k = 0; k < 2; ++k) \
        acc[ai][bj][m][n] = __builtin_amdgcn_mfma_f32_16x16x32_bf16(Bt[n][k], At[m][k], acc[ai][bj][m][n], 0, 0, 0); __builtin_amdgcn_s_setprio(0); } while (0)
#define PG8_WAIT_V(n) asm volatile("s_waitcnt vmcnt(" #n ")" ::: "memory")
#define PG8_WAIT_L(n) asm volatile("s_waitcnt lgkmcnt(" #n ")" ::: "memory")
#define PG8_BAR __builtin_amdgcn_s_barrier()
#define PG8_SCHED __builtin_amdgcn_sched_barrier(0)
#define PG8_A0BASE(u) ((const char*)g.A0 + (size_t)(u).pm * tstepA + (size_t)((u).pn >> g.apn_shift0) * g.apn_bytes0)
    Unit cur, nxt; int ui = 0;
    Sched S = S_in; asm volatile("" : "+s"(S.c));
    if (!S.next(0, cur)) return;
    f32x4 acc[2][2][4][2];
#pragma unroll
    for (int a = 0; a < 2; ++a)
#pragma unroll
        for (int b = 0; b < 2; ++b)
#pragma unroll
            for (int m = 0; m < 4; ++m)
#pragma unroll
                for (int n = 0; n < 2; ++n) acc[a][b][m][n] = (f32x4){0.f, 0.f, 0.f, 0.f};
    bf16x8 At[4][2], B0[2][2], B1[2][2];
    const char* cA = PG8_A0BASE(cur); const char* cB = (const char*)g.B0 + (size_t)cur.pn * tstepB0;
    PG8_STAGE(PG8_SB(0, 0), cB, voffB0); PG8_STAGE(PG8_SB(0, 1), cB + hstepB0, voffB0); PG8_STAGE(PG8_SA(0, 0), cA, voffA); PG8_STAGE(PG8_SA(0, 1), cA + hstepA, voffA);
    if (wr == 1) PG8_BAR;
    PG8_WAIT_V(2); PG8_BAR;
    PG8_STAGE(PG8_SB(1, 0), cB + kstep, voffB0); PG8_STAGE(PG8_SA(1, 0), cA + kstep, voffA); PG8_STAGE(PG8_SB(1, 1), cB + hstepB0 + kstep, voffB0);
    PG8_WAIT_V(6); PG8_BAR;
#define PG8_KLOOP(NT, CA, CB, VC, HC, NA, NB, VN, HN, HOOK) do { \
        _Pragma("unroll 1") for (int t = 0; t < (NT); t += 2) { \
            const bool last = (t == (NT) - 2); \
            if (last) { HOOK; } \
            const char* a1 = (CA) + (size_t)(t + 1) * kstep; \
            const char* a2 = last ? (NA) : (CA) + (size_t)(t + 2) * kstep; const char* b2 = last ? (NB) : (CB) + (size_t)(t + 2) * kstep; \
            const char* a3 = a2 + kstep; const char* b3 = b2 + kstep; \
            const size_t hB = last ? (HN) : (HC); unsigned vB[2]; vB[0] = last ? (VN)[0] : (VC)[0]; vB[1] = last ? (VN)[1] : (VC)[1]; \
            PG8_LDB(B0, 0, 0); PG8_LDB(B1, 0, 1); PG8_SCHED; PG8_LDA(At, 0, 0); PG8_STAGE(PG8_SA(1, 1), a1 + hstepA, voffA); \
            PG8_WAIT_V(8); PG8_WAIT_L(0); PG8_BAR; PG8_MMA(0, 0, At, B0); PG8_MMA(0, 1, At, B1); PG8_BAR; PG8_SCHED; \
            PG8_LDA(At, 0, 1); PG8_STAGE(PG8_SB(0, 0), b2, vB); PG8_STAGE(PG8_SB(0, 1), b2 + hB, vB); PG8_STAGE(PG8_SA(0, 0), a2, voffA); \
            PG8_WAIT_V(8); PG8_WAIT_L(0); PG8_BAR; PG8_MMA(1, 0, At, B0); PG8_MMA(1, 1, At, B1); PG8_BAR; PG8_SCHED; \
            PG8_LDB(B0, 1, 0); PG8_LDB(B1, 1, 1); PG8_SCHED; PG8_LDA(At, 1, 0); PG8_STAGE(PG8_SA(0, 1), a2 + hstepA, voffA); \
            PG8_WAIT_V(8); PG8_WAIT_L(0); PG8_BAR; PG8_MMA(0, 0, At, B0); PG8_MMA(0, 1, At, B1); PG8_BAR; PG8_SCHED; \
            PG8_LDA(At, 1, 1); PG8_STAGE(PG8_SB(1, 0), b3, vB); PG8_STAGE(PG8_SB(1, 1), b3 + hB, vB); PG8_STAGE(PG8_SA(1, 0), a3, voffA); \
            PG8_WAIT_V(8); PG8_WAIT_L(0); PG8_BAR; PG8_MMA(1, 0, At, B0); PG8_MMA(1, 1, At, B1); PG8_BAR; PG8_SCHED; \
        } } while (0)
    const int nt0 = g.K0 / BK, nt1 = g.K1 / BK;
    for (;;) {
        const bool has_next = S.next(ui + 1, nxt);
        const char* cA1 = (const char*)g.A1 + (size_t)cur.pm * tstepA; const char* cB1 = (const char*)g.B1 + (size_t)cur.pn * tstepB1;
        PG8_KLOOP(nt0, cA, cB, voffB0, hstepB0, cA1, cB1, voffB1, hstepB1, (void)0);
        if (wr == 0) PG8_BAR;
        E.mid(acc, cur, wr, wc, fr, fq);
        if (wr == 1) PG8_BAR;
        const char* nA = has_next ? PG8_A0BASE(nxt) : cA1; const char* nB = has_next ? (const char*)g.B0 + (size_t)nxt.pn * tstepB0 : cB1;
        const size_t hBn = has_next ? hstepB0 : hstepB1; unsigned vBn[2]; vBn[0] = has_next ? voffB0[0] : voffB1[0]; vBn[1] = has_next ? voffB0[1] : voffB1[1];
        PG8_KLOOP(nt1, cA1, cB1, voffB1, hstepB1, nA, nB, vBn, hBn, (void)0);
        if (wr == 0) PG8_BAR;
        E.fin(acc, cur, wr, wc, fr, fq);
        if (!has_next) break;
#pragma unroll
        for (int a = 0; a < 2; ++a)
#pragma unroll
            for (int b = 0; b < 2; ++b)
#pragma unroll
                for (int m = 0; m < 4; ++m)
#pragma unroll
                    for (int n = 0; n < 2; ++n) acc[a][b][m][n] = (f32x4){0.f, 0.f, 0.f, 0.f};
        cur = nxt; cA = nA; cB = nB; ++ui;
        if (wr == 1) PG8_BAR;
    }
#undef PG8_KLOOP
    PG8_WAIT_V(0);
    PG8_BAR;
#undef PG8_A0BASE
#undef PG8_SA
#undef PG8_SB
#undef PG8_STAGE
#undef PG8_LDA
#undef PG8_LDB
#undef PG8_MMA
#undef PG8_WAIT_V
#undef PG8_WAIT_L
#undef PG8_BAR
#undef PG8_SCHED
}
}

typedef unsigned short bf16;
typedef float f32x4 __attribute__((ext_vector_type(4)));
typedef unsigned u32x4 __attribute__((ext_vector_type(4)));
typedef unsigned u32x2 __attribute__((ext_vector_type(2)));
#define LAS __attribute__((address_space(3)))

constexpr int D = 1024, MP = 32768, MS = 1024, M = MP + MS, NTILE = M / 256, NTP = MP / 256;
constexpr int INW = 4096, PW = 512, CW = 512, FF = 2816, FF2 = 5632;
constexpr float EPS = 1e-6f;
constexpr int NWAVES = 8, NTHR = 512;
constexpr int LDS_BYTES = 155648;
#ifndef PHMASK
#define PHMASK 0xFFFF
#endif
#ifndef PROBE
#define PROBE 0
#endif

constexpr size_t O_POOLP = (size_t)M * D;
constexpr size_t O_CONVP = O_POOLP + 2 * 8 * 15 * 512;
constexpr size_t O_FFNP = O_CONVP + 2 * 8 * 2 * 512;
constexpr size_t O_POOLS = O_FFNP + 2 * 8 * 2 * 5632;
constexpr size_t O_CONVS = O_POOLS + 2 * 16 * 15 * 512;
constexpr size_t O_FFNS = O_CONVS + 2 * 16 * 2 * 512;
constexpr size_t O_END = O_FFNS + 2 * 16 * 2 * 5632;

constexpr size_t MiB = 1u << 20;
constexpr size_t WS_SSQ = 1 * MiB;
constexpr size_t WS_W = 4 * MiB, W_LAYER = 28 * MiB;
constexpr size_t WO_IN = 0, WO_UP = 8 * MiB, WO_DN = 19 * MiB, WO_O = 24 * MiB + MiB / 2, WO_CO = 26 * MiB + MiB / 2, WO_MAP = 27 * MiB + MiB / 2;
constexpr size_t WS_XB = 60 * MiB;
constexpr size_t WS_ACTV = 126 * MiB;
constexpr size_t WS_UPOOL = WS_ACTV, WS_CVIN = WS_ACTV + 33 * MiB, WS_GB = WS_ACTV + 66 * MiB, WS_SA = WS_ACTV + 99 * MiB, WS_SB = WS_ACTV + 165 * MiB,
                 WS_MIXED = WS_ACTV + 231 * MiB, WS_GBCV = WS_ACTV + 264 * MiB, WS_MA = WS_ACTV;
constexpr size_t WS_ACT = WS_ACTV;
constexpr size_t WS_HALO = WS_ACTV + 182 * MiB;
constexpr size_t WS_END = WS_ACTV + 297 * MiB;
constexpr int BST_OFF = 131072 + 8192;
constexpr int EX_OFF = 131072;
constexpr int RC_OFF = 131072 + 8192 + 256;
constexpr int WCV_OFF = 147456;
constexpr int GATE_OFF = 151552;
constexpr int RCT_OFF = RC_OFF + 4096;

__device__ __forceinline__ float bf_lo(unsigned w) { return __builtin_bit_cast(float, w << 16); }
__device__ __forceinline__ float bf_hi(unsigned w) { return __builtin_bit_cast(float, w & 0xffff0000u); }
__device__ __forceinline__ unsigned pk2(float lo, float hi) { return pg8::cvt_pk_bf16(lo, hi); }
__device__ __forceinline__ float sigmoidf_(float x) { return __builtin_amdgcn_rcpf(1.f + __builtin_amdgcn_exp2f(-1.44269504f * x)); }
#define UNPACK8(V_, F_) do { F_[0] = bf_lo((V_)[0]); F_[1] = bf_hi((V_)[0]); F_[2] = bf_lo((V_)[1]); F_[3] = bf_hi((V_)[1]); F_[4] = bf_lo((V_)[2]); F_[5] = bf_hi((V_)[2]); F_[6] = bf_lo((V_)[3]); F_[7] = bf_hi((V_)[3]); } while (0)

struct Args { const float* in[19]; float* out; unsigned char* ws; };
typedef const __attribute__((address_space(4))) Args* KArgs;
__device__ __forceinline__ Args load_args(KArgs kp) {
    asm volatile("" : "+s"(kp)); Args a;
#pragma unroll
    for (int i = 0; i < 19; ++i) a.in[i] = kp->in[i];
    a.out = kp->out; a.ws = kp->ws; return a;
}

__device__ __forceinline__ void unit_rstd(const float* ssq, int pm, int wr, int wc, int fr, int fq, int tagv, LAS unsigned char* lds, float (&r)[2][4]) {
    const int lane = fq * 16 + fr, wave = wr * 4 + wc;
    LAS float* rc = (LAS float*)(lds + RC_OFF) + (wave * 64 + lane) * 2;
    LAS int* tg = (LAS int*)(lds + RCT_OFF) + wave;
    float rs[2];
    if (__builtin_amdgcn_readfirstlane(tg[0]) == tagv) { rs[0] = rc[0]; rs[1] = rc[1]; }
    else {
#pragma unroll
        for (int ai = 0; ai < 2; ++ai) {
            const f32x4* p = (const f32x4*)(ssq + (size_t)(pm * 256 + ai * 128 + wr * 64 + lane) * 16);
            const f32x4 a = p[0], b = p[1], c = p[2], d = p[3];
            const float s = ((a.x + a.y) + (a.z + a.w)) + ((b.x + b.y) + (b.z + b.w)) + ((c.x + c.y) + (c.z + c.w)) + ((d.x + d.y) + (d.z + d.w));
            rs[ai] = 1.0f / sqrtf(s * (1.0f / D) + EPS);
        }
        rc[0] = rs[0]; rc[1] = rs[1]; if (lane == 0) tg[0] = tagv;
    }
#pragma unroll
    for (int ai = 0; ai < 2; ++ai)
#pragma unroll
        for (int m = 0; m < 4; ++m) r[ai][m] = __shfl(rs[ai], m * 16 + fr);
}

__device__ __forceinline__ void touch_tile_lines(const bf16* base, int pm, int pn, LAS unsigned char* lds, int wid, int lane) {
#pragma unroll
    for (int q = 0; q < 2; ++q) { const int idx = (wid * 2 + q) * 64 + lane, row = idx >> 2, line = idx & 3;
        __builtin_amdgcn_global_load_lds((const unsigned*)(base + ((size_t)pm * 256 + row) * D + pn * 256 + line * 64), (LAS unsigned*)(lds + WCV_OFF + (wid * 2 + q) * 256), 4, 0, 0); }
}
template <class T> __device__ __forceinline__ T* launder_s(T* p) { asm volatile("" : "+s"(p)); return p; }
struct EpiProj {
    static constexpr bool PERM = true, AFTER_DRAIN = false;
    __device__ __forceinline__ void prefetch(const pg8::Unit& u, LAS unsigned char* lds, int wid, int lane) const {
        if (u.pn >= 8 && wid < 3) {
            const Args a_ = load_args(kp);
            const float* src = (wid == 2 ? a_.in[9] + (size_t)l * D : a_.in[7] + (size_t)l * 2 * D + wid * D) + (u.pn - 8) * 128 + lane;
            __builtin_amdgcn_global_load_lds((const unsigned*)src, (LAS unsigned*)(lds + GATE_OFF + wid * 512), 4, 0, 0);
            __builtin_amdgcn_global_load_lds((const unsigned*)(src + 64), (LAS unsigned*)(lds + GATE_OFF + wid * 512 + 256), 4, 0, 0);
        }
    }
    KArgs kp; int l; LAS unsigned char* lds0;
    __device__ __forceinline__ void operator()(const f32x4 (&acc)[2][2][4][2], const pg8::Unit& u, int wr, int wc, int fr, int fq) const {
        const Args a_ = load_args(kp); unsigned char* w_ = a_.ws; float* o_ = a_.out; const float* b_gate = a_.in[7] + (size_t)l * 2 * D; const float* pool_scale = a_.in[9] + (size_t)l * D;
        float r[2][4]; unit_rstd((const float*)(w_ + WS_SSQ), u.pm, wr, wc, fr, fq, (2 * l + 0) * 1024 + u.pm, lds0, r);
        const int pm = u.pm, pn = u.pn;
        const int lc0 = wc * 32 + 8 * fq;
        const bool samp = pm >= NTP;
        if (pn < 4) {
            bf16* O = (bf16*)(w_ + ((pn < 2) ? WS_UPOOL : WS_GB)); const int cb = (pn & 1) * 256 + lc0;
#pragma unroll
            for (int ai = 0; ai < 2; ++ai)
#pragma unroll
                for (int m = 0; m < 4; ++m) { const size_t row = (size_t)pm * 256 + ai * 128 + wr * 64 + m * 16 + fr; const float rr = r[ai][m];
#pragma unroll
                    for (int bj = 0; bj < 2; ++bj) { const f32x4 v0 = acc[ai][bj][m][0] * rr, v1 = acc[ai][bj][m][1] * rr; u32x4 w;
                        w.x = pk2(v0[0], v0[1]); w.y = pk2(v0[2], v0[3]); w.z = pk2(v1[0], v1[1]); w.w = pk2(v1[2], v1[3]);
                        *(u32x4*)(O + row * 512 + cb + bj * 128) = w; } }
            if (pn < 2 && (samp || ((pm & 15) == 15 && wr == 1)) && fr >= 1) {
                float* pool_p = o_ + O_POOLP + (size_t)l * 8 * 15 * 512; float* pool_s = o_ + O_POOLS + (size_t)l * 16 * 15 * 512;
#pragma unroll
                for (int ai = 0; ai < 2; ++ai) { if (!samp && ai == 0) continue;
                    float* sp = samp ? pool_s + ((size_t)((pm - NTP) * 4 + ai * 2 + wr) * 15 + (fr - 1)) * 512 : pool_p + ((size_t)(pm >> 4) * 15 + (fr - 1)) * 512;
                    const float rr = r[ai][3];
#pragma unroll
                    for (int bj = 0; bj < 2; ++bj) { *(f32x4*)(sp + cb + bj * 128) = acc[ai][bj][3][0] * rr; *(f32x4*)(sp + cb + bj * 128 + 4) = acc[ai][bj][3][1] * rr; } }
            }
        } else if (pn < 8) {
            const int cb = (pn - 4) * 128 + lc0; bf16* CVIN = (bf16*)(w_ + WS_CVIN);
            float* conv_p = o_ + O_CONVP + (size_t)l * 8 * 2 * 512; float* conv_s = o_ + O_CONVS + (size_t)l * 16 * 2 * 512;
#pragma unroll
            for (int ai = 0; ai < 2; ++ai)
#pragma unroll
                for (int m = 0; m < 4; ++m) { const size_t row = (size_t)pm * 256 + ai * 128 + wr * 64 + m * 16 + fr; const float rr = r[ai][m] * r[ai][m];
                    const f32x4 v0 = acc[ai][0][m][0] * acc[ai][1][m][0] * rr, v1 = acc[ai][0][m][1] * acc[ai][1][m][1] * rr; u32x4 w;
                    w.x = pk2(v0[0], v0[1]); w.y = pk2(v0[2], v0[3]); w.z = pk2(v1[0], v1[1]); w.w = pk2(v1[2], v1[3]);
                    *(u32x4*)(CVIN + row * 512 + cb) = w;
                    if (m == 3 && fr >= 14 && (samp || ((pm & 15) == 15 && wr == 1 && ai == 1))) {
                        float* sp = samp ? conv_s + ((size_t)((pm - NTP) * 4 + ai * 2 + wr) * 2 + (fr - 14)) * 512 : conv_p + ((size_t)(pm >> 4) * 2 + (fr - 14)) * 512;
                        *(f32x4*)(sp + cb) = v0; *(f32x4*)(sp + cb + 4) = v1; } }
        } else {
            bf16* RHO = (bf16*)(w_ + WS_SA); bf16* SBo = (bf16*)(w_ + WS_SB); const int cb = (pn - 8) * 128 + lc0;
            const LAS float* gl_ = (const LAS float*)(lds0 + GATE_OFF) + lc0;
            const f32x4 ba0 = *(const LAS f32x4*)(gl_), ba1 = *(const LAS f32x4*)(gl_ + 4), bb0 = *(const LAS f32x4*)(gl_ + 128), bb1 = *(const LAS f32x4*)(gl_ + 128 + 4);
            const f32x4 ps0 = *(const LAS f32x4*)(gl_ + 256), ps1 = *(const LAS f32x4*)(gl_ + 256 + 4);
#pragma unroll
            for (int ai = 0; ai < 2; ++ai)
#pragma unroll
                for (int m = 0; m < 4; ++m) { const size_t row = (size_t)pm * 256 + ai * 128 + wr * 64 + m * 16 + fr; const float rr = r[ai][m];
                    const f32x4 xa0 = acc[ai][0][m][0] * rr + ba0, xa1 = acc[ai][0][m][1] * rr + ba1, xb0 = acc[ai][1][m][0] * rr + bb0, xb1 = acc[ai][1][m][1] * rr + bb1;
                    f32x4 rh0, rh1, sb0, sb1;
#pragma unroll
                    for (int e = 0; e < 4; ++e) {
                        const float ea0 = __builtin_amdgcn_exp2f(-1.44269504f * fmaxf(xa0[e], -30.f)), eb0 = __builtin_amdgcn_exp2f(-1.44269504f * fmaxf(xb0[e], -30.f));
                        const float ea1 = __builtin_amdgcn_exp2f(-1.44269504f * fmaxf(xa1[e], -30.f)), eb1 = __builtin_amdgcn_exp2f(-1.44269504f * fmaxf(xb1[e], -30.f));
                        sb0[e] = __builtin_amdgcn_rcpf(1.f + eb0); sb1[e] = __builtin_amdgcn_rcpf(1.f + eb1);
                        rh0[e] = ps0[e] * (1.f + eb0) * __builtin_amdgcn_rcpf(1.f + ea0); rh1[e] = ps1[e] * (1.f + eb1) * __builtin_amdgcn_rcpf(1.f + ea1); }
                    u32x4 w; w.x = pk2(rh0[0], rh0[1]); w.y = pk2(rh0[2], rh0[3]); w.z = pk2(rh1[0], rh1[1]); w.w = pk2(rh1[2], rh1[3]);
                    *(u32x4*)(RHO + row * 1024 + cb) = w;
                    u32x4 v; v.x = pk2(sb0[0], sb0[1]); v.y = pk2(sb0[2], sb0[3]); v.z = pk2(sb1[0], sb1[1]); v.w = pk2(sb1[2], sb1[3]);
                    *(u32x4*)(SBo + row * 1024 + cb) = v; }
        }
    }
};

struct EpiPool2 {
    static constexpr bool PERM = true, AFTER_DRAIN = false;
    const bf16* RHO; const bf16* SB; bf16* MA;
    __device__ __forceinline__ void warm_mid(const pg8::Unit& u, LAS unsigned char* lds, int wid, int lane) const { touch_tile_lines(RHO, u.pm, u.pn, lds, wid, lane); }
    __device__ __forceinline__ void warm_fin(const pg8::Unit& u, LAS unsigned char* lds, int wid, int lane) const { touch_tile_lines(SB, u.pm, u.pn, lds, wid, lane); }
    __device__ __forceinline__ void mid(f32x4 (&acc)[2][2][4][2], const pg8::Unit& u, int wr, int wc, int fr, int fq) const {
        const int cb = u.pn * 256 + wc * 32 + 8 * fq;
#pragma unroll
        for (int ai = 0; ai < 2; ++ai) {
            u32x4 sv[4][2];
#pragma unroll
            for (int m = 0; m < 4; ++m)
#pragma unroll
                for (int bj = 0; bj < 2; ++bj) sv[m][bj] = *(const u32x4*)(RHO + ((size_t)u.pm * 256 + ai * 128 + wr * 64 + m * 16 + fr) * 1024 + cb + bj * 128);
#pragma unroll
            for (int m = 0; m < 4; ++m)
#pragma unroll
                for (int bj = 0; bj < 2; ++bj) { float f[8]; UNPACK8(sv[m][bj], f);
                    acc[ai][bj][m][0] = acc[ai][bj][m][0] * (f32x4){f[0], f[1], f[2], f[3]}; acc[ai][bj][m][1] = acc[ai][bj][m][1] * (f32x4){f[4], f[5], f[6], f[7]}; }
            asm volatile("" ::: "memory");
        }
    }
    __device__ __forceinline__ void fin(const f32x4 (&acc)[2][2][4][2], const pg8::Unit& u, int wr, int wc, int fr, int fq) const {
        const int cb = u.pn * 256 + wc * 32 + 8 * fq;
#pragma unroll
        for (int ai = 0; ai < 2; ++ai) {
            u32x4 sv[4][2];
#pragma unroll
            for (int m = 0; m < 4; ++m)
#pragma unroll
                for (int bj = 0; bj < 2; ++bj) sv[m][bj] = *(const u32x4*)(SB + ((size_t)u.pm * 256 + ai * 128 + wr * 64 + m * 16 + fr) * 1024 + cb + bj * 128);
#pragma unroll
            for (int m = 0; m < 4; ++m) { const size_t row = (size_t)u.pm * 256 + ai * 128 + wr * 64 + m * 16 + fr;
#pragma unroll
                for (int bj = 0; bj < 2; ++bj) { const size_t o = row * 1024 + cb + bj * 128; float f[8]; UNPACK8(sv[m][bj], f);
                    const f32x4 a0 = acc[ai][bj][m][0], a1 = acc[ai][bj][m][1]; u32x4 w;
                    w.x = pk2(a0[0] * f[0], a0[1] * f[1]); w.y = pk2(a0[2] * f[2], a0[3] * f[3]); w.z = pk2(a1[0] * f[4], a1[1] * f[5]); w.w = pk2(a1[2] * f[6], a1[3] * f[7]);
                    *(u32x4*)(MA + o) = w; } }
            asm volatile("" ::: "memory");
        }
    }
};

struct EpiMA {
    static constexpr bool PERM = true, AFTER_DRAIN = false;
    __device__ __forceinline__ void prefetch(const pg8::Unit&, LAS unsigned char*, int, int) const {}
    const bf16* SA; bf16* MA;
    __device__ __forceinline__ void operator()(const f32x4 (&acc)[2][2][4][2], const pg8::Unit& u, int wr, int wc, int fr, int fq) const {
        const int cb = u.pn * 256 + wc * 32 + 8 * fq;
#pragma unroll
        for (int ai = 0; ai < 2; ++ai) {
            u32x4 sv[4][2];
#pragma unroll
            for (int m = 0; m < 4; ++m)
#pragma unroll
                for (int bj = 0; bj < 2; ++bj) sv[m][bj] = *(const u32x4*)(SA + ((size_t)u.pm * 256 + ai * 128 + wr * 64 + m * 16 + fr) * 1024 + cb + bj * 128);
#pragma unroll
            for (int m = 0; m < 4; ++m) { const size_t row = (size_t)u.pm * 256 + ai * 128 + wr * 64 + m * 16 + fr;
#pragma unroll
                for (int bj = 0; bj < 2; ++bj) { const size_t o = row * 1024 + cb + bj * 128; float f[8]; UNPACK8(sv[m][bj], f);
                    const f32x4 a0 = acc[ai][bj][m][0], a1 = acc[ai][bj][m][1]; u32x4 w;
                    w.x = pk2(a0[0] * f[0], a0[1] * f[1]); w.y = pk2(a0[2] * f[2], a0[3] * f[3]); w.z = pk2(a1[0] * f[4], a1[1] * f[5]); w.w = pk2(a1[2] * f[6], a1[3] * f[7]);
                    *(u32x4*)(MA + o) = w; } }
            asm volatile("" ::: "memory");
        }
    }
};
struct EpiMerge {
    static constexpr bool PERM = true, AFTER_DRAIN = false;
    __device__ __forceinline__ void prefetch(const pg8::Unit&, LAS unsigned char*, int, int) const {}
    const bf16* SB; bf16* MA;
    __device__ __forceinline__ void operator()(const f32x4 (&acc)[2][2][4][2], const pg8::Unit& u, int wr, int wc, int fr, int fq) const {
        const int cb = u.pn * 256 + wc * 32 + 8 * fq;
#pragma unroll
        for (int ai = 0; ai < 2; ++ai)
#pragma unroll
          for (int mh = 0; mh < 2; ++mh) {
            u32x4 sv[2][2], pv[2][2];
#pragma unroll
            for (int mm = 0; mm < 2; ++mm)
#pragma unroll
                for (int bj = 0; bj < 2; ++bj) { const size_t o = ((size_t)u.pm * 256 + ai * 128 + wr * 64 + (2 * mh + mm) * 16 + fr) * 1024 + cb + bj * 128; sv[mm][bj] = *(const u32x4*)(SB + o); pv[mm][bj] = *(const u32x4*)(MA + o); }
#pragma unroll
            for (int mm = 0; mm < 2; ++mm) { const int m = 2 * mh + mm; const size_t row = (size_t)u.pm * 256 + ai * 128 + wr * 64 + m * 16 + fr;
#pragma unroll
                for (int bj = 0; bj < 2; ++bj) { const size_t o = row * 1024 + cb + bj * 128; float f[8], q[8]; UNPACK8(sv[mm][bj], f); UNPACK8(pv[mm][bj], q);
                    const f32x4 a0 = acc[ai][bj][m][0], a1 = acc[ai][bj][m][1]; u32x4 w;
                    w.x = pk2(a0[0] * f[0] + q[0], a0[1] * f[1] + q[1]); w.y = pk2(a0[2] * f[2] + q[2], a0[3] * f[3] + q[3]);
                    w.z = pk2(a1[0] * f[4] + q[4], a1[1] * f[5] + q[5]); w.w = pk2(a1[2] * f[6] + q[6], a1[3] * f[7] + q[7]);
                    *(u32x4*)(MA + o) = w; } }
            asm volatile("" ::: "memory");
          }
    }
};
struct EpiRes {
    static constexpr bool PERM = true, AFTER_DRAIN = false;
    __device__ __forceinline__ void prefetch(const pg8::Unit& u, LAS unsigned char* lds, int wid, int lane) const { touch_tile_lines(xb, u.pm, u.pn, lds, wid, lane); }
    bf16* xb; float* ssq;
    __device__ __forceinline__ void operator()(const f32x4 (&acc)[2][2][4][2], const pg8::Unit& u, int wr, int wc, int fr, int fq) const {
        const int pm = u.pm, cb = u.pn * 256 + wc * 32 + 8 * fq;
#pragma unroll
        for (int ai = 0; ai < 2; ++ai) {
            u32x4 old[4][2];
#pragma unroll
            for (int m = 0; m < 4; ++m)
#pragma unroll
                for (int bj = 0; bj < 2; ++bj) old[m][bj] = *(const u32x4*)(xb + ((size_t)pm * 256 + ai * 128 + wr * 64 + m * 16 + fr) * D + cb + bj * 128);
#pragma unroll
            for (int m = 0; m < 4; ++m) { const size_t row = (size_t)pm * 256 + ai * 128 + wr * 64 + m * 16 + fr; float sq = 0.f;
#pragma unroll
                for (int bj = 0; bj < 2; ++bj) { float f[8]; UNPACK8(old[m][bj], f);
                    const f32x4 a0 = acc[ai][bj][m][0], a1 = acc[ai][bj][m][1]; u32x4 w;
                    w.x = pk2(a0[0] + f[0], a0[1] + f[1]); w.y = pk2(a0[2] + f[2], a0[3] + f[3]); w.z = pk2(a1[0] + f[4], a1[1] + f[5]); w.w = pk2(a1[2] + f[6], a1[3] + f[7]);
                    *(u32x4*)(xb + row * D + cb + bj * 128) = w;
                    float g[8]; UNPACK8(w, g);
                    sq += (g[0] * g[0] + g[1] * g[1]) + (g[2] * g[2] + g[3] * g[3]) + (g[4] * g[4] + g[5] * g[5]) + (g[6] * g[6] + g[7] * g[7]); }
                sq += __shfl_xor(sq, 16); sq += __shfl_xor(sq, 32);
                if (fq == 0) ssq[row * 16 + u.pn * 4 + wc] = sq; }
            asm volatile("" ::: "memory");
        }
    }
};
template <int CTRL> __device__ __forceinline__ float dppf(float v) { return __builtin_bit_cast(float, __builtin_amdgcn_update_dpp(0, __builtin_bit_cast(int, v), CTRL, 0xf, 0xf, true)); }
#define DPP_SHR1 0x111
#define DPP_SHR2 0x112
#define DPP_SHL15 0x10F
#define DPP_SHL14 0x10E
struct EpiUpAct {
    static constexpr bool PERM = true, AFTER_DRAIN = false;
    KArgs kp; LAS unsigned char* ex; int l;
    __device__ __forceinline__ void prefetch(const pg8::Unit& u, LAS unsigned char* lds, int wid, int lane) const {
        const Args a_ = load_args(kp);
        const int tap = wid >> 1, h = wid & 1;
        const float* src = (tap < 3 ? a_.in[15] + (size_t)l * 3 * FF2 + (size_t)tap * FF2 : a_.in[16] + (size_t)l * FF2) + h * FF + u.pn * 128 + lane;
        __builtin_amdgcn_global_load_lds((const unsigned*)src, (LAS unsigned*)(lds + WCV_OFF + wid * 512), 4, 0, 0);
        __builtin_amdgcn_global_load_lds((const unsigned*)(src + 64), (LAS unsigned*)(lds + WCV_OFF + wid * 512 + 256), 4, 0, 0);
        if (u.pm >= NTP) {
            const float* sf = a_.in[4] + (size_t)l * 16 * 2 * FF2 + (size_t)(u.pm - NTP) * 4 * 2 * FF2 + u.pn * 128 + lane;
#pragma unroll
            for (int q = 0; q < 2; ++q) { const int sidx = 2 * wid + q, br = sidx >> 1, h = sidx & 1;
                const float* sp = sf + (size_t)br * FF2 + h * FF;
                __builtin_amdgcn_global_load_lds((const unsigned*)sp, (LAS unsigned*)(lds + EX_OFF + sidx * 512), 4, 0, 0);
                __builtin_amdgcn_global_load_lds((const unsigned*)(sp + 64), (LAS unsigned*)(lds + EX_OFF + sidx * 512 + 256), 4, 0, 0); }
        }
    }
    __device__ __forceinline__ void operator()(const f32x4 (&acc)[2][2][4][2], const pg8::Unit& u, int wr, int wc, int fr, int fq) const {
        const Args a_ = load_args(kp); unsigned char* w_ = a_.ws; float* o_ = a_.out;
        const float* fw = a_.in[15] + (size_t)l * 3 * FF2; const float* fb = a_.in[16] + (size_t)l * FF2; const float* sffn = a_.in[4] + (size_t)l * 16 * 2 * FF2;
        const int pm = u.pm, pn = u.pn; const bool samp = pm >= NTP;
        float r[2][4]; unit_rstd((const float*)(w_ + WS_SSQ), pm, wr, wc, fr, fq, (2 * l + 1) * 1024 + pm, ex - EX_OFF, r);
        const int lc0 = wc * 32 + 8 * fq;
        f32x4 x[2][2][4][2];
#pragma unroll
        for (int ai = 0; ai < 2; ++ai)
#pragma unroll
            for (int bj = 0; bj < 2; ++bj)
#pragma unroll
                for (int m = 0; m < 4; ++m)
#pragma unroll
                    for (int n = 0; n < 2; ++n) x[ai][bj][m][n] = acc[ai][bj][m][n] * r[ai][m];
        {
            float* ffn_p = o_ + O_FFNP + (size_t)l * 8 * 2 * FF2; float* ffn_s = o_ + O_FFNS + (size_t)l * 16 * 2 * FF2; float* HALO = (float*)(w_ + WS_HALO) + (size_t)pm * 4 * FF2;
            if (fr >= 14) {
#pragma unroll
                for (int ai = 0; ai < 2; ++ai) {
                    if (samp || ((pm & 15) == 15 && wr == 1 && ai == 1)) {
                        float* sp = samp ? ffn_s + ((size_t)((pm - NTP) * 4 + ai * 2 + wr) * 2 + (fr - 14)) * FF2 : ffn_p + ((size_t)(pm >> 4) * 2 + (fr - 14)) * FF2;
#pragma unroll
                        for (int bj = 0; bj < 2; ++bj) { const int oc = bj * FF + pn * 128 + lc0; *(f32x4*)(sp + oc) = x[ai][bj][3][0]; *(f32x4*)(sp + oc + 4) = x[ai][bj][3][1]; } }
                }
                if (wr == 1) {
#pragma unroll
                    for (int bj = 0; bj < 2; ++bj) { float* hp = HALO + (size_t)(2 + fr - 14) * FF2 + pn * 256 + bj * 128 + lc0; *(f32x4*)hp = x[1][bj][3][0]; *(f32x4*)(hp + 4) = x[1][bj][3][1]; } }
            }
            if (fr < 2 && wr == 0) {
#pragma unroll
                for (int bj = 0; bj < 2; ++bj) { float* hp = HALO + (size_t)fr * FF2 + pn * 256 + bj * 128 + lc0; *(f32x4*)hp = x[0][bj][0][0]; *(f32x4*)(hp + 4) = x[0][bj][0][1]; } }
        }
        if (!samp) {
            if (fr >= 14) {
#pragma unroll
                for (int ai = 0; ai < 2; ++ai)
#pragma unroll
                    for (int bj = 0; bj < 2; ++bj)
#pragma unroll
                        for (int n = 0; n < 2; ++n) *(LAS f32x4*)(ex + ((((2 * ai + wr) * 2 + (fr - 14)) * 256) + bj * 128 + lc0 + 4 * n) * 4) = x[ai][bj][3][n];
            }
            asm volatile("s_waitcnt lgkmcnt(0)" ::: "memory"); __builtin_amdgcn_s_barrier(); asm volatile("" ::: "memory");
        }
        bf16* ACT = (bf16*)(w_ + WS_ACT);
        unsigned pk[2][4][2];
#pragma unroll
        for (int n = 0; n < 2; ++n) {
            const int f = pn * 128 + lc0 + 4 * n;
            const LAS float* wl_ = (const LAS float*)(ex - EX_OFF + WCV_OFF) + lc0 + 4 * n;
            const f32x4 wv0 = *(const LAS f32x4*)(wl_ + 0 * 128), wg0 = *(const LAS f32x4*)(wl_ + 1 * 128), wv1 = *(const LAS f32x4*)(wl_ + 2 * 128), wg1 = *(const LAS f32x4*)(wl_ + 3 * 128);
            const f32x4 wv2 = *(const LAS f32x4*)(wl_ + 4 * 128), wg2 = *(const LAS f32x4*)(wl_ + 5 * 128), bv = *(const LAS f32x4*)(wl_ + 6 * 128), bg = *(const LAS f32x4*)(wl_ + 7 * 128);
#pragma unroll
            for (int ai = 0; ai < 2; ++ai) {
                const int B = 2 * ai + wr;
                f32x4 e1v = (f32x4){0.f, 0.f, 0.f, 0.f}, e2v = e1v, e1g = e1v, e2g = e1v;
                if (fr < 2) {
                    if (samp || B > 0) {
                        const LAS unsigned char* eb = ex + ((samp ? B : B - 1) * 2 * 256 + lc0 + 4 * n) * 4;
                        const f32x4 v63 = *(const LAS f32x4*)(eb + 256 * 4), g63 = *(const LAS f32x4*)(eb + 256 * 4 + 128 * 4);
                        if (fr == 0) { e1v = v63; e1g = g63; e2v = *(const LAS f32x4*)eb; e2g = *(const LAS f32x4*)(eb + 128 * 4); } else { e2v = v63; e2g = g63; }
                    }
                }
#pragma unroll
                for (int m = 0; m < 4; ++m) {
                    float av[4];
#pragma unroll
                    for (int e = 0; e < 4; ++e) {
                        const float xv = x[ai][0][m][n][e], xg = x[ai][1][m][n][e];
                        float yv = bv[e] + wv2[e] * xv, yg = bg[e] + wg2[e] * xg;
                        if (m > 0) {
                            const float pv = x[ai][0][m > 0 ? m - 1 : 0][n][e], pg = x[ai][1][m > 0 ? m - 1 : 0][n][e];
                            asm volatile("s_nop 4\n\t"
                                "v_fmac_f32_dpp %0, %2, %4 row_shr:1 row_mask:0xf bank_mask:0xf bound_ctrl:1\n\t"
                                "v_fmac_f32_dpp %1, %3, %6 row_shr:1 row_mask:0xf bank_mask:0xf bound_ctrl:1\n\t"
                                "v_fmac_f32_dpp %0, %2, %5 row_shr:2 row_mask:0xf bank_mask:0xf bound_ctrl:1\n\t"
                                "v_fmac_f32_dpp %1, %3, %7 row_shr:2 row_mask:0xf bank_mask:0xf bound_ctrl:1\n\t"
                                "v_fmac_f32_dpp %0, %8, %4 row_shl:15 row_mask:0xf bank_mask:0xf bound_ctrl:1\n\t"
                                "v_fmac_f32_dpp %1, %9, %6 row_shl:15 row_mask:0xf bank_mask:0xf bound_ctrl:1\n\t"
                                "v_fmac_f32_dpp %0, %8, %5 row_shl:14 row_mask:0xf bank_mask:0xf bound_ctrl:1\n\t"
                                "v_fmac_f32_dpp %1, %9, %7 row_shl:14 row_mask:0xf bank_mask:0xf bound_ctrl:1"
                                : "+v"(yv), "+v"(yg) : "v"(xv), "v"(xg), "v"(wv1[e]), "v"(wv0[e]), "v"(wg1[e]), "v"(wg0[e]), "v"(pv), "v"(pg));
                        } else {
                            asm volatile("s_nop 4\n\t"
                                "v_fmac_f32_dpp %0, %2, %4 row_shr:1 row_mask:0xf bank_mask:0xf bound_ctrl:1\n\t"
                                "v_fmac_f32_dpp %1, %3, %6 row_shr:1 row_mask:0xf bank_mask:0xf bound_ctrl:1\n\t"
                                "v_fmac_f32_dpp %0, %2, %5 row_shr:2 row_mask:0xf bank_mask:0xf bound_ctrl:1\n\t"
                                "v_fmac_f32_dpp %1, %3, %7 row_shr:2 row_mask:0xf bank_mask:0xf bound_ctrl:1\n\t"
                                "v_fmac_f32_e32 %0, %8, %4\n\t"
                                "v_fmac_f32_e32 %1, %9, %6\n\t"
                                "v_fmac_f32_e32 %0, %10, %5\n\t"
                                "v_fmac_f32_e32 %1, %11, %7"
                                : "+v"(yv), "+v"(yg) : "v"(xv), "v"(xg), "v"(wv1[e]), "v"(wv0[e]), "v"(wg1[e]), "v"(wg0[e]), "v"(e1v[e]), "v"(e1g[e]), "v"(e2v[e]), "v"(e2g[e]));
                        }
                        av[e] = yg * sigmoidf_(yg) * yv;
                    }
                    const unsigned lo = pk2(av[0], av[1]), hi = pk2(av[2], av[3]);
                    if (n == 0) { pk[ai][m][0] = lo; pk[ai][m][1] = hi; }
                    else { u32x4 w; w.x = pk[ai][m][0]; w.y = pk[ai][m][1]; w.z = lo; w.w = hi;
                        *(u32x4*)(ACT + ((size_t)pm * 256 + ai * 128 + wr * 64 + m * 16 + fr) * FF + pn * 128 + lc0) = w; }
                }
            }
        }
    }
};

#define XB_TMO      128
#define XB_XCNT(j)  (256  + 64 * (j))
#define XB_XSUB(j)  (1280 + 64 * (j))
#define XB_XGEN(j)  (2304 + 64 * (j))
#define XB_TOP      3328
#define XB_TOPGEN   3392
#define XCD_BAR_WORDS 3456
#define XB_SPIN_CAP (1u << 18)
__device__ __forceinline__ unsigned xb_ld(unsigned* p)              { return __hip_atomic_load(p, __ATOMIC_RELAXED, __HIP_MEMORY_SCOPE_AGENT); }
__device__ __forceinline__ unsigned xb_add(unsigned* p, unsigned v) { return __hip_atomic_fetch_add(p, v, __ATOMIC_RELAXED, __HIP_MEMORY_SCOPE_AGENT); }
__device__ __forceinline__ unsigned xb_xcc_id() { return (unsigned)__builtin_amdgcn_s_getreg((3 << 11) | 20) & 0xFu; }
#define XB_SPIN(cond, bar) do { unsigned _sp = 0; while (cond) { __builtin_amdgcn_s_sleep(1); \
    if ((++_sp & 255u) == 0u) { if (xb_ld(&(bar)[XB_TMO])) break; if (_sp > XB_SPIN_CAP) { atomicAdd(&(bar)[XB_TMO], 1u); break; } } } } while (0)
struct XcdBarrier { unsigned* bar; unsigned x; volatile LAS unsigned* st; };
__device__ __forceinline__ XcdBarrier xcd_barrier_post(unsigned* bar, volatile LAS unsigned* st) {
    XcdBarrier b; b.bar = bar; b.x = xb_xcc_id(); b.st = st;
    if (threadIdx.x == 0) (void)xb_add(&bar[XB_XCNT(b.x)], 1u);
    return b;
}
__device__ __forceinline__ void xcd_barrier_complete(unsigned* bar, unsigned x, unsigned& nloc, unsigned& nx) {
    const unsigned G = gridDim.x * gridDim.y * gridDim.z;
    unsigned sum, cnt, mine, sp = 0u;
    for (;;) {
        sum = 0u; cnt = 0u; mine = 0u;
#pragma unroll
        for (unsigned j = 0; j < 16; ++j) { const unsigned c = xb_ld(&bar[XB_XCNT(j)]); sum += c; cnt += (c > 0u) ? 1u : 0u; mine = (j == x) ? c : mine; }
        if (sum == G) break;
        __builtin_amdgcn_s_sleep(1);
        if ((++sp & 255u) == 0u) { if (xb_ld(&bar[XB_TMO])) break; if (sp > XB_SPIN_CAP) { atomicAdd(&bar[XB_TMO], 1u); break; } }
    }
    nloc = mine > 0u ? mine : 1u; nx = cnt > 0u ? cnt : 1u;
}
__device__ __forceinline__ void xcd_barrier(const XcdBarrier& b) {
    asm volatile("s_waitcnt vmcnt(0)" ::: "memory");
    __syncthreads();
    int t0_ = threadIdx.x; asm volatile("" : "+v"(t0_));
    if (t0_ == 0) {
        unsigned* bar = b.bar;
        __builtin_amdgcn_s_waitcnt(0);
        unsigned nloc = b.st[0], nx = b.st[1];
        if (nloc == 0u) { xcd_barrier_complete(bar, b.x, nloc, nx); b.st[0] = nloc; b.st[1] = nx; }
        const unsigned old = xb_add(&bar[XB_XSUB(b.x)], 1u);
        const unsigned gen = old / nloc;
        if (old + 1u == (gen + 1u) * nloc) {
            __builtin_amdgcn_fence(__ATOMIC_RELEASE, "agent");
            asm volatile("s_waitcnt vmcnt(0)" ::: "memory");
            const unsigned og = xb_add(&bar[XB_TOP], 1u);
            const unsigned tg = og / nx;
            if (og + 1u == (tg + 1u) * nx) xb_add(&bar[XB_TOPGEN], 1u);
            else XB_SPIN(xb_ld(&bar[XB_TOPGEN]) == tg, bar);
            __builtin_amdgcn_fence(__ATOMIC_ACQUIRE, "agent");
            xb_add(&bar[XB_XGEN(b.x)], 1u);
            asm volatile("s_waitcnt vmcnt(0)" ::: "memory");
        } else {
            XB_SPIN(xb_ld(&bar[XB_XGEN(b.x)]) == gen, bar);
            __builtin_amdgcn_fence(__ATOMIC_ACQUIRE, "agent");
            asm volatile("s_waitcnt vmcnt(0)" ::: "memory");
        }
    }
    __syncthreads();
}


struct Frame {
    LAS unsigned char* lds;
    int tid, lane, wave, G, bid;
};

__device__ __forceinline__ float wave_sum(float v) {
#pragma unroll
    for (int o = 1; o < 64; o <<= 1) v += __shfl_xor(v, o);
    return v;
}

__device__ __forceinline__ void tr_item(const float* W, int ldw, int srccol, int ks0, const float* gs, bf16* WT, int Kd, int dst_row, int kd0, bool zero, LAS float* scr, int lane) {
    const int c = lane & 7;
    f32x4 g0 = (f32x4){1.f, 1.f, 1.f, 1.f}, g1 = g0;
    if (!zero) {
        float v[32];
#pragma unroll
        for (int i = 0; i < 32; ++i) v[i] = __builtin_nontemporal_load(W + (size_t)(ks0 + 2 * i + (lane >> 5)) * ldw + srccol + (lane & 31));
        if (gs) { g0 = *(const f32x4*)(gs + ks0 + 8 * c); g1 = *(const f32x4*)(gs + ks0 + 8 * c + 4); }
#pragma unroll
        for (int i = 0; i < 32; ++i) scr[(2 * i + (lane >> 5)) * 33 + (lane & 31)] = v[i];
    }
    asm volatile("s_waitcnt lgkmcnt(0)" ::: "memory");
#pragma unroll
    for (int j = 0; j < 4; ++j) { const int n = (lane >> 3) + 8 * j; const LAS float* s = scr + (8 * c) * 33 + n;
        u32x4 o;
        if (zero) { unsigned z = 0u; asm volatile("" : "+v"(z)); o = (u32x4){z, z, z, z}; }
        else { o.x = pk2(s[0 * 33] * g0[0], s[1 * 33] * g0[1]); o.y = pk2(s[2 * 33] * g0[2], s[3 * 33] * g0[3]); o.z = pk2(s[4 * 33] * g1[0], s[5 * 33] * g1[1]); o.w = pk2(s[6 * 33] * g1[2], s[7 * 33] * g1[3]); }
        *(u32x4*)(WT + (size_t)(dst_row + n) * Kd + kd0 + 8 * c) = o; }
    asm volatile("s_waitcnt lgkmcnt(0)" ::: "memory");
}

constexpr int I_IN = 16 * 128, I_UP = 16 * 176, I_DN = 44 * 32, I_O = 16 * 32, I_CO = 8 * 32, I_MAP = 128;
constexpr int ITEMS_L = I_IN + I_UP + I_DN + I_O + I_CO + I_MAP;

__device__ __forceinline__ void p0_prologue(const Frame& F, const Args& a) {
    int tid_ = threadIdx.x; asm volatile("" : "+v"(tid_)); const int TID = tid_, LANE = tid_ & 63, WAVE = __builtin_amdgcn_readfirstlane(tid_ >> 6);
    LAS float* scr = (LAS float*)(F.lds + WAVE * 16384);
    const int gw = F.bid * NWAVES + WAVE, NGW = F.G * NWAVES;
    unsigned char* ws = a.ws;
    for (int it = gw; it < 2 * ITEMS_L; it += NGW) {
        const int l = it / ITEMS_L; int r = it % ITEMS_L;
        unsigned char* wl = ws + WS_W + (size_t)l * W_LAYER;
        if (r < I_IN) { const int kb = r / 128, n0 = (r % 128) * 32;
            const int src = n0 < 1024 ? n0 : n0 < 2048 ? 1024 + 512 * (((n0 - 1024) % 256) / 128) + 128 * ((n0 - 1024) / 256) + (n0 % 128)
                                                     : 2048 + 1024 * (((n0 - 2048) % 256) / 128) + 128 * ((n0 - 2048) / 256) + (n0 % 128);
            tr_item(a.in[6] + (size_t)l * D * INW, INW, src, kb * 64, a.in[5] + l * D, (bf16*)(wl + WO_IN), D, n0, kb * 64, false, scr, LANE); continue; } r -= I_IN;
        if (r < I_UP) { const int kb = r / 176, n0 = (r % 176) * 32;
            const int src = ((n0 % 256) / 128) * FF + 128 * (n0 / 256) + (n0 % 128);
            tr_item(a.in[14] + (size_t)l * D * FF2, FF2, src, kb * 64, a.in[13] + l * D, (bf16*)(wl + WO_UP), D, n0, kb * 64, false, scr, LANE); continue; } r -= I_UP;
        if (r < I_DN) { const int kb = r / 32, n0 = (r % 32) * 32;
            tr_item(a.in[17] + (size_t)l * FF * D, D, n0, kb * 64, nullptr, (bf16*)(wl + WO_DN), FF, n0, kb * 64, false, scr, LANE); continue; } r -= I_DN;
        if (r < I_O) { const int kb = r / 32, n0 = (r % 32) * 32;
            tr_item(a.in[12] + (size_t)l * D * D, D, n0, kb * 64, nullptr, (bf16*)(wl + WO_O), D, n0, kb * 64, false, scr, LANE); continue; } r -= I_O;
        if (r < I_CO) { const int kb = r / 32, n0 = (r % 32) * 32;
            tr_item(a.in[11] + (size_t)l * CW * D, D, n0, kb * 64, nullptr, (bf16*)(wl + WO_CO), CW, n0, kb * 64, false, scr, LANE); continue; } r -= I_CO;
        { const int g = r / 32, kb = (r % 32) / 8, nb = r % 8; const bool zero = (kb >> 1) != (g & 1);
            tr_item(a.in[8] + (size_t)l * 4 * 128 * 256 + (size_t)g * 128 * 256, 256, nb * 32, (kb & 1) * 64, nullptr, (bf16*)(wl + WO_MAP), 256, g * 256 + nb * 32, kb * 64, zero, scr, LANE); }
    }
    bf16* XB = (bf16*)(ws + WS_XB); float* SSQ = (float*)(ws + WS_SSQ);
    for (int m0 = gw; m0 < M; m0 += 4 * NGW) {
        f32x4 v[4][4]; float sq[4];
#pragma unroll
        for (int r = 0; r < 4; ++r) { const int m = m0 + r * NGW;
            if (m < M) { const float* xrow = m < MP ? a.in[0] + (size_t)m * D : a.in[1] + (size_t)(m - MP) * D; const f32x4* xr = (const f32x4*)xrow + LANE;
#pragma unroll
                for (int j = 0; j < 4; ++j) v[r][j] = __builtin_nontemporal_load(xr + 64 * j); } }
#pragma unroll
        for (int r = 0; r < 4; ++r) { const int m = m0 + r * NGW;
            if (m < M) { float s = 0.f;
#pragma unroll
                for (int j = 0; j < 4; ++j) s += (v[r][j].x * v[r][j].x + v[r][j].y * v[r][j].y) + (v[r][j].z * v[r][j].z + v[r][j].w * v[r][j].w);
                sq[r] = wave_sum(s);
                u32x2* o8 = (u32x2*)(XB + (size_t)m * D) + LANE;
#pragma unroll
                for (int j = 0; j < 4; ++j) { u32x2 w; w.x = pk2(v[r][j].x, v[r][j].y); w.y = pk2(v[r][j].z, v[r][j].w); o8[64 * j] = w; }
                if (LANE < 16) SSQ[(size_t)m * 16 + LANE] = LANE == 0 ? sq[r] : 0.f; } }
    }
}

constexpr int MIX_RB = 33;
__device__ __forceinline__ void mix_elt(const Frame& F, const Args& a, int l) {
    int tid_ = threadIdx.x; asm volatile("" : "+v"(tid_)); const int TID = tid_;
    unsigned char* ws = a.ws;
    const bf16* UPOOL = (const bf16*)(ws + WS_UPOOL); const bf16* CVIN = (const bf16*)(ws + WS_CVIN); const bf16* GB = (const bf16*)(ws + WS_GB);
    bf16* MIXED = (bf16*)(ws + WS_MIXED); bf16* GBCV = (bf16*)(ws + WS_GBCV);
    const float* spool = a.in[2] + (size_t)l * 16 * 15 * 512; const float* sconv = a.in[3] + (size_t)l * 16 * 2 * 512; const float* cw = a.in[10] + (size_t)l * 3 * 512;
    const int nrb = (M + MIX_RB - 1) / MIX_RB, total = nrb * 128, stride = F.G * NTHR;
    for (int idx = F.bid * NTHR + TID; idx < total; idx += stride) {
        const int rb = idx >> 7, c8 = idx & 127;
        const int r0 = rb * MIX_RB, r1 = (r0 + MIX_RB) < M ? (r0 + MIX_RB) : M;
        if (c8 < 64) {
            const int ch0 = c8 * 8, win = 2 << (c8 >> 4);
            float sum[8], f[8];
            for (int row = r0; row < r1; ++row) {
                const bool samp = row >= MP; int t, sq = 0;
                if (!samp) t = row & 4095; else { const int sr = row - MP; sq = sr >> 6; t = sr & 63; }
                const u32x4 uw = *(const u32x4*)(UPOOL + (size_t)row * 512 + ch0);
                if (row == r0 || t == 0) {
#pragma unroll
                    for (int e = 0; e < 8; ++e) sum[e] = 0.f;
                    for (int j = 1; j < win; ++j) {
                        const int tt = t - j;
                        if (tt >= 0) { const u32x4 w = *(const u32x4*)(UPOOL + (size_t)(row - j) * 512 + ch0); UNPACK8(w, f);
#pragma unroll
                            for (int e = 0; e < 8; ++e) sum[e] += f[e]; }
                        else if (samp) { const float* p = spool + ((size_t)sq * 15 + 15 + tt) * 512 + ch0; const f32x4 p0 = *(const f32x4*)p, p1 = *(const f32x4*)(p + 4);
#pragma unroll
                            for (int e = 0; e < 4; ++e) { sum[e] += p0[e]; sum[4 + e] += p1[e]; } }
                    }
                } else {
                    const int tt = t - win;
                    if (tt >= 0) { const u32x4 w = *(const u32x4*)(UPOOL + (size_t)(row - win) * 512 + ch0); UNPACK8(w, f);
#pragma unroll
                        for (int e = 0; e < 8; ++e) sum[e] -= f[e]; }
                    else if (samp) { const float* p = spool + ((size_t)sq * 15 + 15 + tt) * 512 + ch0; const f32x4 p0 = *(const f32x4*)p, p1 = *(const f32x4*)(p + 4);
#pragma unroll
                        for (int e = 0; e < 4; ++e) { sum[e] -= p0[e]; sum[4 + e] -= p1[e]; } }
                }
                UNPACK8(uw, f);
                const float cnt = samp ? (float)win : (float)(win < t + 1 ? win : t + 1), inv = 1.0f / cnt;
                float o[8];
#pragma unroll
                for (int e = 0; e < 8; ++e) { sum[e] += f[e]; o[e] = sum[e] * inv - f[e]; }
                u32x4 w; w.x = pk2(o[0], o[1]); w.y = pk2(o[2], o[3]); w.z = pk2(o[4], o[5]); w.w = pk2(o[6], o[7]);
                *(u32x4*)(MIXED + (size_t)row * 512 + ch0) = w;
            }
        } else {
            const int ch0 = (c8 - 64) * 8;
            float w0[8], w1[8], w2[8];
#pragma unroll
            for (int h = 0; h < 2; ++h) { const f32x4 a0 = *(const f32x4*)(cw + ch0 + 4 * h), a1 = *(const f32x4*)(cw + 512 + ch0 + 4 * h), a2 = *(const f32x4*)(cw + 1024 + ch0 + 4 * h);
#pragma unroll
                for (int e = 0; e < 4; ++e) { w0[4 * h + e] = a0[e]; w1[4 * h + e] = a1[e]; w2[4 * h + e] = a2[e]; } }
            float x0[8], x1[8], x2[8], gb[8];
#pragma unroll
            for (int e = 0; e < 8; ++e) { x1[e] = 0.f; x2[e] = 0.f; }
            for (int row = r0; row < r1; ++row) {
                const bool samp = row >= MP; int t, sq = 0;
                if (!samp) t = row & 4095; else { const int sr = row - MP; sq = sr >> 6; t = sr & 63; }
                { const u32x4 w = *(const u32x4*)(CVIN + (size_t)row * 512 + ch0); UNPACK8(w, x0); }
                { const u32x4 w = *(const u32x4*)(GB + (size_t)row * 512 + ch0); UNPACK8(w, gb); }
                if (row == r0 || t == 0) {
                    if (t >= 1) { const u32x4 w = *(const u32x4*)(CVIN + (size_t)(row - 1) * 512 + ch0); UNPACK8(w, x1); }
                    else if (samp) { const float* p = sconv + ((size_t)sq * 2 + 1) * 512 + ch0; const f32x4 p0 = *(const f32x4*)p, p1 = *(const f32x4*)(p + 4);
#pragma unroll
                        for (int e = 0; e < 4; ++e) { x1[e] = p0[e]; x1[4 + e] = p1[e]; } }
                    else {
#pragma unroll
                        for (int e = 0; e < 8; ++e) x1[e] = 0.f; }
                    if (t >= 2) { const u32x4 w = *(const u32x4*)(CVIN + (size_t)(row - 2) * 512 + ch0); UNPACK8(w, x2); }
                    else if (samp) { const float* p = sconv + ((size_t)sq * 2 + t) * 512 + ch0; const f32x4 p0 = *(const f32x4*)p, p1 = *(const f32x4*)(p + 4);
#pragma unroll
                        for (int e = 0; e < 4; ++e) { x2[e] = p0[e]; x2[4 + e] = p1[e]; } }
                    else {
#pragma unroll
                        for (int e = 0; e < 8; ++e) x2[e] = 0.f; }
                }
                float o[8];
#pragma unroll
                for (int e = 0; e < 8; ++e) { o[e] = gb[e] * (w0[e] * x2[e] + w1[e] * x1[e] + w2[e] * x0[e]); x2[e] = x1[e]; x1[e] = x0[e]; }
                u32x4 w; w.x = pk2(o[0], o[1]); w.y = pk2(o[2], o[3]); w.z = pk2(o[4], o[5]); w.w = pk2(o[6], o[7]);
                *(u32x4*)(GBCV + (size_t)row * 512 + ch0) = w;
            }
        }
    }
}

__device__ __forceinline__ void ffn_fixup(const Frame& F, const Args& a, int l) {
    int tid_ = threadIdx.x; asm volatile("" : "+v"(tid_)); const int TID = tid_;
    unsigned char* ws = a.ws;
    const float* HALO = (const float*)(ws + WS_HALO); bf16* ACT = (bf16*)(ws + WS_ACT);
    const float* fw = a.in[15] + (size_t)l * 3 * FF2; const float* fb = a.in[16] + (size_t)l * FF2;
    const int total = NTP * 2 * 352, stride = F.G * NTHR;
    for (int idx = F.bid * NTHR + TID; idx < total; idx += stride) {
        const int pm = idx / 704, rem = idx % 704, rr = rem / 352, c8 = rem % 352;
        if ((pm & 15) == 0) continue;
        const int f0 = c8 * 8, pn = f0 >> 7, j0 = f0 & 127;
        float res[2][8];
#pragma unroll
        for (int h = 0; h < 2; ++h) {
            const int pc = pn * 256 + h * 128 + j0, oc = h * FF + f0;
            const float* p0 = HALO + ((size_t)pm * 4 + rr) * FF2 + pc;
            const float* p1 = rr == 1 ? HALO + ((size_t)pm * 4 + 0) * FF2 + pc : HALO + ((size_t)(pm - 1) * 4 + 3) * FF2 + pc;
            const float* p2 = rr == 1 ? HALO + ((size_t)(pm - 1) * 4 + 3) * FF2 + pc : HALO + ((size_t)(pm - 1) * 4 + 2) * FF2 + pc;
#pragma unroll
            for (int q = 0; q < 2; ++q) { const f32x4 x0 = *(const f32x4*)(p0 + 4 * q), x1 = *(const f32x4*)(p1 + 4 * q), x2 = *(const f32x4*)(p2 + 4 * q);
                const f32x4 w0 = *(const f32x4*)(fw + oc + 4 * q), w1 = *(const f32x4*)(fw + FF2 + oc + 4 * q), w2 = *(const f32x4*)(fw + 2 * FF2 + oc + 4 * q), b = *(const f32x4*)(fb + oc + 4 * q);
#pragma unroll
                for (int e = 0; e < 4; ++e) res[h][4 * q + e] = w0[e] * x2[e] + w1[e] * x1[e] + w2[e] * x0[e] + b[e]; }
        }
        float o[8];
#pragma unroll
        for (int e = 0; e < 8; ++e) o[e] = res[1][e] * sigmoidf_(res[1][e]) * res[0][e];
        u32x4 w; w.x = pk2(o[0], o[1]); w.y = pk2(o[2], o[3]); w.z = pk2(o[4], o[5]); w.w = pk2(o[6], o[7]);
        *(u32x4*)(ACT + ((size_t)pm * 256 + rr) * FF + f0) = w;
    }
}

__device__ __forceinline__ void final_norm(const Frame& F, const Args& a) {
    int tid_ = threadIdx.x; asm volatile("" : "+v"(tid_)); const int LANE = tid_ & 63, WAVE = __builtin_amdgcn_readfirstlane(tid_ >> 6);
    const float* SSQ = (const float*)(a.ws + WS_SSQ); const bf16* XB = (const bf16*)(a.ws + WS_XB); const float* g = a.in[18];
    const int gw = F.bid * NWAVES + WAVE, NGW = F.G * NWAVES;
    f32x4 gv[2][2];
#pragma unroll
    for (int j = 0; j < 2; ++j) { gv[j][0] = *(const f32x4*)(g + 512 * j + 8 * LANE); gv[j][1] = *(const f32x4*)(g + 512 * j + 8 * LANE + 4); }
    for (int m0 = gw; m0 < M; m0 += 4 * NGW) {
        u32x4 w[4][2]; float sv[4];
#pragma unroll
        for (int r = 0; r < 4; ++r) { const int m = m0 + r * NGW;
            if (m < M) { sv[r] = LANE < 16 ? SSQ[(size_t)m * 16 + LANE] : 0.f;
#pragma unroll
                for (int j = 0; j < 2; ++j) w[r][j] = *(const u32x4*)(XB + (size_t)m * D + 512 * j + 8 * LANE); } }
#pragma unroll
        for (int r = 0; r < 4; ++r) { const int m = m0 + r * NGW;
            if (m < M) { const float s = wave_sum(sv[r]); const float rs = 1.0f / sqrtf(s * (1.0f / D) + EPS);
                float* orow = a.out + (size_t)m * D;
#pragma unroll
                for (int j = 0; j < 2; ++j) { float f[8]; UNPACK8(w[r][j], f);
                    f32x4 o0, o1;
#pragma unroll
                    for (int e = 0; e < 4; ++e) { o0[e] = f[e] * rs * gv[j][0][e]; o1[e] = f[4 + e] * rs * gv[j][1][e]; }
                    *(f32x4*)(orow + 512 * j + 8 * LANE) = o0; *(f32x4*)(orow + 512 * j + 8 * LANE + 4) = o1; } } }
    }
}

constexpr int SG_PITCH = 272, SG_ROWS = 160, SG_STAGE = SG_ROWS * SG_PITCH;
template <int MODE>
__device__ __forceinline__ void small_gemm(const Frame& F, const bf16* A, int lda, int grp_cols, const bf16* Bt, int K, const bf16* G0, const bf16* G1, bf16* O, float* ssq,
                                           const bf16* A2 = nullptr, const bf16* Bt2 = nullptr, int K2 = 0) {
    int tid_ = threadIdx.x; asm volatile("" : "+v"(tid_)); const int TID = tid_, LANE = tid_ & 63, WAVE = __builtin_amdgcn_readfirstlane(tid_ >> 6);
    const int rb = WAVE >> 2, cg = WAVE & 3, fr = LANE & 15, fq = LANE >> 4;
    LAS float* red = (LAS float*)(F.lds + EX_OFF);
    LAS unsigned char* L0 = F.lds; LAS unsigned char* L1 = F.lds + SG_STAGE;
    const int aoff = (rb * 16 + fr) * SG_PITCH + fq * 16, boff0 = (32 + cg * 32 + fr) * SG_PITCH + fq * 16, boff1 = boff0 + 16 * SG_PITCH;
#define SG_BAR() do { asm volatile("s_waitcnt lgkmcnt(0)" ::: "memory"); __builtin_amdgcn_s_barrier(); asm volatile("" ::: "memory"); } while (0)
#define SG_GLOAD(R, ks) do { _Pragma("unroll") for (int i = 0; i < 5; ++i) R[i] = *(const u32x4*)(gp[i] + (size_t)(ks) * 128); } while (0)
#define SG_LWRITE(Lb, R) do { _Pragma("unroll") for (int i = 0; i < 5; ++i) *(LAS u32x4*)((Lb) + lo[i]) = R[i]; } while (0)
#define SG_COMPUTE(Lb) do { _Pragma("unroll") for (int j = 0; j < 4; ++j) { const pg8::bf16x8 fa = *(const LAS pg8::bf16x8*)((Lb) + aoff + j * 64), f0 = *(const LAS pg8::bf16x8*)((Lb) + boff0 + j * 64), f1 = *(const LAS pg8::bf16x8*)((Lb) + boff1 + j * 64); \
        acc0 = __builtin_amdgcn_mfma_f32_16x16x32_bf16(f0, fa, acc0, 0, 0, 0); acc1 = __builtin_amdgcn_mfma_f32_16x16x32_bf16(f1, fa, acc1, 0, 0, 0); } } while (0)
    for (int T = F.bid; T < 256; T += F.G) {
        const int tr = T >> 3, tc = T & 7;
        const int row = MP + tr * 32 + rb * 16 + fr, c0 = tc * 128 + cg * 32;
        const bf16* gp[5]; int lo[5];
#pragma unroll
        for (int i = 0; i < 5; ++i) { const int idx = TID + 512 * i, r = idx >> 4, c16 = idx & 15;
            gp[i] = (r < 32) ? A + (size_t)(MP + tr * 32 + r) * lda + (grp_cols ? (tc >> 2) * grp_cols : 0) + 8 * c16 : Bt + (size_t)(tc * 128 + r - 32) * K + 8 * c16;
            lo[i] = r * SG_PITCH + c16 * 16; }
        f32x4 acc0 = (f32x4){0.f, 0.f, 0.f, 0.f}, acc1 = acc0;
        u32x2 pg0[2], pg1[2], pq[2];
#pragma unroll
        for (int n2 = 0; n2 < 2; ++n2) { const size_t o = (size_t)row * D + c0 + 16 * n2 + 4 * fq;
            if (MODE == 0 || MODE == 1 || MODE == 3) pg0[n2] = *(const u32x2*)(G0 + o);
            if (MODE == 0 || MODE == 3) pg1[n2] = *(const u32x2*)(G1 + o);
            if (MODE == 1 || MODE == 2) pq[n2] = *(const u32x2*)(O + o); }
#pragma unroll 1
      for (int sg = 0; sg < (MODE == 3 ? 2 : 1); ++sg) {
        if (MODE == 3 && sg == 1) {
#pragma unroll
            for (int i = 0; i < 5; ++i) { const int idx = TID + 512 * i, r = idx >> 4, c16 = idx & 15;
                gp[i] = (r < 32) ? A2 + (size_t)(MP + tr * 32 + r) * lda + 8 * c16 : Bt2 + (size_t)(tc * 128 + r - 32) * K2 + 8 * c16; }
            acc0 = acc0 * (f32x4){bf_lo(pg0[0].x), bf_hi(pg0[0].x), bf_lo(pg0[0].y), bf_hi(pg0[0].y)}; acc1 = acc1 * (f32x4){bf_lo(pg0[1].x), bf_hi(pg0[1].x), bf_lo(pg0[1].y), bf_hi(pg0[1].y)};
        }
        const int nst = ((MODE == 3 && sg == 1) ? K2 : K) >> 7;
        u32x4 R0[5], R1[5];
        SG_BAR();
        SG_GLOAD(R0, 0); SG_GLOAD(R1, 1);
        SG_LWRITE(L0, R0);
        SG_BAR();
#pragma unroll 1
        for (int s = 0; s < nst; s += 2) {
            if (s + 2 < nst) SG_GLOAD(R0, s + 2);
            SG_COMPUTE(L0);
            SG_LWRITE(L1, R1);
            SG_BAR();
            if (s + 3 < nst) SG_GLOAD(R1, s + 3);
            SG_COMPUTE(L1);
            if (s + 2 < nst) SG_LWRITE(L0, R0);
            SG_BAR();
        }
      }
        float ssum = 0.f;
#pragma unroll
        for (int n2 = 0; n2 < 2; ++n2) {
            const f32x4 av = n2 ? acc1 : acc0; const size_t o = (size_t)row * D + c0 + 16 * n2 + 4 * fq;
            if (MODE == 0) { const u32x2 g = pg0[n2], h = pg1[n2]; u32x2 w;
                w.x = pk2(av[0] * (bf_lo(g.x) * bf_lo(h.x)), av[1] * (bf_hi(g.x) * bf_hi(h.x))); w.y = pk2(av[2] * (bf_lo(g.y) * bf_lo(h.y)), av[3] * (bf_hi(g.y) * bf_hi(h.y))); *(u32x2*)(O + o) = w; }
            else if (MODE == 3) { const u32x2 h = pg1[n2]; u32x2 w; w.x = pk2(av[0] * bf_lo(h.x), av[1] * bf_hi(h.x)); w.y = pk2(av[2] * bf_lo(h.y), av[3] * bf_hi(h.y)); *(u32x2*)(O + o) = w; }
            else if (MODE == 1) { const u32x2 g = pg0[n2], q = pq[n2]; u32x2 w;
                w.x = pk2(av[0] * bf_lo(g.x) + bf_lo(q.x), av[1] * bf_hi(g.x) + bf_hi(q.x)); w.y = pk2(av[2] * bf_lo(g.y) + bf_lo(q.y), av[3] * bf_hi(g.y) + bf_hi(q.y)); *(u32x2*)(O + o) = w; }
            else { const u32x2 q = pq[n2]; u32x2 w; w.x = pk2(av[0] + bf_lo(q.x), av[1] + bf_hi(q.x)); w.y = pk2(av[2] + bf_lo(q.y), av[3] + bf_hi(q.y)); *(u32x2*)(O + o) = w;
                const float g0 = bf_lo(w.x), g1 = bf_hi(w.x), g2 = bf_lo(w.y), g3 = bf_hi(w.y); ssum += (g0 * g0 + g1 * g1) + (g2 * g2 + g3 * g3); }
        }
        if (MODE == 2) {
            ssum += __shfl_xor(ssum, 16); ssum += __shfl_xor(ssum, 32);
            __syncthreads();
            if (fq == 0) red[WAVE * 16 + fr] = ssum;
            __syncthreads();
            if (TID < 32) { const int b = TID >> 4, r = TID & 15; const float t = (red[(b * 4 + 0) * 16 + r] + red[(b * 4 + 1) * 16 + r]) + (red[(b * 4 + 2) * 16 + r] + red[(b * 4 + 3) * 16 + r]);
                float* sp = ssq + (size_t)(MP + tr * 32 + TID) * 16; sp[tc] = t; if (tc == 0) { *(f32x4*)(sp + 8) = (f32x4){0.f, 0.f, 0.f, 0.f}; *(f32x4*)(sp + 12) = (f32x4){0.f, 0.f, 0.f, 0.f}; } }
        }
    }
#undef SG_BAR
#undef SG_GLOAD
#undef SG_LWRITE
#undef SG_COMPUTE
}

__global__ void __launch_bounds__(NTHR, 2) fwd_mega(Args a_unused) {
    extern __shared__ __attribute__((aligned(16))) unsigned char lds_raw[];
    cg::grid_group grid = cg::this_grid();
    KArgs kp = (KArgs)__builtin_amdgcn_kernarg_segment_ptr();
    Frame F;
    F.lds = (LAS unsigned char*)lds_raw;
    F.tid = threadIdx.x; F.lane = F.tid & 63; F.wave = __builtin_amdgcn_readfirstlane(F.tid >> 6);
    F.G = gridDim.x; F.bid = blockIdx.x;
    { const Args a = load_args(kp); unsigned* barw = (unsigned*)a.ws;
      (void)barw;
      volatile LAS unsigned* bst = (volatile LAS unsigned*)(F.lds + BST_OFF);
      if (threadIdx.x < 4) bst[threadIdx.x] = 0u;
      if (threadIdx.x < 8) ((volatile LAS int*)(F.lds + RCT_OFF))[threadIdx.x] = -1; }
    __syncthreads();
    { const Args a = load_args(kp); (void)xcd_barrier_post((unsigned*)a.ws, (volatile LAS unsigned*)(F.lds + BST_OFF));
      if (a.ws == nullptr) grid.sync(); }
#define GRID_BAR() do { const Args a_ = load_args(kp); XcdBarrier b_; b_.bar = (unsigned*)a_.ws; b_.x = xb_xcc_id(); b_.st = (volatile LAS unsigned*)(F.lds + BST_OFF); xcd_barrier(b_); } while (0)

    if constexpr (PHMASK & 1) { const Args a = load_args(kp); p0_prologue(F, a); }
    GRID_BAR();
    if constexpr (PROBE == 9) { const unsigned long long t0 = __builtin_amdgcn_s_memrealtime(); while (__builtin_amdgcn_s_memrealtime() - t0 < 20000ull) __builtin_amdgcn_s_sleep(32); }

#pragma unroll 1
    for (int l = 0; l < 2; ++l) {
        if constexpr (PHMASK & 2) {
            const Args a = load_args(kp); unsigned char* ws = a.ws; unsigned char* wl = ws + WS_W + (size_t)l * W_LAYER;
            pg8::Gemm g{(const bf16*)(ws + WS_XB), (const bf16*)(wl + WO_IN), M, INW, D, D, 0, 0}; pg8::StaticOrder S; S.init(M, INW, F.G, F.bid);
            EpiProj E{kp, l, F.lds};
            pg8::gemm_phase<EpiProj, pg8::StaticOrder, true, true>(F.lds, g, S, E);
            if constexpr (PROBE == 4) { __syncthreads(); pg8::gemm_phase<EpiProj, pg8::StaticOrder, true, true>(F.lds, g, S, E); }
        }
        GRID_BAR();
_Pragma("unroll 1")
        for (int rep = 0; rep < (PROBE == 3 ? 2 : 1); ++rep) { const Args a = load_args(kp); mix_elt(F, a, l); }
        GRID_BAR();
        if constexpr (PHMASK & 8) {
            const Args a = load_args(kp); unsigned char* ws = a.ws; unsigned char* wl = ws + WS_W + (size_t)l * W_LAYER;
            pg8::Gemm2 g{(const bf16*)(ws + WS_MIXED), (const bf16*)(wl + WO_MAP), 256, 1, 512, (const bf16*)(ws + WS_GBCV), (const bf16*)(wl + WO_CO), CW, PW}; pg8::StaticOrder S; S.init(MP, D, F.G, F.bid);
            EpiPool2 E{(const bf16*)(ws + WS_SA), (const bf16*)(ws + WS_SB), (bf16*)(ws + WS_MA)};
            pg8::gemm_phase2<EpiPool2, pg8::StaticOrder>(F.lds, g, S, E);
            small_gemm<3>(F, (const bf16*)(ws + WS_MIXED), PW, 256, (const bf16*)(wl + WO_MAP), 256, (const bf16*)(ws + WS_SA), (const bf16*)(ws + WS_SB), (bf16*)(ws + WS_MA), nullptr,
                          (const bf16*)(ws + WS_GBCV), (const bf16*)(wl + WO_CO), CW);
        }
        GRID_BAR();
        if constexpr (PHMASK & 32) {
            const Args a = load_args(kp); unsigned char* ws = a.ws; unsigned char* wl = ws + WS_W + (size_t)l * W_LAYER;
            pg8::Gemm g{(const bf16*)(ws + WS_MA), (const bf16*)(wl + WO_O), MP, D, D, D, 0, 0}; pg8::StaticOrder S; S.init(MP, D, F.G, F.bid);
            EpiRes E{(bf16*)(ws + WS_XB), (float*)(ws + WS_SSQ)};
            pg8::gemm_phase<EpiRes, pg8::StaticOrder, true, true>(F.lds, g, S, E);
            small_gemm<2>(F, (const bf16*)(ws + WS_MA), D, 0, (const bf16*)(wl + WO_O), D, nullptr, nullptr, (bf16*)(ws + WS_XB), (float*)(ws + WS_SSQ));
        }
        GRID_BAR();
        if constexpr (PHMASK & 64) {
            const Args a = load_args(kp); unsigned char* ws = a.ws; unsigned char* wl = ws + WS_W + (size_t)l * W_LAYER;
            pg8::Gemm g{(const bf16*)(ws + WS_XB), (const bf16*)(wl + WO_UP), M, FF2, D, D, 0, 0}; pg8::StaticOrder S; S.init(M, FF2, F.G, F.bid);
            EpiUpAct E{kp, F.lds + EX_OFF, l};
            pg8::gemm_phase<EpiUpAct, pg8::StaticOrder, true, true>(F.lds, g, S, E);
            if constexpr (PROBE == 5) { __syncthreads(); pg8::gemm_phase<EpiUpAct, pg8::StaticOrder, true, true>(F.lds, g, S, E); }
        }
        GRID_BAR();
        if constexpr (PHMASK & 128) { const Args a = load_args(kp); ffn_fixup(F, a, l);
            unsigned char* ws = a.ws; unsigned char* wl = ws + WS_W + (size_t)l * W_LAYER; __syncthreads();
            small_gemm<2>(F, (const bf16*)(ws + WS_ACT), FF, 0, (const bf16*)(wl + WO_DN), FF, nullptr, nullptr, (bf16*)(ws + WS_XB), (float*)(ws + WS_SSQ)); }
        GRID_BAR();
        if constexpr (PHMASK & 256) {
            const Args a = load_args(kp); unsigned char* ws = a.ws; unsigned char* wl = ws + WS_W + (size_t)l * W_LAYER;
            pg8::Gemm g{(const bf16*)(ws + WS_ACT), (const bf16*)(wl + WO_DN), MP, D, FF, FF, 0, 0}; pg8::StaticOrder S; S.init(MP, D, F.G, F.bid);
            EpiRes E{(bf16*)(ws + WS_XB), (float*)(ws + WS_SSQ)};
            pg8::gemm_phase<EpiRes, pg8::StaticOrder, true, true>(F.lds, g, S, E);
        }
        GRID_BAR();
    }
    if constexpr (PHMASK & 512) { const Args a = load_args(kp); final_norm(F, a); }
    if constexpr (PROBE == 1) { for (int i = 0; i < 16; ++i) GRID_BAR(); }
}

extern "C" void kernel_launch(void* const* d_in, const int* in_sizes, int n_in, void* d_out, int out_size, void* d_ws, size_t ws_size, hipStream_t stream) {
    static int grid = 0;
    if (grid == 0) {
        if (n_in != 19 || in_sizes[0] != MP * D || (size_t)out_size != O_END || ws_size < WS_END) {
            fprintf(stderr, "kernel_launch: unexpected shapes: n_in %d in0 %d out %d ws %zu (need %zu)\n", n_in, n_in > 0 ? in_sizes[0] : -1, out_size, ws_size, (size_t)WS_END); grid = -1; return; }
        int dev = 0, cus = 0, per_cu = 0;
        hipGetDevice(&dev); hipDeviceGetAttribute(&cus, hipDeviceAttributeMultiprocessorCount, dev);
        if (hipFuncSetAttribute((const void*)fwd_mega, hipFuncAttributeMaxDynamicSharedMemorySize, LDS_BYTES) != hipSuccess) { fprintf(stderr, "kernel_launch: hipFuncSetAttribute failed\n"); grid = -1; return; }
        if (hipOccupancyMaxActiveBlocksPerMultiprocessor(&per_cu, (const void*)fwd_mega, NTHR, LDS_BYTES) != hipSuccess || per_cu < 1) { fprintf(stderr, "kernel_launch: occupancy query says %d\n", per_cu); per_cu = 1; }
        (void)hipGetLastError();
        grid = cus;
    }
    if (grid < 0) return;
    Args a{};
    for (int i = 0; i < 19; ++i) a.in[i] = (const float*)d_in[i];
    a.out = (float*)d_out; a.ws = (unsigned char*)d_ws;
    void* args[] = {&a};
    if (hipMemsetAsync(d_ws, 0, 16384, stream) != hipSuccess) { fprintf(stderr, "kernel_launch: hipMemsetAsync failed\n"); return; }
    hipError_t e = hipLaunchCooperativeKernel((const void*)fwd_mega, dim3(grid), dim3(NTHR), args, LDS_BYTES, stream);
    if (e != hipSuccess) fprintf(stderr, "cooperative launch failed: %s (grid %d)\n", hipGetErrorString(e), grid);
}
```

```cpp
#include <hip/hip_runtime.h>
#include <hip/hip_cooperative_groups.h>
#include <cstdio>
#include <cstdint>
namespace cg = cooperative_groups;

namespace pg8 {
#define PG8_LAS __attribute__((address_space(3)))
typedef unsigned short bf16_t;
typedef short bf16x8 __attribute__((ext_vector_type(8)));
typedef float f32x4 __attribute__((ext_vector_type(4)));
typedef unsigned u32x4 __attribute__((ext_vector_type(4)));
constexpr int BM = 256, BK = 64, HALF = 128, HTB = HALF * BK * 2, STAGE_BYTES = 8 * HTB, NXCD = 8, WGM = 8;

__host__ __device__ __forceinline__ int lds_byte(int r, int c) { const int st = (r >> 4) * 2 + (c >> 5), rr = r & 15, cc = c & 31, ob = rr * 64 + cc * 2; return st * 1024 + (ob ^ (((ob >> 9) & 1) << 5)); }
__host__ __device__ __forceinline__ void stage_rc(int b, int& R, int& C) { const int st = b / 1024, sb = b % 1024, swz = sb ^ (((sb >> 9) & 1) << 5); R = (st >> 1) * 16 + swz / 64; C = (st & 1) * 32 + (swz % 64) / 2; }
__host__ __device__ __forceinline__ int perm32(int rho) { const int n = rho >> 4, i = rho & 15; return 8 * (i >> 2) + 4 * n + (i & 3); }

struct Unit { int pm, pn; };
struct Gemm { const bf16_t* A; const bf16_t* Bt; int M, N, K, lda, apn_shift, apn_bytes; };

struct StaticOrder {
    int nM, nN, nwg, G, c;
    __host__ __device__ void init(int M, int N, int G_, int c_) { nM = M / BM; nN = N / BM; nwg = nM * nN; G = G_; c = c_; }
    __host__ __device__ bool next(int i, Unit& u) const {
        const long L = (long)i * G + c; if (L >= nwg) return false;
        int wgid = (int)L; { const int q = nwg / NXCD, r = nwg % NXCD, xcd = wgid % NXCD, off = wgid / NXCD; wgid = (xcd < r ? xcd * (q + 1) : r * (q + 1) + (xcd - r) * q) + off; }
        const int nig = WGM * nN, gid = wgid / nig, fm = gid * WGM, gsz = (nM - fm) < WGM ? (nM - fm) : WGM;
        u.pm = fm + ((wgid % nig) % gsz); u.pn = (wgid % nig) / gsz; return true;
    }
    __device__ __forceinline__ void a_ready(const Unit&) const {}
    __device__ __forceinline__ void done(const Unit&) const {}
};

__device__ __forceinline__ unsigned cvt_pk_bf16(float lo, float hi) { unsigned r; asm volatile("v_cvt_pk_bf16_f32 %0, %1, %2" : "=v"(r) : "v"(lo), "v"(hi)); return r; }

template <class Epi, class Sched, bool ALIGN_EPI = false, bool SP2 = false>
__device__ __forceinline__ void gemm_phase(PG8_LAS unsigned char* lds, const Gemm g, const Sched& S_in, const Epi& E) {
    int tid_ = threadIdx.x; asm volatile("" : "+v"(tid_));
    const int tid = tid_, wid = __builtin_amdgcn_readfirstlane(tid >> 6), lane = tid & 63, wr = wid >> 2, wc = wid & 3, fr = lane & 15, fq = lane >> 4;
    const int K = g.K, nt = K / BK, lda = g.lda;
    unsigned voffA[2], voffB[2];
#pragma unroll
    for (int i = 0; i < 2; ++i) { int R, C; stage_rc(tid * 16 + i * 8192, R, C); const int Rb = Epi::PERM ? ((R & ~31) + perm32(R & 31)) : R;
        voffA[i] = (unsigned)(R * lda + C) * 2u; voffB[i] = (unsigned)(Rb * K + C) * 2u; }
    const size_t kstep = (size_t)(BK * 2);
    const size_t hstepA = (size_t)HALF * lda * 2, hstepB = (size_t)HALF * K * 2;
    const size_t tstepA = 2 * hstepA, tstepB = 2 * hstepB;
    const unsigned ldsw = (unsigned)wid * 1024u;
    const int aoff = lds_byte(wr * 64 + fr, fq * 8), boff = lds_byte(wc * 32 + fr, fq * 8);
#define PG8_SA(b, h) (((b) * 2 + (h)) * HTB)
#define PG8_SB(b, h) ((4 + (b) * 2 + (h)) * HTB)
#define PG8_STAGE(bufoff, gbase, voff) do { _Pragma("unroll") for (int _i = 0; _i < 2; ++_i) \
        __builtin_amdgcn_global_load_lds((const unsigned*)((const char*)(gbase) + (voff)[_i]), (PG8_LAS unsigned*)(lds + (bufoff) + ldsw + _i * 8192), 16, 0, 0); } while (0)
#define PG8_LDA(dst, b, h) do { _Pragma("unroll") for (int m = 0; m < 4; ++m) _Pragma("unroll") for (int k = 0; k < 2; ++k) dst[m][k] = *(const PG8_LAS bf16x8*)(lds + PG8_SA(b, h) + aoff + m * 2048 + k * 1024); } while (0)
#define PG8_LDB(dst, b, h) do { _Pragma("unroll") for (int n = 0; n < 2; ++n) _Pragma("unroll") for (int k = 0; k < 2; ++k) dst[n][k] = *(const PG8_LAS bf16x8*)(lds + PG8_SB(b, h) + boff + n * 2048 + k * 1024); } while (0)
#define PG8_MMA(ai, bj, At, Bt) do { __builtin_amdgcn_s_setprio(1); _Pragma("unroll") for (int m = 0; m < 4; ++m) _Pragma("unroll") for (int n = 0; n < 2; ++n) _Pragma("unroll") for (int k = 0; k < 2; ++k) \
        acc[ai][bj][m][n] = __builtin_amdgcn_mfma_f32_16x16x32_bf16(Bt[n][k], At[m][k], acc[ai][bj][m][n], 0, 0, 0); __builtin_amdgcn_s_setprio(0); } while (0)
#define PG8_WAIT_V(n) asm volatile("s_waitcnt vmcnt(" #n ")" ::: "memory")
#define PG8_WAIT_L(n) asm volatile("s_waitcnt lgkmcnt(" #n ")" ::: "memory")
#define PG8_BAR __builtin_amdgcn_s_barrier()
#define PG8_SCHED __builtin_amdgcn_sched_barrier(0)
    Unit cur, nxt; int ui = 0;
    Sched S = S_in; asm volatile("" : "+s"(S.c));
    if (!S.next(0, cur)) return;
    f32x4 acc[2][2][4][2];
#pragma unroll
    for (int a = 0; a < 2; ++a)
#pragma unroll
        for (int b = 0; b < 2; ++b)
#pragma unroll
            for (int m = 0; m < 4; ++m)
#pragma unroll
                for (int n = 0; n < 2; ++n) acc[a][b][m][n] = (f32x4){0.f, 0.f, 0.f, 0.f};
    bf16x8 At[4][2], B0[2][2], B1[2][2];
    const char* cA = (const char*)g.A + (size_t)cur.pm * tstepA + (size_t)(cur.pn >> g.apn_shift) * g.apn_bytes; const char* cB = (const char*)g.Bt + (size_t)cur.pn * tstepB;
    S.a_ready(cur);
    if constexpr (SP2) {
        PG8_STAGE(PG8_SB(0, 0), cB, voffB); PG8_STAGE(PG8_SB(0, 1), cB + hstepB, voffB); PG8_STAGE(PG8_SA(0, 0), cA, voffA); PG8_STAGE(PG8_SA(0, 1), cA + hstepA, voffA);
        if (wr == 1) PG8_BAR;
        PG8_WAIT_V(2); PG8_BAR;
        PG8_STAGE(PG8_SB(1, 0), cB + kstep, voffB); PG8_STAGE(PG8_SA(1, 0), cA + kstep, voffA); PG8_STAGE(PG8_SB(1, 1), cB + hstepB + kstep, voffB);
        PG8_WAIT_V(6); PG8_BAR;
    } else {
        PG8_STAGE(PG8_SB(0, 0), cB, voffB); PG8_STAGE(PG8_SA(0, 0), cA, voffA); PG8_STAGE(PG8_SB(0, 1), cB + hstepB, voffB); PG8_STAGE(PG8_SA(0, 1), cA + hstepA, voffA);
        if (wr == 1) PG8_BAR;
        PG8_WAIT_V(4); PG8_BAR;
        PG8_STAGE(PG8_SB(1, 0), cB + kstep, voffB); PG8_STAGE(PG8_SA(1, 0), cA + kstep, voffA); PG8_STAGE(PG8_SB(1, 1), cB + hstepB + kstep, voffB);
        PG8_WAIT_V(6); PG8_BAR;
    }
    for (;;) {
        const bool has_next = S.next(ui + 1, nxt);
        const char* nA = has_next ? (const char*)g.A + (size_t)nxt.pm * tstepA + (size_t)(nxt.pn >> g.apn_shift) * g.apn_bytes : cA; const char* nB = has_next ? (const char*)g.Bt + (size_t)nxt.pn * tstepB : cB;
#pragma unroll 1
        for (int t = 0; t < nt; t += 2) {
            const bool last = (t == nt - 2);
            const char* a1 = cA + (size_t)(t + 1) * kstep;
            const char* a2 = last ? nA : cA + (size_t)(t + 2) * kstep; const char* b2 = last ? nB : cB + (size_t)(t + 2) * kstep;
            const char* a3 = a2 + kstep; const char* b3 = b2 + kstep;
            if (last && has_next) S.a_ready(nxt);
            if (last) E.prefetch(cur, lds, wid, lane);
            if constexpr (SP2) {
            PG8_LDB(B0, 0, 0); PG8_LDB(B1, 0, 1); PG8_SCHED; PG8_LDA(At, 0, 0); PG8_STAGE(PG8_SA(1, 1), a1 + hstepA, voffA);
            PG8_WAIT_V(8); PG8_WAIT_L(0); PG8_BAR; PG8_MMA(0, 0, At, B0); PG8_MMA(0, 1, At, B1); PG8_BAR; PG8_SCHED;
            PG8_LDA(At, 0, 1); PG8_STAGE(PG8_SB(0, 0), b2, voffB); PG8_STAGE(PG8_SB(0, 1), b2 + hstepB, voffB); PG8_STAGE(PG8_SA(0, 0), a2, voffA);
            PG8_WAIT_V(8); PG8_WAIT_L(0); PG8_BAR; PG8_MMA(1, 0, At, B0); PG8_MMA(1, 1, At, B1); PG8_BAR; PG8_SCHED;
            PG8_LDB(B0, 1, 0); PG8_LDB(B1, 1, 1); PG8_SCHED; PG8_LDA(At, 1, 0); PG8_STAGE(PG8_SA(0, 1), a2 + hstepA, voffA);
            PG8_WAIT_V(8); PG8_WAIT_L(0); PG8_BAR; PG8_MMA(0, 0, At, B0); PG8_MMA(0, 1, At, B1); PG8_BAR; PG8_SCHED;
            PG8_LDA(At, 1, 1); PG8_STAGE(PG8_SB(1, 0), b3, voffB); PG8_STAGE(PG8_SB(1, 1), b3 + hstepB, voffB); PG8_STAGE(PG8_SA(1, 0), a3, voffA);
            PG8_WAIT_V(8); PG8_WAIT_L(0); PG8_BAR; PG8_MMA(1, 0, At, B0); PG8_MMA(1, 1, At, B1); PG8_BAR; PG8_SCHED;
            } else {
            PG8_LDB(B0, 0, 0); PG8_SCHED; PG8_LDA(At, 0, 0); PG8_STAGE(PG8_SA(1, 1), a1 + hstepA, voffA);
            PG8_WAIT_L(8); PG8_BAR; PG8_WAIT_L(0); PG8_MMA(0, 0, At, B0); PG8_BAR; PG8_SCHED;
            PG8_LDB(B1, 0, 1); PG8_STAGE(PG8_SB(0, 0), b2, voffB);
            PG8_BAR; PG8_WAIT_L(0); PG8_MMA(0, 1, At, B1); PG8_BAR;
            PG8_LDA(At, 0, 1); PG8_STAGE(PG8_SA(0, 0), a2, voffA);
            PG8_BAR; PG8_WAIT_L(0); PG8_MMA(1, 0, At, B0); PG8_BAR; PG8_SCHED;
            PG8_STAGE(PG8_SB(0, 1), b2 + hstepB, voffB);
            PG8_WAIT_V(6); PG8_BAR; PG8_MMA(1, 1, At, B1); PG8_BAR;
            PG8_LDB(B0, 1, 0); PG8_SCHED; PG8_LDA(At, 1, 0); PG8_STAGE(PG8_SA(0, 1), a2 + hstepA, voffA);
            PG8_WAIT_L(8); PG8_BAR; PG8_WAIT_L(0); PG8_MMA(0, 0, At, B0); PG8_BAR; PG8_SCHED;
            PG8_LDB(B1, 1, 1); PG8_STAGE(PG8_SB(1, 0), b3, voffB);
            PG8_BAR; PG8_WAIT_L(0); PG8_MMA(0, 1, At, B1); PG8_BAR;
            PG8_LDA(At, 1, 1); PG8_STAGE(PG8_SA(1, 0), a3, voffA);
            PG8_BAR; PG8_WAIT_L(0); PG8_MMA(1, 0, At, B0); PG8_BAR; PG8_SCHED;
            PG8_STAGE(PG8_SB(1, 1), b3 + hstepB, voffB);
            PG8_WAIT_V(6); PG8_BAR; PG8_MMA(1, 1, At, B1); PG8_BAR;
            }
        }
        if constexpr (ALIGN_EPI) { if (wr == 0) PG8_BAR; }
        E(acc, cur, wr, wc, fr, fq); S.done(cur);
        if (!has_next) break;
#pragma unroll
        for (int a = 0; a < 2; ++a)
#pragma unroll
            for (int b = 0; b < 2; ++b)
#pragma unroll
                for (int m = 0; m < 4; ++m)
#pragma unroll
                    for (int n = 0; n < 2; ++n) acc[a][b][m][n] = (f32x4){0.f, 0.f, 0.f, 0.f};
        cur = nxt; cA = nA; cB = nB; ++ui;
        if constexpr (ALIGN_EPI) { if (wr == 1) PG8_BAR; }
    }
    PG8_WAIT_V(0);
    if constexpr (!ALIGN_EPI) { if (wr == 0) PG8_BAR; }
    PG8_BAR;
#undef PG8_SA
#undef PG8_SB
#undef PG8_STAGE
#undef PG8_LDA
#undef PG8_LDB
#undef PG8_MMA
#undef PG8_WAIT_V
#undef PG8_WAIT_L
#undef PG8_BAR
#undef PG8_SCHED
}

struct Gemm2 { const bf16_t* A0; const bf16_t* B0; int K0, apn_shift0, apn_bytes0; const bf16_t* A1; const bf16_t* B1; int K1; int lda; };
template <class Epi, class Sched>
__device__ __forceinline__ void gemm_phase2(PG8_LAS unsigned char* lds, const Gemm2 g, const Sched& S_in, const Epi& E) {
    int tid_ = threadIdx.x; asm volatile("" : "+v"(tid_));
    const int tid = tid_, wid = __builtin_amdgcn_readfirstlane(tid >> 6), lane = tid & 63, wr = wid >> 2, wc = wid & 3, fr = lane & 15, fq = lane >> 4;
    const int lda = g.lda;
    unsigned voffA[2], voffB0[2], voffB1[2];
#pragma unroll
    for (int i = 0; i < 2; ++i) { int R, C; stage_rc(tid * 16 + i * 8192, R, C); const int Rb = Epi::PERM ? ((R & ~31) + perm32(R & 31)) : R;
        voffA[i] = (unsigned)(R * lda + C) * 2u; voffB0[i] = (unsigned)(Rb * g.K0 + C) * 2u; voffB1[i] = (unsigned)(Rb * g.K1 + C) * 2u; }
    const size_t kstep = (size_t)(BK * 2);
    const size_t hstepA = (size_t)HALF * lda * 2, tstepA = 2 * hstepA;
    const size_t hstepB0 = (size_t)HALF * g.K0 * 2, hstepB1 = (size_t)HALF * g.K1 * 2, tstepB0 = 2 * hstepB0, tstepB1 = 2 * hstepB1;
    const unsigned ldsw = (unsigned)wid * 1024u;
    const int aoff = lds_byte(wr * 64 + fr, fq * 8), boff = lds_byte(wc * 32 + fr, fq * 8);
#define PG8_SA(b, h) (((b) * 2 + (h)) * HTB)
#define PG8_SB(b, h) ((4 + (b) * 2 + (h)) * HTB)
#define PG8_STAGE(bufoff, gbase, voff) do { _Pragma("unroll") for (int _i = 0; _i < 2; ++_i) \
        __builtin_amdgcn_global_load_lds((const unsigned*)((const char*)(gbase) + (voff)[_i]), (PG8_LAS unsigned*)(lds + (bufoff) + ldsw + _i * 8192), 16, 0, 0); } while (0)
#define PG8_LDA(dst, b, h) do { _Pragma("unroll") for (int m = 0; m < 4; ++m) _Pragma("unroll") for (int k = 0; k < 2; ++k) dst[m][k] = *(const PG8_LAS bf16x8*)(lds + PG8_SA(b, h) + aoff + m * 2048 + k * 1024); } while (0)
#define PG8_LDB(dst, b, h) do { _Pragma("unroll") for (int n = 0; n < 2; ++n) _Pragma("unroll") for (int k = 0; k < 2; ++k) dst[n][k] = *(const PG8_LAS bf16x8*)(lds + PG8_SB(b, h) + boff + n * 2048 + k * 1024); } while (0)
#define PG8_MMA(ai, bj, At, Bt) do { __builtin_amdgcn_s_setprio(1); _Pragma("unroll") for (int m = 0; m < 4; ++m) _Pragma("unroll") for (int n = 0; n < 2; ++n) _Pragma("unroll") for (int k = 0; k < 2; ++k) \
        acc[ai][bj][m][n] = __builtin_amdgcn_mfma_f32_16x16x32_bf16(Bt[n][k], At[m][k], acc[ai][bj][m][n], 0, 0, 0); __builtin_amdgcn_s_setprio(0); } while (0)
#define PG8_WAIT_V(n) asm volatile("s_waitcnt vmcnt(" #n ")" ::: "memory")
#define PG8_WAIT_L(n) asm volatile("s_waitcnt lgkmcnt(" #n ")" ::: "memory")
#define PG8_BAR __builtin_amdgcn_s_barrier()
#define PG8_SCHED __builtin_amdgcn_sched_barrier(0)
#define PG8_A0BASE(u) ((const char*)g.A0 + (size_t)(u).pm * tstepA + (size_t)((u).pn >> g.apn_shift0) * g.apn_bytes0)
    Unit cur, nxt; int ui = 0;
    Sched S = S_in; asm volatile("" : "+s"(S.c));
    if (!S.next(0, cur)) return;
    f32x4 acc[2][2][4][2];
#pragma unroll
    for (int a = 0; a < 2; ++a)
#pragma unroll
        for (int b = 0; b < 2; ++b)
#pragma unroll
            for (int m = 0; m < 4; ++m)
#pragma unroll
                for (int n = 0; n < 2; ++n) acc[a][b][m][n] = (f32x4){0.f, 0.f, 0.f, 0.f};
    bf16x8 At[4][2], B0[2][2], B1[2][2];
    const char* cA = PG8_A0BASE(cur); const char* cB = (const char*)g.B0 + (size_t)cur.pn * tstepB0;
    PG8_STAGE(PG8_SB(0, 0), cB, voffB0); PG8_STAGE(PG8_SB(0, 1), cB + hstepB0, voffB0); PG8_STAGE(PG8_SA(0, 0), cA, voffA); PG8_STAGE(PG8_SA(0, 1), cA + hstepA, voffA);
    if (wr == 1) PG8_BAR;
    PG8_WAIT_V(2); PG8_BAR;
    PG8_STAGE(PG8_SB(1, 0), cB + kstep, voffB0); PG8_STAGE(PG8_SA(1, 0), cA + kstep, voffA); PG8_STAGE(PG8_SB(1, 1), cB + hstepB0 + kstep, voffB0);
    PG8_WAIT_V(6); PG8_BAR;
#define PG8_KLOOP(NT, CA, CB, VC, HC, NA, NB, VN, HN, HOOK) do { \
        _Pragma("unroll 1") for (int t = 0; t < (NT); t += 2) { \
            const bool last = (t == (NT) - 2); \
            if (last) { HOOK; } \
            const char* a1 = (CA) + (size_t)(t + 1) * kstep; \
            const char* a2 = last ? (NA) : (CA) + (size_t)(t + 2) * kstep; const char* b2 = last ? (NB) : (CB) + (size_t)(t + 2) * kstep; \
            const char* a3 = a2 + kstep; const char* b3 = b2 + kstep; \
            const size_t hB = last ? (HN) : (HC); unsigned vB[2]; vB[0] = last ? (VN)[0] : (VC)[0]; vB[1] = last ? (VN)[1] : (VC)[1]; \
            PG8_LDB(B0, 0, 0); PG8_LDB(B1, 0, 1); PG8_SCHED; PG8_LDA(At, 0, 0); PG8_STAGE(PG8_SA(1, 1), a1 + hstepA, voffA); \
            PG8_WAIT_V(8); PG8_WAIT_L(0); PG8_BAR; PG8_MMA(0, 0, At, B0); PG8_MMA(0, 1, At, B1); PG8_BAR; PG8_SCHED; \
            PG8_LDA(At, 0, 1); PG8_STAGE(PG8_SB(0, 0), b2, vB); PG8_STAGE(PG8_SB(0, 1), b2 + hB, vB); PG8_STAGE(PG8_SA(0, 0), a2, voffA); \
            PG8_WAIT_V(8); PG8_WAIT_L(0); PG8_BAR; PG8_MMA(1, 0, At, B0); PG8_MMA(1, 1, At, B1); PG8_BAR; PG8_SCHED; \
            PG8_LDB(B0, 1, 0); PG8_LDB(B1, 1, 1); PG8_SCHED; PG8_LDA(At, 1, 0); PG8_STAGE(PG8_SA(0, 1), a2 + hstepA, voffA); \
            PG8_WAIT_V(8); PG8_WAIT_L(0); PG8_BAR; PG8_MMA(0, 0, At, B0); PG8_MMA(0, 1, At, B1); PG8_BAR; PG8_SCHED; \
            PG8_LDA(At, 1, 1); PG8_STAGE(PG8_SB(1, 0), b3, vB); PG8_STAGE(PG8_SB(1, 1), b3 + hB, vB); PG8_STAGE(PG8_SA(1, 0), a3, voffA); \
            PG8_WAIT_V(8); PG8_WAIT_L(0); PG8_BAR; PG8_MMA(1, 0, At, B0); PG8_MMA(1, 1, At, B1); PG8_BAR; PG8_SCHED; \
        } } while (0)
    const int nt0 = g.K0 / BK, nt1 = g.K1 / BK;
    for (;;) {
        const bool has_next = S.next(ui + 1, nxt);
        const char* cA1 = (const char*)g.A1 + (size_t)cur.pm * tstepA; const char* cB1 = (const char*)g.B1 + (size_t)cur.pn * tstepB1;
        PG8_KLOOP(nt0, cA, cB, voffB0, hstepB0, cA1, cB1, voffB1, hstepB1, (void)0);
        if (wr == 0) PG8_BAR;
        E.mid(acc, cur, wr, wc, fr, fq);
        if (wr == 1) PG8_BAR;
        const char* nA = has_next ? PG8_A0BASE(nxt) : cA1; const char* nB = has_next ? (const char*)g.B0 + (size_t)nxt.pn * tstepB0 : cB1;
        const size_t hBn = has_next ? hstepB0 : hstepB1; unsigned vBn[2]; vBn[0] = has_next ? voffB0[0] : voffB1[0]; vBn[1] = has_next ? voffB0[1] : voffB1[1];
        PG8_KLOOP(nt1, cA1, cB1, voffB1, hstepB1, nA, nB, vBn, hBn, (void)0);
        if (wr == 0) PG8_BAR;
        E.fin(acc, cur, wr, wc, fr, fq);
        if (!has_next) break;
#pragma unroll
        for (int a = 0; a < 2; ++a)
#pragma unroll
            for (int b = 0; b < 2; ++b)
#pragma unroll
                for (int m = 0; m < 4; ++m)
#pragma unroll
                    for (int n = 0; n < 2; ++n) acc[a][b][m][n] = (f32x4){0.f, 0.f, 0.f, 0.f};
        cur = nxt; cA = nA; cB = nB; ++ui;
        if (wr == 1) PG8_BAR;
    }
#undef PG8_KLOOP
    PG8_WAIT_V(0);
    PG8_BAR;
#undef PG8_A0BASE
#undef PG8_SA
#undef PG8_SB
#undef PG8_STAGE
#undef PG8_LDA
#undef PG8_LDB
#undef PG8_MMA
#undef PG8_WAIT_V
#undef PG8_WAIT_L
#undef PG8_BAR
#undef PG8_SCHED
}
}

typedef unsigned short bf16;
typedef float f32x4 __attribute__((ext_vector_type(4)));
typedef unsigned u32x4 __attribute__((ext_vector_type(4)));
typedef unsigned u32x2 __attribute__((ext_vector_type(2)));
#define LAS __attribute__((address_space(3)))

constexpr int D = 1024, MP = 32768, MS = 1024, M = MP + MS, NTILE = M / 256, NTP = MP / 256;
constexpr int INW = 4096, PW = 512, CW = 512, FF = 2816, FF2 = 5632;
constexpr float EPS = 1e-6f;
constexpr int NWAVES = 8, NTHR = 512;
constexpr int LDS_BYTES = 155648;
#ifndef PHMASK
#define PHMASK 0xFFFF
#endif
#ifndef PROBE
#define PROBE 0
#endif

constexpr size_t O_POOLP = (size_t)M * D;
constexpr size_t O_CONVP = O_POOLP + 2 * 8 * 15 * 512;
constexpr size_t O_FFNP = O_CONVP + 2 * 8 * 2 * 512;
constexpr size_t O_POOLS = O_FFNP + 2 * 8 * 2 * 5632;
constexpr size_t O_CONVS = O_POOLS + 2 * 16 * 15 * 512;
constexpr size_t O_FFNS = O_CONVS + 2 * 16 * 2 * 512;
constexpr size_t O_END = O_FFNS + 2 * 16 * 2 * 5632;

constexpr size_t MiB = 1u << 20;
constexpr size_t WS_SSQ = 1 * MiB;
constexpr size_t WS_W = 4 * MiB, W_LAYER = 28 * MiB;
constexpr size_t WO_IN = 0, WO_UP = 8 * MiB, WO_DN = 19 * MiB, WO_O = 24 * MiB + MiB / 2, WO_CO = 26 * MiB + MiB / 2, WO_MAP = 27 * MiB + MiB / 2;
constexpr size_t WS_XB = 60 * MiB;
constexpr size_t WS_ACTV = 126 * MiB;
constexpr size_t WS_UPOOL = WS_ACTV, WS_CVIN = WS_ACTV + 33 * MiB, WS_GB = WS_ACTV + 66 * MiB, WS_SA = WS_ACTV + 99 * MiB, WS_SB = WS_ACTV + 165 * MiB,
                 WS_MIXED = WS_ACTV + 231 * MiB, WS_GBCV = WS_ACTV + 264 * MiB, WS_MA = WS_ACTV;
constexpr size_t WS_ACT = WS_ACTV;
constexpr size_t WS_HALO = WS_ACTV + 182 * MiB;
constexpr size_t WS_END = WS_ACTV + 297 * MiB;
constexpr int BST_OFF = 131072 + 8192;
constexpr int EX_OFF = 131072;
constexpr int RC_OFF = 131072 + 8192 + 256;
constexpr int WCV_OFF = 147456;
constexpr int GATE_OFF = 151552;
constexpr int RCT_OFF = RC_OFF + 4096;

__device__ __forceinline__ float bf_lo(unsigned w) { return __builtin_bit_cast(float, w << 16); }
__device__ __forceinline__ float bf_hi(unsigned w) { return __builtin_bit_cast(float, w & 0xffff0000u); }
__device__ __forceinline__ unsigned pk2(float lo, float hi) { return pg8::cvt_pk_bf16(lo, hi); }
__device__ __forceinline__ float sigmoidf_(float x) { return __builtin_amdgcn_rcpf(1.f + __builtin_amdgcn_exp2f(-1.44269504f * x)); }
#define UNPACK8(V_, F_) do { F_[0] = bf_lo((V_)[0]); F_[1] = bf_hi((V_)[0]); F_[2] = bf_lo((V_)[1]); F_[3] = bf_hi((V_)[1]); F_[4] = bf_lo((V_)[2]); F_[5] = bf_hi((V_)[2]); F_[6] = bf_lo((V_)[3]); F_[7] = bf_hi((V_)[3]); } while (0)

struct Args { const float* in[19]; float* out; unsigned char* ws; };
typedef const __attribute__((address_space(4))) Args* KArgs;
__device__ __forceinline__ Args load_args(KArgs kp) {
    asm volatile("" : "+s"(kp)); Args a;
#pragma unroll
    for (int i = 0; i < 19; ++i) a.in[i] = kp->in[i];
    a.out = kp->out; a.ws = kp->ws; return a;
}

__device__ __forceinline__ void unit_rstd(const float* ssq, int pm, int wr, int wc, int fr, int fq, int tagv, LAS unsigned char* lds, float (&r)[2][4]) {
    const int lane = fq * 16 + fr, wave = wr * 4 + wc;
    LAS float* rc = (LAS float*)(lds + RC_OFF) + (wave * 64 + lane) * 2;
    LAS int* tg = (LAS int*)(lds + RCT_OFF) + wave;
    float rs[2];
    if (__builtin_amdgcn_readfirstlane(tg[0]) == tagv) { rs[0] = rc[0]; rs[1] = rc[1]; }
    else {
#pragma unroll
        for (int ai = 0; ai < 2; ++ai) {
            const f32x4* p = (const f32x4*)(ssq + (size_t)(pm * 256 + ai * 128 + wr * 64 + lane) * 16);
            const f32x4 a = p[0], b = p[1], c = p[2], d = p[3];
            const float s = ((a.x + a.y) + (a.z + a.w)) + ((b.x + b.y) + (b.z + b.w)) + ((c.x + c.y) + (c.z + c.w)) + ((d.x + d.y) + (d.z + d.w));
            rs[ai] = 1.0f / sqrtf(s * (1.0f / D) + EPS);
        }
        rc[0] = rs[0]; rc[1] = rs[1]; if (lane == 0) tg[0] = tagv;
    }
#pragma unroll
    for (int ai = 0; ai < 2; ++ai)
#pragma unroll
        for (int m = 0; m < 4; ++m) r[ai][m] = __shfl(rs[ai], m * 16 + fr);
}

__device__ __forceinline__ void touch_tile_lines(const bf16* base, int pm, int pn, LAS unsigned char* lds, int wid, int lane) {
#pragma unroll
    for (int q = 0; q < 2; ++q) { const int idx = (wid * 2 + q) * 64 + lane, row = idx >> 2, line = idx & 3;
        __builtin_amdgcn_global_load_lds((const unsigned*)(base + ((size_t)pm * 256 + row) * D + pn * 256 + line * 64), (LAS unsigned*)(lds + WCV_OFF + (wid * 2 + q) * 256), 4, 0, 0); }
}
template <class T> __device__ __forceinline__ T* launder_s(T* p) { asm volatile("" : "+s"(p)); return p; }
struct EpiProj {
    static constexpr bool PERM = true, AFTER_DRAIN = false;
    __device__ __forceinline__ void prefetch(const pg8::Unit& u, LAS unsigned char* lds, int wid, int lane) const {
        if (u.pn >= 8 && wid < 3) {
            const Args a_ = load_args(kp);
            const float* src = (wid == 2 ? a_.in[9] + (size_t)l * D : a_.in[7] + (size_t)l * 2 * D + wid * D) + (u.pn - 8) * 128 + lane;
            __builtin_amdgcn_global_load_lds((const unsigned*)src, (LAS unsigned*)(lds + GATE_OFF + wid * 512), 4, 0, 0);
            __builtin_amdgcn_global_load_lds((const unsigned*)(src + 64), (LAS unsigned*)(lds + GATE_OFF + wid * 512 + 256), 4, 0, 0);
        }
    }
    KArgs kp; int l; LAS unsigned char* lds0;
    __device__ __forceinline__ void operator()(const f32x4 (&acc)[2][2][4][2], const pg8::Unit& u, int wr, int wc, int fr, int fq) const {
        const Args a_ = load_args(kp); unsigned char* w_ = a_.ws; float* o_ = a_.out; const float* b_gate = a_.in[7] + (size_t)l * 2 * D; const float* pool_scale = a_.in[9] + (size_t)l * D;
        float r[2][4]; unit_rstd((const float*)(w_ + WS_SSQ), u.pm, wr, wc, fr, fq, (2 * l + 0) * 1024 + u.pm, lds0, r);
        const int pm = u.pm, pn = u.pn;
        const int lc0 = wc * 32 + 8 * fq;
        const bool samp = pm >= NTP;
        if (pn < 4) {
            bf16* O = (bf16*)(w_ + ((pn < 2) ? WS_UPOOL : WS_GB)); const int cb = (pn & 1) * 256 + lc0;
#pragma unroll
            for (int ai = 0; ai < 2; ++ai)
#pragma unroll
                for (int m = 0; m < 4; ++m) { const size_t row = (size_t)pm * 256 + ai * 128 + wr * 64 + m * 16 + fr; const float rr = r[ai][m];
#pragma unroll
                    for (int bj = 0; bj < 2; ++bj) { const f32x4 v0 = acc[ai][bj][m][0] * rr, v1 = acc[ai][bj][m][1] * rr; u32x4 w;
                        w.x = pk2(v0[0], v0[1]); w.y = pk2(v0[2], v0[3]); w.z = pk2(v1[0], v1[1]); w.w = pk2(v1[2], v1[3]);
                        *(u32x4*)(O + row * 512 + cb + bj * 128) = w; } }
            if (pn < 2 && (samp || ((pm & 15) == 15 && wr == 1)) && fr >= 1) {
                float* pool_p = o_ + O_POOLP + (size_t)l * 8 * 15 * 512; float* pool_s = o_ + O_POOLS + (size_t)l * 16 * 15 * 512;
#pragma unroll
                for (int ai = 0; ai < 2; ++ai) { if (!samp && ai == 0) continue;
                    float* sp = samp ? pool_s + ((size_t)((pm - NTP) * 4 + ai * 2 + wr) * 15 + (fr - 1)) * 512 : pool_p + ((size_t)(pm >> 4) * 15 + (fr - 1)) * 512;
                    const float rr = r[ai][3];
#pragma unroll
                    for (int bj = 0; bj < 2; ++bj) { *(f32x4*)(sp + cb + bj * 128) = acc[ai][bj][3][0] * rr; *(f32x4*)(sp + cb + bj * 128 + 4) = acc[ai][bj][3][1] * rr; } }
            }
        } else if (pn < 8) {
            const int cb = (pn - 4) * 128 + lc0; bf16* CVIN = (bf16*)(w_ + WS_CVIN);
            float* conv_p = o_ + O_CONVP + (size_t)l * 8 * 2 * 512; float* conv_s = o_ + O_CONVS + (size_t)l * 16 * 2 * 512;
#pragma unroll
            for (int ai = 0; ai < 2; ++ai)
#pragma unroll
                for (int m = 0; m < 4; ++m) { const size_t row = (size_t)pm * 256 + ai * 128 + wr * 64 + m * 16 + fr; const float rr = r[ai][m] * r[ai][m];
                    const f32x4 v0 = acc[ai][0][m][0] * acc[ai][1][m][0] * rr, v1 = acc[ai][0][m][1] * acc[ai][1][m][1] * rr; u32x4 w;
                    w.x = pk2(v0[0], v0[1]); w.y = pk2(v0[2], v0[3]); w.z = pk2(v1[0], v1[1]); w.w = pk2(v1[2], v1[3]);
                    *(u32x4*)(CVIN + row * 512 + cb) = w;
                    if (m == 3 && fr >= 14 && (samp || ((pm & 15) == 15 && wr == 1 && ai == 1))) {
                        float* sp = samp ? conv_s + ((size_t)((pm - NTP) * 4 + ai * 2 + wr) * 2 + (fr - 14)) * 512 : conv_p + ((size_t)(pm >> 4) * 2 + (fr - 14)) * 512;
                        *(f32x4*)(sp + cb) = v0; *(f32x4*)(sp + cb + 4) = v1; } }
        } else {
            bf16* RHO = (bf16*)(w_ + WS_SA); bf16* SBo = (bf16*)(w_ + WS_SB); const int cb = (pn - 8) * 128 + lc0;
            const LAS float* gl_ = (const LAS float*)(lds0 + GATE_OFF) + lc0;
            const f32x4 ba0 = *(const LAS f32x4*)(gl_), ba1 = *(const LAS f32x4*)(gl_ + 4), bb0 = *(const LAS f32x4*)(gl_ + 128), bb1 = *(const LAS f32x4*)(gl_ + 128 + 4);
            const f32x4 ps0 = *(const LAS f32x4*)(gl_ + 256), ps1 = *(const LAS f32x4*)(gl_ + 256 + 4);
#pragma unroll
            for (int ai = 0; ai < 2; ++ai)
#pragma unroll
                for (int m = 0; m < 4; ++m) { const size_t row = (size_t)pm * 256 + ai * 128 + wr * 64 + m * 16 + fr; const float rr = r[ai][m];
                    const f32x4 xa0 = acc[ai][0][m][0] * rr + ba0, xa1 = acc[ai][0][m][1] * rr + ba1, xb0 = acc[ai][1][m][0] * rr + bb0, xb1 = acc[ai][1][m][1] * rr + bb1;
                    f32x4 rh0, rh1, sb0, sb1;
#pragma unroll
                    for (int e = 0; e < 4; ++e) {
                        const float ea0 = __builtin_amdgcn_exp2f(-1.44269504f * fmaxf(xa0[e], -30.f)), eb0 = __builtin_amdgcn_exp2f(-1.44269504f * fmaxf(xb0[e], -30.f));
                        const float ea1 = __builtin_amdgcn_exp2f(-1.44269504f * fmaxf(xa1[e], -30.f)), eb1 = __builtin_amdgcn_exp2f(-1.44269504f * fmaxf(xb1[e], -30.f));
                        sb0[e] = __builtin_amdgcn_rcpf(1.f + eb0); sb1[e] = __builtin_amdgcn_rcpf(1.f + eb1);
                        rh0[e] = ps0[e] * (1.f + eb0) * __builtin_amdgcn_rcpf(1.f + ea0); rh1[e] = ps1[e] * (1.f + eb1) * __builtin_amdgcn_rcpf(1.f + ea1); }
                    u32x4 w; w.x = pk2(rh0[0], rh0[1]); w.y = pk2(rh0[2], rh0[3]); w.z = pk2(rh1[0], rh1[1]); w.w = pk2(rh1[2], rh1[3]);
                    *(u32x4*)(RHO + row * 1024 + cb) = w;
                    u32x4 v; v.x = pk2(sb0[0], sb0[1]); v.y = pk2(sb0[2], sb0[3]); v.z = pk2(sb1[0], sb1[1]); v.w = pk2(sb1[2], sb1[3]);
                    *(u32x4*)(SBo + row * 1024 + cb) = v; }
        }
    }
};

struct EpiPool2 {
    static constexpr bool PERM = true, AFTER_DRAIN = false;
    const bf16* RHO; const bf16* SB; bf16* MA;
    __device__ __forceinline__ void warm_mid(const pg8::Unit& u, LAS unsigned char* lds, int wid, int lane) const { touch_tile_lines(RHO, u.pm, u.pn, lds, wid, lane); }
    __device__ __forceinline__ void warm_fin(const pg8::Unit& u, LAS unsigned char* lds, int wid, int lane) const { touch_tile_lines(SB, u.pm, u.pn, lds, wid, lane); }
    __device__ __forceinline__ void mid(f32x4 (&acc)[2][2][4][2], const pg8::Unit& u, int wr, int wc, int fr, int fq) const {
        const int cb = u.pn * 256 + wc * 32 + 8 * fq;
#pragma unroll
        for (int ai = 0; ai < 2; ++ai) {
            u32x4 sv[4][2];
#pragma unroll
            for (int m = 0; m < 4; ++m)
#pragma unroll
                for (int bj = 0; bj < 2; ++bj) sv[m][bj] = *(const u32x4*)(RHO + ((size_t)u.pm * 256 + ai * 128 + wr * 64 + m * 16 + fr) * 1024 + cb + bj * 128);
#pragma unroll
            for (int m = 0; m < 4; ++m)
#pragma unroll
                for (int bj = 0; bj < 2; ++bj) { float f[8]; UNPACK8(sv[m][bj], f);
                    acc[ai][bj][m][0] = acc[ai][bj][m][0] * (f32x4){f[0], f[1], f[2], f[3]}; acc[ai][bj][m][1] = acc[ai][bj][m][1] * (f32x4){f[4], f[5], f[6], f[7]}; }
            asm volatile("" ::: "memory");
        }
    }
    __device__ __forceinline__ void fin(const f32x4 (&acc)[2][2][4][2], const pg8::Unit& u, int wr, int wc, int fr, int fq) const {
        const int cb = u.pn * 256 + wc * 32 + 8 * fq;
#pragma unroll
        for (int ai = 0; ai < 2; ++ai) {
            u32x4 sv[4][2];
#pragma unroll
            for (int m = 0; m < 4; ++m)
#pragma unroll
                for (int bj = 0; bj < 2; ++bj) sv[m][bj] = *(const u32x4*)(SB + ((size_t)u.pm * 256 + ai * 128 + wr * 64 + m * 16 + fr) * 1024 + cb + bj * 128);
#pragma unroll
            for (int m = 0; m < 4; ++m) { const size_t row = (size_t)u.pm * 256 + ai * 128 + wr * 64 + m * 16 + fr;
#pragma unroll
                for (int bj = 0; bj < 2; ++bj) { const size_t o = row * 1024 + cb + bj * 128; float f[8]; UNPACK8(sv[m][bj], f);
                    const f32x4 a0 = acc[ai][bj][m][0], a1 = acc[ai][bj][m][1]; u32x4 w;
                    w.x = pk2(a0[0] * f[0], a0[1] * f[1]); w.y = pk2(a0[2] * f[2], a0[3] * f[3]); w.z = pk2(a1[0] * f[4], a1[1] * f[5]); w.w = pk2(a1[2] * f[6], a1[3] * f[7]);
                    *(u32x4*)(MA + o) = w; } }
            asm volatile("" ::: "memory");
        }
    }
};

struct EpiMA {
    static constexpr bool PERM = true, AFTER_DRAIN = false;
    __device__ __forceinline__ void prefetch(const pg8::Unit&, LAS unsigned char*, int, int) const {}
    const bf16* SA; bf16* MA;
    __device__ __forceinline__ void operator()(const f32x4 (&acc)[2][2][4][2], const pg8::Unit& u, int wr, int wc, int fr, int fq) const {
        const int cb = u.pn * 256 + wc * 32 + 8 * fq;
#pragma unroll
        for (int ai = 0; ai < 2; ++ai) {
            u32x4 sv[4][2];
#pragma unroll
            for (int m = 0; m < 4; ++m)
#pragma unroll
                for (int bj = 0; bj < 2; ++bj) sv[m][bj] = *(const u32x4*)(SA + ((size_t)u.pm * 256 + ai * 128 + wr * 64 + m * 16 + fr) * 1024 + cb + bj * 128);
#pragma unroll
            for (int m = 0; m < 4; ++m) { const size_t row = (size_t)u.pm * 256 + ai * 128 + wr * 64 + m * 16 + fr;
#pragma unroll
                for (int bj = 0; bj < 2; ++bj) { const size_t o = row * 1024 + cb + bj * 128; float f[8]; UNPACK8(sv[m][bj], f);
                    const f32x4 a0 = acc[ai][bj][m][0], a1 = acc[ai][bj][m][1]; u32x4 w;
                    w.x = pk2(a0[0] * f[0], a0[1] * f[1]); w.y = pk2(a0[2] * f[2], a0[3] * f[3]); w.z = pk2(a1[0] * f[4], a1[1] * f[5]); w.w = pk2(a1[2] * f[6], a1[3] * f[7]);
                    *(u32x4*)(MA + o) = w; } }
            asm volatile("" ::: "memory");
        }
    }
};
struct EpiMerge {
    static constexpr bool PERM = true, AFTER_DRAIN = false;
    __device__ __forceinline__ void prefetch(const pg8::Unit&, LAS unsigned char*, int, int) const {}
    const bf16* SB; bf16* MA;
    __device__ __forceinline__ void operator()(const f32x4 (&acc)[2][2][4][2], const pg8::Unit& u, int wr, int wc, int fr, int fq) const {
        const int cb = u.pn * 256 + wc * 32 + 8 * fq;
#pragma unroll
        for (int ai = 0; ai < 2; ++ai)
#pragma unroll
          for (int mh = 0; mh < 2; ++mh) {
            u32x4 sv[2][2], pv[2][2];
#pragma unroll
            for (int mm = 0; mm < 2; ++mm)
#pragma unroll
                for (int bj = 0; bj < 2; ++bj) { const size_t o = ((size_t)u.pm * 256 + ai * 128 + wr * 64 + (2 * mh + mm) * 16 + fr) * 1024 + cb + bj * 128; sv[mm][bj] = *(const u32x4*)(SB + o); pv[mm][bj] = *(const u32x4*)(MA + o); }
#pragma unroll
            for (int mm = 0; mm < 2; ++mm) { const int m = 2 * mh + mm; const size_t row = (size_t)u.pm * 256 + ai * 128 + wr * 64 + m * 16 + fr;
#pragma unroll
                for (int bj = 0; bj < 2; ++bj) { const size_t o = row * 1024 + cb + bj * 128; float f[8], q[8]; UNPACK8(sv[mm][bj], f); UNPACK8(pv[mm][bj], q);
                    const f32x4 a0 = acc[ai][bj][m][0], a1 = acc[ai][bj][m][1]; u32x4 w;
                    w.x = pk2(a0[0] * f[0] + q[0], a0[1] * f[1] + q[1]); w.y = pk2(a0[2] * f[2] + q[2], a0[3] * f[3] + q[3]);
                    w.z = pk2(a1[0] * f[4] + q[4], a1[1] * f[5] + q[5]); w.w = pk2(a1[2] * f[6] + q[6], a1[3] * f[7] + q[7]);
                    *(u32x4*)(MA + o) = w; } }
            asm volatile("" ::: "memory");
          }
    }
};
struct EpiRes {
    static constexpr bool PERM = true, AFTER_DRAIN = false;
    __device__ __forceinline__ void prefetch(const pg8::Unit& u, LAS unsigned char* lds, int wid, int lane) const { touch_tile_lines(xb, u.pm, u.pn, lds, wid, lane); }
    bf16* xb; float* ssq;
    __device__ __forceinline__ void operator()(const f32x4 (&acc)[2][2][4][2], const pg8::Unit& u, int wr, int wc, int fr, int fq) const {
        const int pm = u.pm, cb = u.pn * 256 + wc * 32 + 8 * fq;
#pragma unroll
        for (int ai = 0; ai < 2; ++ai) {
            u32x4 old[4][2];
#pragma unroll
            for (int m = 0; m < 4; ++m)
#pragma unroll
                for (int bj = 0; bj < 2; ++bj) old[m][bj] = *(const u32x4*)(xb + ((size_t)pm * 256 + ai * 128 + wr * 64 + m * 16 + fr) * D + cb + bj * 128);
#pragma unroll
            for (int m = 0; m < 4; ++m) { const size_t row = (size_t)pm * 256 + ai * 128 + wr * 64 + m * 16 + fr; float sq = 0.f;
#pragma unroll
                for (int bj = 0; bj < 2; ++bj) { float f[8]; UNPACK8(old[m][bj], f);
                    const f32x4 a0 = acc[ai][bj][m][0], a1 = acc[ai][bj][m][1]; u32x4 w;
                    w.x = pk2(a0[0] + f[0], a0[1] + f[1]); w.y = pk2(a0[2] + f[2], a0[3] + f[3]); w.z = pk2(a1[0] + f[4], a1[1] + f[5]); w.w = pk2(a1[2] + f[6], a1[3] + f[7]);
                    *(u32x4*)(xb + row * D + cb + bj * 128) = w;
                    float g[8]; UNPACK8(w, g);
                    sq += (g[0] * g[0] + g[1] * g[1]) + (g[2] * g[2] + g[3] * g[3]) + (g[4] * g[4] + g[5] * g[5]) + (g[6] * g[6] + g[7] * g[7]); }
                sq += __shfl_xor(sq, 16); sq += __shfl_xor(sq, 32);
                if (fq == 0) ssq[row * 16 + u.pn * 4 + wc] = sq; }
            asm volatile("" ::: "memory");
        }
    }
};
template <int CTRL> __device__ __forceinline__ float dppf(float v) { return __builtin_bit_cast(float, __builtin_amdgcn_update_dpp(0, __builtin_bit_cast(int, v), CTRL, 0xf, 0xf, true)); }
#define DPP_SHR1 0x111
#define DPP_SHR2 0x112
#define DPP_SHL15 0x10F
#define DPP_SHL14 0x10E
struct EpiUpAct {
    static constexpr bool PERM = true, AFTER_DRAIN = false;
    KArgs kp; LAS unsigned char* ex; int l;
    __device__ __forceinline__ void prefetch(const pg8::Unit& u, LAS unsigned char* lds, int wid, int lane) const {
        const Args a_ = load_args(kp);
        const int tap = wid >> 1, h = wid & 1;
        const float* src = (tap < 3 ? a_.in[15] + (size_t)l * 3 * FF2 + (size_t)tap * FF2 : a_.in[16] + (size_t)l * FF2) + h * FF + u.pn * 128 + lane;
        __builtin_amdgcn_global_load_lds((const unsigned*)src, (LAS unsigned*)(lds + WCV_OFF + wid * 512), 4, 0, 0);
        __builtin_amdgcn_global_load_lds((const unsigned*)(src + 64), (LAS unsigned*)(lds + WCV_OFF + wid * 512 + 256), 4, 0, 0);
        if (u.pm >= NTP) {
            const float* sf = a_.in[4] + (size_t)l * 16 * 2 * FF2 + (size_t)(u.pm - NTP) * 4 * 2 * FF2 + u.pn * 128 + lane;
#pragma unroll
            for (int q = 0; q < 2; ++q) { const int sidx = 2 * wid + q, br = sidx >> 1, h = sidx & 1;
                const float* sp = sf + (size_t)br * FF2 + h * FF;
                __builtin_amdgcn_global_load_lds((const unsigned*)sp, (LAS unsigned*)(lds + EX_OFF + sidx * 512), 4, 0, 0);
                __builtin_amdgcn_global_load_lds((const unsigned*)(sp + 64), (LAS unsigned*)(lds + EX_OFF + sidx * 512 + 256), 4, 0, 0); }
        }
    }
    __device__ __forceinline__ void operator()(const f32x4 (&acc)[2][2][4][2], const pg8::Unit& u, int wr, int wc, int fr, int fq) const {
        const Args a_ = load_args(kp); unsigned char* w_ = a_.ws; float* o_ = a_.out;
        const float* fw = a_.in[15] + (size_t)l * 3 * FF2; const float* fb = a_.in[16] + (size_t)l * FF2; const float* sffn = a_.in[4] + (size_t)l * 16 * 2 * FF2;
        const int pm = u.pm, pn = u.pn; const bool samp = pm >= NTP;
        float r[2][4]; unit_rstd((const float*)(w_ + WS_SSQ), pm, wr, wc, fr, fq, (2 * l + 1) * 1024 + pm, ex - EX_OFF, r);
        const int lc0 = wc * 32 + 8 * fq;
        f32x4 x[2][2][4][2];
#pragma unroll
        for (int ai = 0; ai < 2; ++ai)
#pragma unroll
            for (int bj = 0; bj < 2; ++bj)
#pragma unroll
                for (int m = 0; m < 4; ++m)
#pragma unroll
                    for (int n = 0; n < 2; ++n) x[ai][bj][m][n] = acc[ai][bj][m][n] * r[ai][m];
        {
            float* ffn_p = o_ + O_FFNP + (size_t)l * 8 * 2 * FF2; float* ffn_s = o_ + O_FFNS + (size_t)l * 16 * 2 * FF2; float* HALO = (float*)(w_ + WS_HALO) + (size_t)pm * 4 * FF2;
            if (fr >= 14) {
#pragma unroll
                for (int ai = 0; ai < 2; ++ai) {
                    if (samp || ((pm & 15) == 15 && wr == 1 && ai == 1)) {
                        float* sp = samp ? ffn_s + ((size_t)((pm - NTP) * 4 + ai * 2 + wr) * 2 + (fr - 14)) * FF2 : ffn_p + ((size_t)(pm >> 4) * 2 + (fr - 14)) * FF2;
#pragma unroll
                        for (int bj = 0; bj < 2; ++bj) { const int oc = bj * FF + pn * 128 + lc0; *(f32x4*)(sp + oc) = x[ai][bj][3][0]; *(f32x4*)(sp + oc + 4) = x[ai][bj][3][1]; } }
                }
                if (wr == 1) {
#pragma unroll
                    for (int bj = 0; bj < 2; ++bj) { float* hp = HALO + (size_t)(2 + fr - 14) * FF2 + pn * 256 + bj * 128 + lc0; *(f32x4*)hp = x[1][bj][3][0]; *(f32x4*)(hp + 4) = x[1][bj][3][1]; } }
            }
            if (fr < 2 && wr == 0) {
#pragma unroll
                for (int bj = 0; bj < 2; ++bj) { float* hp = HALO + (size_t)fr * FF2 + pn * 256 + bj * 128 + lc0; *(f32x4*)hp = x[0][bj][0][0]; *(f32x4*)(hp + 4) = x[0][bj][0][1]; } }
        }
        if (!samp) {
            if (fr >= 14) {
#pragma unroll
                for (int ai = 0; ai < 2; ++ai)
#pragma unroll
                    for (int bj = 0; bj < 2; ++bj)
#pragma unroll
                        for (int n = 0; n < 2; ++n) *(LAS f32x4*)(ex + ((((2 * ai + wr) * 2 + (fr - 14)) * 256) + bj * 128 + lc0 + 4 * n) * 4) = x[ai][bj][3][n];
            }
            asm volatile("s_waitcnt lgkmcnt(0)" ::: "memory"); __builtin_amdgcn_s_barrier(); asm volatile("" ::: "memory");
        }
        bf16* ACT = (bf16*)(w_ + WS_ACT);
        unsigned pk[2][4][2];
#pragma unroll
        for (int n = 0; n < 2; ++n) {
            const int f = pn * 128 + lc0 + 4 * n;
            const LAS float* wl_ = (const LAS float*)(ex - EX_OFF + WCV_OFF) + lc0 + 4 * n;
            const f32x4 wv0 = *(const LAS f32x4*)(wl_ + 0 * 128), wg0 = *(const LAS f32x4*)(wl_ + 1 * 128), wv1 = *(const LAS f32x4*)(wl_ + 2 * 128), wg1 = *(const LAS f32x4*)(wl_ + 3 * 128);
            const f32x4 wv2 = *(const LAS f32x4*)(wl_ + 4 * 128), wg2 = *(const LAS f32x4*)(wl_ + 5 * 128), bv = *(const LAS f32x4*)(wl_ + 6 * 128), bg = *(const LAS f32x4*)(wl_ + 7 * 128);
#pragma unroll
            for (int ai = 0; ai < 2; ++ai) {
                const int B = 2 * ai + wr;
                f32x4 e1v = (f32x4){0.f, 0.f, 0.f, 0.f}, e2v = e1v, e1g = e1v, e2g = e1v;
                if (fr < 2) {
                    if (samp || B > 0) {
                        const LAS unsigned char* eb = ex + ((samp ? B : B - 1) * 2 * 256 + lc0 + 4 * n) * 4;
                        const f32x4 v63 = *(const LAS f32x4*)(eb + 256 * 4), g63 = *(const LAS f32x4*)(eb + 256 * 4 + 128 * 4);
                        if (fr == 0) { e1v = v63; e1g = g63; e2v = *(const LAS f32x4*)eb; e2g = *(const LAS f32x4*)(eb + 128 * 4); } else { e2v = v63; e2g = g63; }
                    }
                }
#pragma unroll
                for (int m = 0; m < 4; ++m) {
                    float av[4];
#pragma unroll
                    for (int e = 0; e < 4; ++e) {
                        const float xv = x[ai][0][m][n][e], xg = x[ai][1][m][n][e];
                        float yv = bv[e] + wv2[e] * xv, yg = bg[e] + wg2[e] * xg;
                        if (m > 0) {
                            const float pv = x[ai][0][m > 0 ? m - 1 : 0][n][e], pg = x[ai][1][m > 0 ? m - 1 : 0][n][e];
                            asm volatile("s_nop 4\n\t"
                                "v_fmac_f32_dpp %0, %2, %4 row_shr:1 row_mask:0xf bank_mask:0xf bound_ctrl:1\n\t"
                                "v_fmac_f32_dpp %1, %3, %6 row_shr:1 row_mask:0xf bank_mask:0xf bound_ctrl:1\n\t"
                                "v_fmac_f32_dpp %0, %2, %5 row_shr:2 row_mask:0xf bank_mask:0xf bound_ctrl:1\n\t"
                                "v_fmac_f32_dpp %1, %3, %7 row_shr:2 row_mask:0xf bank_mask:0xf bound_ctrl:1\n\t"
                                "v_fmac_f32_dpp %0, %8, %4 row_shl:15 row_mask:0xf bank_mask:0xf bound_ctrl:1\n\t"
                                "v_fmac_f32_dpp %1, %9, %6 row_shl:15 row_mask:0xf bank_mask:0xf bound_ctrl:1\n\t"
                                "v_fmac_f32_dpp %0, %8, %5 row_shl:14 row_mask:0xf bank_mask:0xf bound_ctrl:1\n\t"
                                "v_fmac_f32_dpp %1, %9, %7 row_shl:14 row_mask:0xf bank_mask:0xf bound_ctrl:1"
                                : "+v"(yv), "+v"(yg) : "v"(xv), "v"(xg), "v"(wv1[e]), "v"(wv0[e]), "v"(wg1[e]), "v"(wg0[e]), "v"(pv), "v"(pg));
                        } else {
                            asm volatile("s_nop 4\n\t"
                                "v_fmac_f32_dpp %0, %2, %4 row_shr:1 row_mask:0xf bank_mask:0xf bound_ctrl:1\n\t"
                                "v_fmac_f32_dpp %1, %3, %6 row_shr:1 row_mask:0xf bank_mask:0xf bound_ctrl:1\n\t"
                                "v_fmac_f32_dpp %0, %2, %5 row_shr:2 row_mask:0xf bank_mask:0xf bound_ctrl:1\n\t"
                                "v_fmac_f32_dpp %1, %3, %7 row_shr:2 row_mask:0xf bank_mask:0xf bound_ctrl:1\n\t"
                                "v_fmac_f32_e32 %0, %8, %4\n\t"
                                "v_fmac_f32_e32 %1, %9, %6\n\t"
                                "v_fmac_f32_e32 %0, %10, %5\n\t"
                                "v_fmac_f32_e32 %1, %11, %7"
                                : "+v"(yv), "+v"(yg) : "v"(xv), "v"(xg), "v"(wv1[e]), "v"(wv0[e]), "v"(wg1[e]), "v"(wg0[e]), "v"(e1v[e]), "v"(e1g[e]), "v"(e2v[e]), "v"(e2g[e]));
                        }
                        av[e] = yg * sigmoidf_(yg) * yv;
                    }
                    const unsigned lo = pk2(av[0], av[1]), hi = pk2(av[2], av[3]);
                    if (n == 0) { pk[ai][m][0] = lo; pk[ai][m][1] = hi; }
                    else { u32x4 w; w.x = pk[ai][m][0]; w.y = pk[ai][m][1]; w.z = lo; w.w = hi;
                        *(u32x4*)(ACT + ((size_t)pm * 256 + ai * 128 + wr * 64 + m * 16 + fr) * FF + pn * 128 + lc0) = w; }
                }
            }
        }
    }
};

#define XB_TMO      128
#define XB_XCNT(j)  (256  + 64 * (j))
#define XB_XSUB(j)  (1280 + 64 * (j))
#define XB_XGEN(j)  (2304 + 64 * (j))
#define XB_TOP      3328
#define XB_TOPGEN   3392
#define XCD_BAR_WORDS 3456
#define XB_SPIN_CAP (1u << 18)
__device__ __forceinline__ unsigned xb_ld(unsigned* p)              { return __hip_atomic_load(p, __ATOMIC_RELAXED, __HIP_MEMORY_SCOPE_AGENT); }
__device__ __forceinline__ unsigned xb_add(unsigned* p, unsigned v) { return __hip_atomic_fetch_add(p, v, __ATOMIC_RELAXED, __HIP_MEMORY_SCOPE_AGENT); }
__device__ __forceinline__ unsigned xb_xcc_id() { return (unsigned)__builtin_amdgcn_s_getreg((3 << 11) | 20) & 0xFu; }
#define XB_SPIN(cond, bar) do { unsigned _sp = 0; while (cond) { __builtin_amdgcn_s_sleep(1); \
    if ((++_sp & 255u) == 0u) { if (xb_ld(&(bar)[XB_TMO])) break; if (_sp > XB_SPIN_CAP) { atomicAdd(&(bar)[XB_TMO], 1u); break; } } } } while (0)
struct XcdBarrier { unsigned* bar; unsigned x; volatile LAS unsigned* st; };
__device__ __forceinline__ XcdBarrier xcd_barrier_post(unsigned* bar, volatile LAS unsigned* st) {
    XcdBarrier b; b.bar = bar; b.x = xb_xcc_id(); b.st = st;
    if (threadIdx.x == 0) (void)xb_add(&bar[XB_XCNT(b.x)], 1u);
    return b;
}
__device__ __forceinline__ void xcd_barrier_complete(unsigned* bar, unsigned x, unsigned& nloc, unsigned& nx) {
    const unsigned G = gridDim.x * gridDim.y * gridDim.z;
    unsigned sum, cnt, mine, sp = 0u;
    for (;;) {
        sum = 0u; cnt = 0u; mine = 0u;
#pragma unroll
        for (unsigned j = 0; j < 16; ++j) { const unsigned c = xb_ld(&bar[XB_XCNT(j)]); sum += c; cnt += (c > 0u) ? 1u : 0u; mine = (j == x) ? c : mine; }
        if (sum == G) break;
        __builtin_amdgcn_s_sleep(1);
        if ((++sp & 255u) == 0u) { if (xb_ld(&bar[XB_TMO])) break; if (sp > XB_SPIN_CAP) { atomicAdd(&bar[XB_TMO], 1u); break; } }
    }
    nloc = mine > 0u ? mine : 1u; nx = cnt > 0u ? cnt : 1u;
}
__device__ __forceinline__ void xcd_barrier(const XcdBarrier& b) {
    asm volatile("s_waitcnt vmcnt(0)" ::: "memory");
    __syncthreads();
    int t0_ = threadIdx.x; asm volatile("" : "+v"(t0_));
    if (t0_ == 0) {
        unsigned* bar = b.bar;
        __builtin_amdgcn_s_waitcnt(0);
        unsigned nloc = b.st[0], nx = b.st[1];
        if (nloc == 0u) { xcd_barrier_complete(bar, b.x, nloc, nx); b.st[0] = nloc; b.st[1] = nx; }
        const unsigned old = xb_add(&bar[XB_XSUB(b.x)], 1u);
        const unsigned gen = old / nloc;
        if (old + 1u == (gen + 1u) * nloc) {
            __builtin_amdgcn_fence(__ATOMIC_RELEASE, "agent");
            asm volatile("s_waitcnt vmcnt(0)" ::: "memory");
            const unsigned og = xb_add(&bar[XB_TOP], 1u);
            const unsigned tg = og / nx;
            if (og + 1u == (tg + 1u) * nx) xb_add(&bar[XB_TOPGEN], 1u);
            else XB_SPIN(xb_ld(&bar[XB_TOPGEN]) == tg, bar);
            __builtin_amdgcn_fence(__ATOMIC_ACQUIRE, "agent");
            xb_add(&bar[XB_XGEN(b.x)], 1u);
            asm volatile("s_waitcnt vmcnt(0)" ::: "memory");
        } else {
            XB_SPIN(xb_ld(&bar[XB_XGEN(b.x)]) == gen, bar);
            __builtin_amdgcn_fence(__ATOMIC_ACQUIRE, "agent");
            asm volatile("s_waitcnt vmcnt(0)" ::: "memory");
        }
    }
    __syncthreads();
}


struct Frame {
    LAS unsigned char* lds;
    int tid, lane, wave, G, bid;
};

__device__ __forceinline__ float wave_sum(float v) {
#pragma unroll
    for (int o = 1; o < 64; o <<= 1) v += __shfl_xor(v, o);
    return v;
}

__device__ __forceinline__ void tr_item(const float* W, int ldw, int srccol, int ks0, const float* gs, bf16* WT, int Kd, int dst_row, int kd0, bool zero, LAS float* scr, int lane) {
    const int c = lane & 7;
    f32x4 g0 = (f32x4){1.f, 1.f, 1.f, 1.f}, g1 = g0;
    if (!zero) {
        float v[32];
#pragma unroll
        for (int i = 0; i < 32; ++i) v[i] = __builtin_nontemporal_load(W + (size_t)(ks0 + 2 * i + (lane >> 5)) * ldw + srccol + (lane & 31));
        if (gs) { g0 = *(const f32x4*)(gs + ks0 + 8 * c); g1 = *(const f32x4*)(gs + ks0 + 8 * c + 4); }
#pragma unroll
        for (int i = 0; i < 32; ++i) scr[(2 * i + (lane >> 5)) * 33 + (lane & 31)] = v[i];
    }
    asm volatile("s_waitcnt lgkmcnt(0)" ::: "memory");
#pragma unroll
    for (int j = 0; j < 4; ++j) { const int n = (lane >> 3) + 8 * j; const LAS float* s = scr + (8 * c) * 33 + n;
        u32x4 o;
        if (zero) { unsigned z = 0u; asm volatile("" : "+v"(z)); o = (u32x4){z, z, z, z}; }
        else { o.x = pk2(s[0 * 33] * g0[0], s[1 * 33] * g0[1]); o.y = pk2(s[2 * 33] * g0[2], s[3 * 33] * g0[3]); o.z = pk2(s[4 * 33] * g1[0], s[5 * 33] * g1[1]); o.w = pk2(s[6 * 33] * g1[2], s[7 * 33] * g1[3]); }
        *(u32x4*)(WT + (size_t)(dst_row + n) * Kd + kd0 + 8 * c) = o; }
    asm volatile("s_waitcnt lgkmcnt(0)" ::: "memory");
}

constexpr int I_IN = 16 * 128, I_UP = 16 * 176, I_DN = 44 * 32, I_O = 16 * 32, I_CO = 8 * 32, I_MAP = 128;
constexpr int ITEMS_L = I_IN + I_UP + I_DN + I_O + I_CO + I_MAP;

__device__ __forceinline__ void p0_prologue(const Frame& F, const Args& a) {
    int tid_ = threadIdx.x; asm volatile("" : "+v"(tid_)); const int TID = tid_, LANE = tid_ & 63, WAVE = __builtin_amdgcn_readfirstlane(tid_ >> 6);
    LAS float* scr = (LAS float*)(F.lds + WAVE * 16384);
    const int gw = F.bid * NWAVES + WAVE, NGW = F.G * NWAVES;
    unsigned char* ws = a.ws;
    for (int it = gw; it < 2 * ITEMS_L; it += NGW) {
        const int l = it / ITEMS_L; int r = it % ITEMS_L;
        unsigned char* wl = ws + WS_W + (size_t)l * W_LAYER;
        if (r < I_IN) { const int kb = r / 128, n0 = (r % 128) * 32;
            const int src = n0 < 1024 ? n0 : n0 < 2048 ? 1024 + 512 * (((n0 - 1024) % 256) / 128) + 128 * ((n0 - 1024) / 256) + (n0 % 128)
                                                     : 2048 + 1024 * (((n0 - 2048) % 256) / 128) + 128 * ((n0 - 2048) / 256) + (n0 % 128);
            tr_item(a.in[6] + (size_t)l * D * INW, INW, src, kb * 64, a.in[5] + l * D, (bf16*)(wl + WO_IN), D, n0, kb * 64, false, scr, LANE); continue; } r -= I_IN;
        if (r < I_UP) { const int kb = r / 176, n0 = (r % 176) * 32;
            const int src = ((n0 % 256) / 128) * FF + 128 * (n0 / 256) + (n0 % 128);
            tr_item(a.in[14] + (size_t)l * D * FF2, FF2, src, kb * 64, a.in[13] + l * D, (bf16*)(wl + WO_UP), D, n0, kb * 64, false, scr, LANE); continue; } r -= I_UP;
        if (r < I_DN) { const int kb = r / 32, n0 = (r % 32) * 32;
            tr_item(a.in[17] + (size_t)l * FF * D, D, n0, kb * 64, nullptr, (bf16*)(wl + WO_DN), FF, n0, kb * 64, false, scr, LANE); continue; } r -= I_DN;
        if (r < I_O) { const int kb = r / 32, n0 = (r % 32) * 32;
            tr_item(a.in[12] + (size_t)l * D * D, D, n0, kb * 64, nullptr, (bf16*)(wl + WO_O), D, n0, kb * 64, false, scr, LANE); continue; } r -= I_O;
        if (r < I_CO) { const int kb = r / 32, n0 = (r % 32) * 32;
            tr_item(a.in[11] + (size_t)l * CW * D, D, n0, kb * 64, nullptr, (bf16*)(wl + WO_CO), CW, n0, kb * 64, false, scr, LANE); continue; } r -= I_CO;
        { const int g = r / 32, kb = (r % 32) / 8, nb = r % 8; const bool zero = (kb >> 1) != (g & 1);
            tr_item(a.in[8] + (size_t)l * 4 * 128 * 256 + (size_t)g * 128 * 256, 256, nb * 32, (kb & 1) * 64, nullptr, (bf16*)(wl + WO_MAP), 256, g * 256 + nb * 32, kb * 64, zero, scr, LANE); }
    }
    bf16* XB = (bf16*)(ws + WS_XB); float* SSQ = (float*)(ws + WS_SSQ);
    for (int m0 = gw; m0 < M; m0 += 2 * NGW) {
        f32x4 v[2][4];
#pragma unroll
        for (int r = 0; r < 2; ++r) { const int m = m0 + r * NGW;
            if (m < M) { const float* xrow = m < MP ? a.in[0] + (size_t)m * D : a.in[1] + (size_t)(m - MP) * D; const f32x4* xr = (const f32x4*)xrow + LANE;
#pragma unroll
                for (int j = 0; j < 4; ++j) v[r][j] = __builtin_nontemporal_load(xr + 64 * j); } }
#pragma unroll
        for (int r = 0; r < 2; ++r) { const int m = m0 + r * NGW;
            if (m < M) { float s = 0.f;
#pragma unroll
                for (int j = 0; j < 4; ++j) s += (v[r][j].x * v[r][j].x + v[r][j].y * v[r][j].y) + (v[r][j].z * v[r][j].z + v[r][j].w * v[r][j].w);
                s = wave_sum(s);
                u32x2* o8 = (u32x2*)(XB + (size_t)m * D) + LANE;
#pragma unroll
                for (int j = 0; j < 4; ++j) { u32x2 w; w.x = pk2(v[r][j].x, v[r][j].y); w.y = pk2(v[r][j].z, v[r][j].w); o8[64 * j] = w; }
                if (LANE < 16) SSQ[(size_t)m * 16 + LANE] = LANE == 0 ? s : 0.f; } }
    }
}

constexpr int MIX_RB = 33;
__device__ __forceinline__ void mix_elt(const Frame& F, const Args& a, int l) {
    int tid_ = threadIdx.x; asm volatile("" : "+v"(tid_)); const int TID = tid_;
    unsigned char* ws = a.ws;
    const bf16* UPOOL = (const bf16*)(ws + WS_UPOOL); const bf16* CVIN = (const bf16*)(ws + WS_CVIN); const bf16* GB = (const bf16*)(ws + WS_GB);
    bf16* MIXED = (bf16*)(ws + WS_MIXED); bf16* GBCV = (bf16*)(ws + WS_GBCV);
    const float* spool = a.in[2] + (size_t)l * 16 * 15 * 512; const float* sconv = a.in[3] + (size_t)l * 16 * 2 * 512; const float* cw = a.in[10] + (size_t)l * 3 * 512;
    const int nrb = (M + MIX_RB - 1) / MIX_RB, total = nrb * 128, stride = F.G * NTHR;
    for (int idx = F.bid * NTHR + TID; idx < total; idx += stride) {
        const int rb = idx >> 7, c8 = idx & 127;
        const int r0 = rb * MIX_RB, r1 = (r0 + MIX_RB) < M ? (r0 + MIX_RB) : M;
        if (c8 < 64) {
            const int ch0 = c8 * 8, win = 2 << (c8 >> 4);
            float sum[8], f[8];
            for (int row = r0; row < r1; ++row) {
                const bool samp = row >= MP; int t, sq = 0;
                if (!samp) t = row & 4095; else { const int sr = row - MP; sq = sr >> 6; t = sr & 63; }
                const u32x4 uw = *(const u32x4*)(UPOOL + (size_t)row * 512 + ch0);
                if (row == r0 || t == 0) {
#pragma unroll
                    for (int e = 0; e < 8; ++e) sum[e] = 0.f;
                    for (int j = 1; j < win; ++j) {
                        const int tt = t - j;
                        if (tt >= 0) { const u32x4 w = *(const u32x4*)(UPOOL + (size_t)(row - j) * 512 + ch0); UNPACK8(w, f);
#pragma unroll
                            for (int e = 0; e < 8; ++e) sum[e] += f[e]; }
                        else if (samp) { const float* p = spool + ((size_t)sq * 15 + 15 + tt) * 512 + ch0; const f32x4 p0 = *(const f32x4*)p, p1 = *(const f32x4*)(p + 4);
#pragma unroll
                            for (int e = 0; e < 4; ++e) { sum[e] += p0[e]; sum[4 + e] += p1[e]; } }
                    }
                } else {
                    const int tt = t - win;
                    if (tt >= 0) { const u32x4 w = *(const u32x4*)(UPOOL + (size_t)(row - win) * 512 + ch0); UNPACK8(w, f);
#pragma unroll
                        for (int e = 0; e < 8; ++e) sum[e] -= f[e]; }
                    else if (samp) { const float* p = spool + ((size_t)sq * 15 + 15 + tt) * 512 + ch0; const f32x4 p0 = *(const f32x4*)p, p1 = *(const f32x4*)(p + 4);
#pragma unroll
                        for (int e = 0; e < 4; ++e) { sum[e] -= p0[e]; sum[4 + e] -= p1[e]; } }
                }
                UNPACK8(uw, f);
                const float cnt = samp ? (float)win : (float)(win < t + 1 ? win : t + 1), inv = 1.0f / cnt;
                float o[8];
#pragma unroll
                for (int e = 0; e < 8; ++e) { sum[e] += f[e]; o[e] = sum[e] * inv - f[e]; }
                u32x4 w; w.x = pk2(o[0], o[1]); w.y = pk2(o[2], o[3]); w.z = pk2(o[4], o[5]); w.w = pk2(o[6], o[7]);
                *(u32x4*)(MIXED + (size_t)row * 512 + ch0) = w;
            }
        } else {
            const int ch0 = (c8 - 64) * 8;
            float w0[8], w1[8], w2[8];
#pragma unroll
            for (int h = 0; h < 2; ++h) { const f32x4 a0 = *(const f32x4*)(cw + ch0 + 4 * h), a1 = *(const f32x4*)(cw + 512 + ch0 + 4 * h), a2 = *(const f32x4*)(cw + 1024 + ch0 + 4 * h);
#pragma unroll
                for (int e = 0; e < 4; ++e) { w0[4 * h + e] = a0[e]; w1[4 * h + e] = a1[e]; w2[4 * h + e] = a2[e]; } }
            float x0[8], x1[8], x2[8], gb[8];
#pragma unroll
            for (int e = 0; e < 8; ++e) { x1[e] = 0.f; x2[e] = 0.f; }
            for (int row = r0; row < r1; ++row) {
                const bool samp = row >= MP; int t, sq = 0;
                if (!samp) t = row & 4095; else { const int sr = row - MP; sq = sr >> 6; t = sr & 63; }
                { const u32x4 w = *(const u32x4*)(CVIN + (size_t)row * 512 + ch0); UNPACK8(w, x0); }
                { const u32x4 w = *(const u32x4*)(GB + (size_t)row * 512 + ch0); UNPACK8(w, gb); }
                if (row == r0 || t == 0) {
                    if (t >= 1) { const u32x4 w = *(const u32x4*)(CVIN + (size_t)(row - 1) * 512 + ch0); UNPACK8(w, x1); }
                    else if (samp) { const float* p = sconv + ((size_t)sq * 2 + 1) * 512 + ch0; const f32x4 p0 = *(const f32x4*)p, p1 = *(const f32x4*)(p + 4);
#pragma unroll
                        for (int e = 0; e < 4; ++e) { x1[e] = p0[e]; x1[4 + e] = p1[e]; } }
                    else {
#pragma unroll
                        for (int e = 0; e < 8; ++e) x1[e] = 0.f; }
                    if (t >= 2) { const u32x4 w = *(const u32x4*)(CVIN + (size_t)(row - 2) * 512 + ch0); UNPACK8(w, x2); }
                    else if (samp) { const float* p = sconv + ((size_t)sq * 2 + t) * 512 + ch0; const f32x4 p0 = *(const f32x4*)p, p1 = *(const f32x4*)(p + 4);
#pragma unroll
                        for (int e = 0; e < 4; ++e) { x2[e] = p0[e]; x2[4 + e] = p1[e]; } }
                    else {
#pragma unroll
                        for (int e = 0; e < 8; ++e) x2[e] = 0.f; }
                }
                float o[8];
#pragma unroll
                for (int e = 0; e < 8; ++e) { o[e] = gb[e] * (w0[e] * x2[e] + w1[e] * x1[e] + w2[e] * x0[e]); x2[e] = x1[e]; x1[e] = x0[e]; }
                u32x4 w; w.x = pk2(o[0], o[1]); w.y = pk2(o[2], o[3]); w.z = pk2(o[4], o[5]); w.w = pk2(o[6], o[7]);
                *(u32x4*)(GBCV + (size_t)row * 512 + ch0) = w;
            }
        }
    }
}

__device__ __forceinline__ void ffn_fixup(const Frame& F, const Args& a, int l) {
    int tid_ = threadIdx.x; asm volatile("" : "+v"(tid_)); const int TID = tid_;
    unsigned char* ws = a.ws;
    const float* HALO = (const float*)(ws + WS_HALO); bf16* ACT = (bf16*)(ws + WS_ACT);
    const float* fw = a.in[15] + (size_t)l * 3 * FF2; const float* fb = a.in[16] + (size_t)l * FF2;
    const int total = NTP * 2 * 352, stride = F.G * NTHR;
    for (int idx = F.bid * NTHR + TID; idx < total; idx += stride) {
        const int pm = idx / 704, rem = idx % 704, rr = rem / 352, c8 = rem % 352;
        if ((pm & 15) == 0) continue;
        const int f0 = c8 * 8, pn = f0 >> 7, j0 = f0 & 127;
        float res[2][8];
#pragma unroll
        for (int h = 0; h < 2; ++h) {
            const int pc = pn * 256 + h * 128 + j0, oc = h * FF + f0;
            const float* p0 = HALO + ((size_t)pm * 4 + rr) * FF2 + pc;
            const float* p1 = rr == 1 ? HALO + ((size_t)pm * 4 + 0) * FF2 + pc : HALO + ((size_t)(pm - 1) * 4 + 3) * FF2 + pc;
            const float* p2 = rr == 1 ? HALO + ((size_t)(pm - 1) * 4 + 3) * FF2 + pc : HALO + ((size_t)(pm - 1) * 4 + 2) * FF2 + pc;
#pragma unroll
            for (int q = 0; q < 2; ++q) { const f32x4 x0 = *(const f32x4*)(p0 + 4 * q), x1 = *(const f32x4*)(p1 + 4 * q), x2 = *(const f32x4*)(p2 + 4 * q);
                const f32x4 w0 = *(const f32x4*)(fw + oc + 4 * q), w1 = *(const f32x4*)(fw + FF2 + oc + 4 * q), w2 = *(const f32x4*)(fw + 2 * FF2 + oc + 4 * q), b = *(const f32x4*)(fb + oc + 4 * q);
#pragma unroll
                for (int e = 0; e < 4; ++e) res[h][4 * q + e] = w0[e] * x2[e] + w1[e] * x1[e] + w2[e] * x0[e] + b[e]; }
        }
        float o[8];
#pragma unroll
        for (int e = 0; e < 8; ++e) o[e] = res[1][e] * sigmoidf_(res[1][e]) * res[0][e];
        u32x4 w; w.x = pk2(o[0], o[1]); w.y = pk2(o[2], o[3]); w.z = pk2(o[4], o[5]); w.w = pk2(o[6], o[7]);
        *(u32x4*)(ACT + ((size_t)pm * 256 + rr) * FF + f0) = w;
    }
}

__device__ __forceinline__ void final_norm(const Frame& F, const Args& a) {
    int tid_ = threadIdx.x; asm volatile("" : "+v"(tid_)); const int LANE = tid_ & 63, WAVE = __builtin_amdgcn_readfirstlane(tid_ >> 6);
    const float* SSQ = (const float*)(a.ws + WS_SSQ); const bf16* XB = (const bf16*)(a.ws + WS_XB); const float* g = a.in[18];
    const int gw = F.bid * NWAVES + WAVE, NGW = F.G * NWAVES;
    f32x4 gv[2][2];
#pragma unroll
    for (int j = 0; j < 2; ++j) { gv[j][0] = *(const f32x4*)(g + 512 * j + 8 * LANE); gv[j][1] = *(const f32x4*)(g + 512 * j + 8 * LANE + 4); }
    for (int m = gw; m < M; m += NGW) {
        float s = LANE < 16 ? SSQ[(size_t)m * 16 + LANE] : 0.f;
        s = wave_sum(s);
        const float rs = 1.0f / sqrtf(s * (1.0f / D) + EPS);
        float* orow = a.out + (size_t)m * D;
#pragma unroll
        for (int j = 0; j < 2; ++j) { const u32x4 w = *(const u32x4*)(XB + (size_t)m * D + 512 * j + 8 * LANE); float f[8]; UNPACK8(w, f);
            f32x4 o0, o1;
#pragma unroll
            for (int e = 0; e < 4; ++e) { o0[e] = f[e] * rs * gv[j][0][e]; o1[e] = f[4 + e] * rs * gv[j][1][e]; }
            *(f32x4*)(orow + 512 * j + 8 * LANE) = o0; *(f32x4*)(orow + 512 * j + 8 * LANE + 4) = o1; }
    }
}

constexpr int SG_PITCH = 272, SG_ROWS = 160, SG_STAGE = SG_ROWS * SG_PITCH;
template <int MODE>
__device__ __forceinline__ void small_gemm(const Frame& F, const bf16* A, int lda, int grp_cols, const bf16* Bt, int K, const bf16* G0, const bf16* G1, bf16* O, float* ssq,
                                           const bf16* A2 = nullptr, const bf16* Bt2 = nullptr, int K2 = 0) {
    int tid_ = threadIdx.x; asm volatile("" : "+v"(tid_)); const int TID = tid_, LANE = tid_ & 63, WAVE = __builtin_amdgcn_readfirstlane(tid_ >> 6);
    const int rb = WAVE >> 2, cg = WAVE & 3, fr = LANE & 15, fq = LANE >> 4;
    LAS float* red = (LAS float*)(F.lds + EX_OFF);
    LAS unsigned char* L0 = F.lds; LAS unsigned char* L1 = F.lds + SG_STAGE;
    const int aoff = (rb * 16 + fr) * SG_PITCH + fq * 16, boff0 = (32 + cg * 32 + fr) * SG_PITCH + fq * 16, boff1 = boff0 + 16 * SG_PITCH;
#define SG_BAR() do { asm volatile("s_waitcnt lgkmcnt(0)" ::: "memory"); __builtin_amdgcn_s_barrier(); asm volatile("" ::: "memory"); } while (0)
#define SG_GLOAD(R, ks) do { _Pragma("unroll") for (int i = 0; i < 5; ++i) R[i] = *(const u32x4*)(gp[i] + (size_t)(ks) * 128); } while (0)
#define SG_LWRITE(Lb, R) do { _Pragma("unroll") for (int i = 0; i < 5; ++i) *(LAS u32x4*)((Lb) + lo[i]) = R[i]; } while (0)
#define SG_COMPUTE(Lb) do { _Pragma("unroll") for (int j = 0; j < 4; ++j) { const pg8::bf16x8 fa = *(const LAS pg8::bf16x8*)((Lb) + aoff + j * 64), f0 = *(const LAS pg8::bf16x8*)((Lb) + boff0 + j * 64), f1 = *(const LAS pg8::bf16x8*)((Lb) + boff1 + j * 64); \
        acc0 = __builtin_amdgcn_mfma_f32_16x16x32_bf16(f0, fa, acc0, 0, 0, 0); acc1 = __builtin_amdgcn_mfma_f32_16x16x32_bf16(f1, fa, acc1, 0, 0, 0); } } while (0)
    for (int T = F.bid; T < 256; T += F.G) {
        const int tr = T >> 3, tc = T & 7;
        const int row = MP + tr * 32 + rb * 16 + fr, c0 = tc * 128 + cg * 32;
        const bf16* gp[5]; int lo[5];
#pragma unroll
        for (int i = 0; i < 5; ++i) { const int idx = TID + 512 * i, r = idx >> 4, c16 = idx & 15;
            gp[i] = (r < 32) ? A + (size_t)(MP + tr * 32 + r) * lda + (grp_cols ? (tc >> 2) * grp_cols : 0) + 8 * c16 : Bt + (size_t)(tc * 128 + r - 32) * K + 8 * c16;
            lo[i] = r * SG_PITCH + c16 * 16; }
        f32x4 acc0 = (f32x4){0.f, 0.f, 0.f, 0.f}, acc1 = acc0;
        u32x2 pg0[2], pg1[2], pq[2];
#pragma unroll
        for (int n2 = 0; n2 < 2; ++n2) { const size_t o = (size_t)row * D + c0 + 16 * n2 + 4 * fq;
            if (MODE == 0 || MODE == 1 || MODE == 3) pg0[n2] = *(const u32x2*)(G0 + o);
            if (MODE == 0 || MODE == 3) pg1[n2] = *(const u32x2*)(G1 + o);
            if (MODE == 1 || MODE == 2) pq[n2] = *(const u32x2*)(O + o); }
#pragma unroll 1
      for (int sg = 0; sg < (MODE == 3 ? 2 : 1); ++sg) {
        if (MODE == 3 && sg == 1) {
#pragma unroll
            for (int i = 0; i < 5; ++i) { const int idx = TID + 512 * i, r = idx >> 4, c16 = idx & 15;
                gp[i] = (r < 32) ? A2 + (size_t)(MP + tr * 32 + r) * lda + 8 * c16 : Bt2 + (size_t)(tc * 128 + r - 32) * K2 + 8 * c16; }
            acc0 = acc0 * (f32x4){bf_lo(pg0[0].x), bf_hi(pg0[0].x), bf_lo(pg0[0].y), bf_hi(pg0[0].y)}; acc1 = acc1 * (f32x4){bf_lo(pg0[1].x), bf_hi(pg0[1].x), bf_lo(pg0[1].y), bf_hi(pg0[1].y)};
        }
        const int nst = ((MODE == 3 && sg == 1) ? K2 : K) >> 7;
        u32x4 R0[5], R1[5];
        SG_BAR();
        SG_GLOAD(R0, 0); SG_GLOAD(R1, 1);
        SG_LWRITE(L0, R0);
        SG_BAR();
#pragma unroll 1
        for (int s = 0; s < nst; s += 2) {
            if (s + 2 < nst) SG_GLOAD(R0, s + 2);
            SG_COMPUTE(L0);
            SG_LWRITE(L1, R1);
            SG_BAR();
            if (s + 3 < nst) SG_GLOAD(R1, s + 3);
            SG_COMPUTE(L1);
            if (s + 2 < nst) SG_LWRITE(L0, R0);
            SG_BAR();
        }
      }
        float ssum = 0.f;
#pragma unroll
        for (int n2 = 0; n2 < 2; ++n2) {
            const f32x4 av = n2 ? acc1 : acc0; const size_t o = (size_t)row * D + c0 + 16 * n2 + 4 * fq;
            if (MODE == 0) { const u32x2 g = pg0[n2], h = pg1[n2]; u32x2 w;
                w.x = pk2(av[0] * (bf_lo(g.x) * bf_lo(h.x)), av[1] * (bf_hi(g.x) * bf_hi(h.x))); w.y = pk2(av[2] * (bf_lo(g.y) * bf_lo(h.y)), av[3] * (bf_hi(g.y) * bf_hi(h.y))); *(u32x2*)(O + o) = w; }
            else if (MODE == 3) { const u32x2 h = pg1[n2]; u32x2 w; w.x = pk2(av[0] * bf_lo(h.x), av[1] * bf_hi(h.x)); w.y = pk2(av[2] * bf_lo(h.y), av[3] * bf_hi(h.y)); *(u32x2*)(O + o) = w; }
            else if (MODE == 1) { const u32x2 g = pg0[n2], q = pq[n2]; u32x2 w;
                w.x = pk2(av[0] * bf_lo(g.x) + bf_lo(q.x), av[1] * bf_hi(g.x) + bf_hi(q.x)); w.y = pk2(av[2] * bf_lo(g.y) + bf_lo(q.y), av[3] * bf_hi(g.y) + bf_hi(q.y)); *(u32x2*)(O + o) = w; }
            else { const u32x2 q = pq[n2]; u32x2 w; w.x = pk2(av[0] + bf_lo(q.x), av[1] + bf_hi(q.x)); w.y = pk2(av[2] + bf_lo(q.y), av[3] + bf_hi(q.y)); *(u32x2*)(O + o) = w;
                const float g0 = bf_lo(w.x), g1 = bf_hi(w.x), g2 = bf_lo(w.y), g3 = bf_hi(w.y); ssum += (g0 * g0 + g1 * g1) + (g2 * g2 + g3 * g3); }
        }
        if (MODE == 2) {
            ssum += __shfl_xor(ssum, 16); ssum += __shfl_xor(ssum, 32);
            __syncthreads();
            if (fq == 0) red[WAVE * 16 + fr] = ssum;
            __syncthreads();
            if (TID < 32) { const int b = TID >> 4, r = TID & 15; const float t = (red[(b * 4 + 0) * 16 + r] + red[(b * 4 + 1) * 16 + r]) + (red[(b * 4 + 2) * 16 + r] + red[(b * 4 + 3) * 16 + r]);
                float* sp = ssq + (size_t)(MP + tr * 32 + TID) * 16; sp[tc] = t; if (tc == 0) { *(f32x4*)(sp + 8) = (f32x4){0.f, 0.f, 0.f, 0.f}; *(f32x4*)(sp + 12) = (f32x4){0.f, 0.f, 0.f, 0.f}; } }
        }
    }
#undef SG_BAR
#undef SG_GLOAD
#undef SG_LWRITE
#undef SG_COMPUTE
}

__global__ void __launch_bounds__(NTHR, 2) fwd_mega(Args a_unused) {
    extern __shared__ __attribute__((aligned(16))) unsigned char lds_raw[];
    cg::grid_group grid = cg::this_grid();
    KArgs kp = (KArgs)__builtin_amdgcn_kernarg_segment_ptr();
    Frame F;
    F.lds = (LAS unsigned char*)lds_raw;
    F.tid = threadIdx.x; F.lane = F.tid & 63; F.wave = __builtin_amdgcn_readfirstlane(F.tid >> 6);
    F.G = gridDim.x; F.bid = blockIdx.x;
    { const Args a = load_args(kp); unsigned* barw = (unsigned*)a.ws;
      (void)barw;
      volatile LAS unsigned* bst = (volatile LAS unsigned*)(F.lds + BST_OFF);
      if (threadIdx.x < 4) bst[threadIdx.x] = 0u;
      if (threadIdx.x < 8) ((volatile LAS int*)(F.lds + RCT_OFF))[threadIdx.x] = -1; }
    __syncthreads();
    { const Args a = load_args(kp); (void)xcd_barrier_post((unsigned*)a.ws, (volatile LAS unsigned*)(F.lds + BST_OFF));
      if (a.ws == nullptr) grid.sync(); }
#define GRID_BAR() do { const Args a_ = load_args(kp); XcdBarrier b_; b_.bar = (unsigned*)a_.ws; b_.x = xb_xcc_id(); b_.st = (volatile LAS unsigned*)(F.lds + BST_OFF); xcd_barrier(b_); } while (0)

    if constexpr (PHMASK & 1) { const Args a = load_args(kp); p0_prologue(F, a); }
    GRID_BAR();
    if constexpr (PROBE == 9) { const unsigned long long t0 = __builtin_amdgcn_s_memrealtime(); while (__builtin_amdgcn_s_memrealtime() - t0 < 20000ull) __builtin_amdgcn_s_sleep(32); }

#pragma unroll 1
    for (int l = 0; l < 2; ++l) {
        if constexpr (PHMASK & 2) {
            const Args a = load_args(kp); unsigned char* ws = a.ws; unsigned char* wl = ws + WS_W + (size_t)l * W_LAYER;
            pg8::Gemm g{(const bf16*)(ws + WS_XB), (const bf16*)(wl + WO_IN), M, INW, D, D, 0, 0}; pg8::StaticOrder S; S.init(M, INW, F.G, F.bid);
            EpiProj E{kp, l, F.lds};
            pg8::gemm_phase<EpiProj, pg8::StaticOrder, true, true>(F.lds, g, S, E);
            if constexpr (PROBE == 4) { __syncthreads(); pg8::gemm_phase<EpiProj, pg8::StaticOrder, true, true>(F.lds, g, S, E); }
        }
        GRID_BAR();
_Pragma("unroll 1")
        for (int rep = 0; rep < (PROBE == 3 ? 2 : 1); ++rep) { const Args a = load_args(kp); mix_elt(F, a, l); }
        GRID_BAR();
        if constexpr (PHMASK & 8) {
            const Args a = load_args(kp); unsigned char* ws = a.ws; unsigned char* wl = ws + WS_W + (size_t)l * W_LAYER;
            pg8::Gemm2 g{(const bf16*)(ws + WS_MIXED), (const bf16*)(wl + WO_MAP), 256, 1, 512, (const bf16*)(ws + WS_GBCV), (const bf16*)(wl + WO_CO), CW, PW}; pg8::StaticOrder S; S.init(MP, D, F.G, F.bid);
            EpiPool2 E{(const bf16*)(ws + WS_SA), (const bf16*)(ws + WS_SB), (bf16*)(ws + WS_MA)};
            pg8::gemm_phase2<EpiPool2, pg8::StaticOrder>(F.lds, g, S, E);
            small_gemm<3>(F, (const bf16*)(ws + WS_MIXED), PW, 256, (const bf16*)(wl + WO_MAP), 256, (const bf16*)(ws + WS_SA), (const bf16*)(ws + WS_SB), (bf16*)(ws + WS_MA), nullptr,
                          (const bf16*)(ws + WS_GBCV), (const bf16*)(wl + WO_CO), CW);
        }
        GRID_BAR();
        if constexpr (PHMASK & 32) {
            const Args a = load_args(kp); unsigned char* ws = a.ws; unsigned char* wl = ws + WS_W + (size_t)l * W_LAYER;
            pg8::Gemm g{(const bf16*)(ws + WS_MA), (const bf16*)(wl + WO_O), MP, D, D, D, 0, 0}; pg8::StaticOrder S; S.init(MP, D, F.G, F.bid);
            EpiRes E{(bf16*)(ws + WS_XB), (float*)(ws + WS_SSQ)};
            pg8::gemm_phase<EpiRes, pg8::StaticOrder, true, true>(F.lds, g, S, E);
            small_gemm<2>(F, (const bf16*)(ws + WS_MA), D, 0, (const bf16*)(wl + WO_O), D, nullptr, nullptr, (bf16*)(ws + WS_XB), (float*)(ws + WS_SSQ));
        }
        GRID_BAR();
        if constexpr (PHMASK & 64) {
            const Args a = load_args(kp); unsigned char* ws = a.ws; unsigned char* wl = ws + WS_W + (size_t)l * W_LAYER;
            pg8::Gemm g{(const bf16*)(ws + WS_XB), (const bf16*)(wl + WO_UP), M, FF2, D, D, 0, 0}; pg8::StaticOrder S; S.init(M, FF2, F.G, F.bid);
            EpiUpAct E{kp, F.lds + EX_OFF, l};
            pg8::gemm_phase<EpiUpAct, pg8::StaticOrder, true, true>(F.lds, g, S, E);
            if constexpr (PROBE == 5) { __syncthreads(); pg8::gemm_phase<EpiUpAct, pg8::StaticOrder, true, true>(F.lds, g, S, E); }
        }
        GRID_BAR();
        if constexpr (PHMASK & 128) { const Args a = load_args(kp); ffn_fixup(F, a, l);
            unsigned char* ws = a.ws; unsigned char* wl = ws + WS_W + (size_t)l * W_LAYER; __syncthreads();
            small_gemm<2>(F, (const bf16*)(ws + WS_ACT), FF, 0, (const bf16*)(wl + WO_DN), FF, nullptr, nullptr, (bf16*)(ws + WS_XB), (float*)(ws + WS_SSQ)); }
        GRID_BAR();
        if constexpr (PHMASK & 256) {
            const Args a = load_args(kp); unsigned char* ws = a.ws; unsigned char* wl = ws + WS_W + (size_t)l * W_LAYER;
            pg8::Gemm g{(const bf16*)(ws + WS_ACT), (const bf16*)(wl + WO_DN), MP, D, FF, FF, 0, 0}; pg8::StaticOrder S; S.init(MP, D, F.G, F.bid);
            EpiRes E{(bf16*)(ws + WS_XB), (float*)(ws + WS_SSQ)};
            pg8::gemm_phase<EpiRes, pg8::StaticOrder, true, true>(F.lds, g, S, E);
        }
        GRID_BAR();
    }
    if constexpr (PHMASK & 512) { const Args a = load_args(kp); final_norm(F, a); }
    if constexpr (PROBE == 1) { for (int i = 0; i < 16; ++i) GRID_BAR(); }
}

extern "C" void kernel_launch(void* const* d_in, const int* in_sizes, int n_in, void* d_out, int out_size, void* d_ws, size_t ws_size, hipStream_t stream) {
    static int grid = 0;
    if (grid == 0) {
        if (n_in != 19 || in_sizes[0] != MP * D || (size_t)out_size != O_END || ws_size < WS_END) {
            fprintf(stderr, "kernel_launch: unexpected shapes: n_in %d in0 %d out %d ws %zu (need %zu)\n", n_in, n_in > 0 ? in_sizes[0] : -1, out_size, ws_size, (size_t)WS_END); grid = -1; return; }
        int dev = 0, cus = 0, per_cu = 0;
        hipGetDevice(&dev); hipDeviceGetAttribute(&cus, hipDeviceAttributeMultiprocessorCount, dev);
        if (hipFuncSetAttribute((const void*)fwd_mega, hipFuncAttributeMaxDynamicSharedMemorySize, LDS_BYTES) != hipSuccess) { fprintf(stderr, "kernel_launch: hipFuncSetAttribute failed\n"); grid = -1; return; }
        if (hipOccupancyMaxActiveBlocksPerMultiprocessor(&per_cu, (const void*)fwd_mega, NTHR, LDS_BYTES) != hipSuccess || per_cu < 1) { fprintf(stderr, "kernel_launch: occupancy query says %d\n", per_cu); per_cu = 1; }
        (void)hipGetLastError();
        grid = cus;
    }
    if (grid < 0) return;
    Args a{};
    for (int i = 0; i < 19; ++i) a.in[i] = (const float*)d_in[i];
    a.out = (float*)d_out; a.ws = (unsigned char*)d_ws;
    void* args[] = {&a};
    if (hipMemsetAsync(d_ws, 0, 16384, stream) != hipSuccess) { fprintf(stderr, "kernel_launch: hipMemsetAsync failed\n"); return; }
    hipError_t e = hipLaunchCooperativeKernel((const void*)fwd_mega, dim3(grid), dim3(NTHR), args, LDS_BYTES, stream);
    if (e != hipSuccess) fprintf(stderr, "cooperative launch failed: %s (grid %d)\n", hipGetErrorString(e), grid);
}
```

```cpp
#include <hip/hip_runtime.h>
#include <hip/hip_cooperative_groups.h>
#include <cstdio>
#include <cstdint>
namespace cg = cooperative_groups;

namespace pg8 {
#define PG8_LAS __attribute__((address_space(3)))
typedef unsigned short bf16_t;
typedef short bf16x8 __attribute__((ext_vector_type(8)));
typedef float f32x4 __attribute__((ext_vector_type(4)));
typedef unsigned u32x4 __attribute__((ext_vector_type(4)));
constexpr int BM = 256, BK = 64, HALF = 128, HTB = HALF * BK * 2, STAGE_BYTES = 8 * HTB, NXCD = 8, WGM = 8;

__host__ __device__ __forceinline__ int lds_byte(int r, int c) { const int st = (r >> 4) * 2 + (c >> 5), rr = r & 15, cc = c & 31, ob = rr * 64 + cc * 2; return st * 1024 + (ob ^ (((ob >> 9) & 1) << 5)); }
__host__ __device__ __forceinline__ void stage_rc(int b, int& R, int& C) { const int st = b / 1024, sb = b % 1024, swz = sb ^ (((sb >> 9) & 1) << 5); R = (st >> 1) * 16 + swz / 64; C = (st & 1) * 32 + (swz % 64) / 2; }
__host__ __device__ __forceinline__ int perm32(int rho) { const int n = rho >> 4, i = rho & 15; return 8 * (i >> 2) + 4 * n + (i & 3); }

struct Unit { int pm, pn; };
struct Gemm { const bf16_t* A; const bf16_t* Bt; int M, N, K, lda, apn_shift, apn_bytes; };

struct StaticOrder {
    int nM, nN, nwg, G, c;
    __host__ __device__ void init(int M, int N, int G_, int c_) { nM = M / BM; nN = N / BM; nwg = nM * nN; G = G_; c = c_; }
    __host__ __device__ bool next(int i, Unit& u) const {
        const long L = (long)i * G + c; if (L >= nwg) return false;
        int wgid = (int)L; { const int q = nwg / NXCD, r = nwg % NXCD, xcd = wgid % NXCD, off = wgid / NXCD; wgid = (xcd < r ? xcd * (q + 1) : r * (q + 1) + (xcd - r) * q) + off; }
        const int nig = WGM * nN, gid = wgid / nig, fm = gid * WGM, gsz = (nM - fm) < WGM ? (nM - fm) : WGM;
        u.pm = fm + ((wgid % nig) % gsz); u.pn = (wgid % nig) / gsz; return true;
    }
    __device__ __forceinline__ void a_ready(const Unit&) const {}
    __device__ __forceinline__ void done(const Unit&) const {}
};

__device__ __forceinline__ unsigned cvt_pk_bf16(float lo, float hi) { unsigned r; asm volatile("v_cvt_pk_bf16_f32 %0, %1, %2" : "=v"(r) : "v"(lo), "v"(hi)); return r; }

template <class Epi, class Sched, bool ALIGN_EPI = false, bool SP2 = false>
__device__ __forceinline__ void gemm_phase(PG8_LAS unsigned char* lds, const Gemm g, const Sched& S_in, const Epi& E) {
    int tid_ = threadIdx.x; asm volatile("" : "+v"(tid_));
    const int tid = tid_, wid = __builtin_amdgcn_readfirstlane(tid >> 6), lane = tid & 63, wr = wid >> 2, wc = wid & 3, fr = lane & 15, fq = lane >> 4;
    const int K = g.K, nt = K / BK, lda = g.lda;
    unsigned voffA[2], voffB[2];
#pragma unroll
    for (int i = 0; i < 2; ++i) { int R, C; stage_rc(tid * 16 + i * 8192, R, C); const int Rb = Epi::PERM ? ((R & ~31) + perm32(R & 31)) : R;
        voffA[i] = (unsigned)(R * lda + C) * 2u; voffB[i] = (unsigned)(Rb * K + C) * 2u; }
    const size_t kstep = (size_t)(BK * 2);
    const size_t hstepA = (size_t)HALF * lda * 2, hstepB = (size_t)HALF * K * 2;
    const size_t tstepA = 2 * hstepA, tstepB = 2 * hstepB;
    const unsigned ldsw = (unsigned)wid * 1024u;
    const int aoff = lds_byte(wr * 64 + fr, fq * 8), boff = lds_byte(wc * 32 + fr, fq * 8);
#define PG8_SA(b, h) (((b) * 2 + (h)) * HTB)
#define PG8_SB(b, h) ((4 + (b) * 2 + (h)) * HTB)
#define PG8_STAGE(bufoff, gbase, voff) do { _Pragma("unroll") for (int _i = 0; _i < 2; ++_i) \
        __builtin_amdgcn_global_load_lds((const unsigned*)((const char*)(gbase) + (voff)[_i]), (PG8_LAS unsigned*)(lds + (bufoff) + ldsw + _i * 8192), 16, 0, 0); } while (0)
#define PG8_LDA(dst, b, h) do { _Pragma("unroll") for (int m = 0; m < 4; ++m) _Pragma("unroll") for (int k = 0; k < 2; ++k) dst[m][k] = *(const PG8_LAS bf16x8*)(lds + PG8_SA(b, h) + aoff + m * 2048 + k * 1024); } while (0)
#define PG8_LDB(dst, b, h) do { _Pragma("unroll") for (int n = 0; n < 2; ++n) _Pragma("unroll") for (int k = 0; k < 2; ++k) dst[n][k] = *(const PG8_LAS bf16x8*)(lds + PG8_SB(b, h) + boff + n * 2048 + k * 1024); } while (0)
#define PG8_MMA(ai, bj, At, Bt) do { __builtin_amdgcn_s_setprio(1); _Pragma("unroll") for (int m = 0; m < 4; ++m) _Pragma("unroll") for (int n = 0; n < 2; ++n) _Pragma("unroll") for (int k = 0; k < 2; ++k) \
        acc[ai][bj][m][n] = __builtin_amdgcn_mfma_f32_16x16x32_bf16(Bt[n][k], At[m][k], acc[ai][bj][m][n], 0, 0, 0); __builtin_amdgcn_s_setprio(0); } while (0)
#define PG8_WAIT_V(n) asm volatile("s_waitcnt vmcnt(" #n ")" ::: "memory")
#define PG8_WAIT_L(n) asm volatile("s_waitcnt lgkmcnt(" #n ")" ::: "memory")
#define PG8_BAR __builtin_amdgcn_s_barrier()
#define PG8_SCHED __builtin_amdgcn_sched_barrier(0)
    Unit cur, nxt; int ui = 0;
    Sched S = S_in; asm volatile("" : "+s"(S.c));
    if (!S.next(0, cur)) return;
    f32x4 acc[2][2][4][2];
#pragma unroll
    for (int a = 0; a < 2; ++a)
#pragma unroll
        for (int b = 0; b < 2; ++b)
#pragma unroll
            for (int m = 0; m < 4; ++m)
#pragma unroll
                for (int n = 0; n < 2; ++n) acc[a][b][m][n] = (f32x4){0.f, 0.f, 0.f, 0.f};
    bf16x8 At[4][2], B0[2][2], B1[2][2];
    const char* cA = (const char*)g.A + (size_t)cur.pm * tstepA + (size_t)(cur.pn >> g.apn_shift) * g.apn_bytes; const char* cB = (const char*)g.Bt + (size_t)cur.pn * tstepB;
    S.a_ready(cur);
    if constexpr (SP2) {
        PG8_STAGE(PG8_SB(0, 0), cB, voffB); PG8_STAGE(PG8_SB(0, 1), cB + hstepB, voffB); PG8_STAGE(PG8_SA(0, 0), cA, voffA); PG8_STAGE(PG8_SA(0, 1), cA + hstepA, voffA);
        if (wr == 1) PG8_BAR;
        PG8_WAIT_V(2); PG8_BAR;
        PG8_STAGE(PG8_SB(1, 0), cB + kstep, voffB); PG8_STAGE(PG8_SA(1, 0), cA + kstep, voffA); PG8_STAGE(PG8_SB(1, 1), cB + hstepB + kstep, voffB);
        PG8_WAIT_V(6); PG8_BAR;
    } else {
        PG8_STAGE(PG8_SB(0, 0), cB, voffB); PG8_STAGE(PG8_SA(0, 0), cA, voffA); PG8_STAGE(PG8_SB(0, 1), cB + hstepB, voffB); PG8_STAGE(PG8_SA(0, 1), cA + hstepA, voffA);
        if (wr == 1) PG8_BAR;
        PG8_WAIT_V(4); PG8_BAR;
        PG8_STAGE(PG8_SB(1, 0), cB + kstep, voffB); PG8_STAGE(PG8_SA(1, 0), cA + kstep, voffA); PG8_STAGE(PG8_SB(1, 1), cB + hstepB + kstep, voffB);
        PG8_WAIT_V(6); PG8_BAR;
    }
    for (;;) {
        const bool has_next = S.next(ui + 1, nxt);
        const char* nA = has_next ? (const char*)g.A + (size_t)nxt.pm * tstepA + (size_t)(nxt.pn >> g.apn_shift) * g.apn_bytes : cA; const char* nB = has_next ? (const char*)g.Bt + (size_t)nxt.pn * tstepB : cB;
#pragma unroll 1
        for (int t = 0; t < nt; t += 2) {
            const bool last = (t == nt - 2);
            const char* a1 = cA + (size_t)(t + 1) * kstep;
            const char* a2 = last ? nA : cA + (size_t)(t + 2) * kstep; const char* b2 = last ? nB : cB + (size_t)(t + 2) * kstep;
            const char* a3 = a2 + kstep; const char* b3 = b2 + kstep;
            if (last && has_next) S.a_ready(nxt);
            if (last) E.prefetch(cur, lds, wid, lane);
            if constexpr (SP2) {
            PG8_LDB(B0, 0, 0); PG8_LDB(B1, 0, 1); PG8_SCHED; PG8_LDA(At, 0, 0); PG8_STAGE(PG8_SA(1, 1), a1 + hstepA, voffA);
            PG8_WAIT_V(8); PG8_WAIT_L(0); PG8_BAR; PG8_MMA(0, 0, At, B0); PG8_MMA(0, 1, At, B1); PG8_BAR; PG8_SCHED;
            PG8_LDA(At, 0, 1); PG8_STAGE(PG8_SB(0, 0), b2, voffB); PG8_STAGE(PG8_SB(0, 1), b2 + hstepB, voffB); PG8_STAGE(PG8_SA(0, 0), a2, voffA);
            PG8_WAIT_V(8); PG8_WAIT_L(0); PG8_BAR; PG8_MMA(1, 0, At, B0); PG8_MMA(1, 1, At, B1); PG8_BAR; PG8_SCHED;
            PG8_LDB(B0, 1, 0); PG8_LDB(B1, 1, 1); PG8_SCHED; PG8_LDA(At, 1, 0); PG8_STAGE(PG8_SA(0, 1), a2 + hstepA, voffA);
            PG8_WAIT_V(8); PG8_WAIT_L(0); PG8_BAR; PG8_MMA(0, 0, At, B0); PG8_MMA(0, 1, At, B1); PG8_BAR; PG8_SCHED;
            PG8_LDA(At, 1, 1); PG8_STAGE(PG8_SB(1, 0), b3, voffB); PG8_STAGE(PG8_SB(1, 1), b3 + hstepB, voffB); PG8_STAGE(PG8_SA(1, 0), a3, voffA);
            PG8_WAIT_V(8); PG8_WAIT_L(0); PG8_BAR; PG8_MMA(1, 0, At, B0); PG8_MMA(1, 1, At, B1); PG8_BAR; PG8_SCHED;
            } else {
            PG8_LDB(B0, 0, 0); PG8_SCHED; PG8_LDA(At, 0, 0); PG8_STAGE(PG8_SA(1, 1), a1 + hstepA, voffA);
            PG8_WAIT_L(8); PG8_BAR; PG8_WAIT_L(0); PG8_MMA(0, 0, At, B0); PG8_BAR; PG8_SCHED;
            PG8_LDB(B1, 0, 1); PG8_STAGE(PG8_SB(0, 0), b2, voffB);
            PG8_BAR; PG8_WAIT_L(0); PG8_MMA(0, 1, At, B1); PG8_BAR;
            PG8_LDA(At, 0, 1); PG8_STAGE(PG8_SA(0, 0), a2, voffA);
            PG8_BAR; PG8_WAIT_L(0); PG8_MMA(1, 0, At, B0); PG8_BAR; PG8_SCHED;
            PG8_STAGE(PG8_SB(0, 1), b2 + hstepB, voffB);
            PG8_WAIT_V(6); PG8_BAR; PG8_MMA(1, 1, At, B1); PG8_BAR;
            PG8_LDB(B0, 1, 0); PG8_SCHED; PG8_LDA(At, 1, 0); PG8_STAGE(PG8_SA(0, 1), a2 + hstepA, voffA);
            PG8_WAIT_L(8); PG8_BAR; PG8_WAIT_L(0); PG8_MMA(0, 0, At, B0); PG8_BAR; PG8_SCHED;
            PG8_LDB(B1, 1, 1); PG8_STAGE(PG8_SB(1, 0), b3, voffB);
            PG8_BAR; PG8_WAIT_L(0); PG8_MMA(0, 1, At, B1); PG8_BAR;
            PG8_LDA(At, 1, 1); PG8_STAGE(PG8_SA(1, 0), a3, voffA);
            PG8_BAR; PG8_WAIT_L(0); PG8_MMA(1, 0, At, B0); PG8_BAR; PG8_SCHED;
            PG8_STAGE(PG8_SB(1, 1), b3 + hstepB, voffB);
            PG8_WAIT_V(6); PG8_BAR; PG8_MMA(1, 1, At, B1); PG8_BAR;
            }
        }
        if constexpr (ALIGN_EPI) { if (wr == 0) PG8_BAR; }
        E(acc, cur, wr, wc, fr, fq); S.done(cur);
        if (!has_next) break;
#pragma unroll
        for (int a = 0; a < 2; ++a)
#pragma unroll
            for (int b = 0; b < 2; ++b)
#pragma unroll
                for (int m = 0; m < 4; ++m)
#pragma unroll
                    for (int n = 0; n < 2; ++n) acc[a][b][m][n] = (f32x4){0.f, 0.f, 0.f, 0.f};
        cur = nxt; cA = nA; cB = nB; ++ui;
        if constexpr (ALIGN_EPI) { if (wr == 1) PG8_BAR; }
    }
    PG8_WAIT_V(0);
    if constexpr (!ALIGN_EPI) { if (wr == 0) PG8_BAR; }
    PG8_BAR;
#undef PG8_SA
#undef PG8_SB
#undef PG8_STAGE
#undef PG8_LDA
#undef PG8_LDB
#undef PG8_MMA
#undef PG8_WAIT_V
#undef PG8_WAIT_L
#undef PG8_BAR
#undef PG8_SCHED
}

struct Gemm2 { const bf16_t* A0; const bf16_t* B0; int K0, apn_shift0, apn_bytes0; const bf16_t* A1; const bf16_t* B1; int K1; int lda; };
template <class Epi, class Sched>
__device__ __forceinline__ void gemm_phase2(PG8_LAS unsigned char* lds, const Gemm2 g, const Sched& S_in, const Epi& E) {
    int tid_ = threadIdx.x; asm volatile("" : "+v"(tid_));
    const int tid = tid_, wid = __builtin_amdgcn_readfirstlane(tid >> 6), lane = tid & 63, wr = wid >> 2, wc = wid & 3, fr = lane & 15, fq = lane >> 4;
    const int lda = g.lda;
    unsigned voffA[2], voffB0[2], voffB1[2];
#pragma unroll
    for (int i = 0; i < 2; ++i) { int R, C; stage_rc(tid * 16 + i * 8192, R, C); const int Rb = Epi::PERM ? ((R & ~31) + perm32(R & 31)) : R;
        voffA[i] = (unsigned)(R * lda + C) * 2u; voffB0[i] = (unsigned)(Rb * g.K0 + C) * 2u; voffB1[i] = (unsigned)(Rb * g.K1 + C) * 2u; }
    const size_t kstep = (size_t)(BK * 2);
    const size_t hstepA = (size_t)HALF * lda * 2, tstepA = 2 * hstepA;
    const size_t hstepB0 = (size_t)HALF * g.K0 * 2, hstepB1 = (size_t)HALF * g.K1 * 2, tstepB0 = 2 * hstepB0, tstepB1 = 2 * hstepB1;
    const unsigned ldsw = (unsigned)wid * 1024u;
    const int aoff = lds_byte(wr * 64 + fr, fq * 8), boff = lds_byte(wc * 32 + fr, fq * 8);
#define PG8_SA(b, h) (((b) * 2 + (h)) * HTB)
#define PG8_SB(b, h) ((4 + (b) * 2 + (h)) * HTB)
#define PG8_STAGE(bufoff, gbase, voff) do { _Pragma("unroll") for (int _i = 0; _i < 2; ++_i) \
        __builtin_amdgcn_global_load_lds((const unsigned*)((const char*)(gbase) + (voff)[_i]), (PG8_LAS unsigned*)(lds + (bufoff) + ldsw + _i * 8192), 16, 0, 0); } while (0)
#define PG8_LDA(dst, b, h) do { _Pragma("unroll") for (int m = 0; m < 4; ++m) _Pragma("unroll") for (int k = 0; k < 2; ++k) dst[m][k] = *(const PG8_LAS bf16x8*)(lds + PG8_SA(b, h) + aoff + m * 2048 + k * 1024); } while (0)
#define PG8_LDB(dst, b, h) do { _Pragma("unroll") for (int n = 0; n < 2; ++n) _Pragma("unroll") for (int k = 0; k < 2; ++k) dst[n][k] = *(const PG8_LAS bf16x8*)(lds + PG8_SB(b, h) + boff + n * 2048 + k * 1024); } while (0)
#define PG8_MMA(ai, bj, At, Bt) do { __builtin_amdgcn_s_setprio(1); _Pragma("unroll") for (int m = 0; m < 4; ++m) _Pragma("unroll") for (int n = 0; n < 2; ++n) _Pragma("unroll") for (int k = 0; k < 2; ++k) \
        acc[ai][bj][m][n] = __builtin_amdgcn_mfma_f32_16x16x32_bf16(Bt[n][k], At[m][k], acc[ai][bj][m][n], 0, 0, 0); __builtin_amdgcn_s_setprio(0); } while (0)
#define PG8_WAIT_V(n) asm volatile("s_waitcnt vmcnt(" #n ")" ::: "memory")
#define PG8_WAIT_L(n) asm volatile("s_waitcnt lgkmcnt(" #n ")" ::: "memory")
#define PG8_BAR __builtin_amdgcn_s_barrier()
#define PG8_SCHED __builtin_amdgcn_sched_barrier(0)
#define PG8_A0BASE(u) ((const char*)g.A0 + (size_t)(u).pm * tstepA + (size_t)((u).pn >> g.apn_shift0) * g.apn_bytes0)
    Unit cur, nxt; int ui = 0;
    Sched S = S_in; asm volatile("" : "+s"(S.c));
    if (!S.next(0, cur)) return;
    f32x4 acc[2][2][4][2];
#pragma unroll
    for (int a = 0; a < 2; ++a)
#pragma unroll
        for (int b = 0; b < 2; ++b)
#pragma unroll
            for (int m = 0; m < 4; ++m)
#pragma unroll
                for (int n = 0; n < 2; ++n) acc[a][b][m][n] = (f32x4){0.f, 0.f, 0.f, 0.f};
    bf16x8 At[4][2], B0[2][2], B1[2][2];
    const char* cA = PG8_A0BASE(cur); const char* cB = (const char*)g.B0 + (size_t)cur.pn * tstepB0;
    PG8_STAGE(PG8_SB(0, 0), cB, voffB0); PG8_STAGE(PG8_SB(0, 1), cB + hstepB0, voffB0); PG8_STAGE(PG8_SA(0, 0), cA, voffA); PG8_STAGE(PG8_SA(0, 1), cA + hstepA, voffA);
    if (wr == 1) PG8_BAR;
    PG8_WAIT_V(2); PG8_BAR;
    PG8_STAGE(PG8_SB(1, 0), cB + kstep, voffB0); PG8_STAGE(PG8_SA(1, 0), cA + kstep, voffA); PG8_STAGE(PG8_SB(1, 1), cB + hstepB0 + kstep, voffB0);
    PG8_WAIT_V(6); PG8_BAR;
#define PG8_KLOOP(NT, CA, CB, VC, HC, NA, NB, VN, HN, HOOK) do { \
        _Pragma("unroll 1") for (int t = 0; t < (NT); t += 2) { \
            const bool last = (t == (NT) - 2); \
            if (last) { HOOK; } \
            const char* a1 = (CA) + (size_t)(t + 1) * kstep; \
            const char* a2 = last ? (NA) : (CA) + (size_t)(t + 2) * kstep; const char* b2 = last ? (NB) : (CB) + (size_t)(t + 2) * kstep; \
            const char* a3 = a2 + kstep; const char* b3 = b2 + kstep; \
            const size_t hB = last ? (HN) : (HC); unsigned vB[2]; vB[0] = last ? (VN)[0] : (VC)[0]; vB[1] = last ? (VN)[1] : (VC)[1]; \
            PG8_LDB(B0, 0, 0); PG8_LDB(B1, 0, 1); PG8_SCHED; PG8_LDA(At, 0, 0); PG8_STAGE(PG8_SA(1, 1), a1 + hstepA, voffA); \
            PG8_WAIT_V(8); PG8_WAIT_L(0); PG8_BAR; PG8_MMA(0, 0, At, B0); PG8_MMA(0, 1, At, B1); PG8_BAR; PG8_SCHED; \
            PG8_LDA(At, 0, 1); PG8_STAGE(PG8_SB(0, 0), b2, vB); PG8_STAGE(PG8_SB(0, 1), b2 + hB, vB); PG8_STAGE(PG8_SA(0, 0), a2, voffA); \
            PG8_WAIT_V(8); PG8_WAIT_L(0); PG8_BAR; PG8_MMA(1, 0, At, B0); PG8_MMA(1, 1, At, B1); PG8_BAR; PG8_SCHED; \
            PG8_LDB(B0, 1, 0); PG8_LDB(B1, 1, 1); PG8_SCHED; PG8_LDA(At, 1, 0); PG8_STAGE(PG8_SA(0, 1), a2 + hstepA, voffA); \
            PG8_WAIT_V(8); PG8_WAIT_L(0); PG8_BAR; PG8_MMA(0, 0, At, B0); PG8_MMA(0, 1, At, B1); PG8_BAR; PG8_SCHED; \
            PG8_LDA(At, 1, 1); PG8_STAGE(PG8_SB(1, 0), b3, vB); PG8_STAGE(PG8_SB(1, 1), b3 + hB, vB); PG8_STAGE(PG8_SA(1, 0), a3, voffA); \
            PG8_WAIT_V(8); PG8_WAIT_L(0); PG8_BAR; PG8_MMA(1, 0, At, B0); PG8_MMA(1, 1, At, B1); PG8_BAR; PG8_SCHED; \
        } } while (0)
    const int nt0 = g.K0 / BK, nt1 = g.K1 / BK;
    for (;;) {
        const bool has_next = S.next(ui + 1, nxt);
        const char* cA1 = (const char*)g.A1 + (size_t)cur.pm * tstepA; const char* cB1 = (const char*)g.B1 + (size_t)cur.pn * tstepB1;
        PG8_KLOOP(nt0, cA, cB, voffB0, hstepB0, cA1, cB1, voffB1, hstepB1, (void)0);
        if (wr == 0) PG8_BAR;
        E.mid(acc, cur, wr, wc, fr, fq);
        if (wr == 1) PG8_BAR;
        const char* nA = has_next ? PG8_A0BASE(nxt) : cA1; const char* nB = has_next ? (const char*)g.B0 + (size_t)nxt.pn * tstepB0 : cB1;
        const size_t hBn = has_next ? hstepB0 : hstepB1; unsigned vBn[2]; vBn[0] = has_next ? voffB0[0] : voffB1[0]; vBn[1] = has_next ? voffB0[1] : voffB1[1];
        PG8_KLOOP(nt1, cA1, cB1, voffB1, hstepB1, nA, nB, vBn, hBn, (void)0);
        if (wr == 0) PG8_BAR;
        E.fin(acc, cur, wr, wc, fr, fq);
        if (!has_next) break;
#pragma unroll
        for (int a = 0; a < 2; ++a)
#pragma unroll
            for (int b = 0; b < 2; ++b)
#pragma unroll
                for (int m = 0; m < 4; ++m)
#pragma unroll
                    for (int n = 0; n < 2; ++n) acc[a][b][m][n] = (f32x4){0.f, 0.f, 0.f, 0.f};
        cur = nxt; cA = nA; cB = nB; ++ui;
        if (wr == 1) PG8_BAR;
    }
#undef PG8_KLOOP
    PG8_WAIT_V(0);
    PG8_BAR;
#undef PG8_A0BASE
#undef PG8_SA
#undef PG8_SB
#undef PG8_STAGE
#undef PG8_LDA
#undef PG8_LDB
#undef PG8_MMA
#undef PG8_WAIT_V
#undef PG8_WAIT_L
#undef PG8_BAR
#undef PG8_SCHED
}
}

typedef unsigned short bf16;
typedef float f32x4 __attribute__((ext_vector_type(4)));
typedef unsigned u32x4 __attribute__((ext_vector_type(4)));
typedef unsigned u32x2 __attribute__((ext_vector_type(2)));
#define LAS __attribute__((address_space(3)))

constexpr int D = 1024, MP = 32768, MS = 1024, M = MP + MS, NTILE = M / 256, NTP = MP / 256;
constexpr int INW = 4096, PW = 512, CW = 512, FF = 2816, FF2 = 5632;
constexpr float EPS = 1e-6f;
constexpr int NWAVES = 8, NTHR = 512;
constexpr int LDS_BYTES = 155648;
#ifndef PHMASK
#define PHMASK 0xFFFF
#endif
#ifndef PROBE
#define PROBE 0
#endif

constexpr size_t O_POOLP = (size_t)M * D;
constexpr size_t O_CONVP = O_POOLP + 2 * 8 * 15 * 512;
constexpr size_t O_FFNP = O_CONVP + 2 * 8 * 2 * 512;
constexpr size_t O_POOLS = O_FFNP + 2 * 8 * 2 * 5632;
constexpr size_t O_CONVS = O_POOLS + 2 * 16 * 15 * 512;
constexpr size_t O_FFNS = O_CONVS + 2 * 16 * 2 * 512;
constexpr size_t O_END = O_FFNS + 2 * 16 * 2 * 5632;

constexpr size_t MiB = 1u << 20;
constexpr size_t WS_SSQ = 1 * MiB;
constexpr size_t WS_W = 4 * MiB, W_LAYER = 28 * MiB;
constexpr size_t WO_IN = 0, WO_UP = 8 * MiB, WO_DN = 19 * MiB, WO_O = 24 * MiB + MiB / 2, WO_CO = 26 * MiB + MiB / 2, WO_MAP = 27 * MiB + MiB / 2;
constexpr size_t WS_XB = 60 * MiB;
constexpr size_t WS_ACTV = 126 * MiB;
constexpr size_t WS_UPOOL = WS_ACTV, WS_CVIN = WS_ACTV + 33 * MiB, WS_GB = WS_ACTV + 66 * MiB, WS_SA = WS_ACTV + 99 * MiB, WS_SB = WS_ACTV + 165 * MiB,
                 WS_MIXED = WS_ACTV + 231 * MiB, WS_GBCV = WS_ACTV + 264 * MiB, WS_MA = WS_ACTV;
constexpr size_t WS_ACT = WS_ACTV;
constexpr size_t WS_HALO = WS_ACTV + 182 * MiB;
constexpr size_t WS_END = WS_ACTV + 297 * MiB;
constexpr int BST_OFF = 131072 + 8192;
constexpr int EX_OFF = 131072;
constexpr int RC_OFF = 131072 + 8192 + 256;
constexpr int WCV_OFF = 147456;
constexpr int GATE_OFF = 151552;
constexpr int RCT_OFF = RC_OFF + 4096;

__device__ __forceinline__ float bf_lo(unsigned w) { return __builtin_bit_cast(float, w << 16); }
__device__ __forceinline__ float bf_hi(unsigned w) { return __builtin_bit_cast(float, w & 0xffff0000u); }
__device__ __forceinline__ unsigned pk2(float lo, float hi) { return pg8::cvt_pk_bf16(lo, hi); }
__device__ __forceinline__ float sigmoidf_(float x) { return __builtin_amdgcn_rcpf(1.f + __builtin_amdgcn_exp2f(-1.44269504f * x)); }
#define UNPACK8(V_, F_) do { F_[0] = bf_lo((V_)[0]); F_[1] = bf_hi((V_)[0]); F_[2] = bf_lo((V_)[1]); F_[3] = bf_hi((V_)[1]); F_[4] = bf_lo((V_)[2]); F_[5] = bf_hi((V_)[2]); F_[6] = bf_lo((V_)[3]); F_[7] = bf_hi((V_)[3]); } while (0)

struct Args { const float* in[19]; float* out; unsigned char* ws; };
typedef const __attribute__((address_space(4))) Args* KArgs;
__device__ __forceinline__ Args load_args(KArgs kp) {
    asm volatile("" : "+s"(kp)); Args a;
#pragma unroll
    for (int i = 0; i < 19; ++i) a.in[i] = kp->in[i];
    a.out = kp->out; a.ws = kp->ws; return a;
}

__device__ __forceinline__ void unit_rstd(const float* ssq, int pm, int wr, int wc, int fr, int fq, int tagv, LAS unsigned char* lds, float (&r)[2][4]) {
    const int lane = fq * 16 + fr, wave = wr * 4 + wc;
    LAS float* rc = (LAS float*)(lds + RC_OFF) + (wave * 64 + lane) * 2;
    LAS int* tg = (LAS int*)(lds + RCT_OFF) + wave;
    float rs[2];
    if (__builtin_amdgcn_readfirstlane(tg[0]) == tagv) { rs[0] = rc[0]; rs[1] = rc[1]; }
    else {
#pragma unroll
        for (int ai = 0; ai < 2; ++ai) {
            const f32x4* p = (const f32x4*)(ssq + (size_t)(pm * 256 + ai * 128 + wr * 64 + lane) * 16);
            const f32x4 a = p[0], b = p[1], c = p[2], d = p[3];
            const float s = ((a.x + a.y) + (a.z + a.w)) + ((b.x + b.y) + (b.z + b.w)) + ((c.x + c.y) + (c.z + c.w)) + ((d.x + d.y) + (d.z + d.w));
            rs[ai] = 1.0f / sqrtf(s * (1.0f / D) + EPS);
        }
        rc[0] = rs[0]; rc[1] = rs[1]; if (lane == 0) tg[0] = tagv;
    }
#pragma unroll
    for (int ai = 0; ai < 2; ++ai)
#pragma unroll
        for (int m = 0; m < 4; ++m) r[ai][m] = __shfl(rs[ai], m * 16 + fr);
}

__device__ __forceinline__ void touch_tile_lines(const bf16* base, int pm, int pn, LAS unsigned char* lds, int wid, int lane) {
#pragma unroll
    for (int q = 0; q < 2; ++q) { const int idx = (wid * 2 + q) * 64 + lane, row = idx >> 2, line = idx & 3;
        __builtin_amdgcn_global_load_lds((const unsigned*)(base + ((size_t)pm * 256 + row) * D + pn * 256 + line * 64), (LAS unsigned*)(lds + WCV_OFF + (wid * 2 + q) * 256), 4, 0, 0); }
}
template <class T> __device__ __forceinline__ T* launder_s(T* p) { asm volatile("" : "+s"(p)); return p; }
struct EpiProj {
    static constexpr bool PERM = true, AFTER_DRAIN = false;
    __device__ __forceinline__ void prefetch(const pg8::Unit& u, LAS unsigned char* lds, int wid, int lane) const {
        if (u.pn >= 8 && wid < 3) {
            const Args a_ = load_args(kp);
            const float* src = (wid == 2 ? a_.in[9] + (size_t)l * D : a_.in[7] + (size_t)l * 2 * D + wid * D) + (u.pn - 8) * 128 + lane;
            __builtin_amdgcn_global_load_lds((const unsigned*)src, (LAS unsigned*)(lds + GATE_OFF + wid * 512), 4, 0, 0);
            __builtin_amdgcn_global_load_lds((const unsigned*)(src + 64), (LAS unsigned*)(lds + GATE_OFF + wid * 512 + 256), 4, 0, 0);
        }
    }
    KArgs kp; int l; LAS unsigned char* lds0;
    __device__ __forceinline__ void operator()(const f32x4 (&acc)[2][2][4][2], const pg8::Unit& u, int wr, int wc, int fr, int fq) const {
        const Args a_ = load_args(kp); unsigned char* w_ = a_.ws; float* o_ = a_.out; const float* b_gate = a_.in[7] + (size_t)l * 2 * D; const float* pool_scale = a_.in[9] + (size_t)l * D;
        float r[2][4]; unit_rstd((const float*)(w_ + WS_SSQ), u.pm, wr, wc, fr, fq, (2 * l + 0) * 1024 + u.pm, lds0, r);
        const int pm = u.pm, pn = u.pn;
        const int lc0 = wc * 32 + 8 * fq;
        const bool samp = pm >= NTP;
        if (pn < 4) {
            bf16* O = (bf16*)(w_ + ((pn < 2) ? WS_UPOOL : WS_GB)); const int cb = (pn & 1) * 256 + lc0;
#pragma unroll
            for (int ai = 0; ai < 2; ++ai)
#pragma unroll
                for (int m = 0; m < 4; ++m) { const size_t row = (size_t)pm * 256 + ai * 128 + wr * 64 + m * 16 + fr; const float rr = r[ai][m];
#pragma unroll
                    for (int bj = 0; bj < 2; ++bj) { const f32x4 v0 = acc[ai][bj][m][0] * rr, v1 = acc[ai][bj][m][1] * rr; u32x4 w;
                        w.x = pk2(v0[0], v0[1]); w.y = pk2(v0[2], v0[3]); w.z = pk2(v1[0], v1[1]); w.w = pk2(v1[2], v1[3]);
                        *(u32x4*)(O + row * 512 + cb + bj * 128) = w; } }
            if (pn < 2 && (samp || ((pm & 15) == 15 && wr == 1)) && fr >= 1) {
                float* pool_p = o_ + O_POOLP + (size_t)l * 8 * 15 * 512; float* pool_s = o_ + O_POOLS + (size_t)l * 16 * 15 * 512;
#pragma unroll
                for (int ai = 0; ai < 2; ++ai) { if (!samp && ai == 0) continue;
                    float* sp = samp ? pool_s + ((size_t)((pm - NTP) * 4 + ai * 2 + wr) * 15 + (fr - 1)) * 512 : pool_p + ((size_t)(pm >> 4) * 15 + (fr - 1)) * 512;
                    const float rr = r[ai][3];
#pragma unroll
                    for (int bj = 0; bj < 2; ++bj) { *(f32x4*)(sp + cb + bj * 128) = acc[ai][bj][3][0] * rr; *(f32x4*)(sp + cb + bj * 128 + 4) = acc[ai][bj][3][1] * rr; } }
            }
        } else if (pn < 8) {
            const int cb = (pn - 4) * 128 + lc0; bf16* CVIN = (bf16*)(w_ + WS_CVIN);
            float* conv_p = o_ + O_CONVP + (size_t)l * 8 * 2 * 512; float* conv_s = o_ + O_CONVS + (size_t)l * 16 * 2 * 512;
#pragma unroll
            for (int ai = 0; ai < 2; ++ai)
#pragma unroll
                for (int m = 0; m < 4; ++m) { const size_t row = (size_t)pm * 256 + ai * 128 + wr * 64 + m * 16 + fr; const float rr = r[ai][m] * r[ai][m];
                    const f32x4 v0 = acc[ai][0][m][0] * acc[ai][1][m][0] * rr, v1 = acc[ai][0][m][1] * acc[ai][1][m][1] * rr; u32x4 w;
                    w.x = pk2(v0[0], v0[1]); w.y = pk2(v0[2], v0[3]); w.z = pk2(v1[0], v1[1]); w.w = pk2(v1[2], v1[3]);
                    *(u32x4*)(CVIN + row * 512 + cb) = w;
                    if (m == 3 && fr >= 14 && (samp || ((pm & 15) == 15 && wr == 1 && ai == 1))) {
                        float* sp = samp ? conv_s + ((size_t)((pm - NTP) * 4 + ai * 2 + wr) * 2 + (fr - 14)) * 512 : conv_p + ((size_t)(pm >> 4) * 2 + (fr - 14)) * 512;
                        *(f32x4*)(sp + cb) = v0; *(f32x4*)(sp + cb + 4) = v1; } }
        } else {
            bf16* RHO = (bf16*)(w_ + WS_SA); bf16* SBo = (bf16*)(w_ + WS_SB); const int cb = (pn - 8) * 128 + lc0;
            const LAS float* gl_ = (const LAS float*)(lds0 + GATE_OFF) + lc0;
            const f32x4 ba0 = *(const LAS f32x4*)(gl_), ba1 = *(const LAS f32x4*)(gl_ + 4), bb0 = *(const LAS f32x4*)(gl_ + 128), bb1 = *(const LAS f32x4*)(gl_ + 128 + 4);
            const f32x4 ps0 = *(const LAS f32x4*)(gl_ + 256), ps1 = *(const LAS f32x4*)(gl_ + 256 + 4);
#pragma unroll
            for (int ai = 0; ai < 2; ++ai)
#pragma unroll
                for (int m = 0; m < 4; ++m) { const size_t row = (size_t)pm * 256 + ai * 128 + wr * 64 + m * 16 + fr; const float rr = r[ai][m];
                    const f32x4 xa0 = acc[ai][0][m][0] * rr + ba0, xa1 = acc[ai][0][m][1] * rr + ba1, xb0 = acc[ai][1][m][0] * rr + bb0, xb1 = acc[ai][1][m][1] * rr + bb1;
                    f32x4 rh0, rh1, sb0, sb1;
#pragma unroll
                    for (int e = 0; e < 4; ++e) {
                        const float ea0 = __builtin_amdgcn_exp2f(-1.44269504f * fmaxf(xa0[e], -30.f)), eb0 = __builtin_amdgcn_exp2f(-1.44269504f * fmaxf(xb0[e], -30.f));
                        const float ea1 = __builtin_amdgcn_exp2f(-1.44269504f * fmaxf(xa1[e], -30.f)), eb1 = __builtin_amdgcn_exp2f(-1.44269504f * fmaxf(xb1[e], -30.f));
                        sb0[e] = __builtin_amdgcn_rcpf(1.f + eb0); sb1[e] = __builtin_amdgcn_rcpf(1.f + eb1);
                        rh0[e] = ps0[e] * (1.f + eb0) * __builtin_amdgcn_rcpf(1.f + ea0); rh1[e] = ps1[e] * (1.f + eb1) * __builtin_amdgcn_rcpf(1.f + ea1); }
                    u32x4 w; w.x = pk2(rh0[0], rh0[1]); w.y = pk2(rh0[2], rh0[3]); w.z = pk2(rh1[0], rh1[1]); w.w = pk2(rh1[2], rh1[3]);
                    *(u32x4*)(RHO + row * 1024 + cb) = w;
                    u32x4 v; v.x = pk2(sb0[0], sb0[1]); v.y = pk2(sb0[2], sb0[3]); v.z = pk2(sb1[0], sb1[1]); v.w = pk2(sb1[2], sb1[3]);
                    *(u32x4*)(SBo + row * 1024 + cb) = v; }
        }
    }
};

struct EpiPool2 {
    static constexpr bool PERM = true, AFTER_DRAIN = false;
    const bf16* RHO; const bf16* SB; bf16* MA;
    __device__ __forceinline__ void warm_mid(const pg8::Unit& u, LAS unsigned char* lds, int wid, int lane) const { touch_tile_lines(RHO, u.pm, u.pn, lds, wid, lane); }
    __device__ __forceinline__ void warm_fin(const pg8::Unit& u, LAS unsigned char* lds, int wid, int lane) const { touch_tile_lines(SB, u.pm, u.pn, lds, wid, lane); }
    __device__ __forceinline__ void mid(f32x4 (&acc)[2][2][4][2], const pg8::Unit& u, int wr, int wc, int fr, int fq) const {
        const int cb = u.pn * 256 + wc * 32 + 8 * fq;
#pragma unroll
        for (int ai = 0; ai < 2; ++ai) {
            u32x4 sv[4][2];
#pragma unroll
            for (int m = 0; m < 4; ++m)
#pragma unroll
                for (int bj = 0; bj < 2; ++bj) sv[m][bj] = *(const u32x4*)(RHO + ((size_t)u.pm * 256 + ai * 128 + wr * 64 + m * 16 + fr) * 1024 + cb + bj * 128);
#pragma unroll
            for (int m = 0; m < 4; ++m)
#pragma unroll
                for (int bj = 0; bj < 2; ++bj) { float f[8]; UNPACK8(sv[m][bj], f);
                    acc[ai][bj][m][0] = acc[ai][bj][m][0] * (f32x4){f[0], f[1], f[2], f[3]}; acc[ai][bj][m][1] = acc[ai][bj][m][1] * (f32x4){f[4], f[5], f[6], f[7]}; }
            asm volatile("" ::: "memory");
        }
    }
    __device__ __forceinline__ void fin(const f32x4 (&acc)[2][2][4][2], const pg8::Unit& u, int wr, int wc, int fr, int fq) const {
        const int cb = u.pn * 256 + wc * 32 + 8 * fq;
#pragma unroll
        for (int ai = 0; ai < 2; ++ai) {
            u32x4 sv[4][2];
#pragma unroll
            for (int m = 0; m < 4; ++m)
#pragma unroll
                for (int bj = 0; bj < 2; ++bj) sv[m][bj] = *(const u32x4*)(SB + ((size_t)u.pm * 256 + ai * 128 + wr * 64 + m * 16 + fr) * 1024 + cb + bj * 128);
#pragma unroll
            for (int m = 0; m < 4; ++m) { const size_t row = (size_t)u.pm * 256 + ai * 128 + wr * 64 + m * 16 + fr;
#pragma unroll
                for (int bj = 0; bj < 2; ++bj) { const size_t o = row * 1024 + cb + bj * 128; float f[8]; UNPACK8(sv[m][bj], f);
                    const f32x4 a0 = acc[ai][bj][m][0], a1 = acc[ai][bj][m][1]; u32x4 w;
                    w.x = pk2(a0[0] * f[0], a0[1] * f[1]); w.y = pk2(a0[2] * f[2], a0[3] * f[3]); w.z = pk2(a1[0] * f[4], a1[1] * f[5]); w.w = pk2(a1[2] * f[6], a1[3] * f[7]);
                    *(u32x4*)(MA + o) = w; } }
            asm volatile("" ::: "memory");
        }
    }
};

struct EpiMA {
    static constexpr bool PERM = true, AFTER_DRAIN = false;
    __device__ __forceinline__ void prefetch(const pg8::Unit&, LAS unsigned char*, int, int) const {}
    const bf16* SA; bf16* MA;
    __device__ __forceinline__ void operator()(const f32x4 (&acc)[2][2][4][2], const pg8::Unit& u, int wr, int wc, int fr, int fq) const {
        const int cb = u.pn * 256 + wc * 32 + 8 * fq;
#pragma unroll
        for (int ai = 0; ai < 2; ++ai) {
            u32x4 sv[4][2];
#pragma unroll
            for (int m = 0; m < 4; ++m)
#pragma unroll
                for (int bj = 0; bj < 2; ++bj) sv[m][bj] = *(const u32x4*)(SA + ((size_t)u.pm * 256 + ai * 128 + wr * 64 + m * 16 + fr) * 1024 + cb + bj * 128);
#pragma unroll
            for (int m = 0; m < 4; ++m) { const size_t row = (size_t)u.pm * 256 + ai * 128 + wr * 64 + m * 16 + fr;
#pragma unroll
                for (int bj = 0; bj < 2; ++bj) { const size_t o = row * 1024 + cb + bj * 128; float f[8]; UNPACK8(sv[m][bj], f);
                    const f32x4 a0 = acc[ai][bj][m][0], a1 = acc[ai][bj][m][1]; u32x4 w;
                    w.x = pk2(a0[0] * f[0], a0[1] * f[1]); w.y = pk2(a0[2] * f[2], a0[3] * f[3]); w.z = pk2(a1[0] * f[4], a1[1] * f[5]); w.w = pk2(a1[2] * f[6], a1[3] * f[7]);
                    *(u32x4*)(MA + o) = w; } }
            asm volatile("" ::: "memory");
        }
    }
};
struct EpiMerge {
    static constexpr bool PERM = true, AFTER_DRAIN = false;
    __device__ __forceinline__ void prefetch(const pg8::Unit&, LAS unsigned char*, int, int) const {}
    const bf16* SB; bf16* MA;
    __device__ __forceinline__ void operator()(const f32x4 (&acc)[2][2][4][2], const pg8::Unit& u, int wr, int wc, int fr, int fq) const {
        const int cb = u.pn * 256 + wc * 32 + 8 * fq;
#pragma unroll
        for (int ai = 0; ai < 2; ++ai)
#pragma unroll
          for (int mh = 0; mh < 2; ++mh) {
            u32x4 sv[2][2], pv[2][2];
#pragma unroll
            for (int mm = 0; mm < 2; ++mm)
#pragma unroll
                for (int bj = 0; bj < 2; ++bj) { const size_t o = ((size_t)u.pm * 256 + ai * 128 + wr * 64 + (2 * mh + mm) * 16 + fr) * 1024 + cb + bj * 128; sv[mm][bj] = *(const u32x4*)(SB + o); pv[mm][bj] = *(const u32x4*)(MA + o); }
#pragma unroll
            for (int mm = 0; mm < 2; ++mm) { const int m = 2 * mh + mm; const size_t row = (size_t)u.pm * 256 + ai * 128 + wr * 64 + m * 16 + fr;
#pragma unroll
                for (int bj = 0; bj < 2; ++bj) { const size_t o = row * 1024 + cb + bj * 128; float f[8], q[8]; UNPACK8(sv[mm][bj], f); UNPACK8(pv[mm][bj], q);
                    const f32x4 a0 = acc[ai][bj][m][0], a1 = acc[ai][bj][m][1]; u32x4 w;
                    w.x = pk2(a0[0] * f[0] + q[0], a0[1] * f[1] + q[1]); w.y = pk2(a0[2] * f[2] + q[2], a0[3] * f[3] + q[3]);
                    w.z = pk2(a1[0] * f[4] + q[4], a1[1] * f[5] + q[5]); w.w = pk2(a1[2] * f[6] + q[6], a1[3] * f[7] + q[7]);
                    *(u32x4*)(MA + o) = w; } }
            asm volatile("" ::: "memory");
          }
    }
};
struct EpiRes {
    static constexpr bool PERM = true, AFTER_DRAIN = false;
    __device__ __forceinline__ void prefetch(const pg8::Unit& u, LAS unsigned char* lds, int wid, int lane) const { touch_tile_lines(xb, u.pm, u.pn, lds, wid, lane); }
    bf16* xb; float* ssq;
    __device__ __forceinline__ void operator()(const f32x4 (&acc)[2][2][4][2], const pg8::Unit& u, int wr, int wc, int fr, int fq) const {
        const int pm = u.pm, cb = u.pn * 256 + wc * 32 + 8 * fq;
#pragma unroll
        for (int ai = 0; ai < 2; ++ai) {
            u32x4 old[4][2];
#pragma unroll
            for (int m = 0; m < 4; ++m)
#pragma unroll
                for (int bj = 0; bj < 2; ++bj) old[m][bj] = *(const u32x4*)(xb + ((size_t)pm * 256 + ai * 128 + wr * 64 + m * 16 + fr) * D + cb + bj * 128);
#pragma unroll
            for (int m = 0; m < 4; ++m) { const size_t row = (size_t)pm * 256 + ai * 128 + wr * 64 + m * 16 + fr; float sq = 0.f;
#pragma unroll
                for (int bj = 0; bj < 2; ++bj) { float f[8]; UNPACK8(old[m][bj], f);
                    const f32x4 a0 = acc[ai][bj][m][0], a1 = acc[ai][bj][m][1]; u32x4 w;
                    w.x = pk2(a0[0] + f[0], a0[1] + f[1]); w.y = pk2(a0[2] + f[2], a0[3] + f[3]); w.z = pk2(a1[0] + f[4], a1[1] + f[5]); w.w = pk2(a1[2] + f[6], a1[3] + f[7]);
                    *(u32x4*)(xb + row * D + cb + bj * 128) = w;
                    float g[8]; UNPACK8(w, g);
                    sq += (g[0] * g[0] + g[1] * g[1]) + (g[2] * g[2] + g[3] * g[3]) + (g[4] * g[4] + g[5] * g[5]) + (g[6] * g[6] + g[7] * g[7]); }
                sq += __shfl_xor(sq, 16); sq += __shfl_xor(sq, 32);
                if (fq == 0) ssq[row * 16 + u.pn * 4 + wc] = sq; }
            asm volatile("" ::: "memory");
        }
    }
};
template <int CTRL> __device__ __forceinline__ float dppf(float v) { return __builtin_bit_cast(float, __builtin_amdgcn_update_dpp(0, __builtin_bit_cast(int, v), CTRL, 0xf, 0xf, true)); }
#define DPP_SHR1 0x111
#define DPP_SHR2 0x112
#define DPP_SHL15 0x10F
#define DPP_SHL14 0x10E
struct EpiUpAct {
    static constexpr bool PERM = true, AFTER_DRAIN = false;
    KArgs kp; LAS unsigned char* ex; int l;
    __device__ __forceinline__ void prefetch(const pg8::Unit& u, LAS unsigned char* lds, int wid, int lane) const {
        const Args a_ = load_args(kp);
        const int tap = wid >> 1, h = wid & 1;
        const float* src = (tap < 3 ? a_.in[15] + (size_t)l * 3 * FF2 + (size_t)tap * FF2 : a_.in[16] + (size_t)l * FF2) + h * FF + u.pn * 128 + lane;
        __builtin_amdgcn_global_load_lds((const unsigned*)src, (LAS unsigned*)(lds + WCV_OFF + wid * 512), 4, 0, 0);
        __builtin_amdgcn_global_load_lds((const unsigned*)(src + 64), (LAS unsigned*)(lds + WCV_OFF + wid * 512 + 256), 4, 0, 0);
        if (u.pm >= NTP) {
            const float* sf = a_.in[4] + (size_t)l * 16 * 2 * FF2 + (size_t)(u.pm - NTP) * 4 * 2 * FF2 + u.pn * 128 + lane;
#pragma unroll
            for (int q = 0; q < 2; ++q) { const int sidx = 2 * wid + q, br = sidx >> 1, h = sidx & 1;
                const float* sp = sf + (size_t)br * FF2 + h * FF;
                __builtin_amdgcn_global_load_lds((const unsigned*)sp, (LAS unsigned*)(lds + EX_OFF + sidx * 512), 4, 0, 0);
                __builtin_amdgcn_global_load_lds((const unsigned*)(sp + 64), (LAS unsigned*)(lds + EX_OFF + sidx * 512 + 256), 4, 0, 0); }
        }
    }
    __device__ __forceinline__ void operator()(const f32x4 (&acc)[2][2][4][2], const pg8::Unit& u, int wr, int wc, int fr, int fq) const {
        const Args a_ = load_args(kp); unsigned char* w_ = a_.ws; float* o_ = a_.out;
        const float* fw = a_.in[15] + (size_t)l * 3 * FF2; const float* fb = a_.in[16] + (size_t)l * FF2; const float* sffn = a_.in[4] + (size_t)l * 16 * 2 * FF2;
        const int pm = u.pm, pn = u.pn; const bool samp = pm >= NTP;
        float r[2][4]; unit_rstd((const float*)(w_ + WS_SSQ), pm, wr, wc, fr, fq, (2 * l + 1) * 1024 + pm, ex - EX_OFF, r);
        const int lc0 = wc * 32 + 8 * fq;
        f32x4 x[2][2][4][2];
#pragma unroll
        for (int ai = 0; ai < 2; ++ai)
#pragma unroll
            for (int bj = 0; bj < 2; ++bj)
#pragma unroll
                for (int m = 0; m < 4; ++m)
#pragma unroll
                    for (int n = 0; n < 2; ++n) x[ai][bj][m][n] = acc[ai][bj][m][n] * r[ai][m];
        {
            float* ffn_p = o_ + O_FFNP + (size_t)l * 8 * 2 * FF2; float* ffn_s = o_ + O_FFNS + (size_t)l * 16 * 2 * FF2; float* HALO = (float*)(w_ + WS_HALO) + (size_t)pm * 4 * FF2;
            if (fr >= 14) {
#pragma unroll
                for (int ai = 0; ai < 2; ++ai) {
                    if (samp || ((pm & 15) == 15 && wr == 1 && ai == 1)) {
                        float* sp = samp ? ffn_s + ((size_t)((pm - NTP) * 4 + ai * 2 + wr) * 2 + (fr - 14)) * FF2 : ffn_p + ((size_t)(pm >> 4) * 2 + (fr - 14)) * FF2;
#pragma unroll
                        for (int bj = 0; bj < 2; ++bj) { const int oc = bj * FF + pn * 128 + lc0; *(f32x4*)(sp + oc) = x[ai][bj][3][0]; *(f32x4*)(sp + oc + 4) = x[ai][bj][3][1]; } }
                }
                if (wr == 1) {
#pragma unroll
                    for (int bj = 0; bj < 2; ++bj) { float* hp = HALO + (size_t)(2 + fr - 14) * FF2 + pn * 256 + bj * 128 + lc0; *(f32x4*)hp = x[1][bj][3][0]; *(f32x4*)(hp + 4) = x[1][bj][3][1]; } }
            }
            if (fr < 2 && wr == 0) {
#pragma unroll
                for (int bj = 0; bj < 2; ++bj) { float* hp = HALO + (size_t)fr * FF2 + pn * 256 + bj * 128 + lc0; *(f32x4*)hp = x[0][bj][0][0]; *(f32x4*)(hp + 4) = x[0][bj][0][1]; } }
        }
        if (!samp) {
            if (fr >= 14) {
#pragma unroll
                for (int ai = 0; ai < 2; ++ai)
#pragma unroll
                    for (int bj = 0; bj < 2; ++bj)
#pragma unroll
                        for (int n = 0; n < 2; ++n) *(LAS f32x4*)(ex + ((((2 * ai + wr) * 2 + (fr - 14)) * 256) + bj * 128 + lc0 + 4 * n) * 4) = x[ai][bj][3][n];
            }
            asm volatile("s_waitcnt lgkmcnt(0)" ::: "memory"); __builtin_amdgcn_s_barrier(); asm volatile("" ::: "memory");
        }
        bf16* ACT = (bf16*)(w_ + WS_ACT);
        unsigned pk[2][4][2];
#pragma unroll
        for (int n = 0; n < 2; ++n) {
            const int f = pn * 128 + lc0 + 4 * n;
            const LAS float* wl_ = (const LAS float*)(ex - EX_OFF + WCV_OFF) + lc0 + 4 * n;
            const f32x4 wv0 = *(const LAS f32x4*)(wl_ + 0 * 128), wg0 = *(const LAS f32x4*)(wl_ + 1 * 128), wv1 = *(const LAS f32x4*)(wl_ + 2 * 128), wg1 = *(const LAS f32x4*)(wl_ + 3 * 128);
            const f32x4 wv2 = *(const LAS f32x4*)(wl_ + 4 * 128), wg2 = *(const LAS f32x4*)(wl_ + 5 * 128), bv = *(const LAS f32x4*)(wl_ + 6 * 128), bg = *(const LAS f32x4*)(wl_ + 7 * 128);
#pragma unroll
            for (int ai = 0; ai < 2; ++ai) {
                const int B = 2 * ai + wr;
                f32x4 e1v = (f32x4){0.f, 0.f, 0.f, 0.f}, e2v = e1v, e1g = e1v, e2g = e1v;
                if (fr < 2) {
                    if (samp || B > 0) {
                        const LAS unsigned char* eb = ex + ((samp ? B : B - 1) * 2 * 256 + lc0 + 4 * n) * 4;
                        const f32x4 v63 = *(const LAS f32x4*)(eb + 256 * 4), g63 = *(const LAS f32x4*)(eb + 256 * 4 + 128 * 4);
                        if (fr == 0) { e1v = v63; e1g = g63; e2v = *(const LAS f32x4*)eb; e2g = *(const LAS f32x4*)(eb + 128 * 4); } else { e2v = v63; e2g = g63; }
                    }
                }
#pragma unroll
                for (int m = 0; m < 4; ++m) {
                    float av[4];
#pragma unroll
                    for (int e = 0; e < 4; ++e) {
                        const float xv = x[ai][0][m][n][e], xg = x[ai][1][m][n][e];
                        float yv = bv[e] + wv2[e] * xv, yg = bg[e] + wg2[e] * xg;
                        if (m > 0) {
                            const float pv = x[ai][0][m > 0 ? m - 1 : 0][n][e], pg = x[ai][1][m > 0 ? m - 1 : 0][n][e];
                            asm volatile("s_nop 4\n\t"
                                "v_fmac_f32_dpp %0, %2, %4 row_shr:1 row_mask:0xf bank_mask:0xf bound_ctrl:1\n\t"
                                "v_fmac_f32_dpp %1, %3, %6 row_shr:1 row_mask:0xf bank_mask:0xf bound_ctrl:1\n\t"
                                "v_fmac_f32_dpp %0, %2, %5 row_shr:2 row_mask:0xf bank_mask:0xf bound_ctrl:1\n\t"
                                "v_fmac_f32_dpp %1, %3, %7 row_shr:2 row_mask:0xf bank_mask:0xf bound_ctrl:1\n\t"
                                "v_fmac_f32_dpp %0, %8, %4 row_shl:15 row_mask:0xf bank_mask:0xf bound_ctrl:1\n\t"
                                "v_fmac_f32_dpp %1, %9, %6 row_shl:15 row_mask:0xf bank_mask:0xf bound_ctrl:1\n\t"
                                "v_fmac_f32_dpp %0, %8, %5 row_shl:14 row_mask:0xf bank_mask:0xf bound_ctrl:1\n\t"
                                "v_fmac_f32_dpp %1, %9, %7 row_shl:14 row_mask:0xf bank_mask:0xf bound_ctrl:1"
                                : "+v"(yv), "+v"(yg) : "v"(xv), "v"(xg), "v"(wv1[e]), "v"(wv0[e]), "v"(wg1[e]), "v"(wg0[e]), "v"(pv), "v"(pg));
                        } else {
                            asm volatile("s_nop 4\n\t"
                                "v_fmac_f32_dpp %0, %2, %4 row_shr:1 row_mask:0xf bank_mask:0xf bound_ctrl:1\n\t"
                                "v_fmac_f32_dpp %1, %3, %6 row_shr:1 row_mask:0xf bank_mask:0xf bound_ctrl:1\n\t"
                                "v_fmac_f32_dpp %0, %2, %5 row_shr:2 row_mask:0xf bank_mask:0xf bound_ctrl:1\n\t"
                                "v_fmac_f32_dpp %1, %3, %7 row_shr:2 row_mask:0xf bank_mask:0xf bound_ctrl:1\n\t"
                                "v_fmac_f32_e32 %0, %8, %4\n\t"
                                "v_fmac_f32_e32 %1, %9, %6\n\t"
                                "v_fmac_f32_e32 %0, %10, %5\n\t"
                                "v_fmac_f32_e32 %1, %11, %7"
                                : "+v"(yv), "+v"(yg) : "v"(xv), "v"(xg), "v"(wv1[e]), "v"(wv0[e]), "v"(wg1[e]), "v"(wg0[e]), "v"(e1v[e]), "v"(e1g[e]), "v"(e2v[e]), "v"(e2g[e]));
                        }
                        av[e] = yg * sigmoidf_(yg) * yv;
                    }
                    const unsigned lo = pk2(av[0], av[1]), hi = pk2(av[2], av[3]);
                    if (n == 0) { pk[ai][m][0] = lo; pk[ai][m][1] = hi; }
                    else { u32x4 w; w.x = pk[ai][m][0]; w.y = pk[ai][m][1]; w.z = lo; w.w = hi;
                        *(u32x4*)(ACT + ((size_t)pm * 256 + ai * 128 + wr * 64 + m * 16 + fr) * FF + pn * 128 + lc0) = w; }
                }
            }
        }
    }
};

#define XB_TMO      128
#define XB_XCNT(j)  (256  + 64 * (j))
#define XB_XSUB(j)  (1280 + 64 * (j))
#define XB_XGEN(j)  (2304 + 64 * (j))
#define XB_TOP      3328
#define XB_TOPGEN   3392
#define XCD_BAR_WORDS 3456
#define XB_SPIN_CAP (1u << 18)
__device__ __forceinline__ unsigned xb_ld(unsigned* p)              { return __hip_atomic_load(p, __ATOMIC_RELAXED, __HIP_MEMORY_SCOPE_AGENT); }
__device__ __forceinline__ unsigned xb_add(unsigned* p, unsigned v) { return __hip_atomic_fetch_add(p, v, __ATOMIC_RELAXED, __HIP_MEMORY_SCOPE_AGENT); }
__device__ __forceinline__ unsigned xb_xcc_id() { return (unsigned)__builtin_amdgcn_s_getreg((3 << 11) | 20) & 0xFu; }
#define XB_SPIN(cond, bar) do { unsigned _sp = 0; while (cond) { __builtin_amdgcn_s_sleep(1); \
    if ((++_sp & 255u) == 0u) { if (xb_ld(&(bar)[XB_TMO])) break; if (_sp > XB_SPIN_CAP) { atomicAdd(&(bar)[XB_TMO], 1u); break; } } } } while (0)
struct XcdBarrier { unsigned* bar; unsigned x; volatile LAS unsigned* st; };
__device__ __forceinline__ XcdBarrier xcd_barrier_post(unsigned* bar, volatile LAS unsigned* st) {
    XcdBarrier b; b.bar = bar; b.x = xb_xcc_id(); b.st = st;
    if (threadIdx.x == 0) (void)xb_add(&bar[XB_XCNT(b.x)], 1u);
    return b;
}
__device__ __forceinline__ void xcd_barrier_complete(unsigned* bar, unsigned x, unsigned& nloc, unsigned& nx) {
    const unsigned G = gridDim.x * gridDim.y * gridDim.z;
    unsigned sum, cnt, mine, sp = 0u;
    for (;;) {
        sum = 0u; cnt = 0u; mine = 0u;
#pragma unroll
        for (unsigned j = 0; j < 16; ++j) { const unsigned c = xb_ld(&bar[XB_XCNT(j)]); sum += c; cnt += (c > 0u) ? 1u : 0u; mine = (j == x) ? c : mine; }
        if (sum == G) break;
        __builtin_amdgcn_s_sleep(1);
        if ((++sp & 255u) == 0u) { if (xb_ld(&bar[XB_TMO])) break; if (sp > XB_SPIN_CAP) { atomicAdd(&bar[XB_TMO], 1u); break; } }
    }
    nloc = mine > 0u ? mine : 1u; nx = cnt > 0u ? cnt : 1u;
}
__device__ __forceinline__ void xcd_barrier(const XcdBarrier& b) {
    asm volatile("s_waitcnt vmcnt(0)" ::: "memory");
    __syncthreads();
    int t0_ = threadIdx.x; asm volatile("" : "+v"(t0_));
    if (t0_ == 0) {
        unsigned* bar = b.bar;
        __builtin_amdgcn_s_waitcnt(0);
        unsigned nloc = b.st[0], nx = b.st[1];
        if (nloc == 0u) { xcd_barrier_complete(bar, b.x, nloc, nx); b.st[0] = nloc; b.st[1] = nx; }
        const unsigned old = xb_add(&bar[XB_XSUB(b.x)], 1u);
        const unsigned gen = old / nloc;
        if (old + 1u == (gen + 1u) * nloc) {
            __builtin_amdgcn_fence(__ATOMIC_RELEASE, "agent");
            asm volatile("s_waitcnt vmcnt(0)" ::: "memory");
            const unsigned og = xb_add(&bar[XB_TOP], 1u);
            const unsigned tg = og / nx;
            if (og + 1u == (tg + 1u) * nx) xb_add(&bar[XB_TOPGEN], 1u);
            else XB_SPIN(xb_ld(&bar[XB_TOPGEN]) == tg, bar);
            __builtin_amdgcn_fence(__ATOMIC_ACQUIRE, "agent");
            xb_add(&bar[XB_XGEN(b.x)], 1u);
            asm volatile("s_waitcnt vmcnt(0)" ::: "memory");
        } else {
            XB_SPIN(xb_ld(&bar[XB_XGEN(b.x)]) == gen, bar);
            __builtin_amdgcn_fence(__ATOMIC_ACQUIRE, "agent");
            asm volatile("s_waitcnt vmcnt(0)" ::: "memory");
        }
    }
    __syncthreads();
}


struct Frame {
    LAS unsigned char* lds;
    int tid, lane, wave, G, bid;
};

__device__ __forceinline__ float wave_sum(float v) {
#pragma unroll
    for (int o = 1; o < 64; o <<= 1) v += __shfl_xor(v, o);
    return v;
}

__device__ __forceinline__ void tr_item(const float* W, int ldw, int srccol, int ks0, const float* gs, bf16* WT, int Kd, int dst_row, int kd0, bool zero, LAS float* scr, int lane) {
    const int c = lane & 7;
    f32x4 g0 = (f32x4){1.f, 1.f, 1.f, 1.f}, g1 = g0;
    if (!zero) {
        float v[32];
#pragma unroll
        for (int i = 0; i < 32; ++i) v[i] = __builtin_nontemporal_load(W + (size_t)(ks0 + 2 * i + (lane >> 5)) * ldw + srccol + (lane & 31));
        if (gs) { g0 = *(const f32x4*)(gs + ks0 + 8 * c); g1 = *(const f32x4*)(gs + ks0 + 8 * c + 4); }
#pragma unroll
        for (int i = 0; i < 32; ++i) scr[(2 * i + (lane >> 5)) * 33 + (lane & 31)] = v[i];
    }
    asm volatile("s_waitcnt lgkmcnt(0)" ::: "memory");
#pragma unroll
    for (int j = 0; j < 4; ++j) { const int n = (lane >> 3) + 8 * j; const LAS float* s = scr + (8 * c) * 33 + n;
        u32x4 o;
        if (zero) { unsigned z = 0u; asm volatile("" : "+v"(z)); o = (u32x4){z, z, z, z}; }
        else { o.x = pk2(s[0 * 33] * g0[0], s[1 * 33] * g0[1]); o.y = pk2(s[2 * 33] * g0[2], s[3 * 33] * g0[3]); o.z = pk2(s[4 * 33] * g1[0], s[5 * 33] * g1[1]); o.w = pk2(s[6 * 33] * g1[2], s[7 * 33] * g1[3]); }
        *(u32x4*)(WT + (size_t)(dst_row + n) * Kd + kd0 + 8 * c) = o; }
    asm volatile("s_waitcnt lgkmcnt(0)" ::: "memory");
}

constexpr int I_IN = 16 * 128, I_UP = 16 * 176, I_DN = 44 * 32, I_O = 16 * 32, I_CO = 8 * 32, I_MAP = 128;
constexpr int ITEMS_L = I_IN + I_UP + I_DN + I_O + I_CO + I_MAP;

__device__ __forceinline__ void p0_prologue(const Frame& F, const Args& a) {
    int tid_ = threadIdx.x; asm volatile("" : "+v"(tid_)); const int TID = tid_, LANE = tid_ & 63, WAVE = __builtin_amdgcn_readfirstlane(tid_ >> 6);
    LAS float* scr = (LAS float*)(F.lds + WAVE * 16384);
    const int gw = F.bid * NWAVES + WAVE, NGW = F.G * NWAVES;
    unsigned char* ws = a.ws;
    for (int it = gw; it < 2 * ITEMS_L; it += NGW) {
        const int l = it / ITEMS_L; int r = it % ITEMS_L;
        unsigned char* wl = ws + WS_W + (size_t)l * W_LAYER;
        if (r < I_IN) { const int kb = r / 128, n0 = (r % 128) * 32;
            const int src = n0 < 1024 ? n0 : n0 < 2048 ? 1024 + 512 * (((n0 - 1024) % 256) / 128) + 128 * ((n0 - 1024) / 256) + (n0 % 128)
                                                     : 2048 + 1024 * (((n0 - 2048) % 256) / 128) + 128 * ((n0 - 2048) / 256) + (n0 % 128);
            tr_item(a.in[6] + (size_t)l * D * INW, INW, src, kb * 64, a.in[5] + l * D, (bf16*)(wl + WO_IN), D, n0, kb * 64, false, scr, LANE); continue; } r -= I_IN;
        if (r < I_UP) { const int kb = r / 176, n0 = (r % 176) * 32;
            const int src = ((n0 % 256) / 128) * FF + 128 * (n0 / 256) + (n0 % 128);
            tr_item(a.in[14] + (size_t)l * D * FF2, FF2, src, kb * 64, a.in[13] + l * D, (bf16*)(wl + WO_UP), D, n0, kb * 64, false, scr, LANE); continue; } r -= I_UP;
        if (r < I_DN) { const int kb = r / 32, n0 = (r % 32) * 32;
            tr_item(a.in[17] + (size_t)l * FF * D, D, n0, kb * 64, nullptr, (bf16*)(wl + WO_DN), FF, n0, kb * 64, false, scr, LANE); continue; } r -= I_DN;
        if (r < I_O) { const int kb = r / 32, n0 = (r % 32) * 32;
            tr_item(a.in[12] + (size_t)l * D * D, D, n0, kb * 64, nullptr, (bf16*)(wl + WO_O), D, n0, kb * 64, false, scr, LANE); continue; } r -= I_O;
        if (r < I_CO) { const int kb = r / 32, n0 = (r % 32) * 32;
            tr_item(a.in[11] + (size_t)l * CW * D, D, n0, kb * 64, nullptr, (bf16*)(wl + WO_CO), CW, n0, kb * 64, false, scr, LANE); continue; } r -= I_CO;
        { const int g = r / 32, kb = (r % 32) / 8, nb = r % 8; const bool zero = (kb >> 1) != (g & 1);
            tr_item(a.in[8] + (size_t)l * 4 * 128 * 256 + (size_t)g * 128 * 256, 256, nb * 32, (kb & 1) * 64, nullptr, (bf16*)(wl + WO_MAP), 256, g * 256 + nb * 32, kb * 64, zero, scr, LANE); }
    }
    bf16* XB = (bf16*)(ws + WS_XB); float* SSQ = (float*)(ws + WS_SSQ);
    for (int m = gw; m < M; m += NGW) {
        const float* xrow = m < MP ? a.in[0] + (size_t)m * D : a.in[1] + (size_t)(m - MP) * D;
        const f32x4* xr = (const f32x4*)xrow + LANE; f32x4 v[4]; float s = 0.f;
#pragma unroll
        for (int j = 0; j < 4; ++j) { v[j] = __builtin_nontemporal_load(xr + 64 * j); s += (v[j].x * v[j].x + v[j].y * v[j].y) + (v[j].z * v[j].z + v[j].w * v[j].w); }
        s = wave_sum(s);
        u32x2* o8 = (u32x2*)(XB + (size_t)m * D) + LANE;
#pragma unroll
        for (int j = 0; j < 4; ++j) { u32x2 w; w.x = pk2(v[j].x, v[j].y); w.y = pk2(v[j].z, v[j].w); o8[64 * j] = w; }
        if (LANE < 16) SSQ[(size_t)m * 16 + LANE] = LANE == 0 ? s : 0.f;
    }
}

constexpr int MIX_RB = 33;
__device__ __forceinline__ void mix_elt(const Frame& F, const Args& a, int l) {
    int tid_ = threadIdx.x; asm volatile("" : "+v"(tid_)); const int TID = tid_;
    unsigned char* ws = a.ws;
    const bf16* UPOOL = (const bf16*)(ws + WS_UPOOL); const bf16* CVIN = (const bf16*)(ws + WS_CVIN); const bf16* GB = (const bf16*)(ws + WS_GB);
    bf16* MIXED = (bf16*)(ws + WS_MIXED); bf16* GBCV = (bf16*)(ws + WS_GBCV);
    const float* spool = a.in[2] + (size_t)l * 16 * 15 * 512; const float* sconv = a.in[3] + (size_t)l * 16 * 2 * 512; const float* cw = a.in[10] + (size_t)l * 3 * 512;
    const int nrb = (M + MIX_RB - 1) / MIX_RB, total = nrb * 128, stride = F.G * NTHR;
    for (int idx = F.bid * NTHR + TID; idx < total; idx += stride) {
        const int rb = idx >> 7, c8 = idx & 127;
        const int r0 = rb * MIX_RB, r1 = (r0 + MIX_RB) < M ? (r0 + MIX_RB) : M;
        if (c8 < 64) {
            const int ch0 = c8 * 8, win = 2 << (c8 >> 4);
            float sum[8], f[8];
            for (int row = r0; row < r1; ++row) {
                const bool samp = row >= MP; int t, sq = 0;
                if (!samp) t = row & 4095; else { const int sr = row - MP; sq = sr >> 6; t = sr & 63; }
                const u32x4 uw = *(const u32x4*)(UPOOL + (size_t)row * 512 + ch0);
                if (row == r0 || t == 0) {
#pragma unroll
                    for (int e = 0; e < 8; ++e) sum[e] = 0.f;
                    if (!samp) {
                        u32x4 hq[15];
#pragma unroll
                        for (int j = 1; j < 16; ++j) { const bool ok = (j < win) && (t - j >= 0); hq[j - 1] = *(const u32x4*)(UPOOL + (size_t)(row - (ok ? j : 0)) * 512 + ch0); }
#pragma unroll
                        for (int j = 1; j < 16; ++j) { const bool ok = (j < win) && (t - j >= 0); UNPACK8(hq[j - 1], f);
#pragma unroll
                            for (int e = 0; e < 8; ++e) sum[e] += ok ? f[e] : 0.f; }
                    } else
                    for (int j = 1; j < win; ++j) {
                        const int tt = t - j;
                        if (tt >= 0) { const u32x4 w = *(const u32x4*)(UPOOL + (size_t)(row - j) * 512 + ch0); UNPACK8(w, f);
#pragma unroll
                            for (int e = 0; e < 8; ++e) sum[e] += f[e]; }
                        else if (samp) { const float* p = spool + ((size_t)sq * 15 + 15 + tt) * 512 + ch0; const f32x4 p0 = *(const f32x4*)p, p1 = *(const f32x4*)(p + 4);
#pragma unroll
                            for (int e = 0; e < 4; ++e) { sum[e] += p0[e]; sum[4 + e] += p1[e]; } }
                    }
                } else {
                    const int tt = t - win;
                    if (tt >= 0) { const u32x4 w = *(const u32x4*)(UPOOL + (size_t)(row - win) * 512 + ch0); UNPACK8(w, f);
#pragma unroll
                        for (int e = 0; e < 8; ++e) sum[e] -= f[e]; }
                    else if (samp) { const float* p = spool + ((size_t)sq * 15 + 15 + tt) * 512 + ch0; const f32x4 p0 = *(const f32x4*)p, p1 = *(const f32x4*)(p + 4);
#pragma unroll
                        for (int e = 0; e < 4; ++e) { sum[e] -= p0[e]; sum[4 + e] -= p1[e]; } }
                }
                UNPACK8(uw, f);
                const float cnt = samp ? (float)win : (float)(win < t + 1 ? win : t + 1), inv = 1.0f / cnt;
                float o[8];
#pragma unroll
                for (int e = 0; e < 8; ++e) { sum[e] += f[e]; o[e] = sum[e] * inv - f[e]; }
                u32x4 w; w.x = pk2(o[0], o[1]); w.y = pk2(o[2], o[3]); w.z = pk2(o[4], o[5]); w.w = pk2(o[6], o[7]);
                *(u32x4*)(MIXED + (size_t)row * 512 + ch0) = w;
            }
        } else {
            const int ch0 = (c8 - 64) * 8;
            float w0[8], w1[8], w2[8];
#pragma unroll
            for (int h = 0; h < 2; ++h) { const f32x4 a0 = *(const f32x4*)(cw + ch0 + 4 * h), a1 = *(const f32x4*)(cw + 512 + ch0 + 4 * h), a2 = *(const f32x4*)(cw + 1024 + ch0 + 4 * h);
#pragma unroll
                for (int e = 0; e < 4; ++e) { w0[4 * h + e] = a0[e]; w1[4 * h + e] = a1[e]; w2[4 * h + e] = a2[e]; } }
            float x0[8], x1[8], x2[8], gb[8];
#pragma unroll
            for (int e = 0; e < 8; ++e) { x1[e] = 0.f; x2[e] = 0.f; }
            for (int row = r0; row < r1; ++row) {
                const bool samp = row >= MP; int t, sq = 0;
                if (!samp) t = row & 4095; else { const int sr = row - MP; sq = sr >> 6; t = sr & 63; }
                { const u32x4 w = *(const u32x4*)(CVIN + (size_t)row * 512 + ch0); UNPACK8(w, x0); }
                { const u32x4 w = *(const u32x4*)(GB + (size_t)row * 512 + ch0); UNPACK8(w, gb); }
                if (row == r0 || t == 0) {
                    if (t >= 1) { const u32x4 w = *(const u32x4*)(CVIN + (size_t)(row - 1) * 512 + ch0); UNPACK8(w, x1); }
                    else if (samp) { const float* p = sconv + ((size_t)sq * 2 + 1) * 512 + ch0; const f32x4 p0 = *(const f32x4*)p, p1 = *(const f32x4*)(p + 4);
#pragma unroll
                        for (int e = 0; e < 4; ++e) { x1[e] = p0[e]; x1[4 + e] = p1[e]; } }
                    else {
#pragma unroll
                        for (int e = 0; e < 8; ++e) x1[e] = 0.f; }
                    if (t >= 2) { const u32x4 w = *(const u32x4*)(CVIN + (size_t)(row - 2) * 512 + ch0); UNPACK8(w, x2); }
                    else if (samp) { const float* p = sconv + ((size_t)sq * 2 + t) * 512 + ch0; const f32x4 p0 = *(const f32x4*)p, p1 = *(const f32x4*)(p + 4);
#pragma unroll
                        for (int e = 0; e < 4; ++e) { x2[e] = p0[e]; x2[4 + e] = p1[e]; } }
                    else {
#pragma unroll
                        for (int e = 0; e < 8; ++e) x2[e] = 0.f; }
                }
                float o[8];
#pragma unroll
                for (int e = 0; e < 8; ++e) { o[e] = gb[e] * (w0[e] * x2[e] + w1[e] * x1[e] + w2[e] * x0[e]); x2[e] = x1[e]; x1[e] = x0[e]; }
                u32x4 w; w.x = pk2(o[0], o[1]); w.y = pk2(o[2], o[3]); w.z = pk2(o[4], o[5]); w.w = pk2(o[6], o[7]);
                *(u32x4*)(GBCV + (size_t)row * 512 + ch0) = w;
            }
        }
    }
}

__device__ __forceinline__ void ffn_fixup(const Frame& F, const Args& a, int l) {
    int tid_ = threadIdx.x; asm volatile("" : "+v"(tid_)); const int TID = tid_;
    unsigned char* ws = a.ws;
    const float* HALO = (const float*)(ws + WS_HALO); bf16* ACT = (bf16*)(ws + WS_ACT);
    const float* fw = a.in[15] + (size_t)l * 3 * FF2; const float* fb = a.in[16] + (size_t)l * FF2;
    const int total = NTP * 2 * 352, stride = F.G * NTHR;
    for (int idx = F.bid * NTHR + TID; idx < total; idx += stride) {
        const int pm = idx / 704, rem = idx % 704, rr = rem / 352, c8 = rem % 352;
        if ((pm & 15) == 0) continue;
        const int f0 = c8 * 8, pn = f0 >> 7, j0 = f0 & 127;
        float res[2][8];
#pragma unroll
        for (int h = 0; h < 2; ++h) {
            const int pc = pn * 256 + h * 128 + j0, oc = h * FF + f0;
            const float* p0 = HALO + ((size_t)pm * 4 + rr) * FF2 + pc;
            const float* p1 = rr == 1 ? HALO + ((size_t)pm * 4 + 0) * FF2 + pc : HALO + ((size_t)(pm - 1) * 4 + 3) * FF2 + pc;
            const float* p2 = rr == 1 ? HALO + ((size_t)(pm - 1) * 4 + 3) * FF2 + pc : HALO + ((size_t)(pm - 1) * 4 + 2) * FF2 + pc;
#pragma unroll
            for (int q = 0; q < 2; ++q) { const f32x4 x0 = *(const f32x4*)(p0 + 4 * q), x1 = *(const f32x4*)(p1 + 4 * q), x2 = *(const f32x4*)(p2 + 4 * q);
                const f32x4 w0 = *(const f32x4*)(fw + oc + 4 * q), w1 = *(const f32x4*)(fw + FF2 + oc + 4 * q), w2 = *(const f32x4*)(fw + 2 * FF2 + oc + 4 * q), b = *(const f32x4*)(fb + oc + 4 * q);
#pragma unroll
                for (int e = 0; e < 4; ++e) res[h][4 * q + e] = w0[e] * x2[e] + w1[e] * x1[e] + w2[e] * x0[e] + b[e]; }
        }
        float o[8];
#pragma unroll
        for (int e = 0; e < 8; ++e) o[e] = res[1][e] * sigmoidf_(res[1][e]) * res[0][e];
        u32x4 w; w.x = pk2(o[0], o[1]); w.y = pk2(o[2], o[3]); w.z = pk2(o[4], o[5]); w.w = pk2(o[6], o[7]);
        *(u32x4*)(ACT + ((size_t)pm * 256 + rr) * FF + f0) = w;
    }
}

__device__ __forceinline__ void final_norm(const Frame& F, const Args& a) {
    int tid_ = threadIdx.x; asm volatile("" : "+v"(tid_)); const int LANE = tid_ & 63, WAVE = __builtin_amdgcn_readfirstlane(tid_ >> 6);
    const float* SSQ = (const float*)(a.ws + WS_SSQ); const bf16* XB = (const bf16*)(a.ws + WS_XB); const float* g = a.in[18];
    const int gw = F.bid * NWAVES + WAVE, NGW = F.G * NWAVES;
    f32x4 gv[2][2];
#pragma unroll
    for (int j = 0; j < 2; ++j) { gv[j][0] = *(const f32x4*)(g + 512 * j + 8 * LANE); gv[j][1] = *(const f32x4*)(g + 512 * j + 8 * LANE + 4); }
    for (int m = gw; m < M; m += NGW) {
        float s = LANE < 16 ? SSQ[(size_t)m * 16 + LANE] : 0.f;
        s = wave_sum(s);
        const float rs = 1.0f / sqrtf(s * (1.0f / D) + EPS);
        float* orow = a.out + (size_t)m * D;
#pragma unroll
        for (int j = 0; j < 2; ++j) { const u32x4 w = *(const u32x4*)(XB + (size_t)m * D + 512 * j + 8 * LANE); float f[8]; UNPACK8(w, f);
            f32x4 o0, o1;
#pragma unroll
            for (int e = 0; e < 4; ++e) { o0[e] = f[e] * rs * gv[j][0][e]; o1[e] = f[4 + e] * rs * gv[j][1][e]; }
            *(f32x4*)(orow + 512 * j + 8 * LANE) = o0; *(f32x4*)(orow + 512 * j + 8 * LANE + 4) = o1; }
    }
}

constexpr int SG_PITCH = 272, SG_ROWS = 160, SG_STAGE = SG_ROWS * SG_PITCH;
template <int MODE>
__device__ __forceinline__ void small_gemm(const Frame& F, const bf16* A, int lda, int grp_cols, const bf16* Bt, int K, const bf16* G0, const bf16* G1, bf16* O, float* ssq,
                                           const bf16* A2 = nullptr, const bf16* Bt2 = nullptr, int K2 = 0) {
    int tid_ = threadIdx.x; asm volatile("" : "+v"(tid_)); const int TID = tid_, LANE = tid_ & 63, WAVE = __builtin_amdgcn_readfirstlane(tid_ >> 6);
    const int rb = WAVE >> 2, cg = WAVE & 3, fr = LANE & 15, fq = LANE >> 4;
    LAS float* red = (LAS float*)(F.lds + EX_OFF);
    LAS unsigned char* L0 = F.lds; LAS unsigned char* L1 = F.lds + SG_STAGE;
    const int aoff = (rb * 16 + fr) * SG_PITCH + fq * 16, boff0 = (32 + cg * 32 + fr) * SG_PITCH + fq * 16, boff1 = boff0 + 16 * SG_PITCH;
#define SG_BAR() do { asm volatile("s_waitcnt lgkmcnt(0)" ::: "memory"); __builtin_amdgcn_s_barrier(); asm volatile("" ::: "memory"); } while (0)
#define SG_GLOAD(R, ks) do { _Pragma("unroll") for (int i = 0; i < 5; ++i) R[i] = *(const u32x4*)(gp[i] + (size_t)(ks) * 128); } while (0)
#define SG_LWRITE(Lb, R) do { _Pragma("unroll") for (int i = 0; i < 5; ++i) *(LAS u32x4*)((Lb) + lo[i]) = R[i]; } while (0)
#define SG_COMPUTE(Lb) do { _Pragma("unroll") for (int j = 0; j < 4; ++j) { const pg8::bf16x8 fa = *(const LAS pg8::bf16x8*)((Lb) + aoff + j * 64), f0 = *(const LAS pg8::bf16x8*)((Lb) + boff0 + j * 64), f1 = *(const LAS pg8::bf16x8*)((Lb) + boff1 + j * 64); \
        acc0 = __builtin_amdgcn_mfma_f32_16x16x32_bf16(f0, fa, acc0, 0, 0, 0); acc1 = __builtin_amdgcn_mfma_f32_16x16x32_bf16(f1, fa, acc1, 0, 0, 0); } } while (0)
    for (int T = F.bid; T < 256; T += F.G) {
        const int tr = T >> 3, tc = T & 7;
        const int row = MP + tr * 32 + rb * 16 + fr, c0 = tc * 128 + cg * 32;
        const bf16* gp[5]; int lo[5];
#pragma unroll
        for (int i = 0; i < 5; ++i) { const int idx = TID + 512 * i, r = idx >> 4, c16 = idx & 15;
            gp[i] = (r < 32) ? A + (size_t)(MP + tr * 32 + r) * lda + (grp_cols ? (tc >> 2) * grp_cols : 0) + 8 * c16 : Bt + (size_t)(tc * 128 + r - 32) * K + 8 * c16;
            lo[i] = r * SG_PITCH + c16 * 16; }
        f32x4 acc0 = (f32x4){0.f, 0.f, 0.f, 0.f}, acc1 = acc0;
        u32x2 pg0[2], pg1[2], pq[2];
#pragma unroll
        for (int n2 = 0; n2 < 2; ++n2) { const size_t o = (size_t)row * D + c0 + 16 * n2 + 4 * fq;
            if (MODE == 0 || MODE == 1 || MODE == 3) pg0[n2] = *(const u32x2*)(G0 + o);
            if (MODE == 0 || MODE == 3) pg1[n2] = *(const u32x2*)(G1 + o);
            if (MODE == 1 || MODE == 2) pq[n2] = *(const u32x2*)(O + o); }
#pragma unroll 1
      for (int sg = 0; sg < (MODE == 3 ? 2 : 1); ++sg) {
        if (MODE == 3 && sg == 1) {
#pragma unroll
            for (int i = 0; i < 5; ++i) { const int idx = TID + 512 * i, r = idx >> 4, c16 = idx & 15;
                gp[i] = (r < 32) ? A2 + (size_t)(MP + tr * 32 + r) * lda + 8 * c16 : Bt2 + (size_t)(tc * 128 + r - 32) * K2 + 8 * c16; }
            acc0 = acc0 * (f32x4){bf_lo(pg0[0].x), bf_hi(pg0[0].x), bf_lo(pg0[0].y), bf_hi(pg0[0].y)}; acc1 = acc1 * (f32x4){bf_lo(pg0[1].x), bf_hi(pg0[1].x), bf_lo(pg0[1].y), bf_hi(pg0[1].y)};
        }
        const int nst = ((MODE == 3 && sg == 1) ? K2 : K) >> 7;
        u32x4 R0[5], R1[5];
        SG_BAR();
        SG_GLOAD(R0, 0); SG_GLOAD(R1, 1);
        SG_LWRITE(L0, R0);
        SG_BAR();
#pragma unroll 1
        for (int s = 0; s < nst; s += 2) {
            if (s + 2 < nst) SG_GLOAD(R0, s + 2);
            SG_COMPUTE(L0);
            SG_LWRITE(L1, R1);
            SG_BAR();
            if (s + 3 < nst) SG_GLOAD(R1, s + 3);
            SG_COMPUTE(L1);
            if (s + 2 < nst) SG_LWRITE(L0, R0);
            SG_BAR();
        }
      }
        float ssum = 0.f;
#pragma unroll
        for (int n2 = 0; n2 < 2; ++n2) {
            const f32x4 av = n2 ? acc1 : acc0; const size_t o = (size_t)row * D + c0 + 16 * n2 + 4 * fq;
            if (MODE == 0) { const u32x2 g = pg0[n2], h = pg1[n2]; u32x2 w;
                w.x = pk2(av[0] * (bf_lo(g.x) * bf_lo(h.x)), av[1] * (bf_hi(g.x) * bf_hi(h.x))); w.y = pk2(av[2] * (bf_lo(g.y) * bf_lo(h.y)), av[3] * (bf_hi(g.y) * bf_hi(h.y))); *(u32x2*)(O + o) = w; }
            else if (MODE == 3) { const u32x2 h = pg1[n2]; u32x2 w; w.x = pk2(av[0] * bf_lo(h.x), av[1] * bf_hi(h.x)); w.y = pk2(av[2] * bf_lo(h.y), av[3] * bf_hi(h.y)); *(u32x2*)(O + o) = w; }
            else if (MODE == 1) { const u32x2 g = pg0[n2], q = pq[n2]; u32x2 w;
                w.x = pk2(av[0] * bf_lo(g.x) + bf_lo(q.x), av[1] * bf_hi(g.x) + bf_hi(q.x)); w.y = pk2(av[2] * bf_lo(g.y) + bf_lo(q.y), av[3] * bf_hi(g.y) + bf_hi(q.y)); *(u32x2*)(O + o) = w; }
            else { const u32x2 q = pq[n2]; u32x2 w; w.x = pk2(av[0] + bf_lo(q.x), av[1] + bf_hi(q.x)); w.y = pk2(av[2] + bf_lo(q.y), av[3] + bf_hi(q.y)); *(u32x2*)(O + o) = w;
                const float g0 = bf_lo(w.x), g1 = bf_hi(w.x), g2 = bf_lo(w.y), g3 = bf_hi(w.y); ssum += (g0 * g0 + g1 * g1) + (g2 * g2 + g3 * g3); }
        }
        if (MODE == 2) {
            ssum += __shfl_xor(ssum, 16); ssum += __shfl_xor(ssum, 32);
            __syncthreads();
            if (fq == 0) red[WAVE * 16 + fr] = ssum;
            __syncthreads();
            if (TID < 32) { const int b = TID >> 4, r = TID & 15; const float t = (red[(b * 4 + 0) * 16 + r] + red[(b * 4 + 1) * 16 + r]) + (red[(b * 4 + 2) * 16 + r] + red[(b * 4 + 3) * 16 + r]);
                float* sp = ssq + (size_t)(MP + tr * 32 + TID) * 16; sp[tc] = t; if (tc == 0) { *(f32x4*)(sp + 8) = (f32x4){0.f, 0.f, 0.f, 0.f}; *(f32x4*)(sp + 12) = (f32x4){0.f, 0.f, 0.f, 0.f}; } }
        }
    }
#undef SG_BAR
#undef SG_GLOAD
#undef SG_LWRITE
#undef SG_COMPUTE
}

__global__ void __launch_bounds__(NTHR, 2) fwd_mega(Args a_unused) {
    extern __shared__ __attribute__((aligned(16))) unsigned char lds_raw[];
    cg::grid_group grid = cg::this_grid();
    KArgs kp = (KArgs)__builtin_amdgcn_kernarg_segment_ptr();
    Frame F;
    F.lds = (LAS unsigned char*)lds_raw;
    F.tid = threadIdx.x; F.lane = F.tid & 63; F.wave = __builtin_amdgcn_readfirstlane(F.tid >> 6);
    F.G = gridDim.x; F.bid = blockIdx.x;
    { const Args a = load_args(kp); unsigned* barw = (unsigned*)a.ws;
      (void)barw;
      volatile LAS unsigned* bst = (volatile LAS unsigned*)(F.lds + BST_OFF);
      if (threadIdx.x < 4) bst[threadIdx.x] = 0u;
      if (threadIdx.x < 8) ((volatile LAS int*)(F.lds + RCT_OFF))[threadIdx.x] = -1; }
    __syncthreads();
    { const Args a = load_args(kp); (void)xcd_barrier_post((unsigned*)a.ws, (volatile LAS unsigned*)(F.lds + BST_OFF));
      if (a.ws == nullptr) grid.sync(); }
#define GRID_BAR() do { const Args a_ = load_args(kp); XcdBarrier b_; b_.bar = (unsigned*)a_.ws; b_.x = xb_xcc_id(); b_.st = (volatile LAS unsigned*)(F.lds + BST_OFF); xcd_barrier(b_); } while (0)

    if constexpr (PHMASK & 1) { const Args a = load_args(kp); p0_prologue(F, a); }
    GRID_BAR();
    if constexpr (PROBE == 9) { const unsigned long long t0 = __builtin_amdgcn_s_memrealtime(); while (__builtin_amdgcn_s_memrealtime() - t0 < 20000ull) __builtin_amdgcn_s_sleep(32); }

#pragma unroll 1
    for (int l = 0; l < 2; ++l) {
        if constexpr (PHMASK & 2) {
            const Args a = load_args(kp); unsigned char* ws = a.ws; unsigned char* wl = ws + WS_W + (size_t)l * W_LAYER;
            pg8::Gemm g{(const bf16*)(ws + WS_XB), (const bf16*)(wl + WO_IN), M, INW, D, D, 0, 0}; pg8::StaticOrder S; S.init(M, INW, F.G, F.bid);
            EpiProj E{kp, l, F.lds};
            pg8::gemm_phase<EpiProj, pg8::StaticOrder, true, true>(F.lds, g, S, E);
            if constexpr (PROBE == 4) { __syncthreads(); pg8::gemm_phase<EpiProj, pg8::StaticOrder, true, true>(F.lds, g, S, E); }
        }
        GRID_BAR();
_Pragma("unroll 1")
        for (int rep = 0; rep < (PROBE == 3 ? 2 : 1); ++rep) { const Args a = load_args(kp); mix_elt(F, a, l); }
        GRID_BAR();
        if constexpr (PHMASK & 8) {
            const Args a = load_args(kp); unsigned char* ws = a.ws; unsigned char* wl = ws + WS_W + (size_t)l * W_LAYER;
            pg8::Gemm2 g{(const bf16*)(ws + WS_MIXED), (const bf16*)(wl + WO_MAP), 256, 1, 512, (const bf16*)(ws + WS_GBCV), (const bf16*)(wl + WO_CO), CW, PW}; pg8::StaticOrder S; S.init(MP, D, F.G, F.bid);
            EpiPool2 E{(const bf16*)(ws + WS_SA), (const bf16*)(ws + WS_SB), (bf16*)(ws + WS_MA)};
            pg8::gemm_phase2<EpiPool2, pg8::StaticOrder>(F.lds, g, S, E);
            small_gemm<3>(F, (const bf16*)(ws + WS_MIXED), PW, 256, (const bf16*)(wl + WO_MAP), 256, (const bf16*)(ws + WS_SA), (const bf16*)(ws + WS_SB), (bf16*)(ws + WS_MA), nullptr,
                          (const bf16*)(ws + WS_GBCV), (const bf16*)(wl + WO_CO), CW);
        }
        GRID_BAR();
        if constexpr (PHMASK & 32) {
            const Args a = load_args(kp); unsigned char* ws = a.ws; unsigned char* wl = ws + WS_W + (size_t)l * W_LAYER;
            pg8::Gemm g{(const bf16*)(ws + WS_MA), (const bf16*)(wl + WO_O), MP, D, D, D, 0, 0}; pg8::StaticOrder S; S.init(MP, D, F.G, F.bid);
            EpiRes E{(bf16*)(ws + WS_XB), (float*)(ws + WS_SSQ)};
            pg8::gemm_phase<EpiRes, pg8::StaticOrder, true, true>(F.lds, g, S, E);
            small_gemm<2>(F, (const bf16*)(ws + WS_MA), D, 0, (const bf16*)(wl + WO_O), D, nullptr, nullptr, (bf16*)(ws + WS_XB), (float*)(ws + WS_SSQ));
        }
        GRID_BAR();
        if constexpr (PHMASK & 64) {
            const Args a = load_args(kp); unsigned char* ws = a.ws; unsigned char* wl = ws + WS_W + (size_t)l * W_LAYER;
            pg8::Gemm g{(const bf16*)(ws + WS_XB), (const bf16*)(wl + WO_UP), M, FF2, D, D, 0, 0}; pg8::StaticOrder S; S.init(M, FF2, F.G, F.bid);
            EpiUpAct E{kp, F.lds + EX_OFF, l};
            pg8::gemm_phase<EpiUpAct, pg8::StaticOrder, true, true>(F.lds, g, S, E);
            if constexpr (PROBE == 5) { __syncthreads(); pg8::gemm_phase<EpiUpAct, pg8::StaticOrder, true, true>(F.lds, g, S, E); }
        }
        GRID_BAR();
        if constexpr (PHMASK & 128) { const Args a = load_args(kp); ffn_fixup(F, a, l);
            unsigned char* ws = a.ws; unsigned char* wl = ws + WS_W + (size_t)l * W_LAYER; __syncthreads();
            small_gemm<2>(F, (const bf16*)(ws + WS_ACT), FF, 0, (const bf16*)(wl + WO_DN), FF, nullptr, nullptr, (bf16*)(ws + WS_XB), (float*)(ws + WS_SSQ)); }
        GRID_BAR();
        if constexpr (PHMASK & 256) {
            const Args a = load_args(kp); unsigned char* ws = a.ws; unsigned char* wl = ws + WS_W + (size_t)l * W_LAYER;
            pg8::Gemm g{(const bf16*)(ws + WS_ACT), (const bf16*)(wl + WO_DN), MP, D, FF, FF, 0, 0}; pg8::StaticOrder S; S.init(MP, D, F.G, F.bid);
            EpiRes E{(bf16*)(ws + WS_XB), (float*)(ws + WS_SSQ)};
            pg8::gemm_phase<EpiRes, pg8::StaticOrder, true, true>(F.lds, g, S, E);
        }
        GRID_BAR();
    }
    if constexpr (PHMASK & 512) { const Args a = load_args(kp); final_norm(F, a); }
    if constexpr (PROBE == 1) { for (int i = 0; i < 16; ++i) GRID_BAR(); }
}

extern "C" void kernel_launch(void* const* d_in, const int* in_sizes, int n_in, void* d_out, int out_size, void* d_ws, size_t ws_size, hipStream_t stream) {
    static int grid = 0;
    if (grid == 0) {
        if (n_in != 19 || in_sizes[0] != MP * D || (size_t)out_size != O_END || ws_size < WS_END) {
            fprintf(stderr, "kernel_launch: unexpected shapes: n_in %d in0 %d out %d ws %zu (need %zu)\n", n_in, n_in > 0 ? in_sizes[0] : -1, out_size, ws_size, (size_t)WS_END); grid = -1; return; }
        int dev = 0, cus = 0, per_cu = 0;
        hipGetDevice(&dev); hipDeviceGetAttribute(&cus, hipDeviceAttributeMultiprocessorCount, dev);
        if (hipFuncSetAttribute((const void*)fwd_mega, hipFuncAttributeMaxDynamicSharedMemorySize, LDS_BYTES) != hipSuccess) { fprintf(stderr, "kernel_launch: hipFuncSetAttribute failed\n"); grid = -1; return; }
        if (hipOccupancyMaxActiveBlocksPerMultiprocessor(&per_cu, (const void*)fwd_mega, NTHR, LDS_BYTES) != hipSuccess || per_cu < 1) { fprintf(stderr, "kernel_launch: occupancy query says %d\n", per_cu); per_cu = 1; }
        (void)hipGetLastError();
        grid = cus;
    }
    if (grid < 0) return;
    Args a{};
    for (int i = 0; i < 19; ++i) a.in[i] = (const float*)d_in[i];
    a.out = (float*)d_out; a.ws = (unsigned char*)d_ws;
    void* args[] = {&a};
    if (hipMemsetAsync(d_ws, 0, 16384, stream) != hipSuccess) { fprintf(stderr, "kernel_launch: hipMemsetAsync failed\n"); return; }
    hipError_t e = hipLaunchCooperativeKernel((const void*)fwd_mega, dim3(grid), dim3(NTHR), args, LDS_BYTES, stream);
    if (e != hipSuccess) fprintf(stderr, "cooperative launch failed: %s (grid %d)\n", hipGetErrorString(e), grid);
}
```
